# Optimizing an MI355X kernel written in HIP

```python
import math
import jax
import jax.numpy as jnp
from jax import lax
import numpy as np

D_MODEL = 4096
BATCH = 2
SEQ = 8192
DEPTH = 4

PLE_DIM = 256
N_MIXERS = 3
N_FOX = (DEPTH + 2) // 3
N_GDN = (DEPTH + 1) // 3
N_SSM = DEPTH // 3
NORM_EPS = 1e-6

FOX_HEADS = 32
FOX_HEAD_DIM = D_MODEL // FOX_HEADS
FOX_WIDTH = FOX_HEADS * FOX_HEAD_DIM
Q_BLOCK = 128

GDN_HEADS = 32
GDN_HEAD_DIM = D_MODEL // GDN_HEADS
GDN_WIDTH = GDN_HEADS * GDN_HEAD_DIM
GDN_CONV = 4
GDN_CHUNK = 64

SSM_WIDTH = D_MODEL
SSM_GROUP = 16
SSM_GROUPS = SSM_WIDTH // SSM_GROUP
SSM_STATE = 64
SSM_CHUNK_MAX = 1024
DT_MIN = 1e-3
DT_MAX = 1e-1

kernel_name = 'hybrid_fox_gdn_s5_ple_trunk'


def rmsnorm(x, g):
    xf = x.astype(jnp.float32)
    y = xf * lax.rsqrt(jnp.mean(xf * xf, axis=-1, keepdims=True) + NORM_EPS)
    return (y * g.astype(jnp.float32)).astype(x.dtype)


def l2norm(x):
    return x * lax.rsqrt(jnp.sum(x * x, axis=-1, keepdims=True) + NORM_EPS)


def fox_mixer(h, w_in, b_f, w_out):
    bsz, s, _ = h.shape
    H, dh, W = FOX_HEADS, FOX_HEAD_DIM, FOX_WIDTH
    proj = h @ w_in
    q, k, v, z, f_logit = jnp.split(proj, [W, 2 * W, 3 * W, 4 * W], axis=-1)
    to_heads = lambda t: t.reshape(bsz, s, H, dh).transpose(0, 2, 1, 3)
    q, k, v = to_heads(q), to_heads(k), to_heads(v)
    log_f = jax.nn.log_sigmoid(f_logit.astype(jnp.float32) + b_f.astype(jnp.float32))
    cum = jnp.cumsum(log_f, axis=1).transpose(0, 2, 1)
    nb = s // Q_BLOCK
    q_blocks = q.reshape(bsz, H, nb, Q_BLOCK, dh).transpose(2, 0, 1, 3, 4)
    c_blocks = cum.reshape(bsz, H, nb, Q_BLOCK).transpose(2, 0, 1, 3)
    key_pos = jnp.arange(s)
    scale = dh ** -0.5

    def attend_block(args):
        q_blk, c_blk, blk = args
        query_pos = blk * Q_BLOCK + jnp.arange(Q_BLOCK)
        logits = jnp.einsum('bhqd,bhkd->bhqk', q_blk, k, preferred_element_type=jnp.float32) * scale
        logits = logits + c_blk[..., :, None] - cum[..., None, :]
        logits = jnp.where(key_pos[None, :] <= query_pos[:, None], logits, -jnp.inf)
        probs = jax.nn.softmax(logits, axis=-1)
        return jnp.einsum('bhqk,bhkd->bhqd', probs.astype(v.dtype), v)

    o = lax.map(attend_block, (q_blocks, c_blocks, jnp.arange(nb)))
    o = o.transpose(1, 0, 3, 2, 4).reshape(bsz, s, W)
    return (o * jax.nn.silu(z)) @ w_out


def causal_conv_silu(x, w):
    k_width, s = w.shape[0], x.shape[1]
    xp = jnp.pad(x, ((0, 0), (k_width - 1, 0), (0, 0)))
    y = xp[:, 0:s] * w[0]
    for j in range(1, k_width):
        y = y + xp[:, j:j + s] * w[j]
    return jax.nn.silu(y)


def chunk_gated_delta_rule(q, k, v, beta, g):
    bsz, nh, s, dk = q.shape
    dv = v.shape[-1]
    c = GDN_CHUNK
    nc = s // c
    q, k, v = (t.reshape(bsz, nh, nc, c, t.shape[-1]) for t in (q, k, v))
    beta = beta.reshape(bsz, nh, nc, c)
    g = jnp.cumsum(g.reshape(bsz, nh, nc, c), axis=-1)
    incl = jnp.tril(jnp.ones((c, c), dtype=bool))
    strict = jnp.tril(jnp.ones((c, c), dtype=bool), k=-1)
    decay = jnp.exp(jnp.where(incl, g[..., :, None] - g[..., None, :], -jnp.inf))
    k_beta = k * beta[..., None]
    lower = jnp.where(strict, jnp.einsum('bhnid,bhnjd->bhnij', k_beta, k) * decay, 0.0)
    rhs = jnp.concatenate([v * beta[..., None], k_beta * jnp.exp(g)[..., None]], axis=-1)
    sol = lax.linalg.triangular_solve(lower + jnp.eye(c, dtype=lower.dtype), rhs,
                                      left_side=True, lower=True, unit_diagonal=True)
    u, w = sol[..., :dv], sol[..., dv:]
    intra = jnp.einsum('bhnid,bhnjd->bhnij', q, k) * decay
    g_last = g[..., -1]
    q_dec = q * jnp.exp(g)[..., None]
    k_dec = k * jnp.exp(g_last[..., None] - g)[..., None]
    xs = tuple(jnp.moveaxis(t, 2, 0) for t in (q_dec, k_dec, intra, u, w, jnp.exp(g_last)))

    def step(state, inp):
        qd, kd, a, u_c, w_c, gl = inp
        v_new = u_c - jnp.einsum('bhck,bhkv->bhcv', w_c, state)
        out = jnp.einsum('bhck,bhkv->bhcv', qd, state) + jnp.einsum('bhcj,bhjv->bhcv', a, v_new)
        state = state * gl[..., None, None] + jnp.einsum('bhck,bhcv->bhkv', kd, v_new)
        return state, out

    state0 = jnp.zeros((bsz, nh, dk, dv), jnp.float32)
    _, o = lax.scan(step, state0, xs)
    return jnp.moveaxis(o, 0, 2).reshape(bsz, nh, s, dv)


def gdn_mixer(h, w_in, conv_w, a_log, dt_bias, norm_w, w_out):
    bsz, s, _ = h.shape
    H, dh, W = GDN_HEADS, GDN_HEAD_DIM, GDN_WIDTH
    proj = h @ w_in
    qkv, z, b_logit, a_logit = jnp.split(proj, [3 * W, 4 * W, 4 * W + H], axis=-1)
    qkv = causal_conv_silu(qkv, conv_w).astype(jnp.float32)
    to_heads = lambda t: t.reshape(bsz, s, H, dh).transpose(0, 2, 1, 3)
    q, k, v = (to_heads(t) for t in jnp.split(qkv, 3, axis=-1))
    q = l2norm(q) * dh ** -0.5
    k = l2norm(k)
    beta = jax.nn.sigmoid(b_logit.astype(jnp.float32)).transpose(0, 2, 1)
    g = -(jnp.exp(a_log.astype(jnp.float32))
          * jax.nn.softplus(a_logit.astype(jnp.float32) + dt_bias.astype(jnp.float32))).transpose(0, 2, 1)
    o = chunk_gated_delta_rule(q, k, v, beta, g).transpose(0, 2, 1, 3)
    o = rmsnorm(o, norm_w) * jax.nn.silu(z.astype(jnp.float32).reshape(bsz, s, H, dh))
    return o.reshape(bsz, s, W).astype(h.dtype) @ w_out


def complex_linear_combine(e1, e2):
    a1r, a1i, b1r, b1i = e1
    a2r, a2i, b2r, b2i = e2
    return (a2r * a1r - a2i * a1i,
            a2r * a1i + a2i * a1r,
            a2r * b1r - a2i * b1i + b2r,
            a2r * b1i + a2i * b1r + b2i)


def ssm_mixer(h, w_in, lam_re, lam_im, b_re, b_im, c_re, c_im, log_step, d_skip, w_glu, b_glu, w_out):
    f32 = jnp.float32
    bsz, s, _ = h.shape
    G, N, P, E = SSM_GROUPS, SSM_GROUP, SSM_STATE, SSM_WIDTH
    u, z = jnp.split(h @ w_in, 2, axis=-1)
    uf = u.astype(f32)
    lam_re, lam_im, b_re, b_im, c_re, c_im = (t.astype(f32) for t in (lam_re, lam_im, b_re, b_im, c_re, c_im))
    step = jnp.exp(log_step.astype(f32))[:, None]
    mag = jnp.exp(lam_re * step)
    lb_re, lb_im = mag * jnp.cos(lam_im * step), mag * jnp.sin(lam_im * step)
    den = lam_re * lam_re + lam_im * lam_im
    num_re = lb_re - 1.0
    zoh_re = (num_re * lam_re + lb_im * lam_im) / den
    zoh_im = (lb_im * lam_re - num_re * lam_im) / den
    bb_re = zoh_re[..., None] * b_re - zoh_im[..., None] * b_im
    bb_im = zoh_re[..., None] * b_im + zoh_im[..., None] * b_re
    ck = math.gcd(s, SSM_CHUNK_MAX)
    nck = s // ck
    u_chunks = uf.reshape(bsz, nck, ck, G, N).transpose(1, 2, 0, 3, 4)
    a_re = jnp.broadcast_to(lb_re, (ck, 1, G, P))
    a_im = jnp.broadcast_to(lb_im, (ck, 1, G, P))

    def chunk_step(carry, u_c):
        h_re, h_im = carry
        bu_re = jnp.einsum('tbgn,gpn->tbgp', u_c, bb_re)
        bu_im = jnp.einsum('tbgn,gpn->tbgp', u_c, bb_im)
        pw_re, pw_im, x_re, x_im = lax.associative_scan(
            complex_linear_combine, (a_re, a_im, bu_re, bu_im), axis=0)
        x_re, x_im = (x_re + pw_re * h_re - pw_im * h_im,
                      x_im + pw_re * h_im + pw_im * h_re)
        y = jnp.einsum('tbgp,gnp->tbgn', x_re, c_re) - jnp.einsum('tbgp,gnp->tbgn', x_im, c_im)
        return (x_re[-1], x_im[-1]), y

    carry0 = (jnp.zeros((bsz, G, P), f32), jnp.zeros((bsz, G, P), f32))
    _, y = lax.scan(chunk_step, carry0, u_chunks)
    y = y.transpose(2, 0, 1, 3, 4).reshape(bsz, s, E) + d_skip.astype(f32) * uf
    y = jax.nn.gelu(y)
    y = y * jax.nn.sigmoid(y @ w_glu.astype(f32) + b_glu.astype(f32))
    y = y * jax.nn.silu(z.astype(f32))
    return y.astype(h.dtype) @ w_out


def setup_inputs(seed: int = 0) -> dict:
    key = jax.random.key(seed)
    ks = jax.random.split(key, 32)
    f32 = jnp.float32
    D = D_MODEL
    nrm = lambda k, shape, scale: jax.random.normal(k, shape, f32) * scale
    unif = lambda k, shape, lo, hi: jax.random.uniform(k, shape, f32, lo, hi)
    x = nrm(ks[0], (BATCH, SEQ, D), 1.0)
    p = nrm(ks[1], (DEPTH, BATCH, SEQ, PLE_DIM), 1.0)
    norm_mix = 1.0 + nrm(ks[2], (DEPTH, D), 0.01)
    fox_w_in = nrm(ks[3], (N_FOX, D, 4 * FOX_WIDTH + FOX_HEADS), D ** -0.5)
    fox_b_f = nrm(ks[4], (N_FOX, FOX_HEADS), 0.1)
    fox_w_out = nrm(ks[5], (N_FOX, FOX_WIDTH, D), FOX_WIDTH ** -0.5)
    gdn_w_in = nrm(ks[6], (N_GDN, D, 4 * GDN_WIDTH + 2 * GDN_HEADS), D ** -0.5)
    gdn_conv = nrm(ks[7], (N_GDN, GDN_CONV, 3 * GDN_WIDTH), GDN_CONV ** -0.5)
    gdn_a_log = jnp.log(unif(ks[8], (N_GDN, GDN_HEADS), 1.0, 16.0))
    dt = jnp.exp(unif(ks[9], (N_GDN, GDN_HEADS), math.log(DT_MIN), math.log(DT_MAX)))
    gdn_dt_bias = dt + jnp.log(-jnp.expm1(-dt))
    gdn_norm = 1.0 + nrm(ks[10], (N_GDN, GDN_HEAD_DIM), 0.01)
    gdn_w_out = nrm(ks[11], (N_GDN, GDN_WIDTH, D), GDN_WIDTH ** -0.5)
    G, N, P, E = SSM_GROUPS, SSM_GROUP, SSM_STATE, SSM_WIDTH
    ssm_w_in = nrm(ks[12], (N_SSM, D, 2 * E), D ** -0.5)
    ssm_lam_re = -0.5 + nrm(ks[13], (N_SSM, G, P), 0.01)
    ssm_lam_im = jnp.pi * jnp.arange(P, dtype=f32) + nrm(ks[14], (N_SSM, G, P), 0.01)
    ssm_b_re = nrm(ks[15], (N_SSM, G, P, N), (2 * N) ** -0.5)
    ssm_b_im = nrm(ks[16], (N_SSM, G, P, N), (2 * N) ** -0.5)
    ssm_c_re = nrm(ks[17], (N_SSM, G, N, P), P ** -0.5)
    ssm_c_im = nrm(ks[18], (N_SSM, G, N, P), P ** -0.5)
    ssm_log_step = unif(ks[19], (N_SSM, G), math.log(DT_MIN), math.log(DT_MAX))
    ssm_d = nrm(ks[20], (N_SSM, E), 1.0)
    ssm_w_glu = nrm(ks[21], (N_SSM, E, E), E ** -0.5)
    ssm_b_glu = nrm(ks[22], (N_SSM, E), 0.01)
    ssm_w_out = nrm(ks[23], (N_SSM, E, D), E ** -0.5)
    norm_ple = 1.0 + nrm(ks[24], (DEPTH, D), 0.01)
    ple_w_proj = nrm(ks[25], (DEPTH, PLE_DIM, D), PLE_DIM ** -0.5)
    ple_w_gate = nrm(ks[26], (DEPTH, D, D), D ** -0.5)
    final_norm = 1.0 + nrm(ks[27], (D,), 0.01)
    return {'x': x, 'p': p, 'norm_mix': norm_mix,
            'fox_w_in': fox_w_in, 'fox_b_f': fox_b_f, 'fox_w_out': fox_w_out,
            'gdn_w_in': gdn_w_in, 'gdn_conv': gdn_conv, 'gdn_a_log': gdn_a_log,
            'gdn_dt_bias': gdn_dt_bias, 'gdn_norm': gdn_norm, 'gdn_w_out': gdn_w_out,
            'ssm_w_in': ssm_w_in, 'ssm_lam_re': ssm_lam_re, 'ssm_lam_im': ssm_lam_im,
            'ssm_b_re': ssm_b_re, 'ssm_b_im': ssm_b_im, 'ssm_c_re': ssm_c_re, 'ssm_c_im': ssm_c_im,
            'ssm_log_step': ssm_log_step, 'ssm_d': ssm_d, 'ssm_w_glu': ssm_w_glu,
            'ssm_b_glu': ssm_b_glu, 'ssm_w_out': ssm_w_out,
            'norm_ple': norm_ple, 'ple_w_proj': ple_w_proj, 'ple_w_gate': ple_w_gate,
            'final_norm': final_norm}


def reference(x, p, norm_mix, fox_w_in, fox_b_f, fox_w_out, gdn_w_in, gdn_conv, gdn_a_log,
              gdn_dt_bias, gdn_norm, gdn_w_out, ssm_w_in, ssm_lam_re, ssm_lam_im, ssm_b_re,
              ssm_b_im, ssm_c_re, ssm_c_im, ssm_log_step, ssm_d, ssm_w_glu, ssm_b_glu, ssm_w_out,
              norm_ple, ple_w_proj, ple_w_gate, final_norm):
    h = x
    for i in range(DEPTH):
        kind, j = i % N_MIXERS, i // N_MIXERS
        hn = rmsnorm(h, norm_mix[i])
        if kind == 0:
            y = fox_mixer(hn, fox_w_in[j], fox_b_f[j], fox_w_out[j])
        elif kind == 1:
            y = gdn_mixer(hn, gdn_w_in[j], gdn_conv[j], gdn_a_log[j], gdn_dt_bias[j],
                          gdn_norm[j], gdn_w_out[j])
        else:
            y = ssm_mixer(hn, ssm_w_in[j], ssm_lam_re[j], ssm_lam_im[j], ssm_b_re[j], ssm_b_im[j],
                          ssm_c_re[j], ssm_c_im[j], ssm_log_step[j], ssm_d[j], ssm_w_glu[j],
                          ssm_b_glu[j], ssm_w_out[j])
        h = h + y
        gate = jax.nn.sigmoid(rmsnorm(h, norm_ple[i]) @ ple_w_gate[i])
        h = h + gate * (p[i] @ ple_w_proj[i])
    return rmsnorm(h, final_norm)
```

```cpp
#include <hip/hip_runtime.h>
#include <cstdio>
#include <cstdint>

#ifndef MK_PER_PHASE
#define MK_PER_PHASE 0
#endif

constexpr int D_MODEL = 4096, BATCH = 2, SEQ = 8192, DEPTH = 4, PLE_DIM = 256;
constexpr int M_TOK = BATCH * SEQ;
constexpr int NHEAD = 32, HDIM = 128;
constexpr float NORM_EPS = 1e-6f;
constexpr int LDP = 16384;
constexpr int ZCOL = 12288;
constexpr int GDN_CHUNK = 64, GDN_NCHUNK = SEQ / GDN_CHUNK;
constexpr int SSM_G = 256, SSM_N = 16, SSM_P = 64, SSM_SL = 256, SSM_NSEG = SEQ / SSM_SL;

constexpr size_t MiB = 1u << 20;
constexpr size_t WS_CTL = 0, CTL_ZERO_BYTES = 2 * MiB;
constexpr size_t WS_WIN = 2 * MiB;
constexpr size_t WS_WSK = 130 * MiB;
constexpr size_t WS_WOUT = 131 * MiB;
constexpr size_t WS_WGATE = 163 * MiB;
constexpr size_t WS_WPP = 195 * MiB;
constexpr size_t WS_WGLU = 197 * MiB;
constexpr size_t WS_PBF = 229 * MiB;
constexpr size_t WS_X0 = 237 * MiB;
constexpr size_t WS_X1 = 365 * MiB;
constexpr size_t WS_PROJ = 493 * MiB;
constexpr size_t WS_MIX = 1005 * MiB;
constexpr size_t WS_PP = 1133 * MiB;
constexpr size_t WS_SCR = 1261 * MiB;
constexpr size_t WS_SMALL = 1837 * MiB;
constexpr size_t WS_ENDST = 1846 * MiB;
constexpr size_t WS_END = 1854 * MiB;
constexpr size_t GR_QD = 0, GR_W = 16384, GR_KT = 32768, GR_U = 49152, GR_IN = 65536, GR_BYTES = 73728;
constexpr size_t SS_U32 = 0, SS_Y1 = 256 * MiB, SS_END = 384 * MiB;
constexpr size_t SM_CUML = 0;
constexpr size_t SM_TTOT = 2 * MiB;
constexpr size_t SM_CUM = 2 * MiB + 65536;
constexpr size_t SM_QN2 = 2 * MiB + 32768;
constexpr size_t SM_KN2 = 4 * MiB + 65536;
constexpr size_t SM_BETA = 5 * MiB;
constexpr size_t SM_GLOG = 7 * MiB;
constexpr size_t SM_SS = SM_CUM;
constexpr size_t SM_GL = 0;
static_assert(SM_CUM + 64 * 8192 * 4 <= SM_BETA && SM_GLOG + (size_t)M_TOK * 32 * 4 <= 9 * MiB, "small tables");
static_assert(WS_SMALL + 9 * MiB <= WS_ENDST && WS_ENDST + 8 * MiB <= WS_END, "ws end");
constexpr int CW_TMO = 0, CW_CODE = 1, CW_ERR = 1024  , CW_BAR = 16384  ;
typedef unsigned long long ssq_t;
constexpr size_t CTL_SUMSQ = 1 * MiB;
constexpr size_t WS_SSQ0 = 130 * MiB + 512 * 1024;
constexpr float SSQ_SCALE = 16777216.0f, SSQ_INV = 1.0f / 16777216.0f;
#define SSQ_PTR(i) ((ssq_t*)(ws + ((i) == 0 ? WS_SSQ0 : CTL_SUMSQ + (size_t)((i) - 1) * M_TOK * sizeof(ssq_t))))

__device__ __forceinline__ int olane_() { unsigned z = 0u; asm volatile("" : "+v"(z)); return (int)__builtin_amdgcn_mbcnt_hi(~0u, __builtin_amdgcn_mbcnt_lo(~0u, z)); }
__device__ __forceinline__ int oshfl_xor(int v, int o) { return __builtin_amdgcn_ds_bpermute((olane_() ^ o) << 2, v); }
__device__ __forceinline__ unsigned oshfl_xor(unsigned v, int o) { return (unsigned)__builtin_amdgcn_ds_bpermute((olane_() ^ o) << 2, (int)v); }
__device__ __forceinline__ float oshfl_xor(float v, int o) { return __int_as_float(__builtin_amdgcn_ds_bpermute((olane_() ^ o) << 2, __float_as_int(v))); }
#define __shfl_xor oshfl_xor
#define LAS __attribute__((address_space(3)))
#define GAS __attribute__((address_space(1)))
typedef unsigned short bf16;
typedef short bf16x8 __attribute__((ext_vector_type(8)));
typedef short s16x4 __attribute__((ext_vector_type(4)));
typedef float f32x2 __attribute__((ext_vector_type(2)));
typedef float f32x4 __attribute__((ext_vector_type(4)));
typedef float f32x16 __attribute__((ext_vector_type(16)));
typedef unsigned u32x2 __attribute__((ext_vector_type(2)));
typedef unsigned u32x4 __attribute__((ext_vector_type(4)));
#define LDS_WAIT() asm volatile("s_waitcnt lgkmcnt(0)" ::: "memory")
#define VM_WAIT() asm volatile("s_waitcnt vmcnt(0)" ::: "memory")
typedef __bf16 bf16x2_t __attribute__((ext_vector_type(2)));
__device__ __forceinline__ unsigned cvtpk(float lo, float hi) { const f32x2 v = {lo, hi}; const bf16x2_t b = __builtin_convertvector(v, bf16x2_t); return __builtin_bit_cast(unsigned, b); }
__device__ __forceinline__ ssq_t ssq_fix(float s) { return (ssq_t)(s * 16777216.0f + 0.5f); }
__device__ __forceinline__ float ssq_val(ssq_t x) { return ((float)(unsigned)(x >> 32) * 4294967296.0f + (float)(unsigned)x) * (1.0f / 16777216.0f); }
__device__ __forceinline__ float bf2f(unsigned short b) { return __uint_as_float(((unsigned)b) << 16); }
__device__ __forceinline__ float bflo(unsigned w) { return __uint_as_float(w << 16); }
__device__ __forceinline__ float bfhi(unsigned w) { return __uint_as_float(w & 0xffff0000u); }
__device__ __forceinline__ float fexp(float x) { return __builtin_amdgcn_exp2f(x * 1.4426950408889634f); }
__device__ __forceinline__ float flog(float x) { return __builtin_amdgcn_logf(x) * 0.6931471805599453f; }
__device__ __forceinline__ float sigmoidf_(float x) { return __builtin_amdgcn_rcpf(1.0f + fexp(-x)); }
__device__ __forceinline__ float siluf_(float x) { return x * sigmoidf_(x); }
__device__ __forceinline__ bf16x8 pack8(f32x4 a, f32x4 b) { u32x4 w = {cvtpk(a[0], a[1]), cvtpk(a[2], a[3]), cvtpk(b[0], b[1]), cvtpk(b[2], b[3])}; return __builtin_bit_cast(bf16x8, w); }
__device__ __forceinline__ void unpack8(u32x4 w, float* f) { f[0] = bflo(w.x); f[1] = bfhi(w.x); f[2] = bflo(w.y); f[3] = bfhi(w.y); f[4] = bflo(w.z); f[5] = bfhi(w.z); f[6] = bflo(w.w); f[7] = bfhi(w.w); }
__device__ __forceinline__ float wave_sum(float v) {
#pragma unroll
    for (int o = 1; o < 64; o <<= 1) v += __shfl_xor(v, o);
    return v;
}
__device__ __forceinline__ int otid(int w0) { unsigned z = 0u; asm volatile("" : "+v"(z));
    int t = (w0 << 6) | (int)__builtin_amdgcn_mbcnt_hi(~0u, __builtin_amdgcn_mbcnt_lo(~0u, z)); asm volatile("" : "+v"(t)); return t; }
__device__ __forceinline__ u32x4 ozero4() { u32x4 z = {0u, 0u, 0u, 0u}; asm volatile("" : "+v"(z)); return z; }
namespace pg8 {
#define PG8_LAS __attribute__((address_space(3)))
typedef unsigned short bf16_t;
typedef short bf16x8 __attribute__((ext_vector_type(8)));
typedef float f32x4 __attribute__((ext_vector_type(4)));
typedef unsigned u32x4 __attribute__((ext_vector_type(4)));
constexpr int BM = 256, BK = 64, HALF = 128, HTB = HALF * BK * 2  , STAGE_BYTES = 8 * HTB, NXCD = 8, WGM = 8;

__host__ __device__ __forceinline__ int lds_byte(int r, int c) { const int st = (r >> 4) * 2 + (c >> 5), rr = r & 15, cc = c & 31, ob = rr * 64 + cc * 2; return st * 1024 + (ob ^ (((ob >> 9) & 1) << 5)); }
__host__ __device__ __forceinline__ void stage_rc(int b, int& R, int& C) { const int st = b / 1024, sb = b % 1024, swz = sb ^ (((sb >> 9) & 1) << 5); R = (st >> 1) * 16 + swz / 64; C = (st & 1) * 32 + (swz % 64) / 2; }
__host__ __device__ __forceinline__ int perm32(int rho) { const int n = rho >> 4, i = rho & 15; return 8 * (i >> 2) + 4 * n + (i & 3); }

struct Unit { int pm, pn; };
struct Gemm { const bf16_t* A; const bf16_t* Bt; int M, N, K; };

struct StaticOrder {
    int nM, nN, nwg, G, c;
    __host__ __device__ void init(int M, int N, int G_, int c_) { nM = M / BM; nN = N / BM; nwg = nM * nN; G = G_; c = c_; }
    __host__ __device__ bool next(int i, Unit& u) const {
        const long L = (long)i * G + c; if (L >= nwg) return false;
        int wgid = (int)L; { const int q = nwg / NXCD, r = nwg % NXCD, xcd = wgid % NXCD, off = wgid / NXCD; wgid = (xcd < r ? xcd * (q + 1) : r * (q + 1) + (xcd - r) * q) + off; }
        const int nig = WGM * nN, gid = wgid / nig, fm = gid * WGM, gsz = (nM - fm) < WGM ? (nM - fm) : WGM;
        u.pm = fm + ((wgid % nig) % gsz); u.pn = (wgid % nig) / gsz; return true;
    }
    __device__ __forceinline__ void a_ready(const Unit&) const {}
    __device__ __forceinline__ void done(const Unit&) const {}
};
__device__ __forceinline__ unsigned cvt_pk_bf16(float lo, float hi) { return ::cvtpk(lo, hi); }
__device__ __forceinline__ float sgm(float x) { return __builtin_amdgcn_rcpf(1.0f + __builtin_amdgcn_exp2f(x * -1.4426950408889634f)); }
__device__ __forceinline__ float bl(unsigned w) { return __uint_as_float(w << 16); }
__device__ __forceinline__ float bh(unsigned w) { return __uint_as_float(w & 0xffff0000u); }
constexpr float kEps = 1e-6f, kInvD = 1.0f / 4096.0f;
#ifndef EPI_RB
#define EPI_RB 4
#endif

struct EpiProj {
    static constexpr bool PERM = true, AFTER_DRAIN = false;
    static constexpr int RELAX = 16;
    bf16_t* O; int ldc; const ssq_t* sumsq; float* F32O; int f32cols;
    __device__ __forceinline__ void operator()(const f32x4 (&acc)[2][2][4][2], const Unit& u, int wr, int wc, int fr, int fq) const {
        const int row0 = u.pm * BM + wr * 64 + fr, colt = u.pn * BM, col0 = colt + wc * 32 + 8 * fq;
        const bool tof32 = colt < f32cols;
        ssq_t rsv[2][4];
#pragma unroll
        for (int ai = 0; ai < 2; ++ai)
#pragma unroll
            for (int m = 0; m < 4; ++m) rsv[ai][m] = sumsq ? sumsq[row0 + ai * HALF + m * 16] : 0ull;
#pragma unroll
        for (int ai = 0; ai < 2; ++ai)
#pragma unroll
            for (int m = 0; m < 4; ++m) { const int r = row0 + ai * HALF + m * 16;
                const float rs = sumsq ? __builtin_amdgcn_rsqf(ssq_val(rsv[ai][m]) * kInvD + kEps) : 1.0f;
#pragma unroll
                for (int bj = 0; bj < 2; ++bj) { const f32x4 v0 = acc[ai][bj][m][0] * rs, v1 = acc[ai][bj][m][1] * rs; const int c = col0 + bj * HALF;
                    if (tof32) { float* p = F32O + (size_t)r * f32cols + c; *(__attribute__((address_space(1))) f32x4*)p = v0; *(__attribute__((address_space(1))) f32x4*)(p + 4) = v1; }
                    else { u32x4 w; w.x = cvt_pk_bf16(v0[0], v0[1]); w.y = cvt_pk_bf16(v0[2], v0[3]); w.z = cvt_pk_bf16(v1[0], v1[1]); w.w = cvt_pk_bf16(v1[2], v1[3]);
                        *(u32x4*)(O + (size_t)r * ldc + c) = w; } } }
    }
};
struct EpiOut {
    static constexpr bool PERM = true, AFTER_DRAIN = false;
    static constexpr int RELAX = 0;
    const bf16_t* hin; bf16_t* hout; ssq_t* sumsq2;
    __device__ __forceinline__ void operator()(const f32x4 (&acc)[2][2][4][2], const Unit& u, int wr, int wc, int fr, int fq) const {
        const int row0 = u.pm * BM + wr * 64 + fr, col0 = u.pn * BM + wc * 32 + 8 * fq;
#pragma unroll
        for (int ai = 0; ai < 2; ++ai)
#pragma unroll
          for (int mp = 0; mp < 4 / EPI_RB; ++mp) {
            u32x4 hv[EPI_RB][2];
#pragma unroll
            for (int mm = 0; mm < EPI_RB; ++mm)
#pragma unroll
                for (int bj = 0; bj < 2; ++bj) hv[mm][bj] = *(const u32x4*)(hin + (size_t)(row0 + ai * HALF + (EPI_RB * mp + mm) * 16) * 4096 + col0 + bj * HALF);
#pragma unroll
            for (int mm = 0; mm < EPI_RB; ++mm) { const int m = EPI_RB * mp + mm, r = row0 + ai * HALF + m * 16; float s = 0.f;
#pragma unroll
                for (int bj = 0; bj < 2; ++bj) { const size_t off = (size_t)r * 4096 + col0 + bj * HALF; const u32x4 hw = hv[mm][bj];
                    const f32x4 v0 = f32x4{bl(hw.x), bh(hw.x), bl(hw.y), bh(hw.y)} + acc[ai][bj][m][0], v1 = f32x4{bl(hw.z), bh(hw.z), bl(hw.w), bh(hw.w)} + acc[ai][bj][m][1];
                    u32x4 w; w.x = cvt_pk_bf16(v0[0], v0[1]); w.y = cvt_pk_bf16(v0[2], v0[3]); w.z = cvt_pk_bf16(v1[0], v1[1]); w.w = cvt_pk_bf16(v1[2], v1[3]);
                    *(u32x4*)(hout + off) = w;
                    s += (bl(w.x) * bl(w.x) + bh(w.x) * bh(w.x)) + (bl(w.y) * bl(w.y) + bh(w.y) * bh(w.y)) + (bl(w.z) * bl(w.z) + bh(w.z) * bh(w.z)) + (bl(w.w) * bl(w.w) + bh(w.w) * bh(w.w)); }
                s += __shfl_xor(s, 16); s += __shfl_xor(s, 32);
                if (fq == 0) atomicAdd(sumsq2 + r, ssq_fix(s)); }
            asm volatile("" ::: "memory"); }
    }
};
struct EpiGate {
    static constexpr bool PERM = true, AFTER_DRAIN = false;
    static constexpr int RELAX = 0;
    const bf16_t* hin; bf16_t* hout; const bf16_t* PP; const ssq_t* sumsq2; ssq_t* sumsqn;
    __device__ __forceinline__ void operator()(const f32x4 (&acc)[2][2][4][2], const Unit& u, int wr, int wc, int fr, int fq) const {
        const int row0 = u.pm * BM + wr * 64 + fr, col0 = u.pn * BM + wc * 32 + 8 * fq;
        ssq_t rsv[2][4];
#pragma unroll
        for (int ai = 0; ai < 2; ++ai)
#pragma unroll
            for (int m = 0; m < 4; ++m) rsv[ai][m] = sumsq2[row0 + ai * HALF + m * 16];
#pragma unroll
        for (int ai = 0; ai < 2; ++ai)
#pragma unroll
            for (int mp = 0; mp < 4 / EPI_RB; ++mp) {
                u32x4 hv[EPI_RB][2], pv[EPI_RB][2];
#pragma unroll
                for (int mm = 0; mm < EPI_RB; ++mm)
#pragma unroll
                    for (int bj = 0; bj < 2; ++bj) { const size_t off = (size_t)(row0 + ai * HALF + (EPI_RB * mp + mm) * 16) * 4096 + col0 + bj * HALF;
                        pv[mm][bj] = *(const u32x4*)(PP + off); hv[mm][bj] = *(const u32x4*)(hin + off); }
#pragma unroll
                for (int mm = 0; mm < EPI_RB; ++mm) { const int m = EPI_RB * mp + mm, r = row0 + ai * HALF + m * 16; float s = 0.f;
                    const float rs = __builtin_amdgcn_rsqf(ssq_val(rsv[ai][m]) * kInvD + kEps);
#pragma unroll
                    for (int bj = 0; bj < 2; ++bj) { const size_t off = (size_t)r * 4096 + col0 + bj * HALF;
                        const u32x4 pw = pv[mm][bj], hw = hv[mm][bj];
                        const f32x4 p0 = {bl(pw.x), bh(pw.x), bl(pw.y), bh(pw.y)}, p1 = {bl(pw.z), bh(pw.z), bl(pw.w), bh(pw.w)};
                        f32x4 g0 = acc[ai][bj][m][0] * rs, g1 = acc[ai][bj][m][1] * rs;
#pragma unroll
                        for (int j = 0; j < 4; ++j) { g0[j] = sgm(g0[j]); g1[j] = sgm(g1[j]); }
                        const f32x4 v0 = f32x4{bl(hw.x), bh(hw.x), bl(hw.y), bh(hw.y)} + g0 * p0, v1 = f32x4{bl(hw.z), bh(hw.z), bl(hw.w), bh(hw.w)} + g1 * p1;
                        u32x4 w; w.x = cvt_pk_bf16(v0[0], v0[1]); w.y = cvt_pk_bf16(v0[2], v0[3]); w.z = cvt_pk_bf16(v1[0], v1[1]); w.w = cvt_pk_bf16(v1[2], v1[3]);
                        *(u32x4*)(hout + off) = w;
                        s += (bl(w.x) * bl(w.x) + bh(w.x) * bh(w.x)) + (bl(w.y) * bl(w.y) + bh(w.y) * bh(w.y)) + (bl(w.z) * bl(w.z) + bh(w.z) * bh(w.z)) + (bl(w.w) * bl(w.w) + bh(w.w) * bh(w.w)); }
                    s += __shfl_xor(s, 16); s += __shfl_xor(s, 32);
                    if (fq == 0) atomicAdd(sumsqn + r, ssq_fix(s)); }
                asm volatile("" ::: "memory"); }
    }
};
struct EpiGlu {
    static constexpr bool PERM = true, AFTER_DRAIN = false;
    static constexpr int RELAX = 0;
    bf16_t* O; const bf16_t* Y1; const bf16_t* Z; int ldz; const float* bias;
    __device__ __forceinline__ void operator()(const f32x4 (&acc)[2][2][4][2], const Unit& u, int wr, int wc, int fr, int fq) const {
        const int row0 = u.pm * BM + wr * 64 + fr, col0 = u.pn * BM + wc * 32 + 8 * fq;
        f32x4 bv[2][2];
#pragma unroll
        for (int bj = 0; bj < 2; ++bj) { bv[bj][0] = *(const f32x4*)(bias + col0 + bj * HALF); bv[bj][1] = *(const f32x4*)(bias + col0 + bj * HALF + 4); }
#pragma unroll
        for (int ai = 0; ai < 2; ++ai)
#pragma unroll
            for (int m = 0; m < 4; ++m) { const int r = row0 + ai * HALF + m * 16;
#pragma unroll
                for (int bj = 0; bj < 2; ++bj) { const int c = col0 + bj * HALF;
                    const u32x4 yw = *(const u32x4*)(Y1 + (size_t)r * 4096 + c), zw = *(const u32x4*)(Z + (size_t)r * ldz + c);
                    const f32x4 y0 = {bl(yw.x), bh(yw.x), bl(yw.y), bh(yw.y)}, y1 = {bl(yw.z), bh(yw.z), bl(yw.w), bh(yw.w)};
                    const f32x4 z0 = {bl(zw.x), bh(zw.x), bl(zw.y), bh(zw.y)}, z1 = {bl(zw.z), bh(zw.z), bl(zw.w), bh(zw.w)};
                    f32x4 g0 = acc[ai][bj][m][0] + bv[bj][0], g1 = acc[ai][bj][m][1] + bv[bj][1];
#pragma unroll
                    for (int j = 0; j < 4; ++j) { g0[j] = y0[j] * sgm(g0[j]) * (z0[j] * sgm(z0[j])); g1[j] = y1[j] * sgm(g1[j]) * (z1[j] * sgm(z1[j])); }
                    u32x4 w; w.x = cvt_pk_bf16(g0[0], g0[1]); w.y = cvt_pk_bf16(g0[2], g0[3]); w.z = cvt_pk_bf16(g1[0], g1[1]); w.w = cvt_pk_bf16(g1[2], g1[3]);
                    *(u32x4*)(O + (size_t)r * 4096 + c) = w; }
                asm volatile("" ::: "memory"); }
    }
};
template <class Epi, class Sched, bool ALIGN_EPI = false, bool SP2 = false>
__device__ __forceinline__ void gemm_phase(PG8_LAS unsigned char* lds, const Gemm g, const Sched& S, const Epi& E, const int w0) {
    const int tid = otid(w0), wid = __builtin_amdgcn_readfirstlane(tid >> 6), lane = tid & 63, wr = wid >> 2, wc = wid & 3, fr = lane & 15, fq = lane >> 4;
    const int K = g.K, nt = K / BK;
    unsigned voffA[2], voffB[2];
#pragma unroll
    for (int i = 0; i < 2; ++i) { int R, C; stage_rc(tid * 16 + i * 8192, R, C); const int Rb = Epi::PERM ? ((R & ~31) + perm32(R & 31)) : R;
        voffA[i] = (unsigned)(R * K + C) * 2u; voffB[i] = (unsigned)(Rb * K + C) * 2u; }
    const size_t kstep = (size_t)(BK * 2);
    const size_t hstep = (size_t)HALF * K * 2;
    const size_t tstep = 2 * hstep;
    const unsigned ldsw = (unsigned)wid * 1024u;
    const int aoff = lds_byte(wr * 64 + fr, fq * 8), boff = lds_byte(wc * 32 + fr, fq * 8);
#define PG8_SA(b, h) (((b) * 2 + (h)) * HTB)
#define PG8_SB(b, h) ((4 + (b) * 2 + (h)) * HTB)
#define PG8_STAGE(bufoff, gbase, voff) do { _Pragma("unroll") for (int _i = 0; _i < 2; ++_i) \
        __builtin_amdgcn_global_load_lds((const unsigned*)((const char*)(gbase) + (voff)[_i]), (PG8_LAS unsigned*)(lds + (bufoff) + ldsw + _i * 8192), 16, 0, 0); } while (0)
#define PG8_LDA(dst, b, h) do { _Pragma("unroll") for (int m = 0; m < 4; ++m) _Pragma("unroll") for (int k = 0; k < 2; ++k) dst[m][k] = *(const PG8_LAS bf16x8*)(lds + PG8_SA(b, h) + aoff + m * 2048 + k * 1024); } while (0)
#define PG8_LDB(dst, b, h) do { _Pragma("unroll") for (int n = 0; n < 2; ++n) _Pragma("unroll") for (int k = 0; k < 2; ++k) dst[n][k] = *(const PG8_LAS bf16x8*)(lds + PG8_SB(b, h) + boff + n * 2048 + k * 1024); } while (0)
#define PG8_MMA(ai, bj, At, Bt) do { __builtin_amdgcn_s_setprio(1); _Pragma("unroll") for (int m = 0; m < 4; ++m) _Pragma("unroll") for (int n = 0; n < 2; ++n) _Pragma("unroll") for (int k = 0; k < 2; ++k) \
        acc[ai][bj][m][n] = __builtin_amdgcn_mfma_f32_16x16x32_bf16(Bt[n][k], At[m][k], acc[ai][bj][m][n], 0, 0, 0); __builtin_amdgcn_s_setprio(0); } while (0)
#define PG8_WAIT_V(n) asm volatile("s_waitcnt vmcnt(" #n ")" ::: "memory")
#define PG8_WAIT_VR asm volatile("s_waitcnt vmcnt(%0)" :: "n"(8 + Epi::RELAX) : "memory")
#define PG8_WAIT_L(n) asm volatile("s_waitcnt lgkmcnt(" #n ")" ::: "memory")
#define PG8_BAR __builtin_amdgcn_s_barrier()
#define PG8_SCHED __builtin_amdgcn_sched_barrier(0)
    Unit cur, nxt; int ui = 0;
    if (!S.next(0, cur)) return;
    f32x4 acc[2][2][4][2];
#pragma unroll
    for (int a = 0; a < 2; ++a)
#pragma unroll
        for (int b = 0; b < 2; ++b)
#pragma unroll
            for (int m = 0; m < 4; ++m)
#pragma unroll
                for (int n = 0; n < 2; ++n) acc[a][b][m][n] = (f32x4){0.f, 0.f, 0.f, 0.f};
    bf16x8 At[4][2], B0[2][2], B1[2][2];
    const char* cA = (const char*)g.A + (size_t)cur.pm * tstep; const char* cB = (const char*)g.Bt + (size_t)cur.pn * tstep;
    S.a_ready(cur);
    if constexpr (SP2) {
        PG8_STAGE(PG8_SB(0, 0), cB, voffB); PG8_STAGE(PG8_SB(0, 1), cB + hstep, voffB); PG8_STAGE(PG8_SA(0, 0), cA, voffA); PG8_STAGE(PG8_SA(0, 1), cA + hstep, voffA);
        if (wr == 1) PG8_BAR;
        PG8_WAIT_V(2); PG8_BAR;
        PG8_STAGE(PG8_SB(1, 0), cB + kstep, voffB); PG8_STAGE(PG8_SA(1, 0), cA + kstep, voffA); PG8_STAGE(PG8_SB(1, 1), cB + hstep + kstep, voffB);
        if constexpr (Epi::RELAX > 0) PG8_WAIT_V(0); else PG8_WAIT_V(6);
        PG8_BAR;
    } else {
        PG8_STAGE(PG8_SB(0, 0), cB, voffB); PG8_STAGE(PG8_SA(0, 0), cA, voffA); PG8_STAGE(PG8_SB(0, 1), cB + hstep, voffB); PG8_STAGE(PG8_SA(0, 1), cA + hstep, voffA);
        if (wr == 1) PG8_BAR;
        PG8_WAIT_V(4); PG8_BAR;
        PG8_STAGE(PG8_SB(1, 0), cB + kstep, voffB); PG8_STAGE(PG8_SA(1, 0), cA + kstep, voffA); PG8_STAGE(PG8_SB(1, 1), cB + hstep + kstep, voffB);
        PG8_WAIT_V(6); PG8_BAR;
    }
    for (;;) {
        const bool has_next = S.next(ui + 1, nxt);
        const char* nA = has_next ? (const char*)g.A + (size_t)nxt.pm * tstep : cA; const char* nB = has_next ? (const char*)g.Bt + (size_t)nxt.pn * tstep : cB;
        if constexpr (SP2 && (Epi::RELAX > 0)) {
            constexpr int t = 0; constexpr bool last = false; (void)t; (void)last;
            const char* a1 = cA + (size_t)(t + 1) * kstep;
            const char* a2 = last ? nA : cA + (size_t)(t + 2) * kstep; const char* b2 = last ? nB : cB + (size_t)(t + 2) * kstep;
            const char* a3 = a2 + kstep; const char* b3 = b2 + kstep;
            if (last && has_next) S.a_ready(nxt);
            PG8_LDB(B0, 0, 0); PG8_LDB(B1, 0, 1); PG8_SCHED; PG8_LDA(At, 0, 0); PG8_STAGE(PG8_SA(1, 1), a1 + hstep, voffA);
            PG8_WAIT_VR; PG8_WAIT_L(0); PG8_BAR; PG8_MMA(0, 0, At, B0); PG8_MMA(0, 1, At, B1); PG8_BAR; PG8_SCHED;
            PG8_LDA(At, 0, 1); PG8_STAGE(PG8_SB(0, 0), b2, voffB); PG8_STAGE(PG8_SB(0, 1), b2 + hstep, voffB); PG8_STAGE(PG8_SA(0, 0), a2, voffA);
            PG8_WAIT_VR; PG8_WAIT_L(0); PG8_BAR; PG8_MMA(1, 0, At, B0); PG8_MMA(1, 1, At, B1); PG8_BAR; PG8_SCHED;
            PG8_LDB(B0, 1, 0); PG8_LDB(B1, 1, 1); PG8_SCHED; PG8_LDA(At, 1, 0); PG8_STAGE(PG8_SA(0, 1), a2 + hstep, voffA);
            PG8_WAIT_V(8); PG8_WAIT_L(0); PG8_BAR; PG8_MMA(0, 0, At, B0); PG8_MMA(0, 1, At, B1); PG8_BAR; PG8_SCHED;
            PG8_LDA(At, 1, 1); PG8_STAGE(PG8_SB(1, 0), b3, voffB); PG8_STAGE(PG8_SB(1, 1), b3 + hstep, voffB); PG8_STAGE(PG8_SA(1, 0), a3, voffA);
            PG8_WAIT_V(8); PG8_WAIT_L(0); PG8_BAR; PG8_MMA(1, 0, At, B0); PG8_MMA(1, 1, At, B1); PG8_BAR; PG8_SCHED;
        }
        for (int t = (SP2 && (Epi::RELAX > 0)) ? 2 : 0; t < nt; t += 2) {
            const bool last = (t == nt - 2);
            const char* a1 = cA + (size_t)(t + 1) * kstep;
            const char* a2 = last ? nA : cA + (size_t)(t + 2) * kstep; const char* b2 = last ? nB : cB + (size_t)(t + 2) * kstep;
            const char* a3 = a2 + kstep; const char* b3 = b2 + kstep;
            if (last && has_next) S.a_ready(nxt);
            if constexpr (SP2) {
            PG8_LDB(B0, 0, 0); PG8_LDB(B1, 0, 1); PG8_SCHED; PG8_LDA(At, 0, 0); PG8_STAGE(PG8_SA(1, 1), a1 + hstep, voffA);
            PG8_WAIT_V(8); PG8_WAIT_L(0); PG8_BAR; PG8_MMA(0, 0, At, B0); PG8_MMA(0, 1, At, B1); PG8_BAR; PG8_SCHED;
            PG8_LDA(At, 0, 1); PG8_STAGE(PG8_SB(0, 0), b2, voffB); PG8_STAGE(PG8_SB(0, 1), b2 + hstep, voffB); PG8_STAGE(PG8_SA(0, 0), a2, voffA);
            PG8_WAIT_V(8); PG8_WAIT_L(0); PG8_BAR; PG8_MMA(1, 0, At, B0); PG8_MMA(1, 1, At, B1); PG8_BAR; PG8_SCHED;
            PG8_LDB(B0, 1, 0); PG8_LDB(B1, 1, 1); PG8_SCHED; PG8_LDA(At, 1, 0); PG8_STAGE(PG8_SA(0, 1), a2 + hstep, voffA);
            PG8_WAIT_V(8); PG8_WAIT_L(0); PG8_BAR; PG8_MMA(0, 0, At, B0); PG8_MMA(0, 1, At, B1); PG8_BAR; PG8_SCHED;
            PG8_LDA(At, 1, 1); PG8_STAGE(PG8_SB(1, 0), b3, voffB); PG8_STAGE(PG8_SB(1, 1), b3 + hstep, voffB); PG8_STAGE(PG8_SA(1, 0), a3, voffA);
            PG8_WAIT_V(8); PG8_WAIT_L(0); PG8_BAR; PG8_MMA(1, 0, At, B0); PG8_MMA(1, 1, At, B1); PG8_BAR; PG8_SCHED;
            } else {
            PG8_LDB(B0, 0, 0); PG8_SCHED; PG8_LDA(At, 0, 0); PG8_STAGE(PG8_SA(1, 1), a1 + hstep, voffA);
            PG8_WAIT_L(8); PG8_BAR; PG8_WAIT_L(0); PG8_MMA(0, 0, At, B0); PG8_BAR; PG8_SCHED;
            PG8_LDB(B1, 0, 1); PG8_STAGE(PG8_SB(0, 0), b2, voffB);
            PG8_BAR; PG8_WAIT_L(0); PG8_MMA(0, 1, At, B1); PG8_BAR;
            PG8_LDA(At, 0, 1); PG8_STAGE(PG8_SA(0, 0), a2, voffA);
            PG8_BAR; PG8_WAIT_L(0); PG8_MMA(1, 0, At, B0); PG8_BAR; PG8_SCHED;
            PG8_STAGE(PG8_SB(0, 1), b2 + hstep, voffB);
            PG8_WAIT_V(6); PG8_BAR; PG8_MMA(1, 1, At, B1); PG8_BAR;
            PG8_LDB(B0, 1, 0); PG8_SCHED; PG8_LDA(At, 1, 0); PG8_STAGE(PG8_SA(0, 1), a2 + hstep, voffA);
            PG8_WAIT_L(8); PG8_BAR; PG8_WAIT_L(0); PG8_MMA(0, 0, At, B0); PG8_BAR; PG8_SCHED;
            PG8_LDB(B1, 1, 1); PG8_STAGE(PG8_SB(1, 0), b3, voffB);
            PG8_BAR; PG8_WAIT_L(0); PG8_MMA(0, 1, At, B1); PG8_BAR;
            PG8_LDA(At, 1, 1); PG8_STAGE(PG8_SA(1, 0), a3, voffA);
            PG8_BAR; PG8_WAIT_L(0); PG8_MMA(1, 0, At, B0); PG8_BAR; PG8_SCHED;
            PG8_STAGE(PG8_SB(1, 1), b3 + hstep, voffB);
            PG8_WAIT_V(6); PG8_BAR; PG8_MMA(1, 1, At, B1); PG8_BAR;
            }
        }
        if constexpr (ALIGN_EPI) { if (wr == 0) PG8_BAR; }
        if constexpr (!Epi::AFTER_DRAIN) { const int te = otid(w0);
            E(acc, cur, wr, wc, te & 15, (te >> 4) & 3); S.done(cur); }
        if (!has_next) break;
#pragma unroll
        for (int a = 0; a < 2; ++a)
#pragma unroll
            for (int b = 0; b < 2; ++b)
#pragma unroll
                for (int m = 0; m < 4; ++m)
#pragma unroll
                    for (int n = 0; n < 2; ++n) acc[a][b][m][n] = (f32x4){0.f, 0.f, 0.f, 0.f};
        cur = nxt; cA = nA; cB = nB; ++ui;
        if constexpr (ALIGN_EPI) { if (wr == 1) PG8_BAR; }
    }
    PG8_WAIT_V(0);
    if constexpr (!ALIGN_EPI) { if (wr == 0) PG8_BAR; }
    PG8_BAR;
    if constexpr (Epi::AFTER_DRAIN) { E.fused(acc, cur, wr, wc, fr, fq, lds, wid, lane); S.done(cur); }
#undef PG8_SA
#undef PG8_SB
#undef PG8_STAGE
#undef PG8_LDA
#undef PG8_LDB
#undef PG8_MMA
#undef PG8_WAIT_V
#undef PG8_WAIT_L
#undef PG8_BAR
#undef PG8_SCHED
}
}
#define XB_TMO      128
#define XB_XCNT(j)  (256  + 64 * (j))
#define XB_XSUB(j)  (1280 + 64 * (j))
#define XB_XGEN(j)  (2304 + 64 * (j))
#define XB_TOP      3328
#define XB_TOPGEN   3392
#define XCD_BAR_WORDS 3456
#define XB_SPIN_CAP (1u << 18)

__device__ __forceinline__ unsigned xb_ld(unsigned* p)              { return __hip_atomic_load(p, __ATOMIC_RELAXED, __HIP_MEMORY_SCOPE_AGENT); }
__device__ __forceinline__ unsigned xb_add(unsigned* p, unsigned v) { return __hip_atomic_fetch_add(p, v, __ATOMIC_RELAXED, __HIP_MEMORY_SCOPE_AGENT); }
__device__ __forceinline__ unsigned xb_xcc_id() { return (unsigned)__builtin_amdgcn_s_getreg((3 << 11) | 20) & 0xFu; }
#define XB_SPIN(cond, bar) do { unsigned _sp = 0; while (cond) { __builtin_amdgcn_s_sleep(1); \
    if ((++_sp & 255u) == 0u) { if (xb_ld(&(bar)[XB_TMO])) break; if (_sp > XB_SPIN_CAP) { atomicAdd(&(bar)[XB_TMO], 1u); break; } } } } while (0)

struct XcdBarrier {
    unsigned* bar; unsigned x;
    volatile LAS unsigned* st;
    unsigned tid;
};

__device__ __forceinline__ XcdBarrier xcd_barrier_post(unsigned* bar, volatile LAS unsigned* st) {
    XcdBarrier b; b.bar = bar; b.x = xb_xcc_id(); b.st = st;
    if (threadIdx.x == 0) (void)xb_add(&bar[XB_XCNT(b.x)], 1u);
    return b;
}
__device__ __forceinline__ void xcd_barrier_complete(unsigned* bar, unsigned x, unsigned& nloc, unsigned& nx) {
    const unsigned G = gridDim.x * gridDim.y * gridDim.z;
    unsigned sum, cnt, mine, sp = 0u;
    for (;;) {
        sum = 0u; cnt = 0u; mine = 0u;
#pragma unroll
        for (unsigned j = 0; j < 16; ++j) { const unsigned c = xb_ld(&bar[XB_XCNT(j)]); sum += c; cnt += (c > 0u) ? 1u : 0u; mine = (j == x) ? c : mine; }
        if (sum == G) break;
        __builtin_amdgcn_s_sleep(1);
        if ((++sp & 255u) == 0u) { if (xb_ld(&bar[XB_TMO])) break; if (sp > XB_SPIN_CAP) { atomicAdd(&bar[XB_TMO], 1u); break; } }
    }
    nloc = mine > 0u ? mine : 1u; nx = cnt > 0u ? cnt : 1u;
}

__device__ __forceinline__ void xcd_barrier(const XcdBarrier& b) {
    asm volatile("s_waitcnt vmcnt(0)" ::: "memory");
    __syncthreads();
    if (b.tid == 0) {
        unsigned* bar = b.bar;
        __builtin_amdgcn_s_waitcnt(0);
        unsigned nloc = b.st[0], nx = b.st[1];
        if (nloc == 0u) { xcd_barrier_complete(bar, b.x, nloc, nx); b.st[0] = nloc; b.st[1] = nx; }
        const unsigned old = xb_add(&bar[XB_XSUB(b.x)], 1u);
        const unsigned gen = old / nloc;
        if (old + 1u == (gen + 1u) * nloc) {
            __builtin_amdgcn_fence(__ATOMIC_RELEASE, "agent");
            asm volatile("s_waitcnt vmcnt(0)" ::: "memory");
            const unsigned og = xb_add(&bar[XB_TOP], 1u);
            const unsigned tg = og / nx;
            if (og + 1u == (tg + 1u) * nx) xb_add(&bar[XB_TOPGEN], 1u);
            else XB_SPIN(xb_ld(&bar[XB_TOPGEN]) == tg, bar);
            __builtin_amdgcn_fence(__ATOMIC_ACQUIRE, "agent");
            xb_add(&bar[XB_XGEN(b.x)], 1u);
            asm volatile("s_waitcnt vmcnt(0)" ::: "memory");
        } else {
            XB_SPIN(xb_ld(&bar[XB_XGEN(b.x)]) == gen, bar);
            __builtin_amdgcn_fence(__ATOMIC_ACQUIRE, "agent");
            asm volatile("s_waitcnt vmcnt(0)" ::: "memory");
        }
    }
    __syncthreads();
}
namespace fox {
constexpr int D = 128;
constexpr float SCALE = 0.08838834764831845f, INV_SCALE = 11.313708498984761f;
constexpr float THR = 8.f;
constexpr int NW = 8, QBLK = 32, KVBLK = 64, QB = NW * QBLK;
constexpr int SHM_V = KVBLK * D * 2, SHM_K = KVBLK * D * 2;
constexpr int KB_OFF = 2 * SHM_V + 2 * SHM_K + NW * 64 * 4;
constexpr int JL_OFF = KB_OFF + 2 * 64 * 4;
constexpr int OT_OFF = JL_OFF + 64, OT_PITCH = 272, OT_WAVE = 32 * OT_PITCH;
constexpr int LDS_BYTES = OT_OFF + NW * OT_WAVE;

#define KSWZ(row, colB) ((row) * 256 + ((colB) ^ (((row) & 7) << 4)))
#define SBAR() __builtin_amdgcn_sched_barrier(0)
__device__ __forceinline__ int v_st(int k, int c) { const int kk = (k & ~0xC) | ((k & 4) << 1) | ((k & 8) >> 1); return ((kk >> 3) * 4 + (c >> 5)) * 512 + ((kk & 7) * 32 + (c & 31)) * 2; }
__device__ __forceinline__ int v_rd_base(int lane) { return ((lane & 3) << 3) | (((lane >> 2) & 3) << 6) | (((lane >> 4) & 1) << 5) | (((lane >> 5) & 1) << 8); }
constexpr int v_rd_off(int d0, int ks, int half) { return d0 * 512 + ks * 4096 + half * 2048; }
__device__ __forceinline__ int crow(int r, int hi) { return (r & 3) + 8 * (r >> 2) + 4 * hi; }
__device__ __forceinline__ bf16x8 load8(const bf16* p) { return *reinterpret_cast<const bf16x8*>(p); }
__device__ __forceinline__ void mask_tile(f32x16& p0, f32x16& p1, int dq) {
    const float NEG = -__builtin_inff();
#pragma unroll
    for (int r = 0; r < 16; ++r) {
        const int c = (r & 3) + 8 * (r >> 2);
        if (dq - c < 0) p0[r] = NEG;
        if (dq - c - 32 < 0) p1[r] = NEG;
    }
}
__device__ __forceinline__ void bias_tile(f32x16& p0, f32x16& p1, const float* kb, int hi) {
#pragma unroll
    for (int g = 0; g < 4; ++g) {
        const f32x4 a = *(const f32x4*)(kb + 8 * g + 4 * hi), b = *(const f32x4*)(kb + 32 + 8 * g + 4 * hi);
#pragma unroll
        for (int j = 0; j < 4; ++j) { p0[4 * g + j] += a[j]; p1[4 * g + j] += b[j]; }
    }
}
__device__ __forceinline__ void partialSM(f32x16& p0, f32x16& p1, float& m_reg, float& mn, float& alpha) {
    float pmax = p0[0]; for (int r = 1; r < 16; ++r) pmax = fmaxf(pmax, p0[r]); for (int r = 0; r < 16; ++r) pmax = fmaxf(pmax, p1[r]);
    { auto rr = __builtin_amdgcn_permlane32_swap(__float_as_uint(pmax), __float_as_uint(pmax), false, false);
      pmax = fmaxf(__uint_as_float(rr[0]), __uint_as_float(rr[1])); }
    constexpr float C2 = 1.4426950408889634f * SCALE;
    if (__builtin_expect(__all((pmax - m_reg) * SCALE <= THR), 1)) { mn = m_reg; alpha = 1.f; }
    else { mn = fmaxf(m_reg, pmax); alpha = __builtin_amdgcn_exp2f((m_reg - mn) * C2); m_reg = mn; }
    const float mnL = -mn * C2;
    for (int r = 0; r < 16; ++r) p0[r] = fmaf(p0[r], C2, mnL); for (int r = 0; r < 16; ++r) p1[r] = fmaf(p1[r], C2, mnL);
    for (int r = 0; r < 16; ++r) p0[r] = __builtin_amdgcn_exp2f(p0[r]);
}
__device__ __forceinline__ void finishSM(f32x16& p0, f32x16& p1, float alpha, float& l_reg, bf16x8& pa0, bf16x8& pa1, bf16x8& pa2, bf16x8& pa3) {
    for (int r = 0; r < 16; ++r) p1[r] = __builtin_amdgcn_exp2f(p1[r]);
    float ps = 0; for (int r = 0; r < 16; ++r) ps += p0[r]; for (int r = 0; r < 16; ++r) ps += p1[r];
    { auto rr = __builtin_amdgcn_permlane32_swap(__float_as_uint(ps), __float_as_uint(ps), false, false);
      ps = __uint_as_float(rr[0]) + __uint_as_float(rr[1]); }
    l_reg = l_reg * alpha + ps;
#define PK4(P, B_, OUT) do { unsigned a0 = cvtpk(P[B_+0], P[B_+1]), a1 = cvtpk(P[B_+2], P[B_+3]);                          \
        unsigned b0 = cvtpk(P[B_+4], P[B_+5]), b1 = cvtpk(P[B_+6], P[B_+7]);                                             \
        auto r0 = __builtin_amdgcn_permlane32_swap(a0, b0, false, false); auto r1 = __builtin_amdgcn_permlane32_swap(a1, b1, false, false); \
        u32x4 w = {r0[0], r1[0], r0[1], r1[1]}; OUT = *reinterpret_cast<bf16x8*>(&w); } while (0)
    PK4(p0, 0, pa0); PK4(p0, 8, pa1); PK4(p1, 0, pa2); PK4(p1, 8, pa3);
#undef PK4
}
template <int KB>
__device__ __forceinline__ void qkt(f32x16& p0, f32x16& p1, const char* K_lds, int r32, int hi, const bf16x8* qr) {
    p0 = f32x16{}; p1 = f32x16{};
    const char* kb[4];
#pragma unroll
    for (int dd = 0; dd < 4; ++dd) kb[dd] = K_lds + KB * SHM_K + KSWZ(r32, (dd * 16 + hi * 8) * 2);
#pragma unroll
    for (int d0 = 0; d0 < 8; ++d0) { const char* a = kb[d0 & 3] + (d0 >> 2) * 128;
        bf16x8 b0 = *reinterpret_cast<const bf16x8*>(a);
        bf16x8 b1 = *reinterpret_cast<const bf16x8*>(a + 32 * 256);
        p0 = __builtin_amdgcn_mfma_f32_32x32x16_bf16(b0, qr[d0], p0, 0, 0, 0);
        p1 = __builtin_amdgcn_mfma_f32_32x32x16_bf16(b1, qr[d0], p1, 0, 0, 0); }
}
template <int VB>
__device__ __forceinline__ void pv_tile(f32x16* o, int vb0, bf16x8 pa0, bf16x8 pa1, bf16x8 pa2, bf16x8 pa3) {
#define TRRD(dst, off) asm volatile("ds_read_b64_tr_b16 %0, %1 offset:%2" : "=&v"(dst) : "v"(vb0), "i"(off) : "memory")
#define PV_D0(d0) do { s16x4 l0, l1, h0, h1; constexpr int b_ = VB * SHM_V + v_rd_off(d0, 0, 0);     \
        TRRD(l0, b_); TRRD(h0, b_ + 2048); TRRD(l1, b_ + 4096); TRRD(h1, b_ + 6144); \
        asm volatile("s_waitcnt lgkmcnt(0)" ::: "memory"); SBAR();   \
        o[d0] = __builtin_amdgcn_mfma_f32_32x32x16_bf16(pa0, (bf16x8){l0[0], l0[1], l0[2], l0[3], h0[0], h0[1], h0[2], h0[3]}, o[d0], 0, 0, 0);   \
        o[d0] = __builtin_amdgcn_mfma_f32_32x32x16_bf16(pa1, (bf16x8){l1[0], l1[1], l1[2], l1[3], h1[0], h1[1], h1[2], h1[3]}, o[d0], 0, 0, 0);   \
        SBAR(); TRRD(l0, b_ + 8192); TRRD(h0, b_ + 10240); TRRD(l1, b_ + 12288); TRRD(h1, b_ + 14336); \
        asm volatile("s_waitcnt lgkmcnt(0)" ::: "memory"); SBAR();   \
        o[d0] = __builtin_amdgcn_mfma_f32_32x32x16_bf16(pa2, (bf16x8){l0[0], l0[1], l0[2], l0[3], h0[0], h0[1], h0[2], h0[3]}, o[d0], 0, 0, 0);   \
        o[d0] = __builtin_amdgcn_mfma_f32_32x32x16_bf16(pa3, (bf16x8){l1[0], l1[1], l1[2], l1[3], h1[0], h1[1], h1[2], h1[3]}, o[d0], 0, 0, 0); } while (0)
    PV_D0(0); PV_D0(1); PV_D0(2); PV_D0(3);
#undef PV_D0
#undef TRRD
}
struct BlockRef { const bf16* Q; const bf16* K; const bf16* V; const bf16* Z; bf16* O; const float* C; const float* QN; const float* KN; int P0; };
constexpr float PRUNE_T = 30.0f;
__device__ __forceinline__ int compute_jlo(const BlockRef& b, int lane) {
    const int ntb = b.P0 / KVBLK;
    if (ntb == 0) return 0;
    float q2 = b.QN[ntb + (lane & 3)];
    q2 = fmaxf(q2, __shfl_xor(q2, 1)); q2 = fmaxf(q2, __shfl_xor(q2, 2));
    float k2 = fmaxf(lane < ntb + 4 ? b.KN[lane] : 0.f, lane + 64 < ntb + 4 ? b.KN[lane + 64] : 0.f);
#pragma unroll
    for (int o = 1; o < 64; o <<= 1) k2 = fmaxf(k2, __shfl_xor(k2, o));
    const float bnd = 2.0f * SCALE * __builtin_amdgcn_sqrtf(q2 * k2) * 1.0001f + b.C[b.P0];
    const bool s0 = lane < ntb && (bnd - b.C[64 * lane + 63] < -PRUNE_T);
    const bool s1 = lane + 64 < ntb && (bnd - b.C[64 * (lane + 64) + 63] < -PRUNE_T);
    const unsigned long long m0 = __ballot(s0), m1 = __ballot(s1);
    int jlo = 0;
    if (m1) jlo = 128 - __builtin_clzll(m1) + 1 - 1; else if (m0) jlo = 64 - __builtin_clzll(m0);
    return __builtin_amdgcn_readfirstlane(jlo);
}
__device__ __forceinline__ void norm_item(const bf16* PROJ, float* QN2, float* KN2, int item, int lane) {
    const int bhh = item >> 7, tile = item & 127, b = bhh >> 5, h = bhh & 31, rs = lane >> 4, cg = lane & 15;
    const bf16* base = PROJ + ((size_t)b * SEQ + (size_t)tile * 64) * LDP + h * HDIM + cg * 8;
    float qm = 0.f, km = 0.f;
#pragma unroll 4
    for (int i = 0; i < 16; ++i) { const bf16* rp = base + (size_t)(4 * i + rs) * LDP;
        const u32x4 qw = *(const u32x4*)rp, kw = *(const u32x4*)(rp + 4096); float q[8], k[8]; unpack8(qw, q); unpack8(kw, k);
        float sq = 0.f, sk = 0.f;
#pragma unroll
        for (int e = 0; e < 8; ++e) { sq += q[e] * q[e]; sk += k[e] * k[e]; }
#pragma unroll
        for (int o = 1; o < 16; o <<= 1) { sq += __shfl_xor(sq, o); sk += __shfl_xor(sk, o); }
        qm = fmaxf(qm, sq); km = fmaxf(km, sk); }
    qm = fmaxf(qm, __shfl_xor(qm, 16)); qm = fmaxf(qm, __shfl_xor(qm, 32)); km = fmaxf(km, __shfl_xor(km, 16)); km = fmaxf(km, __shfl_xor(km, 32));
    if (lane == 0) { QN2[item] = qm; KN2[item] = km; }
}
struct Seam { bf16x8 qr[8]; bf16x8 st_v0, st_v1, st_k0, st_k1; float cb0, cb1; };
#define ROWP(p, k0, rr) ((p) + (size_t)((k0) + (rr)) * LDP + sc)
#define VMWN(n) asm volatile("s_waitcnt vmcnt(%0)" :: "i"(n) : "memory")
#define SLOAD_H(Kp, Vp, Cp, k0) do { const bf16* vp_ = (Vp) + (size_t)(k0) * LDP; const bf16* kp_ = (Kp) + (size_t)(k0) * LDP; const float* cp_ = (Cp) + (k0); \
                         S.st_v0 = load8(vp_ + loff); S.st_v1 = load8(vp_ + 32 * LDP + loff);              \
                         S.st_k0 = load8(kp_ + loff); S.st_k1 = load8(kp_ + 32 * LDP + loff); S.cb0 = cp_[(unsigned)sr]; S.cb1 = (cp_ + 32)[(unsigned)sr]; } while (0)
#define SWRITE_HK(bf, ref) do { *(bf16x8*)(K_lds + (bf) * SHM_K + kws) = S.st_k0; *(bf16x8*)(K_lds + (bf) * SHM_K + kws + 32 * 256) = S.st_k1; \
                         if ((tid & 15) == 0) { kbias[(bf) * 64 + sr] = ((ref) - S.cb0) * INV_SCALE; kbias[(bf) * 64 + 32 + sr] = ((ref) - S.cb1) * INV_SCALE; } } while (0)
#define SWRITE_HV(bf) do { *(bf16x8*)(V_lds + (bf) * SHM_V + vst0) = S.st_v0; *(bf16x8*)(V_lds + (bf) * SHM_V + vst1) = S.st_v1; } while (0)
#define SWRITE_H(bf, ref) do { SWRITE_HV(bf); SWRITE_HK(bf, ref); } while (0)
__device__ __forceinline__ float blk_ref(const BlockRef& b) { const float v = b.P0 > 0 ? b.C[b.P0 - 1] : 0.f; return __uint_as_float(__builtin_amdgcn_readfirstlane(__float_as_uint(v))); }
__device__ __forceinline__ void prime(const BlockRef& cur, int j_lo, char* lds, Seam& S, const int w0) {
    const int tid = otid(w0), wid = __builtin_amdgcn_readfirstlane(tid >> 6), lane = tid & 63, r32 = lane & 31, hi = lane >> 5;
    const int sr = tid >> 4, sc = (tid & 15) * 8, kws = KSWZ(sr, sc * 2); char* K_lds = lds + 2 * SHM_V; float* kbias = (float*)(lds + KB_OFF);
    const unsigned loff = (unsigned)sr * LDP + sc, qoff = (unsigned)r32 * LDP + hi * 8;
    const float ref = blk_ref(cur);
    for (int d0 = 0; d0 < 8; ++d0) S.qr[d0] = load8(cur.Q + (size_t)(wid * QBLK) * LDP + d0 * 16 + qoff);
    SLOAD_H(cur.K, cur.V, cur.C, j_lo * KVBLK); VM_WAIT(); SWRITE_HK(0, ref);
    __syncthreads();
}
__device__ __forceinline__ void block(const BlockRef& cur, const BlockRef& nxt, int j_lo, int jlo_n, char* lds, Seam& S, const int w0) {
    const int tid = otid(w0), wid = __builtin_amdgcn_readfirstlane(tid >> 6), lane = tid & 63, r32 = lane & 31, hi = lane >> 5;
    const int NT = (cur.P0 + QB - 1) / KVBLK + 1 - j_lo;
    const int qlo = cur.P0 + wid * QBLK, qm = qlo + r32 - 4 * hi;
    char* V_lds = lds; char* K_lds = lds + 2 * SHM_V;
    float* ws = (float*)(lds + 2 * SHM_V + 2 * SHM_K) + wid * 64; float* li_l = ws, * al_l = ws + 32; float* kbias = (float*)(lds + KB_OFF);
    float m_reg = -1e30f, l_reg = 0; f32x16 o[4] = {};
    const int sr = tid >> 4, sc = (tid & 15) * 8, vst0 = v_st(sr, sc), vst1 = v_st(32 + sr, sc), kws = KSWZ(sr, sc * 2);
    const int vb0 = (int)(uintptr_t)V_lds + v_rd_base(lane);
    const unsigned loff = (unsigned)sr * LDP + sc, qoff = (unsigned)r32 * LDP + hi * 8;
    const bf16* Kh = cur.K; const bf16* Vh = cur.V; const float* Ch = cur.C;
    const float ref = blk_ref(cur), nref = blk_ref(nxt);
#define RESC(a) do { if (__any((a) < 1.f)) { if (hi == 0) al_l[r32] = (a); asm volatile("s_waitcnt lgkmcnt(0)" ::: "memory");              \
                     for (int d_ = 0; d_ < 4; ++d_) for (int r = 0; r < 16; ++r) o[d_][r] *= al_l[crow(r, hi)]; } } while (0)
#define KBASE(t) ((j_lo + (t)) * KVBLK)
#define BIASMASK(P0_, P1_, t, KB) do { const int kb_ = KBASE(t); bias_tile(P0_, P1_, kbias + (KB) * 64, hi); if (kb_ + KVBLK - 1 > qlo) mask_tile(P0_, P1_, qm - kb_); } while (0)
    constexpr int NQL = 8;
#define SEAM_K0() do { VMWN(NQL); SWRITE_HK(0, nref); SBAR(); } while (0)
    f32x16 pA0, pA1, pB0, pB1; float mnA, mnB, alA, alB; bf16x8 pa0, pa1, pa2, pa3;
    SWRITE_HV(0); SBAR();
    if (NT > 1) SLOAD_H(Kh, Vh, Ch, KBASE(1));
    SBAR(); qkt<0>(pA0, pA1, K_lds, r32, hi, S.qr);
    BIASMASK(pA0, pA1, 0, 0); partialSM(pA0, pA1, m_reg, mnA, alA);
    if (NT > 1) { VM_WAIT(); SWRITE_H(1, ref); }
    __syncthreads();
#define HALF_STEP(PX0, PX1, mnX, alX, PY0, PY1, alY, t, KB, VB, SB) do {                                                      \
        SBAR(); qkt<KB>(PX0, PX1, K_lds, r32, hi, S.qr);                                                                      \
        finishSM(PY0, PY1, alY, l_reg, pa0, pa1, pa2, pa3); SBAR();                                                           \
        if ((t) + 1 < NT) { SLOAD_H(Kh, Vh, Ch, KBASE((t) + 1)); SBAR(); }                                                    \
        pv_tile<VB>(o, vb0, pa0, pa1, pa2, pa3); BIASMASK(PX0, PX1, (t), KB); partialSM(PX0, PX1, m_reg, mnX, alX);           \
        __syncthreads();                                                                                                      \
        if ((t) + 1 < NT) { VM_WAIT(); SWRITE_H(SB, ref); }                                                                   \
        RESC(alX); __syncthreads(); } while (0)
    for (int t = 1; t + 1 < NT; t += 2) {
        HALF_STEP(pB0, pB1, mnB, alB, pA0, pA1, alA, t, 1, 0, 0);
        HALF_STEP(pA0, pA1, mnA, alA, pB0, pB1, alB, t + 1, 0, 1, 1);
    }
    const bool even = (NT & 1) == 0;
    if (even) { SBAR(); qkt<1>(pB0, pB1, K_lds, r32, hi, S.qr); SBAR(); }
    SLOAD_H(nxt.K, nxt.V, nxt.C, jlo_n * KVBLK); SBAR();
#pragma unroll
    for (int d0 = 0; d0 < 8; ++d0) S.qr[d0] = load8(nxt.Q + (size_t)(wid * QBLK) * LDP + d0 * 16 + qoff);
    SBAR();
    finishSM(pA0, pA1, alA, l_reg, pa0, pa1, pa2, pa3); SBAR();
    pv_tile<0>(o, vb0, pa0, pa1, pa2, pa3);
    if (even) { const int t2 = otid(w0), qm2 = qlo + (t2 & 31) - 4 * ((t2 >> 5) & 1), hi2 = (t2 >> 5) & 1;
      { const int kb_ = KBASE(NT - 1); bias_tile(pB0, pB1, kbias + 64, hi2); if (kb_ + KVBLK - 1 > qlo) mask_tile(pB0, pB1, qm2 - kb_); }
      partialSM(pB0, pB1, m_reg, mnB, alB); __syncthreads(); RESC(alB);
      finishSM(pB0, pB1, alB, l_reg, pa0, pa1, pa2, pa3); SBAR(); pv_tile<1>(o, vb0, pa0, pa1, pa2, pa3); }
    SBAR(); SEAM_K0();
    if (hi == 0) li_l[r32] = l_reg; asm volatile("s_waitcnt lgkmcnt(0)" ::: "memory");
    float rli[16];
#pragma unroll
    for (int r = 0; r < 16; ++r) rli[r] = __builtin_amdgcn_rcpf(li_l[crow(r, hi)]);
    bf16* Ow = cur.O + (size_t)(wid * QBLK) * 4096; const bf16* Zw = cur.Z + (size_t)(wid * QBLK) * LDP;
    const int t2 = otid(w0), l2 = t2 & 63;
    const unsigned zoff = (unsigned)(l2 >> 4) * LDP + (l2 & 15) * 8, ooff = (unsigned)(l2 >> 4) * 4096 + (l2 & 15) * 8;
    u32x4 zw[8];
#pragma unroll
    for (int i = 0; i < 8; ++i) zw[i] = *(const u32x4*)(Zw + (size_t)(4 * i) * LDP + zoff);
    char* ot = lds + OT_OFF + wid * OT_WAVE;
#pragma unroll
    for (int d0 = 0; d0 < 4; ++d0)
#pragma unroll
        for (int r = 0; r < 16; ++r) *(bf16*)(ot + crow(r, hi) * OT_PITCH + (d0 * 32 + r32) * 2) = (bf16)(cvtpk(o[d0][r] * rli[r], 0.f) & 0xffffu);
    asm volatile("s_waitcnt lgkmcnt(0)" ::: "memory");
#pragma unroll
    for (int i = 0; i < 8; ++i) { const u32x4 ow = *(const u32x4*)(ot + (4 * i + (l2 >> 4)) * OT_PITCH + (l2 & 15) * 16);
        float ov[8], zv[8]; unpack8(ow, ov); unpack8(zw[i], zv);
        f32x4 a, b;
#pragma unroll
        for (int e = 0; e < 4; ++e) { a[e] = ov[e] * siluf_(zv[e]); b[e] = ov[4 + e] * siluf_(zv[4 + e]); }
        *(bf16x8*)(Ow + (size_t)(4 * i) * 4096 + ooff) = pack8(a, b); }
    __syncthreads();
#undef RESC
#undef KBASE
#undef BIASMASK
#undef SEAM_K0
#undef HALF_STEP
}
#undef ROWP
#undef VMWN
#undef SLOAD_H
#undef SWRITE_HK
#undef SWRITE_HV
#undef SWRITE_H
#undef KSWZ
#undef SBAR
__device__ __forceinline__ void attn_phase(char* lds, const bf16* PROJ, bf16* MIX, const float* CUM, const float* QN2, const float* KN2, int vcu, int G, const int w0) {
    constexpr int NQB = SEQ / QB  , NX = NQB / 2, TOTAL = NX * BATCH * NHEAD;
    auto ref_of = [&](int L, int pass) { const int bhh = L / NX, x = L % NX, qb = pass ? NQB - 1 - x : x, b = bhh / NHEAD, h = bhh % NHEAD;
        BlockRef r; const bf16* base = PROJ + (size_t)b * SEQ * LDP + h * HDIM;
        r.Q = base + (size_t)qb * QB * LDP; r.K = base + 4096; r.V = base + 8192; r.Z = base + (size_t)qb * QB * LDP + ZCOL;
        r.O = MIX + ((size_t)b * SEQ + (size_t)qb * QB) * 4096 + h * HDIM; r.C = CUM + (size_t)bhh * SEQ; r.QN = QN2 + bhh * 128; r.KN = KN2 + bhh * 128; r.P0 = qb * QB; return r; };
    int L = vcu; if (L >= TOTAL) return;
    int pass = 0; BlockRef cur = ref_of(L, 0); Seam S;
    int* jl = (int*)(lds + JL_OFF);
    { const int tid = otid(w0), w = __builtin_amdgcn_readfirstlane(tid >> 6), Lw = vcu + (w >> 1) * G;
      if (Lw < TOTAL) { const BlockRef r = ref_of(Lw, w & 1); const int j = compute_jlo(r, tid & 63); if ((tid & 63) == 0) jl[w] = j; } }
    __syncthreads();
    int bi = 0;
    prime(cur, jl[0], lds, S, w0);
    for (;;) {
        const bool more_pass = pass == 0, more_item = L + G < TOTAL, last = !more_pass && !more_item;
        int passn = pass + 1, Ln = L; if (!more_pass) { passn = 0; Ln = more_item ? L + G : L; }
        const BlockRef nxt = last ? cur : ref_of(Ln, passn);
        { const int ja = __builtin_amdgcn_readfirstlane(jl[bi]), jb = __builtin_amdgcn_readfirstlane(jl[last ? bi : bi + 1]); block(cur, nxt, ja, jb, lds, S, w0); ++bi; }
        if (last) break;
        cur = nxt; pass = passn; L = Ln;
    }
}
}
constexpr int NWAVES = 8, NTHR = 512;
constexpr int RING_BYTES = 131072;
constexpr int MISC_OFF = RING_BYTES + 24576;
constexpr int LDS_BYTES = MISC_OFF + 128;

struct Args {
    const float* in[28]; float* out; unsigned char* ws;
    int ph_lo, ph_hi, li, pad;
};
enum { I_X = 0, I_P, I_NORM_MIX, I_FOX_WIN, I_FOX_BF, I_FOX_WOUT, I_GDN_WIN, I_GDN_CONV, I_GDN_ALOG, I_GDN_DTB, I_GDN_NORM, I_GDN_WOUT,
       I_SSM_WIN, I_SSM_LRE, I_SSM_LIM, I_SSM_BRE, I_SSM_BIM, I_SSM_CRE, I_SSM_CIM, I_SSM_LSTEP, I_SSM_D, I_SSM_WGLU, I_SSM_BGLU, I_SSM_WOUT,
       I_NORM_PLE, I_PLE_WPROJ, I_PLE_WGATE, I_FINAL_NORM };

__device__ __forceinline__ void transpose_item(const float* W, int K, int N, bf16* dst, const float* gk, LAS float* scr, int k0, int n0, int lane) {
#pragma unroll 8
    for (int i = 0; i < 32; ++i) { const int kk = 2 * i + (lane >> 5); scr[kk * 33 + (lane & 31)] = W[(size_t)(k0 + kk) * N + n0 + (lane & 31)]; }
    const int c = lane & 7;
    f32x4 ga = {1.f, 1.f, 1.f, 1.f}, gb = ga;
    if (gk) { ga = *(const f32x4*)(gk + k0 + 8 * c); gb = *(const f32x4*)(gk + k0 + 8 * c + 4); }
    LDS_WAIT(); asm volatile("" ::: "memory");
#pragma unroll
    for (int j = 0; j < 4; ++j) { const int n = (lane >> 3) + 8 * j; const LAS float* s = scr + (8 * c) * 33 + n;
        u32x4 o; o.x = cvtpk(s[0 * 33] * ga[0], s[1 * 33] * ga[1]); o.y = cvtpk(s[2 * 33] * ga[2], s[3 * 33] * ga[3]); o.z = cvtpk(s[4 * 33] * gb[0], s[5 * 33] * gb[1]); o.w = cvtpk(s[6 * 33] * gb[2], s[7 * 33] * gb[3]);
        *(u32x4*)(dst + (size_t)n * K + k0 + 8 * c) = o; }
    LDS_WAIT(); asm volatile("" ::: "memory");
}
__device__ __forceinline__ void transpose_matrix(const float* W, int K, int N, bf16* WT, int nsplit, bf16* WT2, const float* gk, LAS float* scr, int gw, int NGW, int lane) {
    const int nblk = N / 32, nitems = (K / 64) * nblk;
    for (int it = gw; it < nitems; it += NGW) { const int kb = it / nblk, nb = it - kb * nblk, n0 = 32 * nb;
        bf16* dst = n0 < nsplit ? WT + (size_t)n0 * K : WT2 + (size_t)(n0 - nsplit) * K;
        transpose_item(W, K, N, dst, gk, scr, 64 * kb, n0, lane); }
}
__device__ __forceinline__ float row_to_bf16(const float* xrow, bf16* orow, int lane) {
    float s = 0.f;
#pragma unroll
    for (int j = 0; j < 8; ++j) { const int c = (j * 64 + lane) * 8;
        const f32x4 a = *(const f32x4*)(xrow + c), b = *(const f32x4*)(xrow + c + 4);
        const bf16x8 o = pack8(a, b); const u32x4 w = __builtin_bit_cast(u32x4, o);
        s += (bflo(w.x) * bflo(w.x) + bfhi(w.x) * bfhi(w.x)) + (bflo(w.y) * bflo(w.y) + bfhi(w.y) * bfhi(w.y)) + (bflo(w.z) * bflo(w.z) + bfhi(w.z) * bfhi(w.z)) + (bflo(w.w) * bflo(w.w) + bfhi(w.w) * bfhi(w.w));
        *(bf16x8*)(orow + c) = o; }
    return wave_sum(s);
}

template <int NS>
__device__ __forceinline__ void skinny_gemm(const bf16* A1, const bf16* WSK, const ssq_t* sumsq, int r0, LAS float* res, int wid, int lane) {
    constexpr int NT = NS / 32;
    const int mt = wid & 3, ng = wid >> 2, fr = lane & 15, fq = lane >> 4;
    f32x4 acc[NT];
#pragma unroll
    for (int t = 0; t < NT; ++t) acc[t] = (f32x4){0.f, 0.f, 0.f, 0.f};
    const bf16* ap = A1 + (size_t)(r0 + 16 * mt + fr) * 4096 + 8 * fq;
    const bf16* bp = WSK + (size_t)(16 * ng * NT + fr) * 4096 + 8 * fq;
#pragma unroll 8
    for (int k = 0; k < 4096; k += 32) {
        const bf16x8 a = *(const bf16x8*)(ap + k);
#pragma unroll
        for (int t = 0; t < NT; ++t) { const bf16x8 b = *(const bf16x8*)(bp + (size_t)t * 16 * 4096 + k); acc[t] = __builtin_amdgcn_mfma_f32_16x16x32_bf16(a, b, acc[t], 0, 0, 0); }
    }
#pragma unroll
    for (int i = 0; i < 4; ++i) { const int row = 16 * mt + 4 * fq + i; const float rs = __builtin_amdgcn_rsqf(ssq_val(sumsq[r0 + row]) * (1.0f / 4096.0f) + NORM_EPS);
#pragma unroll
        for (int t = 0; t < NT; ++t) res[row * NS + 16 * (ng * NT + t) + fr] = acc[t][i] * rs; }
}
namespace gdn {
constexpr int PQ = 272;
constexpr int PL = 68;
constexpr int G_Q = 0, G_K = 17408, G_V = 34816, G_L = 52224, G_S = 69632, GRP_BYTES = 70656;
static_assert(2 * GRP_BYTES <= 147456, "gdn prep LDS");

__device__ __forceinline__ void group_barrier(LAS unsigned* cnt, unsigned& target) {
    target += 4u;
    asm volatile("s_waitcnt lgkmcnt(0)" ::: "memory");
    if (__builtin_amdgcn_mbcnt_hi(~0u, __builtin_amdgcn_mbcnt_lo(~0u, ({ unsigned z_ = 0u; asm volatile("" : "+v"(z_)); z_; }))) == 0u) __hip_atomic_fetch_add(cnt, 1u, __ATOMIC_RELAXED, __HIP_MEMORY_SCOPE_WORKGROUP);
    while (__hip_atomic_load(cnt, __ATOMIC_RELAXED, __HIP_MEMORY_SCOPE_WORKGROUP) < target) __builtin_amdgcn_s_sleep(1);
    asm volatile("" ::: "memory");
}
__device__ __forceinline__ void prep_pair(LAS unsigned char* lds, int uid0, const bf16* PROJ, const float* convw, const float* BETA, const float* GLOG, float* GL, unsigned char* REC, unsigned& gbt, const int w0) {
    const int tid = otid(w0), wid = __builtin_amdgcn_readfirstlane(tid >> 6), lane = tid & 63, grp = wid >> 2, gw = wid & 3, gt = tid & 255;
    const int uid = uid0 + grp, bhh = uid >> 7, c = uid & 127, b = bhh >> 5, h = bhh & 31;
    LAS unsigned char* gl = lds + grp * GRP_BYTES;
    LAS float* Lm = (LAS float*)(gl + G_L); LAS float* gcs = (LAS float*)(gl + G_S); LAS float* bes = gcs + 64; LAS float* egs = gcs + 128;
    unsigned char* rec = REC + (size_t)uid * GR_BYTES;
    LAS unsigned* gbc = (LAS unsigned*)(gl + G_S + 768);
    const size_t row0 = (size_t)b * SEQ + (size_t)c * 64;
    float g_ld = 0.f, b_ld = 0.f;
    if (gw == 0) { g_ld = GLOG[(row0 + lane) * 32 + h]; b_ld = BETA[(row0 + lane) * 32 + h]; }
    {
    {
        const int cg = gt & 15, rp = gt >> 4;
        u32x4 raw[2][7];
#define GDN_ROWS(s_, buf_) do { const bf16* bp_ = PROJ + (row0 + 4 * rp - 3) * LDP + (s_) * 4096 + h * 128 + 8 * cg; \
            _Pragma("unroll") for (int jj = 0; jj < 7; ++jj) raw[buf_][jj] = (c * 64 + 4 * rp - 3 + jj >= 0) ? *(const u32x4*)(bp_ + (size_t)jj * LDP) : (u32x4){0u, 0u, 0u, 0u}; } while (0)
        GDN_ROWS(0, 0);
#pragma unroll
        for (int s = 0; s < 3; ++s) {
            const int colb = s * 4096 + h * 128 + 8 * cg;
            f32x4 w[4][2];
#pragma unroll
            for (int j = 0; j < 4; ++j) { w[j][0] = *(const f32x4*)(convw + (size_t)j * 12288 + colb); w[j][1] = *(const f32x4*)(convw + (size_t)j * 12288 + colb + 4); }
            if (s == 0) GDN_ROWS(1, 1); else if (s == 1) GDN_ROWS(2, 0);
            float xr[7][8];
#pragma unroll
            for (int jj = 0; jj < 7; ++jj) unpack8(raw[s & 1][jj], xr[jj]);
#pragma unroll
            for (int i = 0; i < 4; ++i) { const int t = 4 * rp + i; float y[8];
#pragma unroll
                for (int e = 0; e < 8; ++e) y[e] = 0.f;
#pragma unroll
                for (int j = 0; j < 4; ++j)
#pragma unroll
                    for (int e = 0; e < 4; ++e) { y[e] += w[j][0][e] * xr[i + j][e]; y[4 + e] += w[j][1][e] * xr[i + j][4 + e]; }
                float ss = 0.f;
#pragma unroll
                for (int e = 0; e < 8; ++e) { y[e] = siluf_(y[e]); ss += y[e] * y[e]; }
                float sc = 1.f;
                if (s < 2) { ss += __shfl_xor(ss, 1); ss += __shfl_xor(ss, 2); ss += __shfl_xor(ss, 4); ss += __shfl_xor(ss, 8);
                    sc = __builtin_amdgcn_rsqf(ss + NORM_EPS) * (s == 0 ? 0.08838834764831845f : 1.0f); }
                *(LAS bf16x8*)(gl + s * 17408 + t * PQ + cg * 16) = pack8((f32x4){y[0] * sc, y[1] * sc, y[2] * sc, y[3] * sc}, (f32x4){y[4] * sc, y[5] * sc, y[6] * sc, y[7] * sc}); }
        }
#undef GDN_ROWS
    }
    }
    if (gw == 0) { float g = g_ld;
#pragma unroll
        for (int o = 1; o < 64; o <<= 1) { const float t = __int_as_float(__builtin_amdgcn_ds_bpermute((olane_() - o) << 2, __float_as_int(g))); if (lane >= o) g += t;     }
        gcs[lane] = g; bes[lane] = b_ld; egs[lane] = fexp(g);
        if (lane == 63) GL[uid] = fexp(g); }
    group_barrier(gbc, gbt);
    {
    {
        const int fr = lane & 15, fq = lane >> 4, mt = gw;
        bf16x8 kA[4], qA[4];
#pragma unroll
        for (int s = 0; s < 4; ++s) { kA[s] = *(const LAS bf16x8*)(gl + G_K + (16 * mt + fr) * PQ + (32 * s + 8 * fq) * 2); qA[s] = *(const LAS bf16x8*)(gl + G_Q + (16 * mt + fr) * PQ + (32 * s + 8 * fq) * 2); }
        bf16* intra = (bf16*)(rec + GR_IN);
#pragma unroll
        for (int nt = 0; nt < 4; ++nt) { f32x4 kk = {0.f, 0.f, 0.f, 0.f}, qk = {0.f, 0.f, 0.f, 0.f};
#pragma unroll
            for (int s = 0; s < 4; ++s) { const bf16x8 kB = *(const LAS bf16x8*)(gl + G_K + (16 * nt + fr) * PQ + (32 * s + 8 * fq) * 2);
                kk = __builtin_amdgcn_mfma_f32_16x16x32_bf16(kA[s], kB, kk, 0, 0, 0); qk = __builtin_amdgcn_mfma_f32_16x16x32_bf16(qA[s], kB, qk, 0, 0, 0); }
            const int j = 16 * nt + fr; const float gj = gcs[j];
#pragma unroll
            for (int e = 0; e < 4; ++e) { const int i = 16 * mt + 4 * fq + e; const float dec = (i >= j) ? fexp(gcs[i] - gj) : 0.f;
                Lm[i * PL + j] = (i > j) ? bes[i] * kk[e] * dec : 0.f;
                intra[i * 64 + j] = (bf16)(cvtpk(qk[e] * dec, 0.f) & 0xffffu); } }
    }
    {
        const int row = gt >> 2, seg = gt & 3; const float e = egs[row];
#pragma unroll
        for (int q4 = 0; q4 < 4; ++q4) { const u32x4 xw = *(const LAS u32x4*)(gl + G_Q + row * PQ + (seg * 32 + q4 * 8) * 2); float x[8]; unpack8(xw, x);
            *(bf16x8*)(rec + GR_QD + ((size_t)row * 128 + seg * 32 + q4 * 8) * 2) = pack8((f32x4){x[0] * e, x[1] * e, x[2] * e, x[3] * e}, (f32x4){x[4] * e, x[5] * e, x[6] * e, x[7] * e}); }
        const int d = gt & 127, half = gt >> 7; const float g63 = gcs[63];
#pragma unroll
        for (int q4 = 0; q4 < 4; ++q4) { float v[8];
#pragma unroll
            for (int e2 = 0; e2 < 8; ++e2) { const int i = 32 * half + 8 * q4 + e2; v[e2] = bf2f(*(const LAS bf16*)(gl + G_K + i * PQ + d * 2)) * fexp(g63 - gcs[i]); }
            *(bf16x8*)(rec + GR_KT + ((size_t)d * 64 + 32 * half + 8 * q4) * 2) = pack8((f32x4){v[0], v[1], v[2], v[3]}, (f32x4){v[4], v[5], v[6], v[7]}); }
    }
    }
    group_barrier(gbc, gbt);
    if (gt < 128) {
        LAS bf16* vp = (LAS bf16*)(gl + G_V) + gt; LAS bf16* kp = (LAS bf16*)(gl + G_K) + gt;
        f32x2 x[64];
#pragma unroll
        for (int i = 0; i < 64; ++i) {
            f32x4 lr[16];
#pragma unroll
            for (int j4 = 0; j4 < (i + 3) / 4; ++j4) lr[j4] = *(const LAS f32x4*)(Lm + i * PL + 4 * j4);
            const float be = bes[i];
            f32x2 a = {bf2f(vp[i * (PQ / 2)]) * be, bf2f(kp[i * (PQ / 2)]) * be * egs[i]};
            f32x2 acc[4] = {{0.f, 0.f}, {0.f, 0.f}, {0.f, 0.f}, {0.f, 0.f}};
#pragma unroll
            for (int j4 = 0; j4 < (i + 3) / 4; ++j4)
#pragma unroll
                for (int e = 0; e < 4; ++e) if (4 * j4 + e < i) acc[e] += x[4 * j4 + e] * lr[j4][e];
            a -= (acc[0] + acc[1]) + (acc[2] + acc[3]);
            x[i] = a;
        }
#pragma unroll
        for (int i = 0; i < 64; ++i) { const unsigned w = cvtpk(x[i].x, x[i].y);
            vp[i * (PQ / 2)] = (bf16)(w & 0xffffu); kp[i * (PQ / 2)] = (bf16)(w >> 16); }
    }
    group_barrier(gbc, gbt);
    {
        const int row = gt >> 2, seg = gt & 3;
#pragma unroll
        for (int q4 = 0; q4 < 4; ++q4) {
            *(u32x4*)(rec + GR_U + ((size_t)row * 128 + seg * 32 + q4 * 8) * 2) = *(const LAS u32x4*)(gl + G_V + row * PQ + (seg * 32 + q4 * 8) * 2);
            *(u32x4*)(rec + GR_W + ((size_t)row * 128 + seg * 32 + q4 * 8) * 2) = *(const LAS u32x4*)(gl + G_K + row * PQ + (seg * 32 + q4 * 8) * 2); }
    }
    group_barrier(gbc, gbt);
}

constexpr int SP = 272, SPT = 144, SPU = 80;
constexpr int L_QD = 0, L_W = 17408, L_KT = 34816, L_IN = 53248, L_U = 62464, L_BUF = 67584;
constexpr int L_ST = 2 * L_BUF, L_VT = L_ST + 32 * SP, SCAN_LDS = L_VT + 32 * SPT;
static_assert(SCAN_LDS <= 155648, "gdn scan LDS");
__device__ __forceinline__ bf16x8 pack_cc(const f32x4& lo, const f32x4& hi) { const u32x4 w = {cvtpk(lo[0], lo[1]), cvtpk(lo[2], lo[3]), cvtpk(hi[0], hi[1]), cvtpk(hi[2], hi[3])}; return __builtin_bit_cast(bf16x8, w); }
__device__ __forceinline__ void scan_unit(LAS unsigned char* lds, int unit, const unsigned char* REC, const float* GL, float* O32  , const int w0) {
    const int tid = otid(w0), wid = __builtin_amdgcn_readfirstlane(tid >> 6), lane = tid & 63, fr = lane & 15, fq = lane >> 4;
    const int bhh = unit >> 2, q4 = unit & 3, b = bhh >> 5, h = bhh & 31, nt = wid & 1, mt = wid >> 1;
    f32x4 S[2];
    S[0] = (f32x4){0.f, 0.f, 0.f, 0.f}; S[1] = (f32x4){0.f, 0.f, 0.f, 0.f};
    u32x4 st[8];
    int srcoff[8], dstoff[8];
#pragma unroll
    for (int i = 0; i < 8; ++i) { const int p = tid + 512 * i; int so, d;
        if (p < 1024) { so = (int)GR_QD + p * 16; d = L_QD + (p >> 4) * SP + (p & 15) * 16; }
        else if (p < 2048) { const int q = p - 1024; so = (int)GR_W + q * 16; d = L_W + (q >> 4) * SP + (q & 15) * 16; }
        else if (p < 3072) { const int q = p - 2048; so = (int)GR_KT + q * 16; d = L_KT + (q >> 3) * SPT + (q & 7) * 16; }
        else if (p < 3584) { const int q = p - 3072; so = (int)GR_IN + q * 16; d = L_IN + (q >> 3) * SPT + (q & 7) * 16; }
        else { const int q = (p - 3584) & 255; so = (int)GR_U + (q >> 2) * 256 + q4 * 64 + (q & 3) * 16; d = L_U + (q >> 2) * SPU + (q & 3) * 16; }
        srcoff[i] = so; dstoff[i] = d; }
    const bool has8 = tid < 256;
#define GDN_ISSUE(c_) do { const unsigned char* rec_ = REC + ((size_t)bhh * 128 + (c_)) * GR_BYTES; \
        _Pragma("unroll") for (int i = 0; i < 7; ++i) st[i] = *(const u32x4*)(rec_ + srcoff[i]); if (has8) st[7] = *(const u32x4*)(rec_ + srcoff[7]); } while (0)
#define GDN_STASH(buf_) do { LAS unsigned char* bp_ = lds + (buf_) * L_BUF; \
        _Pragma("unroll") for (int i = 0; i < 7; ++i) *(LAS u32x4*)(bp_ + dstoff[i]) = st[i]; if (has8) *(LAS u32x4*)(bp_ + dstoff[7]) = st[7]; } while (0)
    { const u32x4 z4 = ozero4(); for (int i = tid; i < (32 * SP) / 16; i += 512) *(LAS u32x4*)(lds + L_ST + i * 16) = z4; }
    GDN_ISSUE(0); GDN_STASH(0); __syncthreads();
    float gl_n = GL[bhh * 128]; asm volatile("" ::: "memory");
    GDN_ISSUE(1);
    float* orow = O32 + ((size_t)b * SEQ + 16 * mt + 4 * fq) * 4096 + h * 128 + 32 * q4 + 16 * nt + fr;
    const LAS unsigned char* stp = lds + L_ST + (16 * nt + fr) * SP + 16 * fq;
    const LAS unsigned char* vtp = lds + L_VT + (16 * nt + fr) * SPT + 16 * fq;
#pragma unroll 1
    for (int c = 0; c < GDN_NCHUNK; ++c) {
        const LAS unsigned char* bp = lds + (c & 1) * L_BUF;
        const float glast = gl_n;
        bf16x8 Sb[4];
#pragma unroll
        for (int s = 0; s < 4; ++s) Sb[s] = *(const LAS bf16x8*)(stp + 64 * s);
        f32x4 aw = {0.f, 0.f, 0.f, 0.f}, ao = {0.f, 0.f, 0.f, 0.f};
#pragma unroll
        for (int s = 0; s < 4; ++s) { aw = __builtin_amdgcn_mfma_f32_16x16x32_bf16(*(const LAS bf16x8*)(bp + L_W + (16 * mt + fr) * SP + 64 * s + 16 * fq), Sb[s], aw, 0, 0, 0);
            ao = __builtin_amdgcn_mfma_f32_16x16x32_bf16(*(const LAS bf16x8*)(bp + L_QD + (16 * mt + fr) * SP + 64 * s + 16 * fq), Sb[s], ao, 0, 0, 0); }
        f32x4 vn;
#pragma unroll
        for (int e = 0; e < 4; ++e) vn[e] = bf2f(*(const LAS bf16*)(bp + L_U + (16 * mt + 4 * fq + e) * SPU + (16 * nt + fr) * 2)) - aw[e];
        *(LAS u32x2*)(lds + L_VT + (16 * nt + fr) * SPT + (16 * mt + 4 * fq) * 2) = (u32x2){cvtpk(vn[0], vn[1]), cvtpk(vn[2], vn[3])};
        __syncthreads();
        bf16x8 vb[2];
        vb[0] = *(const LAS bf16x8*)vtp; vb[1] = *(const LAS bf16x8*)(vtp + 64);
#pragma unroll
        for (int s2 = 0; s2 < 2; ++s2) ao = __builtin_amdgcn_mfma_f32_16x16x32_bf16(*(const LAS bf16x8*)(bp + L_IN + (16 * mt + fr) * SPT + 64 * s2 + 16 * fq), vb[s2], ao, 0, 0, 0);
#pragma unroll
        for (int kk = 0; kk < 2; ++kk) { f32x4 a = S[kk] * glast;
#pragma unroll
            for (int s2 = 0; s2 < 2; ++s2) a = __builtin_amdgcn_mfma_f32_16x16x32_bf16(*(const LAS bf16x8*)(bp + L_KT + (16 * (2 * mt + kk) + fr) * SPT + 64 * s2 + 16 * fq), vb[s2], a, 0, 0, 0);
            S[kk] = a;
            *(LAS u32x2*)(lds + L_ST + (16 * nt + fr) * SP + (16 * (2 * mt + kk) + 4 * fq) * 2) = (u32x2){cvtpk(a[0], a[1]), cvtpk(a[2], a[3])}; }
#pragma unroll
        for (int e = 0; e < 4; ++e) orow[(size_t)(c * 64 + e) * 4096] = ao[e];
        if (c + 1 < GDN_NCHUNK) GDN_STASH((c + 1) & 1);
        __syncthreads();
        if (c + 1 < GDN_NCHUNK) { gl_n = GL[bhh * 128 + c + 1]; asm volatile("" ::: "memory"); }
        if (c + 2 < GDN_NCHUNK) GDN_ISSUE(c + 2);
    }
#undef GDN_ISSUE
#undef GDN_STASH
}
__device__ __forceinline__ void normgate(int gwv, int NGW, int lane, const float* O32, const bf16* PROJ, const float* normw, bf16* MIX) {
    const f32x4 n0 = *(const f32x4*)(normw + ((lane & 15) * 8)), n1 = *(const f32x4*)(normw + ((lane & 15) * 8) + 4);
#pragma unroll 2
    for (int it = gwv; it < M_TOK * 8; it += NGW) { const int row = it >> 3, c8 = (it & 7) * 512 + lane * 8;
        const f32x4 o0 = *(const f32x4*)(O32 + (size_t)row * 4096 + c8), o1 = *(const f32x4*)(O32 + (size_t)row * 4096 + c8 + 4);
        const u32x4 zw = *(const u32x4*)(PROJ + (size_t)row * LDP + ZCOL + c8); float z[8]; unpack8(zw, z);
        float q = (o0[0] * o0[0] + o0[1] * o0[1]) + (o0[2] * o0[2] + o0[3] * o0[3]) + (o1[0] * o1[0] + o1[1] * o1[1]) + (o1[2] * o1[2] + o1[3] * o1[3]);
        q += __shfl_xor(q, 1); q += __shfl_xor(q, 2); q += __shfl_xor(q, 4); q += __shfl_xor(q, 8);
        const float rs = __builtin_amdgcn_rsqf(q * (1.0f / 128.0f) + NORM_EPS);
        f32x4 r0, r1;
#pragma unroll
        for (int e = 0; e < 4; ++e) { r0[e] = o0[e] * rs * n0[e] * siluf_(z[e]); r1[e] = o1[e] * rs * n1[e] * siluf_(z[4 + e]); }
        *(bf16x8*)(MIX + (size_t)row * 4096 + c8) = pack8(r0, r1); }
}
}
namespace s5 {
__device__ __forceinline__ void sincos_cw(float x, float& s, float& c) {
    const float kf = rintf(x * 0.6366197723675814f); const int k = (int)kf;
    float r = fmaf(kf, -1.5703125f, x); r = fmaf(kf, -4.837512969970703125e-4f, r); r = fmaf(kf, -7.54978995489188e-8f, r);
    const float r2 = r * r;
    float c1 = -1.9515295891e-4f, c2 = 8.3321608736e-3f, c3 = 2.443315711809948e-5f, c4 = -1.388731625493765e-3f; asm volatile("" : "+v"(c1), "+v"(c2), "+v"(c3), "+v"(c4));
    const float sp = fmaf(r * r2, fmaf(r2, fmaf(r2, c1, c2), -1.6666654611e-1f), r);
    const float cp = fmaf(r2 * r2, fmaf(r2, fmaf(r2, c3, c4), 4.166664568298827e-2f), fmaf(r2, -0.5f, 1.0f));
    const int q = k & 3;
    s = (q == 0) ? sp : (q == 1) ? cp : (q == 2) ? -sp : -cp;
    c = (q == 0) ? cp : (q == 1) ? -sp : (q == 2) ? -cp : sp;
}
__device__ __forceinline__ void zoh_of(int g, int p, const float* LRE, const float* LIM, const float* LSTEP, float& lr, float& li, float& zr, float& zi) {
    const float lam_re = LRE[g * 64 + p], lam_im = LIM[g * 64 + p], step = fexp(LSTEP[g]);
    const float mag = fexp(lam_re * step); float sn, cs; sincos_cw(lam_im * step, sn, cs);
    lr = mag * cs; li = mag * sn;
    const float den = lam_re * lam_re + lam_im * lam_im, num_re = lr - 1.0f;
    zr = (num_re * lam_re + li * lam_im) / den; zi = (li * lam_re - num_re * lam_im) / den;
}
struct Disc { float lr, li; bf16x8 bh[8], bl[8]; };
__device__ __forceinline__ void discretise(Disc& d, int g, int lane, const float* LRE, const float* LIM, const float* BRE, const float* BIM, const float* LSTEP) {
    float zr, zi; zoh_of(g, lane, LRE, LIM, LSTEP, d.lr, d.li, zr, zi);
    const int fr = lane & 15, fq = lane >> 4, n0 = 8 * (fq & 1);
#pragma unroll
    for (int t = 0; t < 4; ++t) { const int p = 16 * t + fr; float lr, li; zoh_of(g, p, LRE, LIM, LSTEP, lr, li, zr, zi);
        const float* br = BRE + (size_t)(g * 64 + p) * 16 + n0; const float* bi = BIM + (size_t)(g * 64 + p) * 16 + n0;
        const f32x4 r0 = *(const f32x4*)br, r1 = *(const f32x4*)(br + 4), i0 = *(const f32x4*)bi, i1 = *(const f32x4*)(bi + 4);
        const f32x4 re0 = r0 * zr - i0 * zi, re1 = r1 * zr - i1 * zi, im0 = i0 * zr + r0 * zi, im1 = i1 * zr + r1 * zi;
        const u32x4 rh = __builtin_bit_cast(u32x4, pack8(re0, re1)), ih = __builtin_bit_cast(u32x4, pack8(im0, im1));
        float rhf[8], ihf[8]; unpack8(rh, rhf); unpack8(ih, ihf);
        const f32x4 rl0 = {re0[0] - rhf[0], re0[1] - rhf[1], re0[2] - rhf[2], re0[3] - rhf[3]}, rl1 = {re1[0] - rhf[4], re1[1] - rhf[5], re1[2] - rhf[6], re1[3] - rhf[7]};
        const f32x4 il0 = {im0[0] - ihf[0], im0[1] - ihf[1], im0[2] - ihf[2], im0[3] - ihf[3]}, il1 = {im1[0] - ihf[4], im1[1] - ihf[5], im1[2] - ihf[6], im1[3] - ihf[7]};
        const bf16x8 zero8 = {0, 0, 0, 0, 0, 0, 0, 0};
        d.bh[t] = __builtin_bit_cast(bf16x8, rh); d.bh[4 + t] = __builtin_bit_cast(bf16x8, ih);
        d.bl[t] = fq < 2 ? pack8(rl0, rl1) : zero8; d.bl[4 + t] = fq < 2 ? pack8(il0, il1) : zero8; }
}
constexpr int BUP = 20;
__device__ __forceinline__ void bu_tile(const Disc& d, const LAS float* us, LAS float* but, int t0, int lane) {
    const int fr = lane & 15, fq = lane >> 4;
    const f32x4 u0 = *(const LAS f32x4*)(us + (t0 + fr) * 16 + 8 * (fq & 1)), u1 = *(const LAS f32x4*)(us + (t0 + fr) * 16 + 8 * (fq & 1) + 4);
    const u32x4 uh = __builtin_bit_cast(u32x4, pack8(u0, u1)); float uhf[8]; unpack8(uh, uhf);
    const f32x4 l0 = {u0[0] - uhf[0], u0[1] - uhf[1], u0[2] - uhf[2], u0[3] - uhf[3]}, l1 = {u1[0] - uhf[4], u1[1] - uhf[5], u1[2] - uhf[6], u1[3] - uhf[7]};
    const bf16x8 af = fq < 2 ? __builtin_bit_cast(bf16x8, uh) : pack8(l0, l1);
    f32x4 accs[8];
#pragma unroll
    for (int ct = 0; ct < 8; ++ct) { f32x4 acc = {0.f, 0.f, 0.f, 0.f};
        acc = __builtin_amdgcn_mfma_f32_16x16x32_bf16(af, d.bh[ct], acc, 0, 0, 0);
        accs[ct] = __builtin_amdgcn_mfma_f32_16x16x32_bf16(af, d.bl[ct], acc, 0, 0, 0); }
    asm volatile("s_nop 15\n\ts_nop 15" : "+v"(accs[0]), "+v"(accs[1]), "+v"(accs[2]), "+v"(accs[3]), "+v"(accs[4]), "+v"(accs[5]), "+v"(accs[6]), "+v"(accs[7]));
#pragma unroll
    for (int ct = 0; ct < 8; ++ct) *(LAS f32x4*)(but + (16 * ct + fr) * BUP + 4 * fq) = accs[ct];
}
struct Slab { f32x4 r[4]; };
__device__ __forceinline__ void slab_issue(Slab& s, const float* up  , int lane) {
#pragma unroll
    for (int i = 0; i < 4; ++i) { const int pc = 64 * i + lane; s.r[i] = *(const f32x4*)(up + (size_t)(pc >> 2) * 4096 + (pc & 3) * 4); }
}
__device__ __forceinline__ void slab_store(const Slab& s, LAS float* us, int lane) {
#pragma unroll
    for (int i = 0; i < 4; ++i) { const int pc = 64 * i + lane; *(LAS f32x4*)(us + pc * 4) = s.r[i]; }
}
__device__ __forceinline__ void pass1(LAS float* us, LAS float* but, int gwv, int NGW, int lane, const float* U32, const float* LRE, const float* LIM, const float* BRE, const float* BIM, const float* LSTEP, f32x2* ENDST) {
#pragma unroll 1
    for (int wu = gwv; wu < BATCH * SSM_G * SSM_NSEG; wu += NGW) {
        const int g = wu & 255, seg = (wu >> 8) & (SSM_NSEG - 1), b = wu >> 13, bg = b * 256 + g;
        Disc d; discretise(d, g, lane, LRE, LIM, BRE, BIM, LSTEP);
        const float* up = U32 + ((size_t)b * SEQ + (size_t)seg * SSM_SL) * 4096 + 16 * g;
        float xr = 0.f, xi = 0.f;
        Slab sl; slab_issue(sl, up, lane);
#pragma unroll 1
        for (int tb = 0; tb < SSM_SL; tb += 64) {
            slab_store(sl, us, lane);
            if (tb + 64 < SSM_SL) slab_issue(sl, up + (size_t)(tb + 64) * 4096, lane);
#pragma unroll 1
            for (int t0 = 0; t0 < 64; t0 += 16) {
                bu_tile(d, us, but, t0, lane);
                f32x4 brv[4], biv[4];
#pragma unroll
                for (int q = 0; q < 4; ++q) { brv[q] = *(const LAS f32x4*)(but + lane * BUP + 4 * q); biv[q] = *(const LAS f32x4*)(but + (64 + lane) * BUP + 4 * q); }
#pragma unroll
                for (int t = 0; t < 16; ++t) { const float br = brv[t >> 2][t & 3], bi = biv[t >> 2][t & 3];
                    const float nr = fmaf(d.lr, xr, fmaf(-d.li, xi, br)), ni = fmaf(d.lr, xi, fmaf(d.li, xr, bi)); xr = nr; xi = ni; }
            }
        }
        ENDST[((size_t)bg * SSM_NSEG + seg) * 64 + lane] = (f32x2){xr, xi};
    }
}
__device__ __forceinline__ float gelu_tanh(float y) { const float a = 0.7978845608028654f * (y + 0.044715f * y * y * y); const float t = 1.0f - 2.0f * __builtin_amdgcn_rcpf(1.0f + fexp(2.0f * a)); return 0.5f * y * (1.0f + t); }
constexpr int XP = 272;
__device__ __forceinline__ void pass2(LAS unsigned char* xt  , int gwv, int NGW, int lane, const float* U32, const float* LRE, const float* LIM, const float* BRE, const float* BIM,
                                      const float* CRE, const float* CIM, const float* LSTEP, const float* DSK, const f32x2* ENDST, bf16* Y1) {
    const int fr = lane & 15, fq = lane >> 4;
    LAS float* us = (LAS float*)(xt + 16 * XP); LAS float* but = (LAS float*)(xt + 16 * XP + 4096);
#pragma unroll 1
    for (int wu = gwv; wu < BATCH * SSM_G * SSM_NSEG; wu += NGW) {
        const int g = wu & 255, seg = (wu >> 8) & (SSM_NSEG - 1), b = wu >> 13, bg = b * 256 + g;
        Disc d; discretise(d, g, lane, LRE, LIM, BRE, BIM, LSTEP);
        const size_t row0 = (size_t)b * SEQ + (size_t)seg * SSM_SL;
        const float* up = U32 + row0 * 4096 + 16 * g;
        Slab sl; slab_issue(sl, up, lane);
        float pr = d.lr, pi = d.li;
#pragma unroll
        for (int i = 0; i < 8; ++i) { const float a = pr * pr - pi * pi, c = 2.0f * pr * pi; pr = a; pi = c; }
        float xr = 0.f, xi = 0.f;
#pragma unroll 1
        for (int s = 0; s < seg; ++s) { const f32x2 e = ENDST[((size_t)bg * SSM_NSEG + s) * 64 + lane];
            const float nr = fmaf(pr, xr, fmaf(-pi, xi, e.x)), ni = fmaf(pr, xi, fmaf(pi, xr, e.y)); xr = nr; xi = ni; }
        bf16x8 cf[4];
#pragma unroll
        for (int s = 0; s < 4; ++s) { const float* cp = (s < 2 ? CRE : CIM) + (size_t)(g * 16 + fr) * 64 + 32 * (s & 1) + 8 * fq; const float sg = s < 2 ? 1.0f : -1.0f;
            const f32x4 a = *(const f32x4*)cp * sg, c = *(const f32x4*)(cp + 4) * sg; cf[s] = pack8(a, c); }
        const float dsk = DSK[16 * g + fr];
#pragma unroll 1
        for (int tb = 0; tb < SSM_SL; tb += 64) {
            slab_store(sl, us, lane);
            if (tb + 64 < SSM_SL) slab_issue(sl, up + (size_t)(tb + 64) * 4096, lane);
#pragma unroll 1
            for (int t0 = 0; t0 < 64; t0 += 16) {
                bu_tile(d, us, but, t0, lane);
                f32x4 brv[4], biv[4];
#pragma unroll
                for (int q = 0; q < 4; ++q) { brv[q] = *(const LAS f32x4*)(but + lane * BUP + 4 * q); biv[q] = *(const LAS f32x4*)(but + (64 + lane) * BUP + 4 * q); }
#pragma unroll
                for (int t = 0; t < 16; ++t) { const float br = brv[t >> 2][t & 3], bi = biv[t >> 2][t & 3];
                    const float nr = fmaf(d.lr, xr, fmaf(-d.li, xi, br)), ni = fmaf(d.lr, xi, fmaf(d.li, xr, bi)); xr = nr; xi = ni;
                    const unsigned w = cvtpk(xr, xi);
                    *(LAS bf16*)(xt + t * XP + lane * 2) = (bf16)(w & 0xffffu); *(LAS bf16*)(xt + t * XP + 128 + lane * 2) = (bf16)(w >> 16); }
                LDS_WAIT();
                f32x4 acc = {0.f, 0.f, 0.f, 0.f};
#pragma unroll
                for (int s = 0; s < 4; ++s) { const bf16x8 xa = *(const LAS bf16x8*)(xt + fr * XP + (32 * s + 8 * fq) * 2); acc = __builtin_amdgcn_mfma_f32_16x16x32_bf16(xa, cf[s], acc, 0, 0, 0); }
#pragma unroll
                for (int e = 0; e < 4; ++e) { const int tl = t0 + 4 * fq + e; const float u = us[tl * 16 + fr];
                    const float y = gelu_tanh(acc[e] + dsk * u);
                    Y1[(row0 + tb + tl) * 4096 + 16 * g + fr] = (bf16)(cvtpk(y, 0.f) & 0xffffu); }
                LDS_WAIT();
            }
        }
    }
}
}
constexpr int PH_PER_LAYER = 10, PH_FINAL = 40, PH_END = 41;
__host__ __device__ constexpr bool phase_exists(int ph) {
    if (ph == PH_FINAL) return true; if (ph < 0 || ph >= PH_FINAL) return false;
    const int L = ph / PH_PER_LAYER, k = ph % PH_PER_LAYER, kind = L % 3;
    if (k == 4) return kind != 0; return k <= 6;
}
typedef const __attribute__((address_space(4))) Args* kargs_t;
#define KARGS() ({ kargs_t p_ = (kargs_t)__builtin_amdgcn_kernarg_segment_ptr(); asm volatile("" : "+s"(p_)); p_; })
#define WSP(T, off) ((T*)(ws + (off)))
__global__ void __launch_bounds__(NTHR, 2) trunk_fwd(Args args_unused) {
    extern __shared__ __attribute__((aligned(16))) unsigned char lds_raw[];
    LAS unsigned char* lds = (LAS unsigned char*)lds_raw;
    const int w0 = __builtin_amdgcn_readfirstlane(threadIdx.x >> 6);
    const int G = gridDim.x, bx = blockIdx.x, vcu = (G % 8 == 0) ? (bx % 8) * (G / 8) + bx / 8 : bx, NGW = G * NWAVES;
#define TIDS() const int tid = otid(w0), lane = tid & 63, wid = __builtin_amdgcn_readfirstlane(tid >> 6), gwv = vcu * NWAVES + wid; (void)lane; (void)gwv
    { volatile LAS unsigned* MISC = (volatile LAS unsigned*)(lds + MISC_OFF); if (threadIdx.x < 32) MISC[threadIdx.x] = 0u; }
    __syncthreads();
    int lo, hi;
    { kargs_t ap = KARGS(); lo = ap->ph_lo; hi = ap->ph_hi;
      if (hi - lo > 1) (void)xcd_barrier_post((unsigned*)(ap->ws + WS_CTL) + CW_BAR + ap->li * XCD_BAR_WORDS, (volatile LAS unsigned*)(lds + MISC_OFF) + 8); }
#define IN(k) (lo <= (k) && (k) < hi)
#define SEAM(k) do { if ((k) + 1 < hi) { kargs_t ap_ = KARGS(); XcdBarrier b_; b_.bar = (unsigned*)(ap_->ws + WS_CTL) + CW_BAR + ap_->li * XCD_BAR_WORDS; b_.x = xb_xcc_id(); \
        b_.st = (volatile LAS unsigned*)(lds + MISC_OFF) + 8; b_.tid = (unsigned)otid(w0); xcd_barrier(b_); } } while (0)

#pragma unroll 1
    for (int L = 0; L < DEPTH; ++L) {
        const int base = L * PH_PER_LAYER, kind = L % 3, j = L / 3;

        if (IN(base + 0)) {
            kargs_t ap = KARGS(); unsigned char* ws = ap->ws; TIDS();
            LAS float* scr = (LAS float*)(lds + wid * 16384);
            const int n_in = kind == 0 ? 16416 : kind == 1 ? 16448 : 8192;
            const float* w_in = kind == 0 ? ap->in[I_FOX_WIN] + (size_t)j * 4096 * 16416 : kind == 1 ? ap->in[I_GDN_WIN] : ap->in[I_SSM_WIN];
            const float* w_out = kind == 0 ? ap->in[I_FOX_WOUT] + (size_t)j * 4096 * 4096 : kind == 1 ? ap->in[I_GDN_WOUT] : ap->in[I_SSM_WOUT];
            transpose_matrix(w_in, 4096, n_in, WSP(bf16, WS_WIN), 16384, WSP(bf16, WS_WSK), ap->in[I_NORM_MIX] + (size_t)L * D_MODEL, scr, gwv, NGW, lane);
            transpose_matrix(w_out, 4096, 4096, WSP(bf16, WS_WOUT), 4096, WSP(bf16, WS_WOUT), nullptr, scr, gwv, NGW, lane);
            transpose_matrix(ap->in[I_PLE_WGATE] + (size_t)L * 4096 * 4096, 4096, 4096, WSP(bf16, WS_WGATE), 4096, WSP(bf16, WS_WGATE), ap->in[I_NORM_PLE] + (size_t)L * D_MODEL, scr, gwv, NGW, lane);
            transpose_matrix(ap->in[I_PLE_WPROJ] + (size_t)L * 256 * 4096, 256, 4096, WSP(bf16, WS_WPP), 4096, WSP(bf16, WS_WPP), nullptr, scr, gwv, NGW, lane);
            if (kind == 2) transpose_matrix(ap->in[I_SSM_WGLU], 4096, 4096, WSP(bf16, WS_WGLU), 4096, WSP(bf16, WS_WGLU), nullptr, scr, gwv, NGW, lane);
            { const float* p = ap->in[I_P] + (size_t)L * M_TOK * PLE_DIM; bf16* P_BF = WSP(bf16, WS_PBF);
              for (size_t i = (size_t)bx * NTHR + tid; i < (size_t)M_TOK * PLE_DIM / 8; i += (size_t)G * NTHR) {
                  const f32x4 a = *(const f32x4*)(p + i * 8), b = *(const f32x4*)(p + i * 8 + 4); *(bf16x8*)(P_BF + i * 8) = pack8(a, b); } }
            if (L == 0) { const float* x = ap->in[I_X]; bf16* X0 = WSP(bf16, WS_X0); ssq_t* ssq_in = SSQ_PTR(0);
                for (int m = gwv; m < M_TOK; m += NGW) { const float s = row_to_bf16(x + (size_t)m * 4096, X0 + (size_t)m * 4096, lane); if (lane == 0) ssq_in[m] = ssq_fix(s); } }
            __syncthreads();
            SEAM(base + 0);
        }
        if (IN(base + 1)) {
            kargs_t ap = KARGS(); unsigned char* ws = ap->ws; TIDS();
            const bf16* A1 = WSP(bf16, WS_X0); const ssq_t* ssq_in = SSQ_PTR(2 * L);
            if (kind != 2) {
                LAS float* res = (LAS float*)lds; const bf16* W_SK = WSP(bf16, WS_WSK);
                for (int un = vcu; un < M_TOK / 64; un += G) {
                    const int r0 = un * 64;
                    if (kind == 0) {
                        float* CUML = WSP(float, WS_SMALL + SM_CUML); float* TTOT = WSP(float, WS_SMALL + SM_TTOT);
                        skinny_gemm<32>(A1, W_SK, ssq_in, r0, res, wid, lane);
                        __syncthreads();
                        if (tid < 32) { const int h = tid; const float bf = ap->in[I_FOX_BF][j * 32 + h]; float run = 0.f;
                            for (int r = 0; r < 64; ++r) { const float x = res[r * 32 + h] + bf; const float lf = fminf(x, 0.f) - flog(1.0f + fexp(-fabsf(x))); run += lf; CUML[(size_t)(r0 + r) * 32 + h] = run; }
                            TTOT[(size_t)un * 32 + h] = run; }
                    } else {
                        float* BETA = WSP(float, WS_SMALL + SM_BETA); float* GLOG = WSP(float, WS_SMALL + SM_GLOG);
                        const float* dtb = ap->in[I_GDN_DTB]; const float* alog = ap->in[I_GDN_ALOG];
                        skinny_gemm<64>(A1, W_SK, ssq_in, r0, res, wid, lane);
                        __syncthreads();
                        for (int e = tid; e < 64 * 32; e += NTHR) { const int r = e >> 5, h = e & 31;
                            BETA[(size_t)(r0 + r) * 32 + h] = sigmoidf_(res[r * 64 + h]);
                            const float x = res[r * 64 + 32 + h] + dtb[h]; const float sp = fmaxf(x, 0.f) + flog(1.0f + fexp(-fabsf(x)));
                            GLOG[(size_t)(r0 + r) * 32 + h] = -fexp(alog[h]) * sp; }
                    }
                    __syncthreads();
                }
            }
            const int n_main = kind == 2 ? 8192 : 16384;
            pg8::Gemm g{A1, WSP(bf16, WS_WIN), M_TOK, n_main, 4096}; pg8::StaticOrder S; S.init(M_TOK, n_main, G, bx);
            pg8::EpiProj E{kind == 2 ? WSP(bf16, WS_PROJ) + 8192 : WSP(bf16, WS_PROJ), LDP, ssq_in, WSP(float, WS_SCR + SS_U32), kind == 2 ? 4096 : 0};
            pg8::gemm_phase<pg8::EpiProj, pg8::StaticOrder, true, true>(lds, g, S, E, w0);
            SEAM(base + 1);
        }
        if (IN(base + 2)) {
            kargs_t ap = KARGS(); unsigned char* ws = ap->ws; TIDS();
            if (kind == 0) {
                { const bf16* PROJ = WSP(bf16, WS_PROJ); float* QN2 = WSP(float, WS_SMALL + SM_QN2); float* KN2 = WSP(float, WS_SMALL + SM_KN2);
                  for (int it = gwv; it < BATCH * NHEAD * 128; it += NGW) fox::norm_item(PROJ, QN2, KN2, it, lane); }
                { const float* CUML = WSP(float, WS_SMALL + SM_CUML); const float* TTOT = WSP(float, WS_SMALL + SM_TTOT); float* CUM = WSP(float, WS_SMALL + SM_CUM);
                  LAS float* ps = (LAS float*)lds; LAS float* ct = ps + 512; LAS float* pr = ct + 64 * 33;
                  for (int un = vcu; un < BATCH * 128; un += G) { const int b = un >> 7, tile = un & 127, h = tid & 31, part = tid >> 5;
                      float sum = 0.f;
                      for (int tp = part; tp < tile; tp += 16) sum += TTOT[(size_t)(b * 128 + tp) * 32 + h];
                      ps[part * 32 + h] = sum;
                      { const f32x4 cv = *(const f32x4*)(CUML + ((size_t)b * SEQ + 64 * tile) * 32 + tid * 4); const int t = (tid * 4) >> 5, hh = (tid * 4) & 31;
#pragma unroll
                        for (int e = 0; e < 4; ++e) ct[t * 33 + hh + e] = cv[e]; }
                      __syncthreads();
                      if (tid < 32) { float p = 0.f;
#pragma unroll
                          for (int q = 0; q < 16; ++q) p += ps[q * 32 + tid];
                          pr[tid] = p; }
                      __syncthreads();
                      { const int t = tid & 63, hg = tid >> 6;
#pragma unroll
                        for (int k = 0; k < 4; ++k) { const int hh = hg * 4 + k; CUM[(size_t)(b * 32 + hh) * SEQ + 64 * tile + t] = pr[hh] + ct[t * 33 + hh]; } }
                      __syncthreads(); } }
            } else if (kind == 1) {
                const bf16* PROJ = WSP(bf16, WS_PROJ); const float* convw = ap->in[I_GDN_CONV]; const float* BETA = WSP(float, WS_SMALL + SM_BETA); const float* GLOG = WSP(float, WS_SMALL + SM_GLOG);
                float* GLT = WSP(float, WS_SMALL + SM_GL); unsigned char* REC = ws + WS_SCR;
                if (tid < 2) *(LAS unsigned*)(lds + tid * gdn::GRP_BYTES + gdn::G_S + 768) = 0u;
                __syncthreads();
                unsigned gbt = 0u;
                for (int pi = vcu; pi < BATCH * NHEAD * GDN_NCHUNK / 2; pi += G) gdn::prep_pair(lds, 2 * pi, PROJ, convw, BETA, GLOG, GLT, REC, gbt, w0);
                __syncthreads();
            } else if (kind == 2) {
                s5::pass1((LAS float*)(lds + wid * 16384), (LAS float*)(lds + wid * 16384 + 4096), gwv, NGW, lane, WSP(float, WS_SCR + SS_U32), ap->in[I_SSM_LRE], ap->in[I_SSM_LIM], ap->in[I_SSM_BRE], ap->in[I_SSM_BIM], ap->in[I_SSM_LSTEP], WSP(f32x2, WS_ENDST));
            }
            SEAM(base + 2);
        }
        if (IN(base + 3)) {
            kargs_t ap = KARGS(); unsigned char* ws = ap->ws; TIDS();
            if (kind == 0) fox::attn_phase((char*)lds_raw, WSP(bf16, WS_PROJ), WSP(bf16, WS_MIX), WSP(float, WS_SMALL + SM_CUM), WSP(float, WS_SMALL + SM_QN2), WSP(float, WS_SMALL + SM_KN2), vcu, G, w0);
            else if (kind == 1) { for (int un = vcu; un < BATCH * NHEAD * 4; un += G) gdn::scan_unit(lds, un, ws + WS_SCR, WSP(float, WS_SMALL + SM_GL), ap->out, w0); }
            else if (kind == 2) s5::pass2(lds + wid * 18944, gwv, NGW, lane, WSP(float, WS_SCR + SS_U32), ap->in[I_SSM_LRE], ap->in[I_SSM_LIM], ap->in[I_SSM_BRE], ap->in[I_SSM_BIM], ap->in[I_SSM_CRE], ap->in[I_SSM_CIM],
                           ap->in[I_SSM_LSTEP], ap->in[I_SSM_D], WSP(f32x2, WS_ENDST), WSP(bf16, WS_SCR + SS_Y1));
            SEAM(base + 3);
        }
        if (IN(base + 4) && kind == 1) {
            kargs_t ap = KARGS(); unsigned char* ws = ap->ws; TIDS();
            if (kind == 1) gdn::normgate(gwv, NGW, lane, ap->out, WSP(bf16, WS_PROJ), ap->in[I_GDN_NORM], WSP(bf16, WS_MIX));
            SEAM(base + 4);
        }
        if (IN(base + 4) && kind == 2) {
            kargs_t ap = KARGS(); unsigned char* ws = ap->ws; TIDS();
            pg8::Gemm g{WSP(bf16, WS_SCR + SS_Y1), WSP(bf16, WS_WGLU), M_TOK, 4096, 4096}; pg8::StaticOrder S; S.init(M_TOK, 4096, G, bx);
            pg8::EpiGlu E{WSP(bf16, WS_MIX), WSP(bf16, WS_SCR + SS_Y1), WSP(bf16, WS_PROJ) + ZCOL, LDP, ap->in[I_SSM_BGLU]};
            if (kind == 2) pg8::gemm_phase<pg8::EpiGlu, pg8::StaticOrder, true, true>(lds, g, S, E, w0);
            SEAM(base + 4);
        }
        if (IN(base + 5)) {
            { kargs_t ap = KARGS(); unsigned char* ws = ap->ws;
                  pg8::Gemm g{WSP(bf16, WS_PBF), WSP(bf16, WS_WPP), M_TOK, 4096, 256}; pg8::StaticOrder S; S.init(M_TOK, 4096, G, bx);
                  pg8::EpiProj E{WSP(bf16, WS_PP), 4096, nullptr, nullptr, 0};
                  pg8::gemm_phase<pg8::EpiProj, pg8::StaticOrder, true, true>(lds, g, S, E, w0); }
            { kargs_t ap = KARGS(); unsigned char* ws = ap->ws;
                  pg8::Gemm g{WSP(bf16, WS_MIX), WSP(bf16, WS_WOUT), M_TOK, 4096, 4096}; pg8::StaticOrder S; S.init(M_TOK, 4096, G, bx);
                  pg8::EpiOut E{WSP(bf16, WS_X0), WSP(bf16, WS_X1), SSQ_PTR(2 * L + 1)};
                  pg8::gemm_phase<pg8::EpiOut, pg8::StaticOrder, true, true>(lds, g, S, E, w0); }
            SEAM(base + 5);
        }
        if (IN(base + 6)) {
            kargs_t ap = KARGS(); unsigned char* ws = ap->ws; TIDS();
            pg8::Gemm g{WSP(bf16, WS_X1), WSP(bf16, WS_WGATE), M_TOK, 4096, 4096}; pg8::StaticOrder S; S.init(M_TOK, 4096, G, bx);
            pg8::EpiGate E{WSP(bf16, WS_X1), WSP(bf16, WS_X0), WSP(bf16, WS_PP), SSQ_PTR(2 * L + 1), SSQ_PTR(2 * L + 2)};
            pg8::gemm_phase<pg8::EpiGate, pg8::StaticOrder, true, true>(lds, g, S, E, w0);
            SEAM(base + 6);
        }
    }
    if (IN(PH_FINAL)) {
        kargs_t ap = KARGS(); unsigned char* ws = ap->ws; float* H = ap->out; TIDS();
        const float* gf = ap->in[I_FINAL_NORM]; const ssq_t* ssq = SSQ_PTR(8); const bf16* X0 = WSP(bf16, WS_X0);
        const unsigned bad = __hip_atomic_load(WSP(unsigned, WS_CTL) + CW_BAR + XB_TMO, __ATOMIC_RELAXED, __HIP_MEMORY_SCOPE_AGENT);
        for (int m = gwv; m < M_TOK; m += NGW) { const float rs = bad ? __builtin_nanf("") : __builtin_amdgcn_rsqf(ssq_val(ssq[m]) * (1.0f / 4096.0f) + NORM_EPS); float* row = H + (size_t)m * 4096;
#pragma unroll
            for (int jj = 0; jj < 8; ++jj) { const int c = (jj * 64 + lane) * 8; const u32x4 w = *(const u32x4*)(X0 + (size_t)m * 4096 + c);
                const f32x4 g0 = *(const f32x4*)(gf + c), g1 = *(const f32x4*)(gf + c + 4);
                const f32x4 v0 = {bflo(w.x), bfhi(w.x), bflo(w.y), bfhi(w.y)}, v1 = {bflo(w.z), bfhi(w.z), bflo(w.w), bfhi(w.w)};
                *(f32x4*)(row + c) = v0 * rs * g0; *(f32x4*)(row + c + 4) = v1 * rs * g1; } }
    }
#undef IN
#undef SEAM
}

extern "C" void kernel_launch(void* const* d_in, const int* in_sizes, int n_in, void* d_out, int out_size, void* d_ws, size_t ws_size, hipStream_t stream) {
    static int grid = 0;
    if (grid == 0) {
        if (n_in != 28 || out_size != M_TOK * D_MODEL || ws_size < WS_END) { fprintf(stderr, "kernel_launch: unexpected shapes (n_in %d, out %d, ws %zu)\n", n_in, out_size, ws_size); grid = -1; return; }
        int dev = 0, cus = 0, per_cu = 0;
        if (hipGetDevice(&dev) != hipSuccess || hipDeviceGetAttribute(&cus, hipDeviceAttributeMultiprocessorCount, dev) != hipSuccess) { grid = -1; return; }
        if (hipFuncSetAttribute((const void*)trunk_fwd, hipFuncAttributeMaxDynamicSharedMemorySize, LDS_BYTES) != hipSuccess) { fprintf(stderr, "kernel_launch: hipFuncSetAttribute failed\n"); grid = -1; return; }
        if (hipOccupancyMaxActiveBlocksPerMultiprocessor(&per_cu, (const void*)trunk_fwd, NTHR, LDS_BYTES) != hipSuccess || per_cu < 1) { fprintf(stderr, "kernel_launch: occupancy query says %d\n", per_cu); per_cu = 1; }
        (void)hipGetLastError();
        grid = cus;
    }
    if (grid < 0) return;
    if (hipMemsetAsync((char*)d_ws + WS_CTL, 0, CTL_ZERO_BYTES, stream) != hipSuccess) return;
    Args a{};
    for (int i = 0; i < 28; ++i) a.in[i] = (const float*)d_in[i];
    a.out = (float*)d_out; a.ws = (unsigned char*)d_ws;
#if MK_PER_PHASE
    int li = 0;
    for (int ph = 0; ph < PH_END; ++ph) { if (!phase_exists(ph)) continue;
        a.ph_lo = ph; a.ph_hi = ph + 1; a.li = li++; a.pad = 0;
        hipLaunchKernelGGL(trunk_fwd, dim3(grid), dim3(NTHR), LDS_BYTES, stream, a); }
#elif defined(PROBE_PH)
    { int li = 0; const int cut = PROBE_PH + PROBE_LEN;
      a.ph_lo = 0; a.ph_hi = cut; a.li = li++; a.pad = 0; hipLaunchKernelGGL(trunk_fwd, dim3(grid), dim3(NTHR), LDS_BYTES, stream, a);
      a.pad = PROBE_MODE;
      for (int r = 0; r < PROBE_N; ++r) { a.ph_lo = PROBE_PH; a.ph_hi = cut; a.li = li++; hipLaunchKernelGGL(trunk_fwd, dim3(grid), dim3(NTHR), LDS_BYTES, stream, a); }
      a.pad = 0; a.ph_lo = cut; a.ph_hi = PH_END; a.li = li++; hipLaunchKernelGGL(trunk_fwd, dim3(grid), dim3(NTHR), LDS_BYTES, stream, a); }
#else
    a.ph_lo = 0; a.ph_hi = PH_END; a.li = 0; a.pad = 0;
    hipLaunchKernelGGL(trunk_fwd, dim3(grid), dim3(NTHR), LDS_BYTES, stream, a);
#endif
}
```

```cpp
#include <hip/hip_runtime.h>
#include <cstdio>
#include <cstdint>

#ifndef MK_PER_PHASE
#define MK_PER_PHASE 0
#endif

constexpr int D_MODEL = 4096, BATCH = 2, SEQ = 8192, DEPTH = 4, PLE_DIM = 256;
constexpr int M_TOK = BATCH * SEQ;
constexpr int NHEAD = 32, HDIM = 128;
constexpr float NORM_EPS = 1e-6f;
constexpr int LDP = 16384;
constexpr int ZCOL = 12288;
constexpr int GDN_CHUNK = 64, GDN_NCHUNK = SEQ / GDN_CHUNK;
constexpr int SSM_G = 256, SSM_N = 16, SSM_P = 64, SSM_SL = 256, SSM_NSEG = SEQ / SSM_SL;

constexpr size_t MiB = 1u << 20;
constexpr size_t WS_CTL = 0, CTL_ZERO_BYTES = 2 * MiB;
constexpr size_t WS_WIN = 2 * MiB;
constexpr size_t WS_WSK = 130 * MiB;
constexpr size_t WS_WOUT = 131 * MiB;
constexpr size_t WS_WGATE = 163 * MiB;
constexpr size_t WS_WPP = 195 * MiB;
constexpr size_t WS_WGLU = 197 * MiB;
constexpr size_t WS_PBF = 229 * MiB;
constexpr size_t WS_X0 = 237 * MiB;
constexpr size_t WS_X1 = 365 * MiB;
constexpr size_t WS_PROJ = 493 * MiB;
constexpr size_t WS_MIX = 1005 * MiB;
constexpr size_t WS_PP = 1133 * MiB;
constexpr size_t WS_SCR = 1261 * MiB;
constexpr size_t WS_SMALL = 1837 * MiB;
constexpr size_t WS_ENDST = 1846 * MiB;
constexpr size_t WS_END = 1854 * MiB;
constexpr size_t GR_QD = 0, GR_W = 16384, GR_KT = 32768, GR_U = 49152, GR_IN = 65536, GR_BYTES = 73728;
constexpr size_t SS_U32 = 0, SS_Y1 = 256 * MiB, SS_END = 384 * MiB;
constexpr size_t SM_CUML = 0;
constexpr size_t SM_TTOT = 2 * MiB;
constexpr size_t SM_CUM = 2 * MiB + 65536;
constexpr size_t SM_QN2 = 2 * MiB + 32768;
constexpr size_t SM_KN2 = 4 * MiB + 65536;
constexpr size_t SM_BETA = 5 * MiB;
constexpr size_t SM_GLOG = 7 * MiB;
constexpr size_t SM_SS = SM_CUM;
constexpr size_t SM_GL = 0;
static_assert(SM_CUM + 64 * 8192 * 4 <= SM_BETA && SM_GLOG + (size_t)M_TOK * 32 * 4 <= 9 * MiB, "small tables");
static_assert(WS_SMALL + 9 * MiB <= WS_ENDST && WS_ENDST + 8 * MiB <= WS_END, "ws end");
constexpr int CW_TMO = 0, CW_CODE = 1, CW_ERR = 1024  , CW_BAR = 16384  ;
typedef unsigned long long ssq_t;
constexpr size_t CTL_SUMSQ = 1 * MiB;
constexpr size_t WS_SSQ0 = 130 * MiB + 512 * 1024;
constexpr float SSQ_SCALE = 16777216.0f, SSQ_INV = 1.0f / 16777216.0f;
#define SSQ_PTR(i) ((ssq_t*)(ws + ((i) == 0 ? WS_SSQ0 : CTL_SUMSQ + (size_t)((i) - 1) * M_TOK * sizeof(ssq_t))))

#define LAS __attribute__((address_space(3)))
#define GAS __attribute__((address_space(1)))
typedef unsigned short bf16;
typedef short bf16x8 __attribute__((ext_vector_type(8)));
typedef short s16x4 __attribute__((ext_vector_type(4)));
typedef float f32x2 __attribute__((ext_vector_type(2)));
typedef float f32x4 __attribute__((ext_vector_type(4)));
typedef float f32x16 __attribute__((ext_vector_type(16)));
typedef unsigned u32x2 __attribute__((ext_vector_type(2)));
typedef unsigned u32x4 __attribute__((ext_vector_type(4)));
#define LDS_WAIT() asm volatile("s_waitcnt lgkmcnt(0)" ::: "memory")
#define VM_WAIT() asm volatile("s_waitcnt vmcnt(0)" ::: "memory")
typedef __bf16 bf16x2_t __attribute__((ext_vector_type(2)));
__device__ __forceinline__ unsigned cvtpk(float lo, float hi) { const f32x2 v = {lo, hi}; const bf16x2_t b = __builtin_convertvector(v, bf16x2_t); return __builtin_bit_cast(unsigned, b); }
__device__ __forceinline__ ssq_t ssq_fix(float s) { return (ssq_t)(s * 16777216.0f + 0.5f); }
__device__ __forceinline__ float ssq_val(ssq_t x) { return ((float)(unsigned)(x >> 32) * 4294967296.0f + (float)(unsigned)x) * (1.0f / 16777216.0f); }
__device__ __forceinline__ float bf2f(unsigned short b) { return __uint_as_float(((unsigned)b) << 16); }
__device__ __forceinline__ float bflo(unsigned w) { return __uint_as_float(w << 16); }
__device__ __forceinline__ float bfhi(unsigned w) { return __uint_as_float(w & 0xffff0000u); }
__device__ __forceinline__ float fexp(float x) { return __builtin_amdgcn_exp2f(x * 1.4426950408889634f); }
__device__ __forceinline__ float flog(float x) { return __builtin_amdgcn_logf(x) * 0.6931471805599453f; }
__device__ __forceinline__ float sigmoidf_(float x) { return __builtin_amdgcn_rcpf(1.0f + fexp(-x)); }
__device__ __forceinline__ float siluf_(float x) { return x * sigmoidf_(x); }
__device__ __forceinline__ bf16x8 pack8(f32x4 a, f32x4 b) { u32x4 w = {cvtpk(a[0], a[1]), cvtpk(a[2], a[3]), cvtpk(b[0], b[1]), cvtpk(b[2], b[3])}; return __builtin_bit_cast(bf16x8, w); }
__device__ __forceinline__ void unpack8(u32x4 w, float* f) { f[0] = bflo(w.x); f[1] = bfhi(w.x); f[2] = bflo(w.y); f[3] = bfhi(w.y); f[4] = bflo(w.z); f[5] = bfhi(w.z); f[6] = bflo(w.w); f[7] = bfhi(w.w); }
__device__ __forceinline__ float wave_sum(float v) {
#pragma unroll
    for (int o = 1; o < 64; o <<= 1) v += __shfl_xor(v, o);
    return v;
}
__device__ __forceinline__ int otid(int w0) { unsigned z = 0u; asm volatile("" : "+v"(z));
    int t = (w0 << 6) | (int)__builtin_amdgcn_mbcnt_hi(~0u, __builtin_amdgcn_mbcnt_lo(~0u, z)); asm volatile("" : "+v"(t)); return t; }
__device__ __forceinline__ u32x4 ozero4() { u32x4 z = {0u, 0u, 0u, 0u}; asm volatile("" : "+v"(z)); return z; }
namespace pg8 {
#define PG8_LAS __attribute__((address_space(3)))
typedef unsigned short bf16_t;
typedef short bf16x8 __attribute__((ext_vector_type(8)));
typedef float f32x4 __attribute__((ext_vector_type(4)));
typedef unsigned u32x4 __attribute__((ext_vector_type(4)));
constexpr int BM = 256, BK = 64, HALF = 128, HTB = HALF * BK * 2  , STAGE_BYTES = 8 * HTB, NXCD = 8, WGM = 8;

__host__ __device__ __forceinline__ int lds_byte(int r, int c) { const int st = (r >> 4) * 2 + (c >> 5), rr = r & 15, cc = c & 31, ob = rr * 64 + cc * 2; return st * 1024 + (ob ^ (((ob >> 9) & 1) << 5)); }
__host__ __device__ __forceinline__ void stage_rc(int b, int& R, int& C) { const int st = b / 1024, sb = b % 1024, swz = sb ^ (((sb >> 9) & 1) << 5); R = (st >> 1) * 16 + swz / 64; C = (st & 1) * 32 + (swz % 64) / 2; }
__host__ __device__ __forceinline__ int perm32(int rho) { const int n = rho >> 4, i = rho & 15; return 8 * (i >> 2) + 4 * n + (i & 3); }

struct Unit { int pm, pn; };
struct Gemm { const bf16_t* A; const bf16_t* Bt; int M, N, K; };

struct StaticOrder {
    int nM, nN, nwg, G, c;
    __host__ __device__ void init(int M, int N, int G_, int c_) { nM = M / BM; nN = N / BM; nwg = nM * nN; G = G_; c = c_; }
    __host__ __device__ bool next(int i, Unit& u) const {
        const long L = (long)i * G + c; if (L >= nwg) return false;
        int wgid = (int)L; { const int q = nwg / NXCD, r = nwg % NXCD, xcd = wgid % NXCD, off = wgid / NXCD; wgid = (xcd < r ? xcd * (q + 1) : r * (q + 1) + (xcd - r) * q) + off; }
        const int nig = WGM * nN, gid = wgid / nig, fm = gid * WGM, gsz = (nM - fm) < WGM ? (nM - fm) : WGM;
        u.pm = fm + ((wgid % nig) % gsz); u.pn = (wgid % nig) / gsz; return true;
    }
    __device__ __forceinline__ void a_ready(const Unit&) const {}
    __device__ __forceinline__ void done(const Unit&) const {}
};
__device__ __forceinline__ unsigned cvt_pk_bf16(float lo, float hi) { return ::cvtpk(lo, hi); }
__device__ __forceinline__ float sgm(float x) { return __builtin_amdgcn_rcpf(1.0f + __builtin_amdgcn_exp2f(x * -1.4426950408889634f)); }
__device__ __forceinline__ float bl(unsigned w) { return __uint_as_float(w << 16); }
__device__ __forceinline__ float bh(unsigned w) { return __uint_as_float(w & 0xffff0000u); }
constexpr float kEps = 1e-6f, kInvD = 1.0f / 4096.0f;
#ifndef EPI_RB
#define EPI_RB 4
#endif

struct EpiProj {
    static constexpr bool PERM = true, AFTER_DRAIN = false;
    bf16_t* O; int ldc; const ssq_t* sumsq; float* F32O; int f32cols;
    __device__ __forceinline__ void operator()(const f32x4 (&acc)[2][2][4][2], const Unit& u, int wr, int wc, int fr, int fq) const {
        const int row0 = u.pm * BM + wr * 64 + fr, colt = u.pn * BM, col0 = colt + wc * 32 + 8 * fq;
        const bool tof32 = colt < f32cols;
        ssq_t rsv[2][4];
#pragma unroll
        for (int ai = 0; ai < 2; ++ai)
#pragma unroll
            for (int m = 0; m < 4; ++m) rsv[ai][m] = sumsq ? sumsq[row0 + ai * HALF + m * 16] : 0ull;
#pragma unroll
        for (int ai = 0; ai < 2; ++ai)
#pragma unroll
            for (int m = 0; m < 4; ++m) { const int r = row0 + ai * HALF + m * 16;
                const float rs = sumsq ? __builtin_amdgcn_rsqf(ssq_val(rsv[ai][m]) * kInvD + kEps) : 1.0f;
#pragma unroll
                for (int bj = 0; bj < 2; ++bj) { const f32x4 v0 = acc[ai][bj][m][0] * rs, v1 = acc[ai][bj][m][1] * rs; const int c = col0 + bj * HALF;
                    if (tof32) { float* p = F32O + (size_t)r * f32cols + c; *(__attribute__((address_space(1))) f32x4*)p = v0; *(__attribute__((address_space(1))) f32x4*)(p + 4) = v1; }
                    else { u32x4 w; w.x = cvt_pk_bf16(v0[0], v0[1]); w.y = cvt_pk_bf16(v0[2], v0[3]); w.z = cvt_pk_bf16(v1[0], v1[1]); w.w = cvt_pk_bf16(v1[2], v1[3]);
                        *(u32x4*)(O + (size_t)r * ldc + c) = w; } } }
    }
};
struct EpiOut {
    static constexpr bool PERM = true, AFTER_DRAIN = false;
    const bf16_t* hin; bf16_t* hout; ssq_t* sumsq2;
    __device__ __forceinline__ void operator()(const f32x4 (&acc)[2][2][4][2], const Unit& u, int wr, int wc, int fr, int fq) const {
        const int row0 = u.pm * BM + wr * 64 + fr, col0 = u.pn * BM + wc * 32 + 8 * fq;
#pragma unroll
        for (int ai = 0; ai < 2; ++ai)
#pragma unroll
          for (int mp = 0; mp < 4 / EPI_RB; ++mp) {
            u32x4 hv[EPI_RB][2];
#pragma unroll
            for (int mm = 0; mm < EPI_RB; ++mm)
#pragma unroll
                for (int bj = 0; bj < 2; ++bj) hv[mm][bj] = *(const u32x4*)(hin + (size_t)(row0 + ai * HALF + (EPI_RB * mp + mm) * 16) * 4096 + col0 + bj * HALF);
#pragma unroll
            for (int mm = 0; mm < EPI_RB; ++mm) { const int m = EPI_RB * mp + mm, r = row0 + ai * HALF + m * 16; float s = 0.f;
#pragma unroll
                for (int bj = 0; bj < 2; ++bj) { const size_t off = (size_t)r * 4096 + col0 + bj * HALF; const u32x4 hw = hv[mm][bj];
                    const f32x4 v0 = f32x4{bl(hw.x), bh(hw.x), bl(hw.y), bh(hw.y)} + acc[ai][bj][m][0], v1 = f32x4{bl(hw.z), bh(hw.z), bl(hw.w), bh(hw.w)} + acc[ai][bj][m][1];
                    u32x4 w; w.x = cvt_pk_bf16(v0[0], v0[1]); w.y = cvt_pk_bf16(v0[2], v0[3]); w.z = cvt_pk_bf16(v1[0], v1[1]); w.w = cvt_pk_bf16(v1[2], v1[3]);
                    *(u32x4*)(hout + off) = w;
                    s += (bl(w.x) * bl(w.x) + bh(w.x) * bh(w.x)) + (bl(w.y) * bl(w.y) + bh(w.y) * bh(w.y)) + (bl(w.z) * bl(w.z) + bh(w.z) * bh(w.z)) + (bl(w.w) * bl(w.w) + bh(w.w) * bh(w.w)); }
                s += __shfl_xor(s, 16); s += __shfl_xor(s, 32);
                if (fq == 0) atomicAdd(sumsq2 + r, ssq_fix(s)); }
            asm volatile("" ::: "memory"); }
    }
};
struct EpiGate {
    static constexpr bool PERM = true, AFTER_DRAIN = false;
    const bf16_t* hin; bf16_t* hout; const bf16_t* PP; const ssq_t* sumsq2; ssq_t* sumsqn;
    __device__ __forceinline__ void operator()(const f32x4 (&acc)[2][2][4][2], const Unit& u, int wr, int wc, int fr, int fq) const {
        const int row0 = u.pm * BM + wr * 64 + fr, col0 = u.pn * BM + wc * 32 + 8 * fq;
        ssq_t rsv[2][4];
#pragma unroll
        for (int ai = 0; ai < 2; ++ai)
#pragma unroll
            for (int m = 0; m < 4; ++m) rsv[ai][m] = sumsq2[row0 + ai * HALF + m * 16];
#pragma unroll
        for (int ai = 0; ai < 2; ++ai)
#pragma unroll
            for (int mp = 0; mp < 4 / EPI_RB; ++mp) {
                u32x4 hv[EPI_RB][2], pv[EPI_RB][2];
#pragma unroll
                for (int mm = 0; mm < EPI_RB; ++mm)
#pragma unroll
                    for (int bj = 0; bj < 2; ++bj) { const size_t off = (size_t)(row0 + ai * HALF + (EPI_RB * mp + mm) * 16) * 4096 + col0 + bj * HALF;
                        pv[mm][bj] = *(const u32x4*)(PP + off); hv[mm][bj] = *(const u32x4*)(hin + off); }
#pragma unroll
                for (int mm = 0; mm < EPI_RB; ++mm) { const int m = EPI_RB * mp + mm, r = row0 + ai * HALF + m * 16; float s = 0.f;
                    const float rs = __builtin_amdgcn_rsqf(ssq_val(rsv[ai][m]) * kInvD + kEps);
#pragma unroll
                    for (int bj = 0; bj < 2; ++bj) { const size_t off = (size_t)r * 4096 + col0 + bj * HALF;
                        const u32x4 pw = pv[mm][bj], hw = hv[mm][bj];
                        const f32x4 p0 = {bl(pw.x), bh(pw.x), bl(pw.y), bh(pw.y)}, p1 = {bl(pw.z), bh(pw.z), bl(pw.w), bh(pw.w)};
                        f32x4 g0 = acc[ai][bj][m][0] * rs, g1 = acc[ai][bj][m][1] * rs;
#pragma unroll
                        for (int j = 0; j < 4; ++j) { g0[j] = sgm(g0[j]); g1[j] = sgm(g1[j]); }
                        const f32x4 v0 = f32x4{bl(hw.x), bh(hw.x), bl(hw.y), bh(hw.y)} + g0 * p0, v1 = f32x4{bl(hw.z), bh(hw.z), bl(hw.w), bh(hw.w)} + g1 * p1;
                        u32x4 w; w.x = cvt_pk_bf16(v0[0], v0[1]); w.y = cvt_pk_bf16(v0[2], v0[3]); w.z = cvt_pk_bf16(v1[0], v1[1]); w.w = cvt_pk_bf16(v1[2], v1[3]);
                        *(u32x4*)(hout + off) = w;
                        s += (bl(w.x) * bl(w.x) + bh(w.x) * bh(w.x)) + (bl(w.y) * bl(w.y) + bh(w.y) * bh(w.y)) + (bl(w.z) * bl(w.z) + bh(w.z) * bh(w.z)) + (bl(w.w) * bl(w.w) + bh(w.w) * bh(w.w)); }
                    s += __shfl_xor(s, 16); s += __shfl_xor(s, 32);
                    if (fq == 0) atomicAdd(sumsqn + r, ssq_fix(s)); }
                asm volatile("" ::: "memory"); }
    }
};
struct EpiGlu {
    static constexpr bool PERM = true, AFTER_DRAIN = false;
    bf16_t* O; const bf16_t* Y1; const bf16_t* Z; int ldz; const float* bias;
    __device__ __forceinline__ void operator()(const f32x4 (&acc)[2][2][4][2], const Unit& u, int wr, int wc, int fr, int fq) const {
        const int row0 = u.pm * BM + wr * 64 + fr, col0 = u.pn * BM + wc * 32 + 8 * fq;
        f32x4 bv[2][2];
#pragma unroll
        for (int bj = 0; bj < 2; ++bj) { bv[bj][0] = *(const f32x4*)(bias + col0 + bj * HALF); bv[bj][1] = *(const f32x4*)(bias + col0 + bj * HALF + 4); }
#pragma unroll
        for (int ai = 0; ai < 2; ++ai)
#pragma unroll
            for (int m = 0; m < 4; ++m) { const int r = row0 + ai * HALF + m * 16;
#pragma unroll
                for (int bj = 0; bj < 2; ++bj) { const int c = col0 + bj * HALF;
                    const u32x4 yw = *(const u32x4*)(Y1 + (size_t)r * 4096 + c), zw = *(const u32x4*)(Z + (size_t)r * ldz + c);
                    const f32x4 y0 = {bl(yw.x), bh(yw.x), bl(yw.y), bh(yw.y)}, y1 = {bl(yw.z), bh(yw.z), bl(yw.w), bh(yw.w)};
                    const f32x4 z0 = {bl(zw.x), bh(zw.x), bl(zw.y), bh(zw.y)}, z1 = {bl(zw.z), bh(zw.z), bl(zw.w), bh(zw.w)};
                    f32x4 g0 = acc[ai][bj][m][0] + bv[bj][0], g1 = acc[ai][bj][m][1] + bv[bj][1];
#pragma unroll
                    for (int j = 0; j < 4; ++j) { g0[j] = y0[j] * sgm(g0[j]) * (z0[j] * sgm(z0[j])); g1[j] = y1[j] * sgm(g1[j]) * (z1[j] * sgm(z1[j])); }
                    u32x4 w; w.x = cvt_pk_bf16(g0[0], g0[1]); w.y = cvt_pk_bf16(g0[2], g0[3]); w.z = cvt_pk_bf16(g1[0], g1[1]); w.w = cvt_pk_bf16(g1[2], g1[3]);
                    *(u32x4*)(O + (size_t)r * 4096 + c) = w; }
                asm volatile("" ::: "memory"); }
    }
};
template <class Epi, class Sched, bool ALIGN_EPI = false, bool SP2 = false>
__device__ __forceinline__ void gemm_phase(PG8_LAS unsigned char* lds, const Gemm g, const Sched& S, const Epi& E, const int w0) {
    const int tid = otid(w0), wid = __builtin_amdgcn_readfirstlane(tid >> 6), lane = tid & 63, wr = wid >> 2, wc = wid & 3, fr = lane & 15, fq = lane >> 4;
    const int K = g.K, nt = K / BK;
    unsigned voffA[2], voffB[2];
#pragma unroll
    for (int i = 0; i < 2; ++i) { int R, C; stage_rc(tid * 16 + i * 8192, R, C); const int Rb = Epi::PERM ? ((R & ~31) + perm32(R & 31)) : R;
        voffA[i] = (unsigned)(R * K + C) * 2u; voffB[i] = (unsigned)(Rb * K + C) * 2u; }
    const size_t kstep = (size_t)(BK * 2);
    const size_t hstep = (size_t)HALF * K * 2;
    const size_t tstep = 2 * hstep;
    const unsigned ldsw = (unsigned)wid * 1024u;
    const int aoff = lds_byte(wr * 64 + fr, fq * 8), boff = lds_byte(wc * 32 + fr, fq * 8);
#define PG8_SA(b, h) (((b) * 2 + (h)) * HTB)
#define PG8_SB(b, h) ((4 + (b) * 2 + (h)) * HTB)
#define PG8_STAGE(bufoff, gbase, voff) do { _Pragma("unroll") for (int _i = 0; _i < 2; ++_i) \
        __builtin_amdgcn_global_load_lds((const unsigned*)((const char*)(gbase) + (voff)[_i]), (PG8_LAS unsigned*)(lds + (bufoff) + ldsw + _i * 8192), 16, 0, 0); } while (0)
#define PG8_LDA(dst, b, h) do { _Pragma("unroll") for (int m = 0; m < 4; ++m) _Pragma("unroll") for (int k = 0; k < 2; ++k) dst[m][k] = *(const PG8_LAS bf16x8*)(lds + PG8_SA(b, h) + aoff + m * 2048 + k * 1024); } while (0)
#define PG8_LDB(dst, b, h) do { _Pragma("unroll") for (int n = 0; n < 2; ++n) _Pragma("unroll") for (int k = 0; k < 2; ++k) dst[n][k] = *(const PG8_LAS bf16x8*)(lds + PG8_SB(b, h) + boff + n * 2048 + k * 1024); } while (0)
#define PG8_MMA(ai, bj, At, Bt) do { __builtin_amdgcn_s_setprio(1); _Pragma("unroll") for (int m = 0; m < 4; ++m) _Pragma("unroll") for (int n = 0; n < 2; ++n) _Pragma("unroll") for (int k = 0; k < 2; ++k) \
        acc[ai][bj][m][n] = __builtin_amdgcn_mfma_f32_16x16x32_bf16(Bt[n][k], At[m][k], acc[ai][bj][m][n], 0, 0, 0); __builtin_amdgcn_s_setprio(0); } while (0)
#define PG8_WAIT_V(n) asm volatile("s_waitcnt vmcnt(" #n ")" ::: "memory")
#define PG8_WAIT_L(n) asm volatile("s_waitcnt lgkmcnt(" #n ")" ::: "memory")
#define PG8_BAR __builtin_amdgcn_s_barrier()
#define PG8_SCHED __builtin_amdgcn_sched_barrier(0)
    Unit cur, nxt; int ui = 0;
    if (!S.next(0, cur)) return;
    f32x4 acc[2][2][4][2];
#pragma unroll
    for (int a = 0; a < 2; ++a)
#pragma unroll
        for (int b = 0; b < 2; ++b)
#pragma unroll
            for (int m = 0; m < 4; ++m)
#pragma unroll
                for (int n = 0; n < 2; ++n) acc[a][b][m][n] = (f32x4){0.f, 0.f, 0.f, 0.f};
    bf16x8 At[4][2], B0[2][2], B1[2][2];
    const char* cA = (const char*)g.A + (size_t)cur.pm * tstep; const char* cB = (const char*)g.Bt + (size_t)cur.pn * tstep;
    S.a_ready(cur);
    if constexpr (SP2) {
        PG8_STAGE(PG8_SB(0, 0), cB, voffB); PG8_STAGE(PG8_SB(0, 1), cB + hstep, voffB); PG8_STAGE(PG8_SA(0, 0), cA, voffA); PG8_STAGE(PG8_SA(0, 1), cA + hstep, voffA);
        if (wr == 1) PG8_BAR;
        PG8_WAIT_V(2); PG8_BAR;
        PG8_STAGE(PG8_SB(1, 0), cB + kstep, voffB); PG8_STAGE(PG8_SA(1, 0), cA + kstep, voffA); PG8_STAGE(PG8_SB(1, 1), cB + hstep + kstep, voffB);
        PG8_WAIT_V(6); PG8_BAR;
    } else {
        PG8_STAGE(PG8_SB(0, 0), cB, voffB); PG8_STAGE(PG8_SA(0, 0), cA, voffA); PG8_STAGE(PG8_SB(0, 1), cB + hstep, voffB); PG8_STAGE(PG8_SA(0, 1), cA + hstep, voffA);
        if (wr == 1) PG8_BAR;
        PG8_WAIT_V(4); PG8_BAR;
        PG8_STAGE(PG8_SB(1, 0), cB + kstep, voffB); PG8_STAGE(PG8_SA(1, 0), cA + kstep, voffA); PG8_STAGE(PG8_SB(1, 1), cB + hstep + kstep, voffB);
        PG8_WAIT_V(6); PG8_BAR;
    }
    for (;;) {
        const bool has_next = S.next(ui + 1, nxt);
        const char* nA = has_next ? (const char*)g.A + (size_t)nxt.pm * tstep : cA; const char* nB = has_next ? (const char*)g.Bt + (size_t)nxt.pn * tstep : cB;
        for (int t = 0; t < nt; t += 2) {
            const bool last = (t == nt - 2);
            const char* a1 = cA + (size_t)(t + 1) * kstep;
            const char* a2 = last ? nA : cA + (size_t)(t + 2) * kstep; const char* b2 = last ? nB : cB + (size_t)(t + 2) * kstep;
            const char* a3 = a2 + kstep; const char* b3 = b2 + kstep;
            if (last && has_next) S.a_ready(nxt);
            if constexpr (SP2) {
            PG8_LDB(B0, 0, 0); PG8_LDB(B1, 0, 1); PG8_SCHED; PG8_LDA(At, 0, 0); PG8_STAGE(PG8_SA(1, 1), a1 + hstep, voffA);
            PG8_WAIT_V(8); PG8_WAIT_L(0); PG8_BAR; PG8_MMA(0, 0, At, B0); PG8_MMA(0, 1, At, B1); PG8_BAR; PG8_SCHED;
            PG8_LDA(At, 0, 1); PG8_STAGE(PG8_SB(0, 0), b2, voffB); PG8_STAGE(PG8_SB(0, 1), b2 + hstep, voffB); PG8_STAGE(PG8_SA(0, 0), a2, voffA);
            PG8_WAIT_V(8); PG8_WAIT_L(0); PG8_BAR; PG8_MMA(1, 0, At, B0); PG8_MMA(1, 1, At, B1); PG8_BAR; PG8_SCHED;
            PG8_LDB(B0, 1, 0); PG8_LDB(B1, 1, 1); PG8_SCHED; PG8_LDA(At, 1, 0); PG8_STAGE(PG8_SA(0, 1), a2 + hstep, voffA);
            PG8_WAIT_V(8); PG8_WAIT_L(0); PG8_BAR; PG8_MMA(0, 0, At, B0); PG8_MMA(0, 1, At, B1); PG8_BAR; PG8_SCHED;
            PG8_LDA(At, 1, 1); PG8_STAGE(PG8_SB(1, 0), b3, voffB); PG8_STAGE(PG8_SB(1, 1), b3 + hstep, voffB); PG8_STAGE(PG8_SA(1, 0), a3, voffA);
            PG8_WAIT_V(8); PG8_WAIT_L(0); PG8_BAR; PG8_MMA(1, 0, At, B0); PG8_MMA(1, 1, At, B1); PG8_BAR; PG8_SCHED;
            } else {
            PG8_LDB(B0, 0, 0); PG8_SCHED; PG8_LDA(At, 0, 0); PG8_STAGE(PG8_SA(1, 1), a1 + hstep, voffA);
            PG8_WAIT_L(8); PG8_BAR; PG8_WAIT_L(0); PG8_MMA(0, 0, At, B0); PG8_BAR; PG8_SCHED;
            PG8_LDB(B1, 0, 1); PG8_STAGE(PG8_SB(0, 0), b2, voffB);
            PG8_BAR; PG8_WAIT_L(0); PG8_MMA(0, 1, At, B1); PG8_BAR;
            PG8_LDA(At, 0, 1); PG8_STAGE(PG8_SA(0, 0), a2, voffA);
            PG8_BAR; PG8_WAIT_L(0); PG8_MMA(1, 0, At, B0); PG8_BAR; PG8_SCHED;
            PG8_STAGE(PG8_SB(0, 1), b2 + hstep, voffB);
            PG8_WAIT_V(6); PG8_BAR; PG8_MMA(1, 1, At, B1); PG8_BAR;
            PG8_LDB(B0, 1, 0); PG8_SCHED; PG8_LDA(At, 1, 0); PG8_STAGE(PG8_SA(0, 1), a2 + hstep, voffA);
            PG8_WAIT_L(8); PG8_BAR; PG8_WAIT_L(0); PG8_MMA(0, 0, At, B0); PG8_BAR; PG8_SCHED;
            PG8_LDB(B1, 1, 1); PG8_STAGE(PG8_SB(1, 0), b3, voffB);
            PG8_BAR; PG8_WAIT_L(0); PG8_MMA(0, 1, At, B1); PG8_BAR;
            PG8_LDA(At, 1, 1); PG8_STAGE(PG8_SA(1, 0), a3, voffA);
            PG8_BAR; PG8_WAIT_L(0); PG8_MMA(1, 0, At, B0); PG8_BAR; PG8_SCHED;
            PG8_STAGE(PG8_SB(1, 1), b3 + hstep, voffB);
            PG8_WAIT_V(6); PG8_BAR; PG8_MMA(1, 1, At, B1); PG8_BAR;
            }
        }
        if constexpr (ALIGN_EPI) { if (wr == 0) PG8_BAR; }
        if constexpr (!Epi::AFTER_DRAIN) { E(acc, cur, wr, wc, fr, fq); S.done(cur); }
        if (!has_next) break;
#pragma unroll
        for (int a = 0; a < 2; ++a)
#pragma unroll
            for (int b = 0; b < 2; ++b)
#pragma unroll
                for (int m = 0; m < 4; ++m)
#pragma unroll
                    for (int n = 0; n < 2; ++n) acc[a][b][m][n] = (f32x4){0.f, 0.f, 0.f, 0.f};
        cur = nxt; cA = nA; cB = nB; ++ui;
        if constexpr (ALIGN_EPI) { if (wr == 1) PG8_BAR; }
    }
    PG8_WAIT_V(0);
    if constexpr (!ALIGN_EPI) { if (wr == 0) PG8_BAR; }
    PG8_BAR;
    if constexpr (Epi::AFTER_DRAIN) { E.fused(acc, cur, wr, wc, fr, fq, lds, wid, lane); S.done(cur); }
#undef PG8_SA
#undef PG8_SB
#undef PG8_STAGE
#undef PG8_LDA
#undef PG8_LDB
#undef PG8_MMA
#undef PG8_WAIT_V
#undef PG8_WAIT_L
#undef PG8_BAR
#undef PG8_SCHED
}
}
#define XB_TMO      128
#define XB_XCNT(j)  (256  + 64 * (j))
#define XB_XSUB(j)  (1280 + 64 * (j))
#define XB_XGEN(j)  (2304 + 64 * (j))
#define XB_TOP      3328
#define XB_TOPGEN   3392
#define XCD_BAR_WORDS 3456
#define XB_SPIN_CAP (1u << 18)

__device__ __forceinline__ unsigned xb_ld(unsigned* p)              { return __hip_atomic_load(p, __ATOMIC_RELAXED, __HIP_MEMORY_SCOPE_AGENT); }
__device__ __forceinline__ unsigned xb_add(unsigned* p, unsigned v) { return __hip_atomic_fetch_add(p, v, __ATOMIC_RELAXED, __HIP_MEMORY_SCOPE_AGENT); }
__device__ __forceinline__ unsigned xb_xcc_id() { return (unsigned)__builtin_amdgcn_s_getreg((3 << 11) | 20) & 0xFu; }
#define XB_SPIN(cond, bar) do { unsigned _sp = 0; while (cond) { __builtin_amdgcn_s_sleep(1); \
    if ((++_sp & 255u) == 0u) { if (xb_ld(&(bar)[XB_TMO])) break; if (_sp > XB_SPIN_CAP) { atomicAdd(&(bar)[XB_TMO], 1u); break; } } } } while (0)

struct XcdBarrier {
    unsigned* bar; unsigned x;
    volatile LAS unsigned* st;
    unsigned tid;
};

__device__ __forceinline__ XcdBarrier xcd_barrier_post(unsigned* bar, volatile LAS unsigned* st) {
    XcdBarrier b; b.bar = bar; b.x = xb_xcc_id(); b.st = st;
    if (threadIdx.x == 0) (void)xb_add(&bar[XB_XCNT(b.x)], 1u);
    return b;
}
__device__ __forceinline__ void xcd_barrier_complete(unsigned* bar, unsigned x, unsigned& nloc, unsigned& nx) {
    const unsigned G = gridDim.x * gridDim.y * gridDim.z;
    unsigned sum, cnt, mine, sp = 0u;
    for (;;) {
        sum = 0u; cnt = 0u; mine = 0u;
#pragma unroll
        for (unsigned j = 0; j < 16; ++j) { const unsigned c = xb_ld(&bar[XB_XCNT(j)]); sum += c; cnt += (c > 0u) ? 1u : 0u; mine = (j == x) ? c : mine; }
        if (sum == G) break;
        __builtin_amdgcn_s_sleep(1);
        if ((++sp & 255u) == 0u) { if (xb_ld(&bar[XB_TMO])) break; if (sp > XB_SPIN_CAP) { atomicAdd(&bar[XB_TMO], 1u); break; } }
    }
    nloc = mine > 0u ? mine : 1u; nx = cnt > 0u ? cnt : 1u;
}

__device__ __forceinline__ void xcd_barrier(const XcdBarrier& b) {
    asm volatile("s_waitcnt vmcnt(0)" ::: "memory");
    __syncthreads();
    if (b.tid == 0) {
        unsigned* bar = b.bar;
        __builtin_amdgcn_s_waitcnt(0);
        unsigned nloc = b.st[0], nx = b.st[1];
        if (nloc == 0u) { xcd_barrier_complete(bar, b.x, nloc, nx); b.st[0] = nloc; b.st[1] = nx; }
        const unsigned old = xb_add(&bar[XB_XSUB(b.x)], 1u);
        const unsigned gen = old / nloc;
        if (old + 1u == (gen + 1u) * nloc) {
            __builtin_amdgcn_fence(__ATOMIC_RELEASE, "agent");
            asm volatile("s_waitcnt vmcnt(0)" ::: "memory");
            const unsigned og = xb_add(&bar[XB_TOP], 1u);
            const unsigned tg = og / nx;
            if (og + 1u == (tg + 1u) * nx) xb_add(&bar[XB_TOPGEN], 1u);
            else XB_SPIN(xb_ld(&bar[XB_TOPGEN]) == tg, bar);
            __builtin_amdgcn_fence(__ATOMIC_ACQUIRE, "agent");
            xb_add(&bar[XB_XGEN(b.x)], 1u);
            asm volatile("s_waitcnt vmcnt(0)" ::: "memory");
        } else {
            XB_SPIN(xb_ld(&bar[XB_XGEN(b.x)]) == gen, bar);
            __builtin_amdgcn_fence(__ATOMIC_ACQUIRE, "agent");
            asm volatile("s_waitcnt vmcnt(0)" ::: "memory");
        }
    }
    __syncthreads();
}
namespace fox {
constexpr int D = 128;
constexpr float SCALE = 0.08838834764831845f, INV_SCALE = 11.313708498984761f;
constexpr float THR = 8.f;
constexpr int NW = 8, QBLK = 32, KVBLK = 64, QB = NW * QBLK;
constexpr int SHM_V = KVBLK * D * 2, SHM_K = KVBLK * D * 2;
constexpr int KB_OFF = 2 * SHM_V + 2 * SHM_K + NW * 64 * 4;
constexpr int JL_OFF = KB_OFF + 2 * 64 * 4;
constexpr int OT_OFF = JL_OFF + 64, OT_PITCH = 272, OT_WAVE = 32 * OT_PITCH;
constexpr int LDS_BYTES = OT_OFF + NW * OT_WAVE;

#define KSWZ(row, colB) ((row) * 256 + ((colB) ^ (((row) & 7) << 4)))
#define SBAR() __builtin_amdgcn_sched_barrier(0)
__device__ __forceinline__ int v_st(int k, int c) { const int kk = (k & ~0xC) | ((k & 4) << 1) | ((k & 8) >> 1); return ((kk >> 3) * 4 + (c >> 5)) * 512 + ((kk & 7) * 32 + (c & 31)) * 2; }
__device__ __forceinline__ int v_rd_base(int lane) { return ((lane & 3) << 3) | (((lane >> 2) & 3) << 6) | (((lane >> 4) & 1) << 5) | (((lane >> 5) & 1) << 8); }
constexpr int v_rd_off(int d0, int ks, int half) { return d0 * 512 + ks * 4096 + half * 2048; }
__device__ __forceinline__ int crow(int r, int hi) { return (r & 3) + 8 * (r >> 2) + 4 * hi; }
__device__ __forceinline__ bf16x8 load8(const bf16* p) { return *reinterpret_cast<const bf16x8*>(p); }
__device__ __forceinline__ void mask_tile(f32x16& p0, f32x16& p1, int dq) {
    const float NEG = -__builtin_inff();
#pragma unroll
    for (int r = 0; r < 16; ++r) {
        const int c = (r & 3) + 8 * (r >> 2);
        if (dq - c < 0) p0[r] = NEG;
        if (dq - c - 32 < 0) p1[r] = NEG;
    }
}
__device__ __forceinline__ void bias_tile(f32x16& p0, f32x16& p1, const float* kb, int hi) {
#pragma unroll
    for (int g = 0; g < 4; ++g) {
        const f32x4 a = *(const f32x4*)(kb + 8 * g + 4 * hi), b = *(const f32x4*)(kb + 32 + 8 * g + 4 * hi);
#pragma unroll
        for (int j = 0; j < 4; ++j) { p0[4 * g + j] += a[j]; p1[4 * g + j] += b[j]; }
    }
}
__device__ __forceinline__ void partialSM(f32x16& p0, f32x16& p1, float& m_reg, float& mn, float& alpha) {
    float pmax = p0[0]; for (int r = 1; r < 16; ++r) pmax = fmaxf(pmax, p0[r]); for (int r = 0; r < 16; ++r) pmax = fmaxf(pmax, p1[r]);
    { auto rr = __builtin_amdgcn_permlane32_swap(__float_as_uint(pmax), __float_as_uint(pmax), false, false);
      pmax = fmaxf(__uint_as_float(rr[0]), __uint_as_float(rr[1])); }
    constexpr float C2 = 1.4426950408889634f * SCALE;
    if (__builtin_expect(__all((pmax - m_reg) * SCALE <= THR), 1)) { mn = m_reg; alpha = 1.f; }
    else { mn = fmaxf(m_reg, pmax); alpha = __builtin_amdgcn_exp2f((m_reg - mn) * C2); m_reg = mn; }
    const float mnL = -mn * C2;
    for (int r = 0; r < 16; ++r) p0[r] = fmaf(p0[r], C2, mnL); for (int r = 0; r < 16; ++r) p1[r] = fmaf(p1[r], C2, mnL);
    for (int r = 0; r < 16; ++r) p0[r] = __builtin_amdgcn_exp2f(p0[r]);
}
__device__ __forceinline__ void finishSM(f32x16& p0, f32x16& p1, float alpha, float& l_reg, bf16x8& pa0, bf16x8& pa1, bf16x8& pa2, bf16x8& pa3) {
    for (int r = 0; r < 16; ++r) p1[r] = __builtin_amdgcn_exp2f(p1[r]);
    float ps = 0; for (int r = 0; r < 16; ++r) ps += p0[r]; for (int r = 0; r < 16; ++r) ps += p1[r];
    { auto rr = __builtin_amdgcn_permlane32_swap(__float_as_uint(ps), __float_as_uint(ps), false, false);
      ps = __uint_as_float(rr[0]) + __uint_as_float(rr[1]); }
    l_reg = l_reg * alpha + ps;
#define PK4(P, B_, OUT) do { unsigned a0 = cvtpk(P[B_+0], P[B_+1]), a1 = cvtpk(P[B_+2], P[B_+3]);                          \
        unsigned b0 = cvtpk(P[B_+4], P[B_+5]), b1 = cvtpk(P[B_+6], P[B_+7]);                                             \
        auto r0 = __builtin_amdgcn_permlane32_swap(a0, b0, false, false); auto r1 = __builtin_amdgcn_permlane32_swap(a1, b1, false, false); \
        u32x4 w = {r0[0], r1[0], r0[1], r1[1]}; OUT = *reinterpret_cast<bf16x8*>(&w); } while (0)
    PK4(p0, 0, pa0); PK4(p0, 8, pa1); PK4(p1, 0, pa2); PK4(p1, 8, pa3);
#undef PK4
}
template <int KB>
__device__ __forceinline__ void qkt(f32x16& p0, f32x16& p1, const char* K_lds, int r32, int hi, const bf16x8* qr) {
    p0 = f32x16{}; p1 = f32x16{};
    const char* kb[4];
#pragma unroll
    for (int dd = 0; dd < 4; ++dd) kb[dd] = K_lds + KB * SHM_K + KSWZ(r32, (dd * 16 + hi * 8) * 2);
#pragma unroll
    for (int d0 = 0; d0 < 8; ++d0) { const char* a = kb[d0 & 3] + (d0 >> 2) * 128;
        bf16x8 b0 = *reinterpret_cast<const bf16x8*>(a);
        bf16x8 b1 = *reinterpret_cast<const bf16x8*>(a + 32 * 256);
        p0 = __builtin_amdgcn_mfma_f32_32x32x16_bf16(b0, qr[d0], p0, 0, 0, 0);
        p1 = __builtin_amdgcn_mfma_f32_32x32x16_bf16(b1, qr[d0], p1, 0, 0, 0); }
}
template <int VB>
__device__ __forceinline__ void pv_tile(f32x16* o, int vb0, bf16x8 pa0, bf16x8 pa1, bf16x8 pa2, bf16x8 pa3) {
#define TRRD(dst, off) asm volatile("ds_read_b64_tr_b16 %0, %1 offset:%2" : "=&v"(dst) : "v"(vb0), "i"(off) : "memory")
#define PV_D0(d0) do { s16x4 l0, l1, h0, h1; constexpr int b_ = VB * SHM_V + v_rd_off(d0, 0, 0);     \
        TRRD(l0, b_); TRRD(h0, b_ + 2048); TRRD(l1, b_ + 4096); TRRD(h1, b_ + 6144); \
        asm volatile("s_waitcnt lgkmcnt(0)" ::: "memory"); SBAR();   \
        o[d0] = __builtin_amdgcn_mfma_f32_32x32x16_bf16(pa0, (bf16x8){l0[0], l0[1], l0[2], l0[3], h0[0], h0[1], h0[2], h0[3]}, o[d0], 0, 0, 0);   \
        o[d0] = __builtin_amdgcn_mfma_f32_32x32x16_bf16(pa1, (bf16x8){l1[0], l1[1], l1[2], l1[3], h1[0], h1[1], h1[2], h1[3]}, o[d0], 0, 0, 0);   \
        SBAR(); TRRD(l0, b_ + 8192); TRRD(h0, b_ + 10240); TRRD(l1, b_ + 12288); TRRD(h1, b_ + 14336); \
        asm volatile("s_waitcnt lgkmcnt(0)" ::: "memory"); SBAR();   \
        o[d0] = __builtin_amdgcn_mfma_f32_32x32x16_bf16(pa2, (bf16x8){l0[0], l0[1], l0[2], l0[3], h0[0], h0[1], h0[2], h0[3]}, o[d0], 0, 0, 0);   \
        o[d0] = __builtin_amdgcn_mfma_f32_32x32x16_bf16(pa3, (bf16x8){l1[0], l1[1], l1[2], l1[3], h1[0], h1[1], h1[2], h1[3]}, o[d0], 0, 0, 0); } while (0)
    PV_D0(0); PV_D0(1); PV_D0(2); PV_D0(3);
#undef PV_D0
#undef TRRD
}
struct BlockRef { const bf16* Q; const bf16* K; const bf16* V; const bf16* Z; bf16* O; const float* C; const float* QN; const float* KN; int P0; };
constexpr float PRUNE_T = 30.0f;
__device__ __forceinline__ int compute_jlo(const BlockRef& b, int lane) {
    const int ntb = b.P0 / KVBLK;
    if (ntb == 0) return 0;
    float q2 = b.QN[ntb + (lane & 3)];
    q2 = fmaxf(q2, __shfl_xor(q2, 1)); q2 = fmaxf(q2, __shfl_xor(q2, 2));
    float k2 = fmaxf(lane < ntb + 4 ? b.KN[lane] : 0.f, lane + 64 < ntb + 4 ? b.KN[lane + 64] : 0.f);
#pragma unroll
    for (int o = 1; o < 64; o <<= 1) k2 = fmaxf(k2, __shfl_xor(k2, o));
    const float bnd = 2.0f * SCALE * __builtin_amdgcn_sqrtf(q2 * k2) * 1.0001f + b.C[b.P0];
    const bool s0 = lane < ntb && (bnd - b.C[64 * lane + 63] < -PRUNE_T);
    const bool s1 = lane + 64 < ntb && (bnd - b.C[64 * (lane + 64) + 63] < -PRUNE_T);
    const unsigned long long m0 = __ballot(s0), m1 = __ballot(s1);
    int jlo = 0;
    if (m1) jlo = 128 - __builtin_clzll(m1) + 1 - 1; else if (m0) jlo = 64 - __builtin_clzll(m0);
    return __builtin_amdgcn_readfirstlane(jlo);
}
__device__ __forceinline__ void norm_item(const bf16* PROJ, float* QN2, float* KN2, int item, int lane) {
    const int bhh = item >> 7, tile = item & 127, b = bhh >> 5, h = bhh & 31, rs = lane >> 4, cg = lane & 15;
    const bf16* base = PROJ + ((size_t)b * SEQ + (size_t)tile * 64) * LDP + h * HDIM + cg * 8;
    float qm = 0.f, km = 0.f;
#pragma unroll 4
    for (int i = 0; i < 16; ++i) { const bf16* rp = base + (size_t)(4 * i + rs) * LDP;
        const u32x4 qw = *(const u32x4*)rp, kw = *(const u32x4*)(rp + 4096); float q[8], k[8]; unpack8(qw, q); unpack8(kw, k);
        float sq = 0.f, sk = 0.f;
#pragma unroll
        for (int e = 0; e < 8; ++e) { sq += q[e] * q[e]; sk += k[e] * k[e]; }
#pragma unroll
        for (int o = 1; o < 16; o <<= 1) { sq += __shfl_xor(sq, o); sk += __shfl_xor(sk, o); }
        qm = fmaxf(qm, sq); km = fmaxf(km, sk); }
    qm = fmaxf(qm, __shfl_xor(qm, 16)); qm = fmaxf(qm, __shfl_xor(qm, 32)); km = fmaxf(km, __shfl_xor(km, 16)); km = fmaxf(km, __shfl_xor(km, 32));
    if (lane == 0) { QN2[item] = qm; KN2[item] = km; }
}
struct Seam { bf16x8 qr[8]; bf16x8 st_v0, st_v1, st_k0, st_k1; float cb0, cb1; };
#define ROWP(p, k0, rr) ((p) + (size_t)((k0) + (rr)) * LDP + sc)
#define VMWN(n) asm volatile("s_waitcnt vmcnt(%0)" :: "i"(n) : "memory")
#define SLOAD_H(Kp, Vp, Cp, k0) do { const bf16* vp_ = (Vp) + (size_t)(k0) * LDP; const bf16* kp_ = (Kp) + (size_t)(k0) * LDP; const float* cp_ = (Cp) + (k0); \
                         S.st_v0 = load8(vp_ + loff); S.st_v1 = load8(vp_ + 32 * LDP + loff);              \
                         S.st_k0 = load8(kp_ + loff); S.st_k1 = load8(kp_ + 32 * LDP + loff); S.cb0 = cp_[(unsigned)sr]; S.cb1 = (cp_ + 32)[(unsigned)sr]; } while (0)
#define SWRITE_HK(bf, ref) do { *(bf16x8*)(K_lds + (bf) * SHM_K + kws) = S.st_k0; *(bf16x8*)(K_lds + (bf) * SHM_K + kws + 32 * 256) = S.st_k1; \
                         if ((tid & 15) == 0) { kbias[(bf) * 64 + sr] = ((ref) - S.cb0) * INV_SCALE; kbias[(bf) * 64 + 32 + sr] = ((ref) - S.cb1) * INV_SCALE; } } while (0)
#define SWRITE_HV(bf) do { *(bf16x8*)(V_lds + (bf) * SHM_V + vst0) = S.st_v0; *(bf16x8*)(V_lds + (bf) * SHM_V + vst1) = S.st_v1; } while (0)
#define SWRITE_H(bf, ref) do { SWRITE_HV(bf); SWRITE_HK(bf, ref); } while (0)
__device__ __forceinline__ float blk_ref(const BlockRef& b) { const float v = b.P0 > 0 ? b.C[b.P0 - 1] : 0.f; return __uint_as_float(__builtin_amdgcn_readfirstlane(__float_as_uint(v))); }
__device__ __forceinline__ void prime(const BlockRef& cur, int j_lo, char* lds, Seam& S, const int w0) {
    const int tid = otid(w0), wid = __builtin_amdgcn_readfirstlane(tid >> 6), lane = tid & 63, r32 = lane & 31, hi = lane >> 5;
    const int sr = tid >> 4, sc = (tid & 15) * 8, kws = KSWZ(sr, sc * 2); char* K_lds = lds + 2 * SHM_V; float* kbias = (float*)(lds + KB_OFF);
    const unsigned loff = (unsigned)sr * LDP + sc, qoff = (unsigned)r32 * LDP + hi * 8;
    const float ref = blk_ref(cur);
    for (int d0 = 0; d0 < 8; ++d0) S.qr[d0] = load8(cur.Q + (size_t)(wid * QBLK) * LDP + d0 * 16 + qoff);
    SLOAD_H(cur.K, cur.V, cur.C, j_lo * KVBLK); VM_WAIT(); SWRITE_HK(0, ref);
    __syncthreads();
}
__device__ __forceinline__ void block(const BlockRef& cur, const BlockRef& nxt, int j_lo, int jlo_n, char* lds, Seam& S, const int w0) {
    const int tid = otid(w0), wid = __builtin_amdgcn_readfirstlane(tid >> 6), lane = tid & 63, r32 = lane & 31, hi = lane >> 5;
    const int NT = (cur.P0 + QB - 1) / KVBLK + 1 - j_lo;
    const int qlo = cur.P0 + wid * QBLK, qm = qlo + r32 - 4 * hi;
    char* V_lds = lds; char* K_lds = lds + 2 * SHM_V;
    float* ws = (float*)(lds + 2 * SHM_V + 2 * SHM_K) + wid * 64; float* li_l = ws, * al_l = ws + 32; float* kbias = (float*)(lds + KB_OFF);
    float m_reg = -1e30f, l_reg = 0; f32x16 o[4] = {};
    const int sr = tid >> 4, sc = (tid & 15) * 8, vst0 = v_st(sr, sc), vst1 = v_st(32 + sr, sc), kws = KSWZ(sr, sc * 2);
    const int vb0 = (int)(uintptr_t)V_lds + v_rd_base(lane);
    const unsigned loff = (unsigned)sr * LDP + sc, qoff = (unsigned)r32 * LDP + hi * 8;
    const bf16* Kh = cur.K; const bf16* Vh = cur.V; const float* Ch = cur.C;
    const float ref = blk_ref(cur), nref = blk_ref(nxt);
#define RESC(a) do { if (__any((a) < 1.f)) { if (hi == 0) al_l[r32] = (a); asm volatile("s_waitcnt lgkmcnt(0)" ::: "memory");              \
                     for (int d_ = 0; d_ < 4; ++d_) for (int r = 0; r < 16; ++r) o[d_][r] *= al_l[crow(r, hi)]; } } while (0)
#define KBASE(t) ((j_lo + (t)) * KVBLK)
#define BIASMASK(P0_, P1_, t, KB) do { const int kb_ = KBASE(t); bias_tile(P0_, P1_, kbias + (KB) * 64, hi); if (kb_ + KVBLK - 1 > qlo) mask_tile(P0_, P1_, qm - kb_); } while (0)
    constexpr int NQL = 8;
#define SEAM_K0() do { VMWN(NQL); SWRITE_HK(0, nref); SBAR(); } while (0)
    f32x16 pA0, pA1, pB0, pB1; float mnA, mnB, alA, alB; bf16x8 pa0, pa1, pa2, pa3;
    SWRITE_HV(0); SBAR();
    if (NT > 1) SLOAD_H(Kh, Vh, Ch, KBASE(1));
    SBAR(); qkt<0>(pA0, pA1, K_lds, r32, hi, S.qr);
    BIASMASK(pA0, pA1, 0, 0); partialSM(pA0, pA1, m_reg, mnA, alA);
    if (NT > 1) { VM_WAIT(); SWRITE_H(1, ref); }
    __syncthreads();
#define HALF_STEP(PX0, PX1, mnX, alX, PY0, PY1, alY, t, KB, VB, SB) do {                                                      \
        SBAR(); qkt<KB>(PX0, PX1, K_lds, r32, hi, S.qr);                                                                      \
        finishSM(PY0, PY1, alY, l_reg, pa0, pa1, pa2, pa3); SBAR();                                                           \
        if ((t) + 1 < NT) { SLOAD_H(Kh, Vh, Ch, KBASE((t) + 1)); SBAR(); }                                                    \
        pv_tile<VB>(o, vb0, pa0, pa1, pa2, pa3); BIASMASK(PX0, PX1, (t), KB); partialSM(PX0, PX1, m_reg, mnX, alX);           \
        __syncthreads();                                                                                                      \
        if ((t) + 1 < NT) { VM_WAIT(); SWRITE_H(SB, ref); }                                                                   \
        RESC(alX); __syncthreads(); } while (0)
    for (int t = 1; t + 1 < NT; t += 2) {
        HALF_STEP(pB0, pB1, mnB, alB, pA0, pA1, alA, t, 1, 0, 0);
        HALF_STEP(pA0, pA1, mnA, alA, pB0, pB1, alB, t + 1, 0, 1, 1);
    }
    const bool even = (NT & 1) == 0;
    if (even) { SBAR(); qkt<1>(pB0, pB1, K_lds, r32, hi, S.qr); SBAR(); }
    SLOAD_H(nxt.K, nxt.V, nxt.C, jlo_n * KVBLK); SBAR();
#pragma unroll
    for (int d0 = 0; d0 < 8; ++d0) S.qr[d0] = load8(nxt.Q + (size_t)(wid * QBLK) * LDP + d0 * 16 + qoff);
    SBAR();
    finishSM(pA0, pA1, alA, l_reg, pa0, pa1, pa2, pa3); SBAR();
    pv_tile<0>(o, vb0, pa0, pa1, pa2, pa3);
    if (even) { const int t2 = otid(w0), qm2 = qlo + (t2 & 31) - 4 * ((t2 >> 5) & 1), hi2 = (t2 >> 5) & 1;
      { const int kb_ = KBASE(NT - 1); bias_tile(pB0, pB1, kbias + 64, hi2); if (kb_ + KVBLK - 1 > qlo) mask_tile(pB0, pB1, qm2 - kb_); }
      partialSM(pB0, pB1, m_reg, mnB, alB); __syncthreads(); RESC(alB);
      finishSM(pB0, pB1, alB, l_reg, pa0, pa1, pa2, pa3); SBAR(); pv_tile<1>(o, vb0, pa0, pa1, pa2, pa3); }
    SBAR(); SEAM_K0();
    if (hi == 0) li_l[r32] = l_reg; asm volatile("s_waitcnt lgkmcnt(0)" ::: "memory");
    float rli[16];
#pragma unroll
    for (int r = 0; r < 16; ++r) rli[r] = __builtin_amdgcn_rcpf(li_l[crow(r, hi)]);
    bf16* Ow = cur.O + (size_t)(wid * QBLK) * 4096; const bf16* Zw = cur.Z + (size_t)(wid * QBLK) * LDP;
    const int t2 = otid(w0), l2 = t2 & 63;
    const unsigned zoff = (unsigned)(l2 >> 4) * LDP + (l2 & 15) * 8, ooff = (unsigned)(l2 >> 4) * 4096 + (l2 & 15) * 8;
    u32x4 zw[8];
#pragma unroll
    for (int i = 0; i < 8; ++i) zw[i] = *(const u32x4*)(Zw + (size_t)(4 * i) * LDP + zoff);
    char* ot = lds + OT_OFF + wid * OT_WAVE;
#pragma unroll
    for (int d0 = 0; d0 < 4; ++d0)
#pragma unroll
        for (int r = 0; r < 16; ++r) *(bf16*)(ot + crow(r, hi) * OT_PITCH + (d0 * 32 + r32) * 2) = (bf16)(cvtpk(o[d0][r] * rli[r], 0.f) & 0xffffu);
    asm volatile("s_waitcnt lgkmcnt(0)" ::: "memory");
#pragma unroll
    for (int i = 0; i < 8; ++i) { const u32x4 ow = *(const u32x4*)(ot + (4 * i + (l2 >> 4)) * OT_PITCH + (l2 & 15) * 16);
        float ov[8], zv[8]; unpack8(ow, ov); unpack8(zw[i], zv);
        f32x4 a, b;
#pragma unroll
        for (int e = 0; e < 4; ++e) { a[e] = ov[e] * siluf_(zv[e]); b[e] = ov[4 + e] * siluf_(zv[4 + e]); }
        *(bf16x8*)(Ow + (size_t)(4 * i) * 4096 + ooff) = pack8(a, b); }
    __syncthreads();
#undef RESC
#undef KBASE
#undef BIASMASK
#undef SEAM_K0
#undef HALF_STEP
}
#undef ROWP
#undef VMWN
#undef SLOAD_H
#undef SWRITE_HK
#undef SWRITE_HV
#undef SWRITE_H
#undef KSWZ
#undef SBAR
__device__ __forceinline__ void attn_phase(char* lds, const bf16* PROJ, bf16* MIX, const float* CUM, const float* QN2, const float* KN2, int vcu, int G, const int w0) {
    constexpr int NQB = SEQ / QB  , NX = NQB / 2, TOTAL = NX * BATCH * NHEAD;
    auto ref_of = [&](int L, int pass) { const int bhh = L / NX, x = L % NX, qb = pass ? NQB - 1 - x : x, b = bhh / NHEAD, h = bhh % NHEAD;
        BlockRef r; const bf16* base = PROJ + (size_t)b * SEQ * LDP + h * HDIM;
        r.Q = base + (size_t)qb * QB * LDP; r.K = base + 4096; r.V = base + 8192; r.Z = base + (size_t)qb * QB * LDP + ZCOL;
        r.O = MIX + ((size_t)b * SEQ + (size_t)qb * QB) * 4096 + h * HDIM; r.C = CUM + (size_t)bhh * SEQ; r.QN = QN2 + bhh * 128; r.KN = KN2 + bhh * 128; r.P0 = qb * QB; return r; };
    int L = vcu; if (L >= TOTAL) return;
    int pass = 0; BlockRef cur = ref_of(L, 0); Seam S;
    int* jl = (int*)(lds + JL_OFF);
    { const int tid = otid(w0), w = __builtin_amdgcn_readfirstlane(tid >> 6), Lw = vcu + (w >> 1) * G;
      if (Lw < TOTAL) { const BlockRef r = ref_of(Lw, w & 1); const int j = compute_jlo(r, tid & 63); if ((tid & 63) == 0) jl[w] = j; } }
    __syncthreads();
    int bi = 0;
    prime(cur, jl[0], lds, S, w0);
    for (;;) {
        const bool more_pass = pass == 0, more_item = L + G < TOTAL, last = !more_pass && !more_item;
        int passn = pass + 1, Ln = L; if (!more_pass) { passn = 0; Ln = more_item ? L + G : L; }
        const BlockRef nxt = last ? cur : ref_of(Ln, passn);
        { const int ja = __builtin_amdgcn_readfirstlane(jl[bi]), jb = __builtin_amdgcn_readfirstlane(jl[last ? bi : bi + 1]); block(cur, nxt, ja, jb, lds, S, w0); ++bi; }
        if (last) break;
        cur = nxt; pass = passn; L = Ln;
    }
}
}
constexpr int NWAVES = 8, NTHR = 512;
constexpr int RING_BYTES = 131072;
constexpr int MISC_OFF = RING_BYTES + 24576;
constexpr int LDS_BYTES = MISC_OFF + 128;

struct Args {
    const float* in[28]; float* out; unsigned char* ws;
    int ph_lo, ph_hi, li, pad;
};
enum { I_X = 0, I_P, I_NORM_MIX, I_FOX_WIN, I_FOX_BF, I_FOX_WOUT, I_GDN_WIN, I_GDN_CONV, I_GDN_ALOG, I_GDN_DTB, I_GDN_NORM, I_GDN_WOUT,
       I_SSM_WIN, I_SSM_LRE, I_SSM_LIM, I_SSM_BRE, I_SSM_BIM, I_SSM_CRE, I_SSM_CIM, I_SSM_LSTEP, I_SSM_D, I_SSM_WGLU, I_SSM_BGLU, I_SSM_WOUT,
       I_NORM_PLE, I_PLE_WPROJ, I_PLE_WGATE, I_FINAL_NORM };

__device__ __forceinline__ void transpose_item(const float* W, int K, int N, bf16* dst, const float* gk, LAS float* scr, int k0, int n0, int lane) {
#pragma unroll 8
    for (int i = 0; i < 32; ++i) { const int kk = 2 * i + (lane >> 5); scr[kk * 33 + (lane & 31)] = W[(size_t)(k0 + kk) * N + n0 + (lane & 31)]; }
    const int c = lane & 7;
    f32x4 ga = {1.f, 1.f, 1.f, 1.f}, gb = ga;
    if (gk) { ga = *(const f32x4*)(gk + k0 + 8 * c); gb = *(const f32x4*)(gk + k0 + 8 * c + 4); }
    LDS_WAIT(); asm volatile("" ::: "memory");
#pragma unroll
    for (int j = 0; j < 4; ++j) { const int n = (lane >> 3) + 8 * j; const LAS float* s = scr + (8 * c) * 33 + n;
        u32x4 o; o.x = cvtpk(s[0 * 33] * ga[0], s[1 * 33] * ga[1]); o.y = cvtpk(s[2 * 33] * ga[2], s[3 * 33] * ga[3]); o.z = cvtpk(s[4 * 33] * gb[0], s[5 * 33] * gb[1]); o.w = cvtpk(s[6 * 33] * gb[2], s[7 * 33] * gb[3]);
        *(u32x4*)(dst + (size_t)n * K + k0 + 8 * c) = o; }
    LDS_WAIT(); asm volatile("" ::: "memory");
}
__device__ __forceinline__ void transpose_matrix(const float* W, int K, int N, bf16* WT, int nsplit, bf16* WT2, const float* gk, LAS float* scr, int gw, int NGW, int lane) {
    const int nblk = N / 32, nitems = (K / 64) * nblk;
    for (int it = gw; it < nitems; it += NGW) { const int kb = it / nblk, nb = it - kb * nblk, n0 = 32 * nb;
        bf16* dst = n0 < nsplit ? WT + (size_t)n0 * K : WT2 + (size_t)(n0 - nsplit) * K;
        transpose_item(W, K, N, dst, gk, scr, 64 * kb, n0, lane); }
}
__device__ __forceinline__ float row_to_bf16(const float* xrow, bf16* orow, int lane) {
    float s = 0.f;
#pragma unroll
    for (int j = 0; j < 8; ++j) { const int c = (j * 64 + lane) * 8;
        const f32x4 a = *(const f32x4*)(xrow + c), b = *(const f32x4*)(xrow + c + 4);
        const bf16x8 o = pack8(a, b); const u32x4 w = __builtin_bit_cast(u32x4, o);
        s += (bflo(w.x) * bflo(w.x) + bfhi(w.x) * bfhi(w.x)) + (bflo(w.y) * bflo(w.y) + bfhi(w.y) * bfhi(w.y)) + (bflo(w.z) * bflo(w.z) + bfhi(w.z) * bfhi(w.z)) + (bflo(w.w) * bflo(w.w) + bfhi(w.w) * bfhi(w.w));
        *(bf16x8*)(orow + c) = o; }
    return wave_sum(s);
}

template <int NS>
__device__ __forceinline__ void skinny_gemm(const bf16* A1, const bf16* WSK, const ssq_t* sumsq, int r0, LAS float* res, int wid, int lane) {
    constexpr int NT = NS / 32;
    const int mt = wid & 3, ng = wid >> 2, fr = lane & 15, fq = lane >> 4;
    f32x4 acc[NT];
#pragma unroll
    for (int t = 0; t < NT; ++t) acc[t] = (f32x4){0.f, 0.f, 0.f, 0.f};
    const bf16* ap = A1 + (size_t)(r0 + 16 * mt + fr) * 4096 + 8 * fq;
    const bf16* bp = WSK + (size_t)(16 * ng * NT + fr) * 4096 + 8 * fq;
#pragma unroll 8
    for (int k = 0; k < 4096; k += 32) {
        const bf16x8 a = *(const bf16x8*)(ap + k);
#pragma unroll
        for (int t = 0; t < NT; ++t) { const bf16x8 b = *(const bf16x8*)(bp + (size_t)t * 16 * 4096 + k); acc[t] = __builtin_amdgcn_mfma_f32_16x16x32_bf16(a, b, acc[t], 0, 0, 0); }
    }
#pragma unroll
    for (int i = 0; i < 4; ++i) { const int row = 16 * mt + 4 * fq + i; const float rs = __builtin_amdgcn_rsqf(ssq_val(sumsq[r0 + row]) * (1.0f / 4096.0f) + NORM_EPS);
#pragma unroll
        for (int t = 0; t < NT; ++t) res[row * NS + 16 * (ng * NT + t) + fr] = acc[t][i] * rs; }
}
namespace gdn {
constexpr int PQ = 272;
constexpr int PL = 68;
constexpr int G_Q = 0, G_K = 17408, G_V = 34816, G_L = 52224, G_S = 69632, GRP_BYTES = 70656;
static_assert(2 * GRP_BYTES <= 147456, "gdn prep LDS");

__device__ __forceinline__ void group_barrier(LAS unsigned* cnt, unsigned& target) {
    target += 4u;
    asm volatile("s_waitcnt lgkmcnt(0)" ::: "memory");
    if (__builtin_amdgcn_mbcnt_hi(~0u, __builtin_amdgcn_mbcnt_lo(~0u, 0u)) == 0u) __hip_atomic_fetch_add(cnt, 1u, __ATOMIC_RELAXED, __HIP_MEMORY_SCOPE_WORKGROUP);
    while (__hip_atomic_load(cnt, __ATOMIC_RELAXED, __HIP_MEMORY_SCOPE_WORKGROUP) < target) __builtin_amdgcn_s_sleep(1);
    asm volatile("" ::: "memory");
}
__device__ __forceinline__ void prep_pair(LAS unsigned char* lds, int uid0, const bf16* PROJ, const float* convw, const float* BETA, const float* GLOG, float* GL, unsigned char* REC, unsigned& gbt, const int w0) {
    const int tid = otid(w0), wid = __builtin_amdgcn_readfirstlane(tid >> 6), lane = tid & 63, grp = wid >> 2, gw = wid & 3, gt = tid & 255;
    const int uid = uid0 + grp, bhh = uid >> 7, c = uid & 127, b = bhh >> 5, h = bhh & 31;
    LAS unsigned char* gl = lds + grp * GRP_BYTES;
    LAS float* Lm = (LAS float*)(gl + G_L); LAS float* gcs = (LAS float*)(gl + G_S); LAS float* bes = gcs + 64; LAS float* egs = gcs + 128;
    unsigned char* rec = REC + (size_t)uid * GR_BYTES;
    LAS unsigned* gbc = (LAS unsigned*)(gl + G_S + 768);
    const size_t row0 = (size_t)b * SEQ + (size_t)c * 64;
    float g_ld = 0.f, b_ld = 0.f;
    if (gw == 0) { g_ld = GLOG[(row0 + lane) * 32 + h]; b_ld = BETA[(row0 + lane) * 32 + h]; }
    {
    {
        const int cg = gt & 15, rp = gt >> 4;
        u32x4 raw[2][7];
#define GDN_ROWS(s_, buf_) do { const bf16* bp_ = PROJ + (row0 + 4 * rp - 3) * LDP + (s_) * 4096 + h * 128 + 8 * cg; \
            _Pragma("unroll") for (int jj = 0; jj < 7; ++jj) raw[buf_][jj] = (c * 64 + 4 * rp - 3 + jj >= 0) ? *(const u32x4*)(bp_ + (size_t)jj * LDP) : (u32x4){0u, 0u, 0u, 0u}; } while (0)
        GDN_ROWS(0, 0);
#pragma unroll
        for (int s = 0; s < 3; ++s) {
            const int colb = s * 4096 + h * 128 + 8 * cg;
            f32x4 w[4][2];
#pragma unroll
            for (int j = 0; j < 4; ++j) { w[j][0] = *(const f32x4*)(convw + (size_t)j * 12288 + colb); w[j][1] = *(const f32x4*)(convw + (size_t)j * 12288 + colb + 4); }
            if (s == 0) GDN_ROWS(1, 1); else if (s == 1) GDN_ROWS(2, 0);
            float xr[7][8];
#pragma unroll
            for (int jj = 0; jj < 7; ++jj) unpack8(raw[s & 1][jj], xr[jj]);
#pragma unroll
            for (int i = 0; i < 4; ++i) { const int t = 4 * rp + i; float y[8];
#pragma unroll
                for (int e = 0; e < 8; ++e) y[e] = 0.f;
#pragma unroll
                for (int j = 0; j < 4; ++j)
#pragma unroll
                    for (int e = 0; e < 4; ++e) { y[e] += w[j][0][e] * xr[i + j][e]; y[4 + e] += w[j][1][e] * xr[i + j][4 + e]; }
                float ss = 0.f;
#pragma unroll
                for (int e = 0; e < 8; ++e) { y[e] = siluf_(y[e]); ss += y[e] * y[e]; }
                float sc = 1.f;
                if (s < 2) { ss += __shfl_xor(ss, 1); ss += __shfl_xor(ss, 2); ss += __shfl_xor(ss, 4); ss += __shfl_xor(ss, 8);
                    sc = __builtin_amdgcn_rsqf(ss + NORM_EPS) * (s == 0 ? 0.08838834764831845f : 1.0f); }
                *(LAS bf16x8*)(gl + s * 17408 + t * PQ + cg * 16) = pack8((f32x4){y[0] * sc, y[1] * sc, y[2] * sc, y[3] * sc}, (f32x4){y[4] * sc, y[5] * sc, y[6] * sc, y[7] * sc}); }
        }
#undef GDN_ROWS
    }
    }
    if (gw == 0) { float g = g_ld;
#pragma unroll
        for (int o = 1; o < 64; o <<= 1) { const float t = __shfl_up(g, o); if (lane >= o) g += t; }
        gcs[lane] = g; bes[lane] = b_ld; egs[lane] = fexp(g);
        if (lane == 63) GL[uid] = fexp(g); }
    group_barrier(gbc, gbt);
    {
    {
        const int fr = lane & 15, fq = lane >> 4, mt = gw;
        bf16x8 kA[4], qA[4];
#pragma unroll
        for (int s = 0; s < 4; ++s) { kA[s] = *(const LAS bf16x8*)(gl + G_K + (16 * mt + fr) * PQ + (32 * s + 8 * fq) * 2); qA[s] = *(const LAS bf16x8*)(gl + G_Q + (16 * mt + fr) * PQ + (32 * s + 8 * fq) * 2); }
        bf16* intra = (bf16*)(rec + GR_IN);
#pragma unroll
        for (int nt = 0; nt < 4; ++nt) { f32x4 kk = {0.f, 0.f, 0.f, 0.f}, qk = {0.f, 0.f, 0.f, 0.f};
#pragma unroll
            for (int s = 0; s < 4; ++s) { const bf16x8 kB = *(const LAS bf16x8*)(gl + G_K + (16 * nt + fr) * PQ + (32 * s + 8 * fq) * 2);
                kk = __builtin_amdgcn_mfma_f32_16x16x32_bf16(kA[s], kB, kk, 0, 0, 0); qk = __builtin_amdgcn_mfma_f32_16x16x32_bf16(qA[s], kB, qk, 0, 0, 0); }
            const int j = 16 * nt + fr; const float gj = gcs[j];
#pragma unroll
            for (int e = 0; e < 4; ++e) { const int i = 16 * mt + 4 * fq + e; const float dec = (i >= j) ? fexp(gcs[i] - gj) : 0.f;
                Lm[i * PL + j] = (i > j) ? bes[i] * kk[e] * dec : 0.f;
                intra[i * 64 + j] = (bf16)(cvtpk(qk[e] * dec, 0.f) & 0xffffu); } }
    }
    {
        const int row = gt >> 2, seg = gt & 3; const float e = egs[row];
#pragma unroll
        for (int q4 = 0; q4 < 4; ++q4) { const u32x4 xw = *(const LAS u32x4*)(gl + G_Q + row * PQ + (seg * 32 + q4 * 8) * 2); float x[8]; unpack8(xw, x);
            *(bf16x8*)(rec + GR_QD + ((size_t)row * 128 + seg * 32 + q4 * 8) * 2) = pack8((f32x4){x[0] * e, x[1] * e, x[2] * e, x[3] * e}, (f32x4){x[4] * e, x[5] * e, x[6] * e, x[7] * e}); }
        const int d = gt & 127, half = gt >> 7; const float g63 = gcs[63];
#pragma unroll
        for (int q4 = 0; q4 < 4; ++q4) { float v[8];
#pragma unroll
            for (int e2 = 0; e2 < 8; ++e2) { const int i = 32 * half + 8 * q4 + e2; v[e2] = bf2f(*(const LAS bf16*)(gl + G_K + i * PQ + d * 2)) * fexp(g63 - gcs[i]); }
            *(bf16x8*)(rec + GR_KT + ((size_t)d * 64 + 32 * half + 8 * q4) * 2) = pack8((f32x4){v[0], v[1], v[2], v[3]}, (f32x4){v[4], v[5], v[6], v[7]}); }
    }
    }
    group_barrier(gbc, gbt);
    if (gt < 128) {
        LAS bf16* vp = (LAS bf16*)(gl + G_V) + gt; LAS bf16* kp = (LAS bf16*)(gl + G_K) + gt;
        f32x2 x[64];
#pragma unroll
        for (int i = 0; i < 64; ++i) {
            f32x4 lr[16];
#pragma unroll
            for (int j4 = 0; j4 < (i + 3) / 4; ++j4) lr[j4] = *(const LAS f32x4*)(Lm + i * PL + 4 * j4);
            const float be = bes[i];
            f32x2 a = {bf2f(vp[i * (PQ / 2)]) * be, bf2f(kp[i * (PQ / 2)]) * be * egs[i]};
            f32x2 acc[4] = {{0.f, 0.f}, {0.f, 0.f}, {0.f, 0.f}, {0.f, 0.f}};
#pragma unroll
            for (int j4 = 0; j4 < (i + 3) / 4; ++j4)
#pragma unroll
                for (int e = 0; e < 4; ++e) if (4 * j4 + e < i) acc[e] += x[4 * j4 + e] * lr[j4][e];
            a -= (acc[0] + acc[1]) + (acc[2] + acc[3]);
            x[i] = a;
        }
#pragma unroll
        for (int i = 0; i < 64; ++i) { const unsigned w = cvtpk(x[i].x, x[i].y);
            vp[i * (PQ / 2)] = (bf16)(w & 0xffffu); kp[i * (PQ / 2)] = (bf16)(w >> 16); }
    }
    group_barrier(gbc, gbt);
    {
        const int row = gt >> 2, seg = gt & 3;
#pragma unroll
        for (int q4 = 0; q4 < 4; ++q4) {
            *(u32x4*)(rec + GR_U + ((size_t)row * 128 + seg * 32 + q4 * 8) * 2) = *(const LAS u32x4*)(gl + G_V + row * PQ + (seg * 32 + q4 * 8) * 2);
            *(u32x4*)(rec + GR_W + ((size_t)row * 128 + seg * 32 + q4 * 8) * 2) = *(const LAS u32x4*)(gl + G_K + row * PQ + (seg * 32 + q4 * 8) * 2); }
    }
    group_barrier(gbc, gbt);
}

constexpr int SP = 272, SPT = 144, SPU = 80;
constexpr int L_QD = 0, L_W = 17408, L_KT = 34816, L_IN = 53248, L_U = 62464, L_BUF = 67584;
constexpr int L_ST = 2 * L_BUF, L_VT = L_ST + 32 * SP, SCAN_LDS = L_VT + 32 * SPT;
static_assert(SCAN_LDS <= 155648, "gdn scan LDS");
__device__ __forceinline__ bf16x8 pack_cc(const f32x4& lo, const f32x4& hi) { const u32x4 w = {cvtpk(lo[0], lo[1]), cvtpk(lo[2], lo[3]), cvtpk(hi[0], hi[1]), cvtpk(hi[2], hi[3])}; return __builtin_bit_cast(bf16x8, w); }
__device__ __forceinline__ void scan_unit(LAS unsigned char* lds, int unit, const unsigned char* REC, const float* GL, float* O32  , const int w0) {
    const int tid = otid(w0), wid = __builtin_amdgcn_readfirstlane(tid >> 6), lane = tid & 63, fr = lane & 15, fq = lane >> 4;
    const int bhh = unit >> 2, q4 = unit & 3, b = bhh >> 5, h = bhh & 31, nt = wid & 1, mt = wid >> 1;
    f32x4 S[2];
    S[0] = (f32x4){0.f, 0.f, 0.f, 0.f}; S[1] = (f32x4){0.f, 0.f, 0.f, 0.f};
    u32x4 st[8];
    int srcoff[8], dstoff[8];
#pragma unroll
    for (int i = 0; i < 8; ++i) { const int p = tid + 512 * i; int so, d;
        if (p < 1024) { so = (int)GR_QD + p * 16; d = L_QD + (p >> 4) * SP + (p & 15) * 16; }
        else if (p < 2048) { const int q = p - 1024; so = (int)GR_W + q * 16; d = L_W + (q >> 4) * SP + (q & 15) * 16; }
        else if (p < 3072) { const int q = p - 2048; so = (int)GR_KT + q * 16; d = L_KT + (q >> 3) * SPT + (q & 7) * 16; }
        else if (p < 3584) { const int q = p - 3072; so = (int)GR_IN + q * 16; d = L_IN + (q >> 3) * SPT + (q & 7) * 16; }
        else { const int q = (p - 3584) & 255; so = (int)GR_U + (q >> 2) * 256 + q4 * 64 + (q & 3) * 16; d = L_U + (q >> 2) * SPU + (q & 3) * 16; }
        srcoff[i] = so; dstoff[i] = d; }
    const bool has8 = tid < 256;
#define GDN_ISSUE(c_) do { const unsigned char* rec_ = REC + ((size_t)bhh * 128 + (c_)) * GR_BYTES; \
        _Pragma("unroll") for (int i = 0; i < 7; ++i) st[i] = *(const u32x4*)(rec_ + srcoff[i]); if (has8) st[7] = *(const u32x4*)(rec_ + srcoff[7]); } while (0)
#define GDN_STASH(buf_) do { LAS unsigned char* bp_ = lds + (buf_) * L_BUF; \
        _Pragma("unroll") for (int i = 0; i < 7; ++i) *(LAS u32x4*)(bp_ + dstoff[i]) = st[i]; if (has8) *(LAS u32x4*)(bp_ + dstoff[7]) = st[7]; } while (0)
    { const u32x4 z4 = ozero4(); for (int i = tid; i < (32 * SP) / 16; i += 512) *(LAS u32x4*)(lds + L_ST + i * 16) = z4; }
    GDN_ISSUE(0); GDN_STASH(0); __syncthreads();
    float gl_n = GL[bhh * 128]; asm volatile("" ::: "memory");
    GDN_ISSUE(1);
    float* orow = O32 + ((size_t)b * SEQ + 16 * mt + 4 * fq) * 4096 + h * 128 + 32 * q4 + 16 * nt + fr;
    const LAS unsigned char* stp = lds + L_ST + (16 * nt + fr) * SP + 16 * fq;
    const LAS unsigned char* vtp = lds + L_VT + (16 * nt + fr) * SPT + 16 * fq;
#pragma unroll 1
    for (int c = 0; c < GDN_NCHUNK; ++c) {
        const LAS unsigned char* bp = lds + (c & 1) * L_BUF;
        const float glast = gl_n;
        bf16x8 Sb[4];
#pragma unroll
        for (int s = 0; s < 4; ++s) Sb[s] = *(const LAS bf16x8*)(stp + 64 * s);
        f32x4 aw = {0.f, 0.f, 0.f, 0.f}, ao = {0.f, 0.f, 0.f, 0.f};
#pragma unroll
        for (int s = 0; s < 4; ++s) { aw = __builtin_amdgcn_mfma_f32_16x16x32_bf16(*(const LAS bf16x8*)(bp + L_W + (16 * mt + fr) * SP + 64 * s + 16 * fq), Sb[s], aw, 0, 0, 0);
            ao = __builtin_amdgcn_mfma_f32_16x16x32_bf16(*(const LAS bf16x8*)(bp + L_QD + (16 * mt + fr) * SP + 64 * s + 16 * fq), Sb[s], ao, 0, 0, 0); }
        f32x4 vn;
#pragma unroll
        for (int e = 0; e < 4; ++e) vn[e] = bf2f(*(const LAS bf16*)(bp + L_U + (16 * mt + 4 * fq + e) * SPU + (16 * nt + fr) * 2)) - aw[e];
        *(LAS u32x2*)(lds + L_VT + (16 * nt + fr) * SPT + (16 * mt + 4 * fq) * 2) = (u32x2){cvtpk(vn[0], vn[1]), cvtpk(vn[2], vn[3])};
        __syncthreads();
        bf16x8 vb[2];
        vb[0] = *(const LAS bf16x8*)vtp; vb[1] = *(const LAS bf16x8*)(vtp + 64);
#pragma unroll
        for (int s2 = 0; s2 < 2; ++s2) ao = __builtin_amdgcn_mfma_f32_16x16x32_bf16(*(const LAS bf16x8*)(bp + L_IN + (16 * mt + fr) * SPT + 64 * s2 + 16 * fq), vb[s2], ao, 0, 0, 0);
#pragma unroll
        for (int kk = 0; kk < 2; ++kk) { f32x4 a = S[kk] * glast;
#pragma unroll
            for (int s2 = 0; s2 < 2; ++s2) a = __builtin_amdgcn_mfma_f32_16x16x32_bf16(*(const LAS bf16x8*)(bp + L_KT + (16 * (2 * mt + kk) + fr) * SPT + 64 * s2 + 16 * fq), vb[s2], a, 0, 0, 0);
            S[kk] = a;
            *(LAS u32x2*)(lds + L_ST + (16 * nt + fr) * SP + (16 * (2 * mt + kk) + 4 * fq) * 2) = (u32x2){cvtpk(a[0], a[1]), cvtpk(a[2], a[3])}; }
#pragma unroll
        for (int e = 0; e < 4; ++e) orow[(size_t)(c * 64 + e) * 4096] = ao[e];
        if (c + 1 < GDN_NCHUNK) GDN_STASH((c + 1) & 1);
        __syncthreads();
        if (c + 1 < GDN_NCHUNK) { gl_n = GL[bhh * 128 + c + 1]; asm volatile("" ::: "memory"); }
        if (c + 2 < GDN_NCHUNK) GDN_ISSUE(c + 2);
    }
#undef GDN_ISSUE
#undef GDN_STASH
}
__device__ __forceinline__ void normgate(int gwv, int NGW, int lane, const float* O32, const bf16* PROJ, const float* normw, bf16* MIX) {
    const f32x4 n0 = *(const f32x4*)(normw + ((lane & 15) * 8)), n1 = *(const f32x4*)(normw + ((lane & 15) * 8) + 4);
#pragma unroll 2
    for (int it = gwv; it < M_TOK * 8; it += NGW) { const int row = it >> 3, c8 = (it & 7) * 512 + lane * 8;
        const f32x4 o0 = *(const f32x4*)(O32 + (size_t)row * 4096 + c8), o1 = *(const f32x4*)(O32 + (size_t)row * 4096 + c8 + 4);
        const u32x4 zw = *(const u32x4*)(PROJ + (size_t)row * LDP + ZCOL + c8); float z[8]; unpack8(zw, z);
        float q = (o0[0] * o0[0] + o0[1] * o0[1]) + (o0[2] * o0[2] + o0[3] * o0[3]) + (o1[0] * o1[0] + o1[1] * o1[1]) + (o1[2] * o1[2] + o1[3] * o1[3]);
        q += __shfl_xor(q, 1); q += __shfl_xor(q, 2); q += __shfl_xor(q, 4); q += __shfl_xor(q, 8);
        const float rs = __builtin_amdgcn_rsqf(q * (1.0f / 128.0f) + NORM_EPS);
        f32x4 r0, r1;
#pragma unroll
        for (int e = 0; e < 4; ++e) { r0[e] = o0[e] * rs * n0[e] * siluf_(z[e]); r1[e] = o1[e] * rs * n1[e] * siluf_(z[4 + e]); }
        *(bf16x8*)(MIX + (size_t)row * 4096 + c8) = pack8(r0, r1); }
}
}
namespace s5 {
__device__ __forceinline__ void sincos_cw(float x, float& s, float& c) {
    const float kf = rintf(x * 0.6366197723675814f); const int k = (int)kf;
    float r = fmaf(kf, -1.5703125f, x); r = fmaf(kf, -4.837512969970703125e-4f, r); r = fmaf(kf, -7.54978995489188e-8f, r);
    const float r2 = r * r;
    float c1 = -1.9515295891e-4f, c2 = 8.3321608736e-3f, c3 = 2.443315711809948e-5f, c4 = -1.388731625493765e-3f; asm volatile("" : "+v"(c1), "+v"(c2), "+v"(c3), "+v"(c4));
    const float sp = fmaf(r * r2, fmaf(r2, fmaf(r2, c1, c2), -1.6666654611e-1f), r);
    const float cp = fmaf(r2 * r2, fmaf(r2, fmaf(r2, c3, c4), 4.166664568298827e-2f), fmaf(r2, -0.5f, 1.0f));
    const int q = k & 3;
    s = (q == 0) ? sp : (q == 1) ? cp : (q == 2) ? -sp : -cp;
    c = (q == 0) ? cp : (q == 1) ? -sp : (q == 2) ? -cp : sp;
}
__device__ __forceinline__ void zoh_of(int g, int p, const float* LRE, const float* LIM, const float* LSTEP, float& lr, float& li, float& zr, float& zi) {
    const float lam_re = LRE[g * 64 + p], lam_im = LIM[g * 64 + p], step = fexp(LSTEP[g]);
    const float mag = fexp(lam_re * step); float sn, cs; sincos_cw(lam_im * step, sn, cs);
    lr = mag * cs; li = mag * sn;
    const float den = lam_re * lam_re + lam_im * lam_im, num_re = lr - 1.0f;
    zr = (num_re * lam_re + li * lam_im) / den; zi = (li * lam_re - num_re * lam_im) / den;
}
struct Disc { float lr, li; bf16x8 bh[8], bl[8]; };
__device__ __forceinline__ void discretise(Disc& d, int g, int lane, const float* LRE, const float* LIM, const float* BRE, const float* BIM, const float* LSTEP) {
    float zr, zi; zoh_of(g, lane, LRE, LIM, LSTEP, d.lr, d.li, zr, zi);
    const int fr = lane & 15, fq = lane >> 4, n0 = 8 * (fq & 1);
#pragma unroll
    for (int t = 0; t < 4; ++t) { const int p = 16 * t + fr; float lr, li; zoh_of(g, p, LRE, LIM, LSTEP, lr, li, zr, zi);
        const float* br = BRE + (size_t)(g * 64 + p) * 16 + n0; const float* bi = BIM + (size_t)(g * 64 + p) * 16 + n0;
        const f32x4 r0 = *(const f32x4*)br, r1 = *(const f32x4*)(br + 4), i0 = *(const f32x4*)bi, i1 = *(const f32x4*)(bi + 4);
        const f32x4 re0 = r0 * zr - i0 * zi, re1 = r1 * zr - i1 * zi, im0 = i0 * zr + r0 * zi, im1 = i1 * zr + r1 * zi;
        const u32x4 rh = __builtin_bit_cast(u32x4, pack8(re0, re1)), ih = __builtin_bit_cast(u32x4, pack8(im0, im1));
        float rhf[8], ihf[8]; unpack8(rh, rhf); unpack8(ih, ihf);
        const f32x4 rl0 = {re0[0] - rhf[0], re0[1] - rhf[1], re0[2] - rhf[2], re0[3] - rhf[3]}, rl1 = {re1[0] - rhf[4], re1[1] - rhf[5], re1[2] - rhf[6], re1[3] - rhf[7]};
        const f32x4 il0 = {im0[0] - ihf[0], im0[1] - ihf[1], im0[2] - ihf[2], im0[3] - ihf[3]}, il1 = {im1[0] - ihf[4], im1[1] - ihf[5], im1[2] - ihf[6], im1[3] - ihf[7]};
        const bf16x8 zero8 = {0, 0, 0, 0, 0, 0, 0, 0};
        d.bh[t] = __builtin_bit_cast(bf16x8, rh); d.bh[4 + t] = __builtin_bit_cast(bf16x8, ih);
        d.bl[t] = fq < 2 ? pack8(rl0, rl1) : zero8; d.bl[4 + t] = fq < 2 ? pack8(il0, il1) : zero8; }
}
constexpr int BUP = 20;
__device__ __forceinline__ void bu_tile(const Disc& d, const LAS float* us, LAS float* but, int t0, int lane) {
    const int fr = lane & 15, fq = lane >> 4;
    const f32x4 u0 = *(const LAS f32x4*)(us + (t0 + fr) * 16 + 8 * (fq & 1)), u1 = *(const LAS f32x4*)(us + (t0 + fr) * 16 + 8 * (fq & 1) + 4);
    const u32x4 uh = __builtin_bit_cast(u32x4, pack8(u0, u1)); float uhf[8]; unpack8(uh, uhf);
    const f32x4 l0 = {u0[0] - uhf[0], u0[1] - uhf[1], u0[2] - uhf[2], u0[3] - uhf[3]}, l1 = {u1[0] - uhf[4], u1[1] - uhf[5], u1[2] - uhf[6], u1[3] - uhf[7]};
    const bf16x8 af = fq < 2 ? __builtin_bit_cast(bf16x8, uh) : pack8(l0, l1);
    f32x4 accs[8];
#pragma unroll
    for (int ct = 0; ct < 8; ++ct) { f32x4 acc = {0.f, 0.f, 0.f, 0.f};
        acc = __builtin_amdgcn_mfma_f32_16x16x32_bf16(af, d.bh[ct], acc, 0, 0, 0);
        accs[ct] = __builtin_amdgcn_mfma_f32_16x16x32_bf16(af, d.bl[ct], acc, 0, 0, 0); }
    asm volatile("s_nop 15\n\ts_nop 15" : "+v"(accs[0]), "+v"(accs[1]), "+v"(accs[2]), "+v"(accs[3]), "+v"(accs[4]), "+v"(accs[5]), "+v"(accs[6]), "+v"(accs[7]));
#pragma unroll
    for (int ct = 0; ct < 8; ++ct) *(LAS f32x4*)(but + (16 * ct + fr) * BUP + 4 * fq) = accs[ct];
}
struct Slab { f32x4 r[4]; };
__device__ __forceinline__ void slab_issue(Slab& s, const float* up  , int lane) {
#pragma unroll
    for (int i = 0; i < 4; ++i) { const int pc = 64 * i + lane; s.r[i] = *(const f32x4*)(up + (size_t)(pc >> 2) * 4096 + (pc & 3) * 4); }
}
__device__ __forceinline__ void slab_store(const Slab& s, LAS float* us, int lane) {
#pragma unroll
    for (int i = 0; i < 4; ++i) { const int pc = 64 * i + lane; *(LAS f32x4*)(us + pc * 4) = s.r[i]; }
}
__device__ __forceinline__ void pass1(LAS float* us, LAS float* but, int gwv, int NGW, int lane, const float* U32, const float* LRE, const float* LIM, const float* BRE, const float* BIM, const float* LSTEP, f32x2* ENDST) {
#pragma unroll 1
    for (int wu = gwv; wu < BATCH * SSM_G * SSM_NSEG; wu += NGW) {
        const int g = wu & 255, seg = (wu >> 8) & (SSM_NSEG - 1), b = wu >> 13, bg = b * 256 + g;
        Disc d; discretise(d, g, lane, LRE, LIM, BRE, BIM, LSTEP);
        const float* up = U32 + ((size_t)b * SEQ + (size_t)seg * SSM_SL) * 4096 + 16 * g;
        float xr = 0.f, xi = 0.f;
        Slab sl; slab_issue(sl, up, lane);
#pragma unroll 1
        for (int tb = 0; tb < SSM_SL; tb += 64) {
            slab_store(sl, us, lane);
            if (tb + 64 < SSM_SL) slab_issue(sl, up + (size_t)(tb + 64) * 4096, lane);
#pragma unroll 1
            for (int t0 = 0; t0 < 64; t0 += 16) {
                bu_tile(d, us, but, t0, lane);
                f32x4 brv[4], biv[4];
#pragma unroll
                for (int q = 0; q < 4; ++q) { brv[q] = *(const LAS f32x4*)(but + lane * BUP + 4 * q); biv[q] = *(const LAS f32x4*)(but + (64 + lane) * BUP + 4 * q); }
#pragma unroll
                for (int t = 0; t < 16; ++t) { const float br = brv[t >> 2][t & 3], bi = biv[t >> 2][t & 3];
                    const float nr = fmaf(d.lr, xr, fmaf(-d.li, xi, br)), ni = fmaf(d.lr, xi, fmaf(d.li, xr, bi)); xr = nr; xi = ni; }
            }
        }
        ENDST[((size_t)bg * SSM_NSEG + seg) * 64 + lane] = (f32x2){xr, xi};
    }
}
__device__ __forceinline__ float gelu_tanh(float y) { const float a = 0.7978845608028654f * (y + 0.044715f * y * y * y); const float t = 1.0f - 2.0f * __builtin_amdgcn_rcpf(1.0f + fexp(2.0f * a)); return 0.5f * y * (1.0f + t); }
constexpr int XP = 272;
__device__ __forceinline__ void pass2(LAS unsigned char* xt  , int gwv, int NGW, int lane, const float* U32, const float* LRE, const float* LIM, const float* BRE, const float* BIM,
                                      const float* CRE, const float* CIM, const float* LSTEP, const float* DSK, const f32x2* ENDST, bf16* Y1) {
    const int fr = lane & 15, fq = lane >> 4;
    LAS float* us = (LAS float*)(xt + 16 * XP); LAS float* but = (LAS float*)(xt + 16 * XP + 4096);
#pragma unroll 1
    for (int wu = gwv; wu < BATCH * SSM_G * SSM_NSEG; wu += NGW) {
        const int g = wu & 255, seg = (wu >> 8) & (SSM_NSEG - 1), b = wu >> 13, bg = b * 256 + g;
        Disc d; discretise(d, g, lane, LRE, LIM, BRE, BIM, LSTEP);
        const size_t row0 = (size_t)b * SEQ + (size_t)seg * SSM_SL;
        const float* up = U32 + row0 * 4096 + 16 * g;
        Slab sl; slab_issue(sl, up, lane);
        float pr = d.lr, pi = d.li;
#pragma unroll
        for (int i = 0; i < 8; ++i) { const float a = pr * pr - pi * pi, c = 2.0f * pr * pi; pr = a; pi = c; }
        float xr = 0.f, xi = 0.f;
#pragma unroll 1
        for (int s = 0; s < seg; ++s) { const f32x2 e = ENDST[((size_t)bg * SSM_NSEG + s) * 64 + lane];
            const float nr = fmaf(pr, xr, fmaf(-pi, xi, e.x)), ni = fmaf(pr, xi, fmaf(pi, xr, e.y)); xr = nr; xi = ni; }
        bf16x8 cf[4];
#pragma unroll
        for (int s = 0; s < 4; ++s) { const float* cp = (s < 2 ? CRE : CIM) + (size_t)(g * 16 + fr) * 64 + 32 * (s & 1) + 8 * fq; const float sg = s < 2 ? 1.0f : -1.0f;
            const f32x4 a = *(const f32x4*)cp * sg, c = *(const f32x4*)(cp + 4) * sg; cf[s] = pack8(a, c); }
        const float dsk = DSK[16 * g + fr];
#pragma unroll 1
        for (int tb = 0; tb < SSM_SL; tb += 64) {
            slab_store(sl, us, lane);
            if (tb + 64 < SSM_SL) slab_issue(sl, up + (size_t)(tb + 64) * 4096, lane);
#pragma unroll 1
            for (int t0 = 0; t0 < 64; t0 += 16) {
                bu_tile(d, us, but, t0, lane);
                f32x4 brv[4], biv[4];
#pragma unroll
                for (int q = 0; q < 4; ++q) { brv[q] = *(const LAS f32x4*)(but + lane * BUP + 4 * q); biv[q] = *(const LAS f32x4*)(but + (64 + lane) * BUP + 4 * q); }
#pragma unroll
                for (int t = 0; t < 16; ++t) { const float br = brv[t >> 2][t & 3], bi = biv[t >> 2][t & 3];
                    const float nr = fmaf(d.lr, xr, fmaf(-d.li, xi, br)), ni = fmaf(d.lr, xi, fmaf(d.li, xr, bi)); xr = nr; xi = ni;
                    const unsigned w = cvtpk(xr, xi);
                    *(LAS bf16*)(xt + t * XP + lane * 2) = (bf16)(w & 0xffffu); *(LAS bf16*)(xt + t * XP + 128 + lane * 2) = (bf16)(w >> 16); }
                LDS_WAIT();
                f32x4 acc = {0.f, 0.f, 0.f, 0.f};
#pragma unroll
                for (int s = 0; s < 4; ++s) { const bf16x8 xa = *(const LAS bf16x8*)(xt + fr * XP + (32 * s + 8 * fq) * 2); acc = __builtin_amdgcn_mfma_f32_16x16x32_bf16(xa, cf[s], acc, 0, 0, 0); }
#pragma unroll
                for (int e = 0; e < 4; ++e) { const int tl = t0 + 4 * fq + e; const float u = us[tl * 16 + fr];
                    const float y = gelu_tanh(acc[e] + dsk * u);
                    Y1[(row0 + tb + tl) * 4096 + 16 * g + fr] = (bf16)(cvtpk(y, 0.f) & 0xffffu); }
                LDS_WAIT();
            }
        }
    }
}
}
constexpr int PH_PER_LAYER = 10, PH_FINAL = 40, PH_END = 41;
__host__ __device__ constexpr bool phase_exists(int ph) {
    if (ph == PH_FINAL) return true; if (ph < 0 || ph >= PH_FINAL) return false;
    const int L = ph / PH_PER_LAYER, k = ph % PH_PER_LAYER, kind = L % 3;
    if (k == 4) return kind != 0; return k <= 6;
}
typedef const __attribute__((address_space(4))) Args* kargs_t;
#define KARGS() ({ kargs_t p_ = (kargs_t)__builtin_amdgcn_kernarg_segment_ptr(); asm volatile("" : "+s"(p_)); p_; })
#define WSP(T, off) ((T*)(ws + (off)))
__global__ void __launch_bounds__(NTHR, 2) trunk_fwd(Args args_unused) {
    extern __shared__ __attribute__((aligned(16))) unsigned char lds_raw[];
    LAS unsigned char* lds = (LAS unsigned char*)lds_raw;
    const int w0 = __builtin_amdgcn_readfirstlane(threadIdx.x >> 6);
    const int G = gridDim.x, bx = blockIdx.x, vcu = (G % 8 == 0) ? (bx % 8) * (G / 8) + bx / 8 : bx, NGW = G * NWAVES;
#define TIDS() const int tid = otid(w0), lane = tid & 63, wid = __builtin_amdgcn_readfirstlane(tid >> 6), gwv = vcu * NWAVES + wid; (void)lane; (void)gwv
    { volatile LAS unsigned* MISC = (volatile LAS unsigned*)(lds + MISC_OFF); if (threadIdx.x < 32) MISC[threadIdx.x] = 0u; }
    __syncthreads();
    int lo, hi;
    { kargs_t ap = KARGS(); lo = ap->ph_lo; hi = ap->ph_hi;
      if (hi - lo > 1) (void)xcd_barrier_post((unsigned*)(ap->ws + WS_CTL) + CW_BAR + ap->li * XCD_BAR_WORDS, (volatile LAS unsigned*)(lds + MISC_OFF) + 8); }
#define IN(k) (lo <= (k) && (k) < hi)
#define SEAM(k) do { if ((k) + 1 < hi) { kargs_t ap_ = KARGS(); XcdBarrier b_; b_.bar = (unsigned*)(ap_->ws + WS_CTL) + CW_BAR + ap_->li * XCD_BAR_WORDS; b_.x = xb_xcc_id(); \
        b_.st = (volatile LAS unsigned*)(lds + MISC_OFF) + 8; b_.tid = (unsigned)otid(w0); xcd_barrier(b_); } } while (0)

#pragma unroll 1
    for (int L = 0; L < DEPTH; ++L) {
        const int base = L * PH_PER_LAYER, kind = L % 3, j = L / 3;

        if (IN(base + 0)) {
            kargs_t ap = KARGS(); unsigned char* ws = ap->ws; TIDS();
            LAS float* scr = (LAS float*)(lds + wid * 16384);
            const int n_in = kind == 0 ? 16416 : kind == 1 ? 16448 : 8192;
            const float* w_in = kind == 0 ? ap->in[I_FOX_WIN] + (size_t)j * 4096 * 16416 : kind == 1 ? ap->in[I_GDN_WIN] : ap->in[I_SSM_WIN];
            const float* w_out = kind == 0 ? ap->in[I_FOX_WOUT] + (size_t)j * 4096 * 4096 : kind == 1 ? ap->in[I_GDN_WOUT] : ap->in[I_SSM_WOUT];
            transpose_matrix(w_in, 4096, n_in, WSP(bf16, WS_WIN), 16384, WSP(bf16, WS_WSK), ap->in[I_NORM_MIX] + (size_t)L * D_MODEL, scr, gwv, NGW, lane);
            transpose_matrix(w_out, 4096, 4096, WSP(bf16, WS_WOUT), 4096, WSP(bf16, WS_WOUT), nullptr, scr, gwv, NGW, lane);
            transpose_matrix(ap->in[I_PLE_WGATE] + (size_t)L * 4096 * 4096, 4096, 4096, WSP(bf16, WS_WGATE), 4096, WSP(bf16, WS_WGATE), ap->in[I_NORM_PLE] + (size_t)L * D_MODEL, scr, gwv, NGW, lane);
            transpose_matrix(ap->in[I_PLE_WPROJ] + (size_t)L * 256 * 4096, 256, 4096, WSP(bf16, WS_WPP), 4096, WSP(bf16, WS_WPP), nullptr, scr, gwv, NGW, lane);
            if (kind == 2) transpose_matrix(ap->in[I_SSM_WGLU], 4096, 4096, WSP(bf16, WS_WGLU), 4096, WSP(bf16, WS_WGLU), nullptr, scr, gwv, NGW, lane);
            { const float* p = ap->in[I_P] + (size_t)L * M_TOK * PLE_DIM; bf16* P_BF = WSP(bf16, WS_PBF);
              for (size_t i = (size_t)bx * NTHR + tid; i < (size_t)M_TOK * PLE_DIM / 8; i += (size_t)G * NTHR) {
                  const f32x4 a = *(const f32x4*)(p + i * 8), b = *(const f32x4*)(p + i * 8 + 4); *(bf16x8*)(P_BF + i * 8) = pack8(a, b); } }
            if (L == 0) { const float* x = ap->in[I_X]; bf16* X0 = WSP(bf16, WS_X0); ssq_t* ssq_in = SSQ_PTR(0);
                for (int m = gwv; m < M_TOK; m += NGW) { const float s = row_to_bf16(x + (size_t)m * 4096, X0 + (size_t)m * 4096, lane); if (lane == 0) ssq_in[m] = ssq_fix(s); } }
            __syncthreads();
            SEAM(base + 0);
        }
        if (IN(base + 1)) {
            kargs_t ap = KARGS(); unsigned char* ws = ap->ws; TIDS();
            const bf16* A1 = WSP(bf16, WS_X0); const ssq_t* ssq_in = SSQ_PTR(2 * L);
            if (kind != 2) {
                LAS float* res = (LAS float*)lds; const bf16* W_SK = WSP(bf16, WS_WSK);
                for (int un = vcu; un < M_TOK / 64; un += G) {
                    const int r0 = un * 64;
                    if (kind == 0) {
                        float* CUML = WSP(float, WS_SMALL + SM_CUML); float* TTOT = WSP(float, WS_SMALL + SM_TTOT);
                        skinny_gemm<32>(A1, W_SK, ssq_in, r0, res, wid, lane);
                        __syncthreads();
                        if (tid < 32) { const int h = tid; const float bf = ap->in[I_FOX_BF][j * 32 + h]; float run = 0.f;
                            for (int r = 0; r < 64; ++r) { const float x = res[r * 32 + h] + bf; const float lf = fminf(x, 0.f) - flog(1.0f + fexp(-fabsf(x))); run += lf; CUML[(size_t)(r0 + r) * 32 + h] = run; }
                            TTOT[(size_t)un * 32 + h] = run; }
                    } else {
                        float* BETA = WSP(float, WS_SMALL + SM_BETA); float* GLOG = WSP(float, WS_SMALL + SM_GLOG);
                        const float* dtb = ap->in[I_GDN_DTB]; const float* alog = ap->in[I_GDN_ALOG];
                        skinny_gemm<64>(A1, W_SK, ssq_in, r0, res, wid, lane);
                        __syncthreads();
                        for (int e = tid; e < 64 * 32; e += NTHR) { const int r = e >> 5, h = e & 31;
                            BETA[(size_t)(r0 + r) * 32 + h] = sigmoidf_(res[r * 64 + h]);
                            const float x = res[r * 64 + 32 + h] + dtb[h]; const float sp = fmaxf(x, 0.f) + flog(1.0f + fexp(-fabsf(x)));
                            GLOG[(size_t)(r0 + r) * 32 + h] = -fexp(alog[h]) * sp; }
                    }
                    __syncthreads();
                }
            }
            const int n_main = kind == 2 ? 8192 : 16384;
            pg8::Gemm g{A1, WSP(bf16, WS_WIN), M_TOK, n_main, 4096}; pg8::StaticOrder S; S.init(M_TOK, n_main, G, bx);
            pg8::EpiProj E{kind == 2 ? WSP(bf16, WS_PROJ) + 8192 : WSP(bf16, WS_PROJ), LDP, ssq_in, WSP(float, WS_SCR + SS_U32), kind == 2 ? 4096 : 0};
            pg8::gemm_phase<pg8::EpiProj, pg8::StaticOrder, true, true>(lds, g, S, E, w0);
            SEAM(base + 1);
        }
        if (IN(base + 2)) {
            kargs_t ap = KARGS(); unsigned char* ws = ap->ws; TIDS();
            if (kind == 0) {
                { const bf16* PROJ = WSP(bf16, WS_PROJ); float* QN2 = WSP(float, WS_SMALL + SM_QN2); float* KN2 = WSP(float, WS_SMALL + SM_KN2);
                  for (int it = gwv; it < BATCH * NHEAD * 128; it += NGW) fox::norm_item(PROJ, QN2, KN2, it, lane); }
                { const float* CUML = WSP(float, WS_SMALL + SM_CUML); const float* TTOT = WSP(float, WS_SMALL + SM_TTOT); float* CUM = WSP(float, WS_SMALL + SM_CUM);
                  LAS float* ps = (LAS float*)lds; LAS float* ct = ps + 512; LAS float* pr = ct + 64 * 33;
                  for (int un = vcu; un < BATCH * 128; un += G) { const int b = un >> 7, tile = un & 127, h = tid & 31, part = tid >> 5;
                      float sum = 0.f;
                      for (int tp = part; tp < tile; tp += 16) sum += TTOT[(size_t)(b * 128 + tp) * 32 + h];
                      ps[part * 32 + h] = sum;
                      { const f32x4 cv = *(const f32x4*)(CUML + ((size_t)b * SEQ + 64 * tile) * 32 + tid * 4); const int t = (tid * 4) >> 5, hh = (tid * 4) & 31;
#pragma unroll
                        for (int e = 0; e < 4; ++e) ct[t * 33 + hh + e] = cv[e]; }
                      __syncthreads();
                      if (tid < 32) { float p = 0.f;
#pragma unroll
                          for (int q = 0; q < 16; ++q) p += ps[q * 32 + tid];
                          pr[tid] = p; }
                      __syncthreads();
                      { const int t = tid & 63, hg = tid >> 6;
#pragma unroll
                        for (int k = 0; k < 4; ++k) { const int hh = hg * 4 + k; CUM[(size_t)(b * 32 + hh) * SEQ + 64 * tile + t] = pr[hh] + ct[t * 33 + hh]; } }
                      __syncthreads(); } }
            } else if (kind == 1) {
                const bf16* PROJ = WSP(bf16, WS_PROJ); const float* convw = ap->in[I_GDN_CONV]; const float* BETA = WSP(float, WS_SMALL + SM_BETA); const float* GLOG = WSP(float, WS_SMALL + SM_GLOG);
                float* GLT = WSP(float, WS_SMALL + SM_GL); unsigned char* REC = ws + WS_SCR;
                if (tid < 2) *(LAS unsigned*)(lds + tid * gdn::GRP_BYTES + gdn::G_S + 768) = 0u;
                __syncthreads();
                unsigned gbt = 0u;
                for (int pi = vcu; pi < BATCH * NHEAD * GDN_NCHUNK / 2; pi += G) gdn::prep_pair(lds, 2 * pi, PROJ, convw, BETA, GLOG, GLT, REC, gbt, w0);
                __syncthreads();
            } else if (kind == 2) {
                s5::pass1((LAS float*)(lds + wid * 16384), (LAS float*)(lds + wid * 16384 + 4096), gwv, NGW, lane, WSP(float, WS_SCR + SS_U32), ap->in[I_SSM_LRE], ap->in[I_SSM_LIM], ap->in[I_SSM_BRE], ap->in[I_SSM_BIM], ap->in[I_SSM_LSTEP], WSP(f32x2, WS_ENDST));
            }
            SEAM(base + 2);
        }
        if (IN(base + 3)) {
            kargs_t ap = KARGS(); unsigned char* ws = ap->ws; TIDS();
            if (kind == 0) fox::attn_phase((char*)lds_raw, WSP(bf16, WS_PROJ), WSP(bf16, WS_MIX), WSP(float, WS_SMALL + SM_CUM), WSP(float, WS_SMALL + SM_QN2), WSP(float, WS_SMALL + SM_KN2), vcu, G, w0);
            else if (kind == 1) { for (int un = vcu; un < BATCH * NHEAD * 4; un += G) gdn::scan_unit(lds, un, ws + WS_SCR, WSP(float, WS_SMALL + SM_GL), ap->out, w0); }
            else if (kind == 2) s5::pass2(lds + wid * 18944, gwv, NGW, lane, WSP(float, WS_SCR + SS_U32), ap->in[I_SSM_LRE], ap->in[I_SSM_LIM], ap->in[I_SSM_BRE], ap->in[I_SSM_BIM], ap->in[I_SSM_CRE], ap->in[I_SSM_CIM],
                           ap->in[I_SSM_LSTEP], ap->in[I_SSM_D], WSP(f32x2, WS_ENDST), WSP(bf16, WS_SCR + SS_Y1));
            SEAM(base + 3);
        }
        if (IN(base + 4) && kind == 1) {
            kargs_t ap = KARGS(); unsigned char* ws = ap->ws; TIDS();
            if (kind == 1) gdn::normgate(gwv, NGW, lane, ap->out, WSP(bf16, WS_PROJ), ap->in[I_GDN_NORM], WSP(bf16, WS_MIX));
            SEAM(base + 4);
        }
        if (IN(base + 4) && kind == 2) {
            kargs_t ap = KARGS(); unsigned char* ws = ap->ws; TIDS();
            pg8::Gemm g{WSP(bf16, WS_SCR + SS_Y1), WSP(bf16, WS_WGLU), M_TOK, 4096, 4096}; pg8::StaticOrder S; S.init(M_TOK, 4096, G, bx);
            pg8::EpiGlu E{WSP(bf16, WS_MIX), WSP(bf16, WS_SCR + SS_Y1), WSP(bf16, WS_PROJ) + ZCOL, LDP, ap->in[I_SSM_BGLU]};
            if (kind == 2) pg8::gemm_phase<pg8::EpiGlu, pg8::StaticOrder, true, true>(lds, g, S, E, w0);
            SEAM(base + 4);
        }
        if (IN(base + 5)) {
            { kargs_t ap = KARGS(); unsigned char* ws = ap->ws;
                  pg8::Gemm g{WSP(bf16, WS_MIX), WSP(bf16, WS_WOUT), M_TOK, 4096, 4096}; pg8::StaticOrder S; S.init(M_TOK, 4096, G, bx);
                  pg8::EpiOut E{WSP(bf16, WS_X0), WSP(bf16, WS_X1), SSQ_PTR(2 * L + 1)};
                  pg8::gemm_phase<pg8::EpiOut, pg8::StaticOrder, true, true>(lds, g, S, E, w0); }
            { kargs_t ap = KARGS(); unsigned char* ws = ap->ws;
                  pg8::Gemm g{WSP(bf16, WS_PBF), WSP(bf16, WS_WPP), M_TOK, 4096, 256}; pg8::StaticOrder S; S.init(M_TOK, 4096, G, bx);
                  pg8::EpiProj E{WSP(bf16, WS_PP), 4096, nullptr, nullptr, 0};
                  pg8::gemm_phase<pg8::EpiProj, pg8::StaticOrder, true, true>(lds, g, S, E, w0); }
            SEAM(base + 5);
        }
        if (IN(base + 6)) {
            kargs_t ap = KARGS(); unsigned char* ws = ap->ws; TIDS();
            pg8::Gemm g{WSP(bf16, WS_X1), WSP(bf16, WS_WGATE), M_TOK, 4096, 4096}; pg8::StaticOrder S; S.init(M_TOK, 4096, G, bx);
            pg8::EpiGate E{WSP(bf16, WS_X1), WSP(bf16, WS_X0), WSP(bf16, WS_PP), SSQ_PTR(2 * L + 1), SSQ_PTR(2 * L + 2)};
            pg8::gemm_phase<pg8::EpiGate, pg8::StaticOrder, true, true>(lds, g, S, E, w0);
            SEAM(base + 6);
        }
    }
    if (IN(PH_FINAL)) {
        kargs_t ap = KARGS(); unsigned char* ws = ap->ws; float* H = ap->out; TIDS();
        const float* gf = ap->in[I_FINAL_NORM]; const ssq_t* ssq = SSQ_PTR(8); const bf16* X0 = WSP(bf16, WS_X0);
        const unsigned bad = __hip_atomic_load(WSP(unsigned, WS_CTL) + CW_BAR + XB_TMO, __ATOMIC_RELAXED, __HIP_MEMORY_SCOPE_AGENT);
        for (int m = gwv; m < M_TOK; m += NGW) { const float rs = bad ? __builtin_nanf("") : __builtin_amdgcn_rsqf(ssq_val(ssq[m]) * (1.0f / 4096.0f) + NORM_EPS); float* row = H + (size_t)m * 4096;
#pragma unroll
            for (int jj = 0; jj < 8; ++jj) { const int c = (jj * 64 + lane) * 8; const u32x4 w = *(const u32x4*)(X0 + (size_t)m * 4096 + c);
                const f32x4 g0 = *(const f32x4*)(gf + c), g1 = *(const f32x4*)(gf + c + 4);
                const f32x4 v0 = {bflo(w.x), bfhi(w.x), bflo(w.y), bfhi(w.y)}, v1 = {bflo(w.z), bfhi(w.z), bflo(w.w), bfhi(w.w)};
                *(f32x4*)(row + c) = v0 * rs * g0; *(f32x4*)(row + c + 4) = v1 * rs * g1; } }
    }
#undef IN
#undef SEAM
}

extern "C" void kernel_launch(void* const* d_in, const int* in_sizes, int n_in, void* d_out, int out_size, void* d_ws, size_t ws_size, hipStream_t stream) {
    static int grid = 0;
    if (grid == 0) {
        if (n_in != 28 || out_size != M_TOK * D_MODEL || ws_size < WS_END) { fprintf(stderr, "kernel_launch: unexpected shapes (n_in %d, out %d, ws %zu)\n", n_in, out_size, ws_size); grid = -1; return; }
        int dev = 0, cus = 0, per_cu = 0;
        if (hipGetDevice(&dev) != hipSuccess || hipDeviceGetAttribute(&cus, hipDeviceAttributeMultiprocessorCount, dev) != hipSuccess) { grid = -1; return; }
        if (hipFuncSetAttribute((const void*)trunk_fwd, hipFuncAttributeMaxDynamicSharedMemorySize, LDS_BYTES) != hipSuccess) { fprintf(stderr, "kernel_launch: hipFuncSetAttribute failed\n"); grid = -1; return; }
        if (hipOccupancyMaxActiveBlocksPerMultiprocessor(&per_cu, (const void*)trunk_fwd, NTHR, LDS_BYTES) != hipSuccess || per_cu < 1) { fprintf(stderr, "kernel_launch: occupancy query says %d\n", per_cu); per_cu = 1; }
        (void)hipGetLastError();
        grid = cus;
    }
    if (grid < 0) return;
    if (hipMemsetAsync((char*)d_ws + WS_CTL, 0, CTL_ZERO_BYTES, stream) != hipSuccess) return;
    Args a{};
    for (int i = 0; i < 28; ++i) a.in[i] = (const float*)d_in[i];
    a.out = (float*)d_out; a.ws = (unsigned char*)d_ws;
#if MK_PER_PHASE
    int li = 0;
    for (int ph = 0; ph < PH_END; ++ph) { if (!phase_exists(ph)) continue;
        a.ph_lo = ph; a.ph_hi = ph + 1; a.li = li++; a.pad = 0;
        hipLaunchKernelGGL(trunk_fwd, dim3(grid), dim3(NTHR), LDS_BYTES, stream, a); }
#elif defined(PROBE_PH)
    { int li = 0; const int cut = PROBE_PH + PROBE_LEN;
      a.ph_lo = 0; a.ph_hi = cut; a.li = li++; a.pad = 0; hipLaunchKernelGGL(trunk_fwd, dim3(grid), dim3(NTHR), LDS_BYTES, stream, a);
      a.pad = PROBE_MODE;
      for (int r = 0; r < PROBE_N; ++r) { a.ph_lo = PROBE_PH; a.ph_hi = cut; a.li = li++; hipLaunchKernelGGL(trunk_fwd, dim3(grid), dim3(NTHR), LDS_BYTES, stream, a); }
      a.pad = 0; a.ph_lo = cut; a.ph_hi = PH_END; a.li = li++; hipLaunchKernelGGL(trunk_fwd, dim3(grid), dim3(NTHR), LDS_BYTES, stream, a); }
#else
    a.ph_lo = 0; a.ph_hi = PH_END; a.li = 0; a.pad = 0;
    hipLaunchKernelGGL(trunk_fwd, dim3(grid), dim3(NTHR), LDS_BYTES, stream, a);
#endif
}
```

```cpp
#include <hip/hip_runtime.h>
#include <cstdio>
#include <cstdint>

#ifndef MK_PER_PHASE
#define MK_PER_PHASE 0
#endif

constexpr int D_MODEL = 4096, BATCH = 2, SEQ = 8192, DEPTH = 4, PLE_DIM = 256;
constexpr int M_TOK = BATCH * SEQ;
constexpr int NHEAD = 32, HDIM = 128;
constexpr float NORM_EPS = 1e-6f;
constexpr int LDP = 16384;
constexpr int ZCOL = 12288;
constexpr int GDN_CHUNK = 64, GDN_NCHUNK = SEQ / GDN_CHUNK;
constexpr int SSM_G = 256, SSM_N = 16, SSM_P = 64, SSM_SL = 256, SSM_NSEG = SEQ / SSM_SL;

constexpr size_t MiB = 1u << 20;
constexpr size_t WS_CTL = 0, CTL_ZERO_BYTES = 2 * MiB;
constexpr size_t WS_WIN = 2 * MiB;
constexpr size_t WS_WSK = 130 * MiB;
constexpr size_t WS_WOUT = 131 * MiB;
constexpr size_t WS_WGATE = 163 * MiB;
constexpr size_t WS_WPP = 195 * MiB;
constexpr size_t WS_WGLU = 197 * MiB;
constexpr size_t WS_PBF = 229 * MiB;
constexpr size_t WS_X0 = 237 * MiB;
constexpr size_t WS_X1 = 365 * MiB;
constexpr size_t WS_PROJ = 493 * MiB;
constexpr size_t WS_MIX = 1005 * MiB;
constexpr size_t WS_PP = 1133 * MiB;
constexpr size_t WS_SCR = 1261 * MiB;
constexpr size_t WS_SMALL = 1837 * MiB;
constexpr size_t WS_ENDST = 1846 * MiB;
constexpr size_t WS_END = 1854 * MiB;
constexpr size_t GR_QD = 0, GR_W = 16384, GR_KT = 32768, GR_U = 49152, GR_IN = 65536, GR_BYTES = 73728;
constexpr size_t SS_U32 = 0, SS_Y1 = 256 * MiB, SS_END = 384 * MiB;
constexpr size_t SM_CUML = 0;
constexpr size_t SM_TTOT = 2 * MiB;
constexpr size_t SM_CUM = 2 * MiB + 65536;
constexpr size_t SM_QN2 = 2 * MiB + 32768;
constexpr size_t SM_KN2 = 4 * MiB + 65536;
constexpr size_t SM_BETA = 5 * MiB;
constexpr size_t SM_GLOG = 7 * MiB;
constexpr size_t SM_SS = SM_CUM;
constexpr size_t SM_GL = 0;
static_assert(SM_CUM + 64 * 8192 * 4 <= SM_BETA && SM_GLOG + (size_t)M_TOK * 32 * 4 <= 9 * MiB, "small tables");
static_assert(WS_SMALL + 9 * MiB <= WS_ENDST && WS_ENDST + 8 * MiB <= WS_END, "ws end");
constexpr int CW_TMO = 0, CW_CODE = 1, CW_ERR = 1024  , CW_BAR = 16384  ;
typedef unsigned long long ssq_t;
constexpr size_t CTL_SUMSQ = 1 * MiB;
constexpr size_t WS_SSQ0 = 130 * MiB + 512 * 1024;
constexpr float SSQ_SCALE = 16777216.0f, SSQ_INV = 1.0f / 16777216.0f;
#define SSQ_PTR(i) ((ssq_t*)(ws + ((i) == 0 ? WS_SSQ0 : CTL_SUMSQ + (size_t)((i) - 1) * M_TOK * sizeof(ssq_t))))

#define LAS __attribute__((address_space(3)))
#define GAS __attribute__((address_space(1)))
typedef unsigned short bf16;
typedef short bf16x8 __attribute__((ext_vector_type(8)));
typedef short s16x4 __attribute__((ext_vector_type(4)));
typedef float f32x2 __attribute__((ext_vector_type(2)));
typedef float f32x4 __attribute__((ext_vector_type(4)));
typedef float f32x16 __attribute__((ext_vector_type(16)));
typedef unsigned u32x2 __attribute__((ext_vector_type(2)));
typedef unsigned u32x4 __attribute__((ext_vector_type(4)));
#define LDS_WAIT() asm volatile("s_waitcnt lgkmcnt(0)" ::: "memory")
#define VM_WAIT() asm volatile("s_waitcnt vmcnt(0)" ::: "memory")
typedef __bf16 bf16x2_t __attribute__((ext_vector_type(2)));
__device__ __forceinline__ unsigned cvtpk(float lo, float hi) { const f32x2 v = {lo, hi}; const bf16x2_t b = __builtin_convertvector(v, bf16x2_t); return __builtin_bit_cast(unsigned, b); }
__device__ __forceinline__ ssq_t ssq_fix(float s) { return (ssq_t)(s * 16777216.0f + 0.5f); }
__device__ __forceinline__ float ssq_val(ssq_t x) { return ((float)(unsigned)(x >> 32) * 4294967296.0f + (float)(unsigned)x) * (1.0f / 16777216.0f); }
__device__ __forceinline__ float bf2f(unsigned short b) { return __uint_as_float(((unsigned)b) << 16); }
__device__ __forceinline__ float bflo(unsigned w) { return __uint_as_float(w << 16); }
__device__ __forceinline__ float bfhi(unsigned w) { return __uint_as_float(w & 0xffff0000u); }
__device__ __forceinline__ float fexp(float x) { return __builtin_amdgcn_exp2f(x * 1.4426950408889634f); }
__device__ __forceinline__ float flog(float x) { return __builtin_amdgcn_logf(x) * 0.6931471805599453f; }
__device__ __forceinline__ float sigmoidf_(float x) { return __builtin_amdgcn_rcpf(1.0f + fexp(-x)); }
__device__ __forceinline__ float siluf_(float x) { return x * sigmoidf_(x); }
__device__ __forceinline__ bf16x8 pack8(f32x4 a, f32x4 b) { u32x4 w = {cvtpk(a[0], a[1]), cvtpk(a[2], a[3]), cvtpk(b[0], b[1]), cvtpk(b[2], b[3])}; return __builtin_bit_cast(bf16x8, w); }
__device__ __forceinline__ void unpack8(u32x4 w, float* f) { f[0] = bflo(w.x); f[1] = bfhi(w.x); f[2] = bflo(w.y); f[3] = bfhi(w.y); f[4] = bflo(w.z); f[5] = bfhi(w.z); f[6] = bflo(w.w); f[7] = bfhi(w.w); }
__device__ __forceinline__ float wave_sum(float v) {
#pragma unroll
    for (int o = 1; o < 64; o <<= 1) v += __shfl_xor(v, o);
    return v;
}
__device__ __forceinline__ int otid(int w0) { unsigned z = 0u; asm volatile("" : "+v"(z));
    int t = (w0 << 6) | (int)__builtin_amdgcn_mbcnt_hi(~0u, __builtin_amdgcn_mbcnt_lo(~0u, z)); asm volatile("" : "+v"(t)); return t; }
__device__ __forceinline__ u32x4 ozero4() { u32x4 z = {0u, 0u, 0u, 0u}; asm volatile("" : "+v"(z)); return z; }
namespace pg8 {
#define PG8_LAS __attribute__((address_space(3)))
typedef unsigned short bf16_t;
typedef short bf16x8 __attribute__((ext_vector_type(8)));
typedef float f32x4 __attribute__((ext_vector_type(4)));
typedef unsigned u32x4 __attribute__((ext_vector_type(4)));
constexpr int BM = 256, BK = 64, HALF = 128, HTB = HALF * BK * 2  , STAGE_BYTES = 8 * HTB, NXCD = 8, WGM = 8;

__host__ __device__ __forceinline__ int lds_byte(int r, int c) { const int st = (r >> 4) * 2 + (c >> 5), rr = r & 15, cc = c & 31, ob = rr * 64 + cc * 2; return st * 1024 + (ob ^ (((ob >> 9) & 1) << 5)); }
__host__ __device__ __forceinline__ void stage_rc(int b, int& R, int& C) { const int st = b / 1024, sb = b % 1024, swz = sb ^ (((sb >> 9) & 1) << 5); R = (st >> 1) * 16 + swz / 64; C = (st & 1) * 32 + (swz % 64) / 2; }
__host__ __device__ __forceinline__ int perm32(int rho) { const int n = rho >> 4, i = rho & 15; return 8 * (i >> 2) + 4 * n + (i & 3); }

struct Unit { int pm, pn; };
struct Gemm { const bf16_t* A; const bf16_t* Bt; int M, N, K; };

struct StaticOrder {
    int nM, nN, nwg, G, c;
    __host__ __device__ void init(int M, int N, int G_, int c_) { nM = M / BM; nN = N / BM; nwg = nM * nN; G = G_; c = c_; }
    __host__ __device__ bool next(int i, Unit& u) const {
        const long L = (long)i * G + c; if (L >= nwg) return false;
        int wgid = (int)L; { const int q = nwg / NXCD, r = nwg % NXCD, xcd = wgid % NXCD, off = wgid / NXCD; wgid = (xcd < r ? xcd * (q + 1) : r * (q + 1) + (xcd - r) * q) + off; }
        const int nig = WGM * nN, gid = wgid / nig, fm = gid * WGM, gsz = (nM - fm) < WGM ? (nM - fm) : WGM;
        u.pm = fm + ((wgid % nig) % gsz); u.pn = (wgid % nig) / gsz; return true;
    }
    __device__ __forceinline__ void a_ready(const Unit&) const {}
    __device__ __forceinline__ void done(const Unit&) const {}
};
__device__ __forceinline__ unsigned cvt_pk_bf16(float lo, float hi) { return ::cvtpk(lo, hi); }
__device__ __forceinline__ float sgm(float x) { return __builtin_amdgcn_rcpf(1.0f + __builtin_amdgcn_exp2f(x * -1.4426950408889634f)); }
__device__ __forceinline__ float bl(unsigned w) { return __uint_as_float(w << 16); }
__device__ __forceinline__ float bh(unsigned w) { return __uint_as_float(w & 0xffff0000u); }
constexpr float kEps = 1e-6f, kInvD = 1.0f / 4096.0f;
#ifndef EPI_RB
#define EPI_RB 4
#endif

struct EpiProj {
    static constexpr bool PERM = true, AFTER_DRAIN = false;
    bf16_t* O; int ldc; const ssq_t* sumsq; float* F32O; int f32cols;
    __device__ __forceinline__ void operator()(const f32x4 (&acc)[2][2][4][2], const Unit& u, int wr, int wc, int fr, int fq) const {
        const int row0 = u.pm * BM + wr * 64 + fr, colt = u.pn * BM, col0 = colt + wc * 32 + 8 * fq;
        const bool tof32 = colt < f32cols;
        ssq_t rsv[2][4];
#pragma unroll
        for (int ai = 0; ai < 2; ++ai)
#pragma unroll
            for (int m = 0; m < 4; ++m) rsv[ai][m] = sumsq ? sumsq[row0 + ai * HALF + m * 16] : 0ull;
#pragma unroll
        for (int ai = 0; ai < 2; ++ai)
#pragma unroll
            for (int m = 0; m < 4; ++m) { const int r = row0 + ai * HALF + m * 16;
                const float rs = sumsq ? __builtin_amdgcn_rsqf(ssq_val(rsv[ai][m]) * kInvD + kEps) : 1.0f;
#pragma unroll
                for (int bj = 0; bj < 2; ++bj) { const f32x4 v0 = acc[ai][bj][m][0] * rs, v1 = acc[ai][bj][m][1] * rs; const int c = col0 + bj * HALF;
                    if (tof32) { float* p = F32O + (size_t)r * f32cols + c; *(__attribute__((address_space(1))) f32x4*)p = v0; *(__attribute__((address_space(1))) f32x4*)(p + 4) = v1; }
                    else { u32x4 w; w.x = cvt_pk_bf16(v0[0], v0[1]); w.y = cvt_pk_bf16(v0[2], v0[3]); w.z = cvt_pk_bf16(v1[0], v1[1]); w.w = cvt_pk_bf16(v1[2], v1[3]);
                        *(u32x4*)(O + (size_t)r * ldc + c) = w; } } }
    }
};
struct EpiOut {
    static constexpr bool PERM = true, AFTER_DRAIN = false;
    const bf16_t* hin; bf16_t* hout; ssq_t* sumsq2;
    __device__ __forceinline__ void operator()(const f32x4 (&acc)[2][2][4][2], const Unit& u, int wr, int wc, int fr, int fq) const {
        const int row0 = u.pm * BM + wr * 64 + fr, col0 = u.pn * BM + wc * 32 + 8 * fq;
#pragma unroll
        for (int ai = 0; ai < 2; ++ai)
#pragma unroll
          for (int mp = 0; mp < 4 / EPI_RB; ++mp) {
            u32x4 hv[EPI_RB][2];
#pragma unroll
            for (int mm = 0; mm < EPI_RB; ++mm)
#pragma unroll
                for (int bj = 0; bj < 2; ++bj) hv[mm][bj] = *(const u32x4*)(hin + (size_t)(row0 + ai * HALF + (EPI_RB * mp + mm) * 16) * 4096 + col0 + bj * HALF);
#pragma unroll
            for (int mm = 0; mm < EPI_RB; ++mm) { const int m = EPI_RB * mp + mm, r = row0 + ai * HALF + m * 16; float s = 0.f;
#pragma unroll
                for (int bj = 0; bj < 2; ++bj) { const size_t off = (size_t)r * 4096 + col0 + bj * HALF; const u32x4 hw = hv[mm][bj];
                    const f32x4 v0 = f32x4{bl(hw.x), bh(hw.x), bl(hw.y), bh(hw.y)} + acc[ai][bj][m][0], v1 = f32x4{bl(hw.z), bh(hw.z), bl(hw.w), bh(hw.w)} + acc[ai][bj][m][1];
                    u32x4 w; w.x = cvt_pk_bf16(v0[0], v0[1]); w.y = cvt_pk_bf16(v0[2], v0[3]); w.z = cvt_pk_bf16(v1[0], v1[1]); w.w = cvt_pk_bf16(v1[2], v1[3]);
                    *(u32x4*)(hout + off) = w;
                    s += (bl(w.x) * bl(w.x) + bh(w.x) * bh(w.x)) + (bl(w.y) * bl(w.y) + bh(w.y) * bh(w.y)) + (bl(w.z) * bl(w.z) + bh(w.z) * bh(w.z)) + (bl(w.w) * bl(w.w) + bh(w.w) * bh(w.w)); }
                s += __shfl_xor(s, 16); s += __shfl_xor(s, 32);
                if (fq == 0) atomicAdd(sumsq2 + r, ssq_fix(s)); }
            asm volatile("" ::: "memory"); }
    }
};
struct EpiGate {
    static constexpr bool PERM = true, AFTER_DRAIN = false;
    const bf16_t* hin; bf16_t* hout; const bf16_t* PP; const ssq_t* sumsq2; ssq_t* sumsqn;
    __device__ __forceinline__ void operator()(const f32x4 (&acc)[2][2][4][2], const Unit& u, int wr, int wc, int fr, int fq) const {
        const int row0 = u.pm * BM + wr * 64 + fr, col0 = u.pn * BM + wc * 32 + 8 * fq;
        ssq_t rsv[2][4];
#pragma unroll
        for (int ai = 0; ai < 2; ++ai)
#pragma unroll
            for (int m = 0; m < 4; ++m) rsv[ai][m] = sumsq2[row0 + ai * HALF + m * 16];
#pragma unroll
        for (int ai = 0; ai < 2; ++ai)
#pragma unroll
            for (int mp = 0; mp < 4 / EPI_RB; ++mp) {
                u32x4 hv[EPI_RB][2], pv[EPI_RB][2];
#pragma unroll
                for (int mm = 0; mm < EPI_RB; ++mm)
#pragma unroll
                    for (int bj = 0; bj < 2; ++bj) { const size_t off = (size_t)(row0 + ai * HALF + (EPI_RB * mp + mm) * 16) * 4096 + col0 + bj * HALF;
                        pv[mm][bj] = *(const u32x4*)(PP + off); hv[mm][bj] = *(const u32x4*)(hin + off); }
#pragma unroll
                for (int mm = 0; mm < EPI_RB; ++mm) { const int m = EPI_RB * mp + mm, r = row0 + ai * HALF + m * 16; float s = 0.f;
                    const float rs = __builtin_amdgcn_rsqf(ssq_val(rsv[ai][m]) * kInvD + kEps);
#pragma unroll
                    for (int bj = 0; bj < 2; ++bj) { const size_t off = (size_t)r * 4096 + col0 + bj * HALF;
                        const u32x4 pw = pv[mm][bj], hw = hv[mm][bj];
                        const f32x4 p0 = {bl(pw.x), bh(pw.x), bl(pw.y), bh(pw.y)}, p1 = {bl(pw.z), bh(pw.z), bl(pw.w), bh(pw.w)};
                        f32x4 g0 = acc[ai][bj][m][0] * rs, g1 = acc[ai][bj][m][1] * rs;
#pragma unroll
                        for (int j = 0; j < 4; ++j) { g0[j] = sgm(g0[j]); g1[j] = sgm(g1[j]); }
                        const f32x4 v0 = f32x4{bl(hw.x), bh(hw.x), bl(hw.y), bh(hw.y)} + g0 * p0, v1 = f32x4{bl(hw.z), bh(hw.z), bl(hw.w), bh(hw.w)} + g1 * p1;
                        u32x4 w; w.x = cvt_pk_bf16(v0[0], v0[1]); w.y = cvt_pk_bf16(v0[2], v0[3]); w.z = cvt_pk_bf16(v1[0], v1[1]); w.w = cvt_pk_bf16(v1[2], v1[3]);
                        *(u32x4*)(hout + off) = w;
                        s += (bl(w.x) * bl(w.x) + bh(w.x) * bh(w.x)) + (bl(w.y) * bl(w.y) + bh(w.y) * bh(w.y)) + (bl(w.z) * bl(w.z) + bh(w.z) * bh(w.z)) + (bl(w.w) * bl(w.w) + bh(w.w) * bh(w.w)); }
                    s += __shfl_xor(s, 16); s += __shfl_xor(s, 32);
                    if (fq == 0) atomicAdd(sumsqn + r, ssq_fix(s)); }
                asm volatile("" ::: "memory"); }
    }
};
struct EpiGlu {
    static constexpr bool PERM = true, AFTER_DRAIN = false;
    bf16_t* O; const bf16_t* Y1; const bf16_t* Z; int ldz; const float* bias;
    __device__ __forceinline__ void operator()(const f32x4 (&acc)[2][2][4][2], const Unit& u, int wr, int wc, int fr, int fq) const {
        const int row0 = u.pm * BM + wr * 64 + fr, col0 = u.pn * BM + wc * 32 + 8 * fq;
        f32x4 bv[2][2];
#pragma unroll
        for (int bj = 0; bj < 2; ++bj) { bv[bj][0] = *(const f32x4*)(bias + col0 + bj * HALF); bv[bj][1] = *(const f32x4*)(bias + col0 + bj * HALF + 4); }
#pragma unroll
        for (int ai = 0; ai < 2; ++ai)
#pragma unroll
            for (int m = 0; m < 4; ++m) { const int r = row0 + ai * HALF + m * 16;
#pragma unroll
                for (int bj = 0; bj < 2; ++bj) { const int c = col0 + bj * HALF;
                    const u32x4 yw = *(const u32x4*)(Y1 + (size_t)r * 4096 + c), zw = *(const u32x4*)(Z + (size_t)r * ldz + c);
                    const f32x4 y0 = {bl(yw.x), bh(yw.x), bl(yw.y), bh(yw.y)}, y1 = {bl(yw.z), bh(yw.z), bl(yw.w), bh(yw.w)};
                    const f32x4 z0 = {bl(zw.x), bh(zw.x), bl(zw.y), bh(zw.y)}, z1 = {bl(zw.z), bh(zw.z), bl(zw.w), bh(zw.w)};
                    f32x4 g0 = acc[ai][bj][m][0] + bv[bj][0], g1 = acc[ai][bj][m][1] + bv[bj][1];
#pragma unroll
                    for (int j = 0; j < 4; ++j) { g0[j] = y0[j] * sgm(g0[j]) * (z0[j] * sgm(z0[j])); g1[j] = y1[j] * sgm(g1[j]) * (z1[j] * sgm(z1[j])); }
                    u32x4 w; w.x = cvt_pk_bf16(g0[0], g0[1]); w.y = cvt_pk_bf16(g0[2], g0[3]); w.z = cvt_pk_bf16(g1[0], g1[1]); w.w = cvt_pk_bf16(g1[2], g1[3]);
                    *(u32x4*)(O + (size_t)r * 4096 + c) = w; }
                asm volatile("" ::: "memory"); }
    }
};
template <class Epi, class Sched, bool ALIGN_EPI = false, bool SP2 = false>
__device__ __forceinline__ void gemm_phase(PG8_LAS unsigned char* lds, const Gemm g, const Sched& S, const Epi& E, const int w0) {
    const int tid = otid(w0), wid = __builtin_amdgcn_readfirstlane(tid >> 6), lane = tid & 63, wr = wid >> 2, wc = wid & 3, fr = lane & 15, fq = lane >> 4;
    const int K = g.K, nt = K / BK;
    unsigned voffA[2], voffB[2];
#pragma unroll
    for (int i = 0; i < 2; ++i) { int R, C; stage_rc(tid * 16 + i * 8192, R, C); const int Rb = Epi::PERM ? ((R & ~31) + perm32(R & 31)) : R;
        voffA[i] = (unsigned)(R * K + C) * 2u; voffB[i] = (unsigned)(Rb * K + C) * 2u; }
    const size_t kstep = (size_t)(BK * 2);
    const size_t hstep = (size_t)HALF * K * 2;
    const size_t tstep = 2 * hstep;
    const unsigned ldsw = (unsigned)wid * 1024u;
    const int aoff = lds_byte(wr * 64 + fr, fq * 8), boff = lds_byte(wc * 32 + fr, fq * 8);
#define PG8_SA(b, h) (((b) * 2 + (h)) * HTB)
#define PG8_SB(b, h) ((4 + (b) * 2 + (h)) * HTB)
#define PG8_STAGE(bufoff, gbase, voff) do { _Pragma("unroll") for (int _i = 0; _i < 2; ++_i) \
        __builtin_amdgcn_global_load_lds((const unsigned*)((const char*)(gbase) + (voff)[_i]), (PG8_LAS unsigned*)(lds + (bufoff) + ldsw + _i * 8192), 16, 0, 0); } while (0)
#define PG8_LDA(dst, b, h) do { _Pragma("unroll") for (int m = 0; m < 4; ++m) _Pragma("unroll") for (int k = 0; k < 2; ++k) dst[m][k] = *(const PG8_LAS bf16x8*)(lds + PG8_SA(b, h) + aoff + m * 2048 + k * 1024); } while (0)
#define PG8_LDB(dst, b, h) do { _Pragma("unroll") for (int n = 0; n < 2; ++n) _Pragma("unroll") for (int k = 0; k < 2; ++k) dst[n][k] = *(const PG8_LAS bf16x8*)(lds + PG8_SB(b, h) + boff + n * 2048 + k * 1024); } while (0)
#define PG8_MMA(ai, bj, At, Bt) do { __builtin_amdgcn_s_setprio(1); _Pragma("unroll") for (int m = 0; m < 4; ++m) _Pragma("unroll") for (int n = 0; n < 2; ++n) _Pragma("unroll") for (int k = 0; k < 2; ++k) \
        acc[ai][bj][m][n] = __builtin_amdgcn_mfma_f32_16x16x32_bf16(Bt[n][k], At[m][k], acc[ai][bj][m][n], 0, 0, 0); __builtin_amdgcn_s_setprio(0); } while (0)
#define PG8_WAIT_V(n) asm volatile("s_waitcnt vmcnt(" #n ")" ::: "memory")
#define PG8_WAIT_L(n) asm volatile("s_waitcnt lgkmcnt(" #n ")" ::: "memory")
#define PG8_BAR __builtin_amdgcn_s_barrier()
#define PG8_SCHED __builtin_amdgcn_sched_barrier(0)
    Unit cur, nxt; int ui = 0;
    if (!S.next(0, cur)) return;
    f32x4 acc[2][2][4][2];
#pragma unroll
    for (int a = 0; a < 2; ++a)
#pragma unroll
        for (int b = 0; b < 2; ++b)
#pragma unroll
            for (int m = 0; m < 4; ++m)
#pragma unroll
                for (int n = 0; n < 2; ++n) acc[a][b][m][n] = (f32x4){0.f, 0.f, 0.f, 0.f};
    bf16x8 At[4][2], B0[2][2], B1[2][2];
    const char* cA = (const char*)g.A + (size_t)cur.pm * tstep; const char* cB = (const char*)g.Bt + (size_t)cur.pn * tstep;
    S.a_ready(cur);
    if constexpr (SP2) {
        PG8_STAGE(PG8_SB(0, 0), cB, voffB); PG8_STAGE(PG8_SB(0, 1), cB + hstep, voffB); PG8_STAGE(PG8_SA(0, 0), cA, voffA); PG8_STAGE(PG8_SA(0, 1), cA + hstep, voffA);
        if (wr == 1) PG8_BAR;
        PG8_WAIT_V(2); PG8_BAR;
        PG8_STAGE(PG8_SB(1, 0), cB + kstep, voffB); PG8_STAGE(PG8_SA(1, 0), cA + kstep, voffA); PG8_STAGE(PG8_SB(1, 1), cB + hstep + kstep, voffB);
        PG8_WAIT_V(6); PG8_BAR;
    } else {
        PG8_STAGE(PG8_SB(0, 0), cB, voffB); PG8_STAGE(PG8_SA(0, 0), cA, voffA); PG8_STAGE(PG8_SB(0, 1), cB + hstep, voffB); PG8_STAGE(PG8_SA(0, 1), cA + hstep, voffA);
        if (wr == 1) PG8_BAR;
        PG8_WAIT_V(4); PG8_BAR;
        PG8_STAGE(PG8_SB(1, 0), cB + kstep, voffB); PG8_STAGE(PG8_SA(1, 0), cA + kstep, voffA); PG8_STAGE(PG8_SB(1, 1), cB + hstep + kstep, voffB);
        PG8_WAIT_V(6); PG8_BAR;
    }
    for (;;) {
        const bool has_next = S.next(ui + 1, nxt);
        const char* nA = has_next ? (const char*)g.A + (size_t)nxt.pm * tstep : cA; const char* nB = has_next ? (const char*)g.Bt + (size_t)nxt.pn * tstep : cB;
        for (int t = 0; t < nt; t += 2) {
            const bool last = (t == nt - 2);
            const char* a1 = cA + (size_t)(t + 1) * kstep;
            const char* a2 = last ? nA : cA + (size_t)(t + 2) * kstep; const char* b2 = last ? nB : cB + (size_t)(t + 2) * kstep;
            const char* a3 = a2 + kstep; const char* b3 = b2 + kstep;
            if (last && has_next) S.a_ready(nxt);
            if constexpr (SP2) {
            PG8_LDB(B0, 0, 0); PG8_LDB(B1, 0, 1); PG8_SCHED; PG8_LDA(At, 0, 0); PG8_STAGE(PG8_SA(1, 1), a1 + hstep, voffA);
            PG8_WAIT_V(8); PG8_WAIT_L(0); PG8_BAR; PG8_MMA(0, 0, At, B0); PG8_MMA(0, 1, At, B1); PG8_BAR; PG8_SCHED;
            PG8_LDA(At, 0, 1); PG8_STAGE(PG8_SB(0, 0), b2, voffB); PG8_STAGE(PG8_SB(0, 1), b2 + hstep, voffB); PG8_STAGE(PG8_SA(0, 0), a2, voffA);
            PG8_WAIT_V(8); PG8_WAIT_L(0); PG8_BAR; PG8_MMA(1, 0, At, B0); PG8_MMA(1, 1, At, B1); PG8_BAR; PG8_SCHED;
            PG8_LDB(B0, 1, 0); PG8_LDB(B1, 1, 1); PG8_SCHED; PG8_LDA(At, 1, 0); PG8_STAGE(PG8_SA(0, 1), a2 + hstep, voffA);
            PG8_WAIT_V(8); PG8_WAIT_L(0); PG8_BAR; PG8_MMA(0, 0, At, B0); PG8_MMA(0, 1, At, B1); PG8_BAR; PG8_SCHED;
            PG8_LDA(At, 1, 1); PG8_STAGE(PG8_SB(1, 0), b3, voffB); PG8_STAGE(PG8_SB(1, 1), b3 + hstep, voffB); PG8_STAGE(PG8_SA(1, 0), a3, voffA);
            PG8_WAIT_V(8); PG8_WAIT_L(0); PG8_BAR; PG8_MMA(1, 0, At, B0); PG8_MMA(1, 1, At, B1); PG8_BAR; PG8_SCHED;
            } else {
            PG8_LDB(B0, 0, 0); PG8_SCHED; PG8_LDA(At, 0, 0); PG8_STAGE(PG8_SA(1, 1), a1 + hstep, voffA);
            PG8_WAIT_L(8); PG8_BAR; PG8_WAIT_L(0); PG8_MMA(0, 0, At, B0); PG8_BAR; PG8_SCHED;
            PG8_LDB(B1, 0, 1); PG8_STAGE(PG8_SB(0, 0), b2, voffB);
            PG8_BAR; PG8_WAIT_L(0); PG8_MMA(0, 1, At, B1); PG8_BAR;
            PG8_LDA(At, 0, 1); PG8_STAGE(PG8_SA(0, 0), a2, voffA);
            PG8_BAR; PG8_WAIT_L(0); PG8_MMA(1, 0, At, B0); PG8_BAR; PG8_SCHED;
            PG8_STAGE(PG8_SB(0, 1), b2 + hstep, voffB);
            PG8_WAIT_V(6); PG8_BAR; PG8_MMA(1, 1, At, B1); PG8_BAR;
            PG8_LDB(B0, 1, 0); PG8_SCHED; PG8_LDA(At, 1, 0); PG8_STAGE(PG8_SA(0, 1), a2 + hstep, voffA);
            PG8_WAIT_L(8); PG8_BAR; PG8_WAIT_L(0); PG8_MMA(0, 0, At, B0); PG8_BAR; PG8_SCHED;
            PG8_LDB(B1, 1, 1); PG8_STAGE(PG8_SB(1, 0), b3, voffB);
            PG8_BAR; PG8_WAIT_L(0); PG8_MMA(0, 1, At, B1); PG8_BAR;
            PG8_LDA(At, 1, 1); PG8_STAGE(PG8_SA(1, 0), a3, voffA);
            PG8_BAR; PG8_WAIT_L(0); PG8_MMA(1, 0, At, B0); PG8_BAR; PG8_SCHED;
            PG8_STAGE(PG8_SB(1, 1), b3 + hstep, voffB);
            PG8_WAIT_V(6); PG8_BAR; PG8_MMA(1, 1, At, B1); PG8_BAR;
            }
        }
        if constexpr (ALIGN_EPI) { if (wr == 0) PG8_BAR; }
        if constexpr (!Epi::AFTER_DRAIN) { E(acc, cur, wr, wc, fr, fq); S.done(cur); }
        if (!has_next) break;
#pragma unroll
        for (int a = 0; a < 2; ++a)
#pragma unroll
            for (int b = 0; b < 2; ++b)
#pragma unroll
                for (int m = 0; m < 4; ++m)
#pragma unroll
                    for (int n = 0; n < 2; ++n) acc[a][b][m][n] = (f32x4){0.f, 0.f, 0.f, 0.f};
        cur = nxt; cA = nA; cB = nB; ++ui;
        if constexpr (ALIGN_EPI) { if (wr == 1) PG8_BAR; }
    }
    PG8_WAIT_V(0);
    if constexpr (!ALIGN_EPI) { if (wr == 0) PG8_BAR; }
    PG8_BAR;
    if constexpr (Epi::AFTER_DRAIN) { E.fused(acc, cur, wr, wc, fr, fq, lds, wid, lane); S.done(cur); }
#undef PG8_SA
#undef PG8_SB
#undef PG8_STAGE
#undef PG8_LDA
#undef PG8_LDB
#undef PG8_MMA
#undef PG8_WAIT_V
#undef PG8_WAIT_L
#undef PG8_BAR
#undef PG8_SCHED
}
}
#define XB_TMO      128
#define XB_XCNT(j)  (256  + 64 * (j))
#define XB_XSUB(j)  (1280 + 64 * (j))
#define XB_XGEN(j)  (2304 + 64 * (j))
#define XB_TOP      3328
#define XB_TOPGEN   3392
#define XCD_BAR_WORDS 3456
#define XB_SPIN_CAP (1u << 18)

__device__ __forceinline__ unsigned xb_ld(unsigned* p)              { return __hip_atomic_load(p, __ATOMIC_RELAXED, __HIP_MEMORY_SCOPE_AGENT); }
__device__ __forceinline__ unsigned xb_add(unsigned* p, unsigned v) { return __hip_atomic_fetch_add(p, v, __ATOMIC_RELAXED, __HIP_MEMORY_SCOPE_AGENT); }
__device__ __forceinline__ unsigned xb_xcc_id() { return (unsigned)__builtin_amdgcn_s_getreg((3 << 11) | 20) & 0xFu; }
#define XB_SPIN(cond, bar) do { unsigned _sp = 0; while (cond) { __builtin_amdgcn_s_sleep(1); \
    if ((++_sp & 255u) == 0u) { if (xb_ld(&(bar)[XB_TMO])) break; if (_sp > XB_SPIN_CAP) { atomicAdd(&(bar)[XB_TMO], 1u); break; } } } } while (0)

struct XcdBarrier {
    unsigned* bar; unsigned x;
    volatile LAS unsigned* st;
    unsigned tid;
};

__device__ __forceinline__ XcdBarrier xcd_barrier_post(unsigned* bar, volatile LAS unsigned* st) {
    XcdBarrier b; b.bar = bar; b.x = xb_xcc_id(); b.st = st;
    if (threadIdx.x == 0) (void)xb_add(&bar[XB_XCNT(b.x)], 1u);
    return b;
}
__device__ __forceinline__ void xcd_barrier_complete(unsigned* bar, unsigned x, unsigned& nloc, unsigned& nx) {
    const unsigned G = gridDim.x * gridDim.y * gridDim.z;
    unsigned sum, cnt, mine, sp = 0u;
    for (;;) {
        sum = 0u; cnt = 0u; mine = 0u;
#pragma unroll
        for (unsigned j = 0; j < 16; ++j) { const unsigned c = xb_ld(&bar[XB_XCNT(j)]); sum += c; cnt += (c > 0u) ? 1u : 0u; mine = (j == x) ? c : mine; }
        if (sum == G) break;
        __builtin_amdgcn_s_sleep(1);
        if ((++sp & 255u) == 0u) { if (xb_ld(&bar[XB_TMO])) break; if (sp > XB_SPIN_CAP) { atomicAdd(&bar[XB_TMO], 1u); break; } }
    }
    nloc = mine > 0u ? mine : 1u; nx = cnt > 0u ? cnt : 1u;
}

__device__ __forceinline__ void xcd_barrier(const XcdBarrier& b) {
    asm volatile("s_waitcnt vmcnt(0)" ::: "memory");
    __syncthreads();
    if (b.tid == 0) {
        unsigned* bar = b.bar;
        __builtin_amdgcn_s_waitcnt(0);
        unsigned nloc = b.st[0], nx = b.st[1];
        if (nloc == 0u) { xcd_barrier_complete(bar, b.x, nloc, nx); b.st[0] = nloc; b.st[1] = nx; }
        const unsigned old = xb_add(&bar[XB_XSUB(b.x)], 1u);
        const unsigned gen = old / nloc;
        if (old + 1u == (gen + 1u) * nloc) {
            __builtin_amdgcn_fence(__ATOMIC_RELEASE, "agent");
            asm volatile("s_waitcnt vmcnt(0)" ::: "memory");
            const unsigned og = xb_add(&bar[XB_TOP], 1u);
            const unsigned tg = og / nx;
            if (og + 1u == (tg + 1u) * nx) xb_add(&bar[XB_TOPGEN], 1u);
            else XB_SPIN(xb_ld(&bar[XB_TOPGEN]) == tg, bar);
            __builtin_amdgcn_fence(__ATOMIC_ACQUIRE, "agent");
            xb_add(&bar[XB_XGEN(b.x)], 1u);
            asm volatile("s_waitcnt vmcnt(0)" ::: "memory");
        } else {
            XB_SPIN(xb_ld(&bar[XB_XGEN(b.x)]) == gen, bar);
            __builtin_amdgcn_fence(__ATOMIC_ACQUIRE, "agent");
            asm volatile("s_waitcnt vmcnt(0)" ::: "memory");
        }
    }
    __syncthreads();
}
namespace fox {
constexpr int D = 128;
constexpr float SCALE = 0.08838834764831845f, INV_SCALE = 11.313708498984761f;
constexpr float THR = 8.f;
constexpr int NW = 8, QBLK = 32, KVBLK = 64, QB = NW * QBLK;
constexpr int SHM_V = KVBLK * D * 2, SHM_K = KVBLK * D * 2;
constexpr int KB_OFF = 2 * SHM_V + 2 * SHM_K + NW * 64 * 4;
constexpr int JL_OFF = KB_OFF + 2 * 64 * 4;
constexpr int OT_OFF = JL_OFF + 64, OT_PITCH = 272, OT_WAVE = 32 * OT_PITCH;
constexpr int LDS_BYTES = OT_OFF + NW * OT_WAVE;

#define KSWZ(row, colB) ((row) * 256 + ((colB) ^ (((row) & 7) << 4)))
#define SBAR() __builtin_amdgcn_sched_barrier(0)
__device__ __forceinline__ int v_st(int k, int c) { const int kk = (k & ~0xC) | ((k & 4) << 1) | ((k & 8) >> 1); return ((kk >> 3) * 4 + (c >> 5)) * 512 + ((kk & 7) * 32 + (c & 31)) * 2; }
__device__ __forceinline__ int v_rd_base(int lane) { return ((lane & 3) << 3) | (((lane >> 2) & 3) << 6) | (((lane >> 4) & 1) << 5) | (((lane >> 5) & 1) << 8); }
constexpr int v_rd_off(int d0, int ks, int half) { return d0 * 512 + ks * 4096 + half * 2048; }
__device__ __forceinline__ int crow(int r, int hi) { return (r & 3) + 8 * (r >> 2) + 4 * hi; }
__device__ __forceinline__ bf16x8 load8(const bf16* p) { return *reinterpret_cast<const bf16x8*>(p); }
__device__ __forceinline__ void mask_tile(f32x16& p0, f32x16& p1, int dq) {
    const float NEG = -__builtin_inff();
#pragma unroll
    for (int r = 0; r < 16; ++r) {
        const int c = (r & 3) + 8 * (r >> 2);
        if (dq - c < 0) p0[r] = NEG;
        if (dq - c - 32 < 0) p1[r] = NEG;
    }
}
__device__ __forceinline__ void bias_tile(f32x16& p0, f32x16& p1, const float* kb, int hi) {
#pragma unroll
    for (int g = 0; g < 4; ++g) {
        const f32x4 a = *(const f32x4*)(kb + 8 * g + 4 * hi), b = *(const f32x4*)(kb + 32 + 8 * g + 4 * hi);
#pragma unroll
        for (int j = 0; j < 4; ++j) { p0[4 * g + j] += a[j]; p1[4 * g + j] += b[j]; }
    }
}
__device__ __forceinline__ void partialSM(f32x16& p0, f32x16& p1, float& m_reg, float& mn, float& alpha) {
    float pmax = p0[0]; for (int r = 1; r < 16; ++r) pmax = fmaxf(pmax, p0[r]); for (int r = 0; r < 16; ++r) pmax = fmaxf(pmax, p1[r]);
    { auto rr = __builtin_amdgcn_permlane32_swap(__float_as_uint(pmax), __float_as_uint(pmax), false, false);
      pmax = fmaxf(__uint_as_float(rr[0]), __uint_as_float(rr[1])); }
    constexpr float C2 = 1.4426950408889634f * SCALE;
    if (__builtin_expect(__all((pmax - m_reg) * SCALE <= THR), 1)) { mn = m_reg; alpha = 1.f; }
    else { mn = fmaxf(m_reg, pmax); alpha = __builtin_amdgcn_exp2f((m_reg - mn) * C2); m_reg = mn; }
    const float mnL = -mn * C2;
    for (int r = 0; r < 16; ++r) p0[r] = fmaf(p0[r], C2, mnL); for (int r = 0; r < 16; ++r) p1[r] = fmaf(p1[r], C2, mnL);
    for (int r = 0; r < 16; ++r) p0[r] = __builtin_amdgcn_exp2f(p0[r]);
}
__device__ __forceinline__ void finishSM(f32x16& p0, f32x16& p1, float alpha, float& l_reg, bf16x8& pa0, bf16x8& pa1, bf16x8& pa2, bf16x8& pa3) {
    for (int r = 0; r < 16; ++r) p1[r] = __builtin_amdgcn_exp2f(p1[r]);
    float ps = 0; for (int r = 0; r < 16; ++r) ps += p0[r]; for (int r = 0; r < 16; ++r) ps += p1[r];
    { auto rr = __builtin_amdgcn_permlane32_swap(__float_as_uint(ps), __float_as_uint(ps), false, false);
      ps = __uint_as_float(rr[0]) + __uint_as_float(rr[1]); }
    l_reg = l_reg * alpha + ps;
#define PK4(P, B_, OUT) do { unsigned a0 = cvtpk(P[B_+0], P[B_+1]), a1 = cvtpk(P[B_+2], P[B_+3]);                          \
        unsigned b0 = cvtpk(P[B_+4], P[B_+5]), b1 = cvtpk(P[B_+6], P[B_+7]);                                             \
        auto r0 = __builtin_amdgcn_permlane32_swap(a0, b0, false, false); auto r1 = __builtin_amdgcn_permlane32_swap(a1, b1, false, false); \
        u32x4 w = {r0[0], r1[0], r0[1], r1[1]}; OUT = *reinterpret_cast<bf16x8*>(&w); } while (0)
    PK4(p0, 0, pa0); PK4(p0, 8, pa1); PK4(p1, 0, pa2); PK4(p1, 8, pa3);
#undef PK4
}
template <int KB>
__device__ __forceinline__ void qkt(f32x16& p0, f32x16& p1, const char* K_lds, int r32, int hi, const bf16x8* qr) {
    p0 = f32x16{}; p1 = f32x16{};
    const char* kb[4];
#pragma unroll
    for (int dd = 0; dd < 4; ++dd) kb[dd] = K_lds + KB * SHM_K + KSWZ(r32, (dd * 16 + hi * 8) * 2);
#pragma unroll
    for (int d0 = 0; d0 < 8; ++d0) { const char* a = kb[d0 & 3] + (d0 >> 2) * 128;
        bf16x8 b0 = *reinterpret_cast<const bf16x8*>(a);
        bf16x8 b1 = *reinterpret_cast<const bf16x8*>(a + 32 * 256);
        p0 = __builtin_amdgcn_mfma_f32_32x32x16_bf16(b0, qr[d0], p0, 0, 0, 0);
        p1 = __builtin_amdgcn_mfma_f32_32x32x16_bf16(b1, qr[d0], p1, 0, 0, 0); }
}
template <int VB>
__device__ __forceinline__ void pv_tile(f32x16* o, int vb0, bf16x8 pa0, bf16x8 pa1, bf16x8 pa2, bf16x8 pa3) {
#define TRRD(dst, off) asm volatile("ds_read_b64_tr_b16 %0, %1 offset:%2" : "=&v"(dst) : "v"(vb0), "i"(off) : "memory")
#define PV_D0(d0) do { s16x4 l0, l1, h0, h1; constexpr int b_ = VB * SHM_V + v_rd_off(d0, 0, 0);     \
        TRRD(l0, b_); TRRD(h0, b_ + 2048); TRRD(l1, b_ + 4096); TRRD(h1, b_ + 6144); \
        asm volatile("s_waitcnt lgkmcnt(0)" ::: "memory"); SBAR();   \
        o[d0] = __builtin_amdgcn_mfma_f32_32x32x16_bf16(pa0, (bf16x8){l0[0], l0[1], l0[2], l0[3], h0[0], h0[1], h0[2], h0[3]}, o[d0], 0, 0, 0);   \
        o[d0] = __builtin_amdgcn_mfma_f32_32x32x16_bf16(pa1, (bf16x8){l1[0], l1[1], l1[2], l1[3], h1[0], h1[1], h1[2], h1[3]}, o[d0], 0, 0, 0);   \
        SBAR(); TRRD(l0, b_ + 8192); TRRD(h0, b_ + 10240); TRRD(l1, b_ + 12288); TRRD(h1, b_ + 14336); \
        asm volatile("s_waitcnt lgkmcnt(0)" ::: "memory"); SBAR();   \
        o[d0] = __builtin_amdgcn_mfma_f32_32x32x16_bf16(pa2, (bf16x8){l0[0], l0[1], l0[2], l0[3], h0[0], h0[1], h0[2], h0[3]}, o[d0], 0, 0, 0);   \
        o[d0] = __builtin_amdgcn_mfma_f32_32x32x16_bf16(pa3, (bf16x8){l1[0], l1[1], l1[2], l1[3], h1[0], h1[1], h1[2], h1[3]}, o[d0], 0, 0, 0); } while (0)
    PV_D0(0); PV_D0(1); PV_D0(2); PV_D0(3);
#undef PV_D0
#undef TRRD
}
struct BlockRef { const bf16* Q; const bf16* K; const bf16* V; const bf16* Z; bf16* O; const float* C; const float* QN; const float* KN; int P0; };
constexpr float PRUNE_T = 30.0f;
__device__ __forceinline__ int compute_jlo(const BlockRef& b, int lane) {
    const int ntb = b.P0 / KVBLK;
    if (ntb == 0) return 0;
    float q2 = b.QN[ntb + (lane & 3)];
    q2 = fmaxf(q2, __shfl_xor(q2, 1)); q2 = fmaxf(q2, __shfl_xor(q2, 2));
    float k2 = fmaxf(lane < ntb + 4 ? b.KN[lane] : 0.f, lane + 64 < ntb + 4 ? b.KN[lane + 64] : 0.f);
#pragma unroll
    for (int o = 1; o < 64; o <<= 1) k2 = fmaxf(k2, __shfl_xor(k2, o));
    const float bnd = 2.0f * SCALE * __builtin_amdgcn_sqrtf(q2 * k2) * 1.0001f + b.C[b.P0];
    const bool s0 = lane < ntb && (bnd - b.C[64 * lane + 63] < -PRUNE_T);
    const bool s1 = lane + 64 < ntb && (bnd - b.C[64 * (lane + 64) + 63] < -PRUNE_T);
    const unsigned long long m0 = __ballot(s0), m1 = __ballot(s1);
    int jlo = 0;
    if (m1) jlo = 128 - __builtin_clzll(m1) + 1 - 1; else if (m0) jlo = 64 - __builtin_clzll(m0);
    return __builtin_amdgcn_readfirstlane(jlo);
}
__device__ __forceinline__ void norm_item(const bf16* PROJ, float* QN2, float* KN2, int item, int lane) {
    const int bhh = item >> 7, tile = item & 127, b = bhh >> 5, h = bhh & 31, rs = lane >> 4, cg = lane & 15;
    const bf16* base = PROJ + ((size_t)b * SEQ + (size_t)tile * 64) * LDP + h * HDIM + cg * 8;
    float qm = 0.f, km = 0.f;
#pragma unroll 4
    for (int i = 0; i < 16; ++i) { const bf16* rp = base + (size_t)(4 * i + rs) * LDP;
        const u32x4 qw = *(const u32x4*)rp, kw = *(const u32x4*)(rp + 4096); float q[8], k[8]; unpack8(qw, q); unpack8(kw, k);
        float sq = 0.f, sk = 0.f;
#pragma unroll
        for (int e = 0; e < 8; ++e) { sq += q[e] * q[e]; sk += k[e] * k[e]; }
#pragma unroll
        for (int o = 1; o < 16; o <<= 1) { sq += __shfl_xor(sq, o); sk += __shfl_xor(sk, o); }
        qm = fmaxf(qm, sq); km = fmaxf(km, sk); }
    qm = fmaxf(qm, __shfl_xor(qm, 16)); qm = fmaxf(qm, __shfl_xor(qm, 32)); km = fmaxf(km, __shfl_xor(km, 16)); km = fmaxf(km, __shfl_xor(km, 32));
    if (lane == 0) { QN2[item] = qm; KN2[item] = km; }
}
struct Seam { bf16x8 qr[8]; bf16x8 st_v0, st_v1, st_k0, st_k1; float cb0, cb1; };
#define ROWP(p, k0, rr) ((p) + (size_t)((k0) + (rr)) * LDP + sc)
#define VMWN(n) asm volatile("s_waitcnt vmcnt(%0)" :: "i"(n) : "memory")
#define SLOAD_H(Kp, Vp, Cp, k0) do { const bf16* vp_ = (Vp) + (size_t)(k0) * LDP; const bf16* kp_ = (Kp) + (size_t)(k0) * LDP; const float* cp_ = (Cp) + (k0); \
                         S.st_v0 = load8(vp_ + loff); S.st_v1 = load8(vp_ + 32 * LDP + loff);              \
                         S.st_k0 = load8(kp_ + loff); S.st_k1 = load8(kp_ + 32 * LDP + loff); S.cb0 = cp_[(unsigned)sr]; S.cb1 = (cp_ + 32)[(unsigned)sr]; } while (0)
#define SWRITE_HK(bf, ref) do { *(bf16x8*)(K_lds + (bf) * SHM_K + kws) = S.st_k0; *(bf16x8*)(K_lds + (bf) * SHM_K + kws + 32 * 256) = S.st_k1; \
                         if ((tid & 15) == 0) { kbias[(bf) * 64 + sr] = ((ref) - S.cb0) * INV_SCALE; kbias[(bf) * 64 + 32 + sr] = ((ref) - S.cb1) * INV_SCALE; } } while (0)
#define SWRITE_HV(bf) do { *(bf16x8*)(V_lds + (bf) * SHM_V + vst0) = S.st_v0; *(bf16x8*)(V_lds + (bf) * SHM_V + vst1) = S.st_v1; } while (0)
#define SWRITE_H(bf, ref) do { SWRITE_HV(bf); SWRITE_HK(bf, ref); } while (0)
__device__ __forceinline__ float blk_ref(const BlockRef& b) { const float v = b.P0 > 0 ? b.C[b.P0 - 1] : 0.f; return __uint_as_float(__builtin_amdgcn_readfirstlane(__float_as_uint(v))); }
__device__ __forceinline__ void prime(const BlockRef& cur, int j_lo, char* lds, Seam& S, const int w0) {
    const int tid = otid(w0), wid = __builtin_amdgcn_readfirstlane(tid >> 6), lane = tid & 63, r32 = lane & 31, hi = lane >> 5;
    const int sr = tid >> 4, sc = (tid & 15) * 8, kws = KSWZ(sr, sc * 2); char* K_lds = lds + 2 * SHM_V; float* kbias = (float*)(lds + KB_OFF);
    const unsigned loff = (unsigned)sr * LDP + sc, qoff = (unsigned)r32 * LDP + hi * 8;
    const float ref = blk_ref(cur);
    for (int d0 = 0; d0 < 8; ++d0) S.qr[d0] = load8(cur.Q + (size_t)(wid * QBLK) * LDP + d0 * 16 + qoff);
    SLOAD_H(cur.K, cur.V, cur.C, j_lo * KVBLK); VM_WAIT(); SWRITE_HK(0, ref);
    __syncthreads();
}
__device__ __forceinline__ void block(const BlockRef& cur, const BlockRef& nxt, int j_lo, int jlo_n, char* lds, Seam& S, const int w0) {
    const int tid = otid(w0), wid = __builtin_amdgcn_readfirstlane(tid >> 6), lane = tid & 63, r32 = lane & 31, hi = lane >> 5;
    const int NT = (cur.P0 + QB - 1) / KVBLK + 1 - j_lo;
    const int qlo = cur.P0 + wid * QBLK, qm = qlo + r32 - 4 * hi;
    char* V_lds = lds; char* K_lds = lds + 2 * SHM_V;
    float* ws = (float*)(lds + 2 * SHM_V + 2 * SHM_K) + wid * 64; float* li_l = ws, * al_l = ws + 32; float* kbias = (float*)(lds + KB_OFF);
    float m_reg = -1e30f, l_reg = 0; f32x16 o[4] = {};
    const int sr = tid >> 4, sc = (tid & 15) * 8, vst0 = v_st(sr, sc), vst1 = v_st(32 + sr, sc), kws = KSWZ(sr, sc * 2);
    const int vb0 = (int)(uintptr_t)V_lds + v_rd_base(lane);
    const unsigned loff = (unsigned)sr * LDP + sc, qoff = (unsigned)r32 * LDP + hi * 8;
    const bf16* Kh = cur.K; const bf16* Vh = cur.V; const float* Ch = cur.C;
    const float ref = blk_ref(cur), nref = blk_ref(nxt);
#define RESC(a) do { if (__any((a) < 1.f)) { if (hi == 0) al_l[r32] = (a); asm volatile("s_waitcnt lgkmcnt(0)" ::: "memory");              \
                     for (int d_ = 0; d_ < 4; ++d_) for (int r = 0; r < 16; ++r) o[d_][r] *= al_l[crow(r, hi)]; } } while (0)
#define KBASE(t) ((j_lo + (t)) * KVBLK)
#define BIASMASK(P0_, P1_, t, KB) do { const int kb_ = KBASE(t); bias_tile(P0_, P1_, kbias + (KB) * 64, hi); if (kb_ + KVBLK - 1 > qlo) mask_tile(P0_, P1_, qm - kb_); } while (0)
    constexpr int NQL = 8;
#define SEAM_K0() do { VMWN(NQL); SWRITE_HK(0, nref); SBAR(); } while (0)
    f32x16 pA0, pA1, pB0, pB1; float mnA, mnB, alA, alB; bf16x8 pa0, pa1, pa2, pa3;
    SWRITE_HV(0); SBAR();
    if (NT > 1) SLOAD_H(Kh, Vh, Ch, KBASE(1));
    SBAR(); qkt<0>(pA0, pA1, K_lds, r32, hi, S.qr);
    BIASMASK(pA0, pA1, 0, 0); partialSM(pA0, pA1, m_reg, mnA, alA);
    if (NT > 1) { VM_WAIT(); SWRITE_H(1, ref); }
    __syncthreads();
#define HALF_STEP(PX0, PX1, mnX, alX, PY0, PY1, alY, t, KB, VB, SB) do {                                                      \
        SBAR(); qkt<KB>(PX0, PX1, K_lds, r32, hi, S.qr);                                                                      \
        finishSM(PY0, PY1, alY, l_reg, pa0, pa1, pa2, pa3); SBAR();                                                           \
        if ((t) + 1 < NT) { SLOAD_H(Kh, Vh, Ch, KBASE((t) + 1)); SBAR(); }                                                    \
        pv_tile<VB>(o, vb0, pa0, pa1, pa2, pa3); BIASMASK(PX0, PX1, (t), KB); partialSM(PX0, PX1, m_reg, mnX, alX);           \
        __syncthreads();                                                                                                      \
        if ((t) + 1 < NT) { VM_WAIT(); SWRITE_H(SB, ref); }                                                                   \
        RESC(alX); __syncthreads(); } while (0)
    for (int t = 1; t + 1 < NT; t += 2) {
        HALF_STEP(pB0, pB1, mnB, alB, pA0, pA1, alA, t, 1, 0, 0);
        HALF_STEP(pA0, pA1, mnA, alA, pB0, pB1, alB, t + 1, 0, 1, 1);
    }
    const bool even = (NT & 1) == 0;
    if (even) { SBAR(); qkt<1>(pB0, pB1, K_lds, r32, hi, S.qr); SBAR(); }
    SLOAD_H(nxt.K, nxt.V, nxt.C, jlo_n * KVBLK); SBAR();
#pragma unroll
    for (int d0 = 0; d0 < 8; ++d0) S.qr[d0] = load8(nxt.Q + (size_t)(wid * QBLK) * LDP + d0 * 16 + qoff);
    SBAR();
    finishSM(pA0, pA1, alA, l_reg, pa0, pa1, pa2, pa3); SBAR();
    pv_tile<0>(o, vb0, pa0, pa1, pa2, pa3);
    if (even) { const int t2 = otid(w0), qm2 = qlo + (t2 & 31) - 4 * ((t2 >> 5) & 1), hi2 = (t2 >> 5) & 1;
      { const int kb_ = KBASE(NT - 1); bias_tile(pB0, pB1, kbias + 64, hi2); if (kb_ + KVBLK - 1 > qlo) mask_tile(pB0, pB1, qm2 - kb_); }
      partialSM(pB0, pB1, m_reg, mnB, alB); __syncthreads(); RESC(alB);
      finishSM(pB0, pB1, alB, l_reg, pa0, pa1, pa2, pa3); SBAR(); pv_tile<1>(o, vb0, pa0, pa1, pa2, pa3); }
    SBAR(); SEAM_K0();
    if (hi == 0) li_l[r32] = l_reg; asm volatile("s_waitcnt lgkmcnt(0)" ::: "memory");
    float rli[16];
#pragma unroll
    for (int r = 0; r < 16; ++r) rli[r] = __builtin_amdgcn_rcpf(li_l[crow(r, hi)]);
    bf16* Ow = cur.O + (size_t)(wid * QBLK) * 4096; const bf16* Zw = cur.Z + (size_t)(wid * QBLK) * LDP;
    const int t2 = otid(w0), l2 = t2 & 63;
    const unsigned zoff = (unsigned)(l2 >> 4) * LDP + (l2 & 15) * 8, ooff = (unsigned)(l2 >> 4) * 4096 + (l2 & 15) * 8;
    u32x4 zw[8];
#pragma unroll
    for (int i = 0; i < 8; ++i) zw[i] = *(const u32x4*)(Zw + (size_t)(4 * i) * LDP + zoff);
    char* ot = lds + OT_OFF + wid * OT_WAVE;
#pragma unroll
    for (int d0 = 0; d0 < 4; ++d0)
#pragma unroll
        for (int r = 0; r < 16; ++r) *(bf16*)(ot + crow(r, hi) * OT_PITCH + (d0 * 32 + r32) * 2) = (bf16)(cvtpk(o[d0][r] * rli[r], 0.f) & 0xffffu);
    asm volatile("s_waitcnt lgkmcnt(0)" ::: "memory");
#pragma unroll
    for (int i = 0; i < 8; ++i) { const u32x4 ow = *(const u32x4*)(ot + (4 * i + (l2 >> 4)) * OT_PITCH + (l2 & 15) * 16);
        float ov[8], zv[8]; unpack8(ow, ov); unpack8(zw[i], zv);
        f32x4 a, b;
#pragma unroll
        for (int e = 0; e < 4; ++e) { a[e] = ov[e] * siluf_(zv[e]); b[e] = ov[4 + e] * siluf_(zv[4 + e]); }
        *(bf16x8*)(Ow + (size_t)(4 * i) * 4096 + ooff) = pack8(a, b); }
    __syncthreads();
#undef RESC
#undef KBASE
#undef BIASMASK
#undef SEAM_K0
#undef HALF_STEP
}
#undef ROWP
#undef VMWN
#undef SLOAD_H
#undef SWRITE_HK
#undef SWRITE_HV
#undef SWRITE_H
#undef KSWZ
#undef SBAR
__device__ __forceinline__ void attn_phase(char* lds, const bf16* PROJ, bf16* MIX, const float* CUM, const float* QN2, const float* KN2, int vcu, int G, const int w0) {
    constexpr int NQB = SEQ / QB  , NX = NQB / 2, TOTAL = NX * BATCH * NHEAD;
    auto ref_of = [&](int L, int pass) { const int bhh = L / NX, x = L % NX, qb = pass ? NQB - 1 - x : x, b = bhh / NHEAD, h = bhh % NHEAD;
        BlockRef r; const bf16* base = PROJ + (size_t)b * SEQ * LDP + h * HDIM;
        r.Q = base + (size_t)qb * QB * LDP; r.K = base + 4096; r.V = base + 8192; r.Z = base + (size_t)qb * QB * LDP + ZCOL;
        r.O = MIX + ((size_t)b * SEQ + (size_t)qb * QB) * 4096 + h * HDIM; r.C = CUM + (size_t)bhh * SEQ; r.QN = QN2 + bhh * 128; r.KN = KN2 + bhh * 128; r.P0 = qb * QB; return r; };
    int L = vcu; if (L >= TOTAL) return;
    int pass = 0; BlockRef cur = ref_of(L, 0); Seam S;
    int* jl = (int*)(lds + JL_OFF);
    { const int tid = otid(w0), w = __builtin_amdgcn_readfirstlane(tid >> 6), Lw = vcu + (w >> 1) * G;
      if (Lw < TOTAL) { const BlockRef r = ref_of(Lw, w & 1); const int j = compute_jlo(r, tid & 63); if ((tid & 63) == 0) jl[w] = j; } }
    __syncthreads();
    int bi = 0;
    prime(cur, jl[0], lds, S, w0);
    for (;;) {
        const bool more_pass = pass == 0, more_item = L + G < TOTAL, last = !more_pass && !more_item;
        int passn = pass + 1, Ln = L; if (!more_pass) { passn = 0; Ln = more_item ? L + G : L; }
        const BlockRef nxt = last ? cur : ref_of(Ln, passn);
        { const int ja = __builtin_amdgcn_readfirstlane(jl[bi]), jb = __builtin_amdgcn_readfirstlane(jl[last ? bi : bi + 1]); block(cur, nxt, ja, jb, lds, S, w0); ++bi; }
        if (last) break;
        cur = nxt; pass = passn; L = Ln;
    }
}
}
constexpr int NWAVES = 8, NTHR = 512;
constexpr int RING_BYTES = 131072;
constexpr int MISC_OFF = RING_BYTES + 24576;
constexpr int LDS_BYTES = MISC_OFF + 128;

struct Args {
    const float* in[28]; float* out; unsigned char* ws;
    int ph_lo, ph_hi, li, pad;
};
enum { I_X = 0, I_P, I_NORM_MIX, I_FOX_WIN, I_FOX_BF, I_FOX_WOUT, I_GDN_WIN, I_GDN_CONV, I_GDN_ALOG, I_GDN_DTB, I_GDN_NORM, I_GDN_WOUT,
       I_SSM_WIN, I_SSM_LRE, I_SSM_LIM, I_SSM_BRE, I_SSM_BIM, I_SSM_CRE, I_SSM_CIM, I_SSM_LSTEP, I_SSM_D, I_SSM_WGLU, I_SSM_BGLU, I_SSM_WOUT,
       I_NORM_PLE, I_PLE_WPROJ, I_PLE_WGATE, I_FINAL_NORM };

__device__ __forceinline__ void transpose_item(const float* W, int K, int N, bf16* dst, const float* gk, LAS float* scr, int k0, int n0, int lane) {
#pragma unroll 8
    for (int i = 0; i < 32; ++i) { const int kk = 2 * i + (lane >> 5); scr[kk * 33 + (lane & 31)] = W[(size_t)(k0 + kk) * N + n0 + (lane & 31)]; }
    const int c = lane & 7;
    f32x4 ga = {1.f, 1.f, 1.f, 1.f}, gb = ga;
    if (gk) { ga = *(const f32x4*)(gk + k0 + 8 * c); gb = *(const f32x4*)(gk + k0 + 8 * c + 4); }
    LDS_WAIT(); asm volatile("" ::: "memory");
#pragma unroll
    for (int j = 0; j < 4; ++j) { const int n = (lane >> 3) + 8 * j; const LAS float* s = scr + (8 * c) * 33 + n;
        u32x4 o; o.x = cvtpk(s[0 * 33] * ga[0], s[1 * 33] * ga[1]); o.y = cvtpk(s[2 * 33] * ga[2], s[3 * 33] * ga[3]); o.z = cvtpk(s[4 * 33] * gb[0], s[5 * 33] * gb[1]); o.w = cvtpk(s[6 * 33] * gb[2], s[7 * 33] * gb[3]);
        *(u32x4*)(dst + (size_t)n * K + k0 + 8 * c) = o; }
    LDS_WAIT(); asm volatile("" ::: "memory");
}
__device__ __forceinline__ void transpose_matrix(const float* W, int K, int N, bf16* WT, int nsplit, bf16* WT2, const float* gk, LAS float* scr, int gw, int NGW, int lane) {
    const int nblk = N / 32, nitems = (K / 64) * nblk;
    for (int it = gw; it < nitems; it += NGW) { const int kb = it / nblk, nb = it - kb * nblk, n0 = 32 * nb;
        bf16* dst = n0 < nsplit ? WT + (size_t)n0 * K : WT2 + (size_t)(n0 - nsplit) * K;
        transpose_item(W, K, N, dst, gk, scr, 64 * kb, n0, lane); }
}
__device__ __forceinline__ float row_to_bf16(const float* xrow, bf16* orow, int lane) {
    float s = 0.f;
#pragma unroll
    for (int j = 0; j < 8; ++j) { const int c = (j * 64 + lane) * 8;
        const f32x4 a = *(const f32x4*)(xrow + c), b = *(const f32x4*)(xrow + c + 4);
        const bf16x8 o = pack8(a, b); const u32x4 w = __builtin_bit_cast(u32x4, o);
        s += (bflo(w.x) * bflo(w.x) + bfhi(w.x) * bfhi(w.x)) + (bflo(w.y) * bflo(w.y) + bfhi(w.y) * bfhi(w.y)) + (bflo(w.z) * bflo(w.z) + bfhi(w.z) * bfhi(w.z)) + (bflo(w.w) * bflo(w.w) + bfhi(w.w) * bfhi(w.w));
        *(bf16x8*)(orow + c) = o; }
    return wave_sum(s);
}

template <int NS>
__device__ __forceinline__ void skinny_gemm(const bf16* A1, const bf16* WSK, const ssq_t* sumsq, int r0, LAS float* res, int wid, int lane) {
    constexpr int NT = NS / 32;
    const int mt = wid & 3, ng = wid >> 2, fr = lane & 15, fq = lane >> 4;
    f32x4 acc[NT];
#pragma unroll
    for (int t = 0; t < NT; ++t) acc[t] = (f32x4){0.f, 0.f, 0.f, 0.f};
    const bf16* ap = A1 + (size_t)(r0 + 16 * mt + fr) * 4096 + 8 * fq;
    const bf16* bp = WSK + (size_t)(16 * ng * NT + fr) * 4096 + 8 * fq;
#pragma unroll 8
    for (int k = 0; k < 4096; k += 32) {
        const bf16x8 a = *(const bf16x8*)(ap + k);
#pragma unroll
        for (int t = 0; t < NT; ++t) { const bf16x8 b = *(const bf16x8*)(bp + (size_t)t * 16 * 4096 + k); acc[t] = __builtin_amdgcn_mfma_f32_16x16x32_bf16(a, b, acc[t], 0, 0, 0); }
    }
#pragma unroll
    for (int i = 0; i < 4; ++i) { const int row = 16 * mt + 4 * fq + i; const float rs = __builtin_amdgcn_rsqf(ssq_val(sumsq[r0 + row]) * (1.0f / 4096.0f) + NORM_EPS);
#pragma unroll
        for (int t = 0; t < NT; ++t) res[row * NS + 16 * (ng * NT + t) + fr] = acc[t][i] * rs; }
}
namespace gdn {
constexpr int PQ = 272;
constexpr int PL = 68;
constexpr int G_Q = 0, G_K = 17408, G_V = 34816, G_L = 52224, G_S = 69632, GRP_BYTES = 70656;
static_assert(2 * GRP_BYTES <= 147456, "gdn prep LDS");

__device__ __forceinline__ void group_barrier(LAS unsigned* cnt, unsigned& target) {
    target += 4u;
    asm volatile("s_waitcnt lgkmcnt(0)" ::: "memory");
    if (__builtin_amdgcn_mbcnt_hi(~0u, __builtin_amdgcn_mbcnt_lo(~0u, 0u)) == 0u) __hip_atomic_fetch_add(cnt, 1u, __ATOMIC_RELAXED, __HIP_MEMORY_SCOPE_WORKGROUP);
    while (__hip_atomic_load(cnt, __ATOMIC_RELAXED, __HIP_MEMORY_SCOPE_WORKGROUP) < target) __builtin_amdgcn_s_sleep(1);
    asm volatile("" ::: "memory");
}
__device__ __forceinline__ void prep_pair(LAS unsigned char* lds, int uid0, const bf16* PROJ, const float* convw, const float* BETA, const float* GLOG, float* GL, unsigned char* REC, unsigned& gbt, const int w0) {
    const int tid = otid(w0), wid = __builtin_amdgcn_readfirstlane(tid >> 6), lane = tid & 63, grp = wid >> 2, gw = wid & 3, gt = tid & 255;
    const int uid = uid0 + grp, bhh = uid >> 7, c = uid & 127, b = bhh >> 5, h = bhh & 31;
    LAS unsigned char* gl = lds + grp * GRP_BYTES;
    LAS float* Lm = (LAS float*)(gl + G_L); LAS float* gcs = (LAS float*)(gl + G_S); LAS float* bes = gcs + 64; LAS float* egs = gcs + 128;
    unsigned char* rec = REC + (size_t)uid * GR_BYTES;
    LAS unsigned* gbc = (LAS unsigned*)(gl + G_S + 768);
    const size_t row0 = (size_t)b * SEQ + (size_t)c * 64;
    float g_ld = 0.f, b_ld = 0.f;
    if (gw == 0) { g_ld = GLOG[(row0 + lane) * 32 + h]; b_ld = BETA[(row0 + lane) * 32 + h]; }
    {
    {
        const int cg = gt & 15, rp = gt >> 4;
        u32x4 raw[2][7];
#define GDN_ROWS(s_, buf_) do { const bf16* bp_ = PROJ + (row0 + 4 * rp - 3) * LDP + (s_) * 4096 + h * 128 + 8 * cg; \
            _Pragma("unroll") for (int jj = 0; jj < 7; ++jj) raw[buf_][jj] = (c * 64 + 4 * rp - 3 + jj >= 0) ? *(const u32x4*)(bp_ + (size_t)jj * LDP) : (u32x4){0u, 0u, 0u, 0u}; } while (0)
        GDN_ROWS(0, 0);
#pragma unroll
        for (int s = 0; s < 3; ++s) {
            const int colb = s * 4096 + h * 128 + 8 * cg;
            f32x4 w[4][2];
#pragma unroll
            for (int j = 0; j < 4; ++j) { w[j][0] = *(const f32x4*)(convw + (size_t)j * 12288 + colb); w[j][1] = *(const f32x4*)(convw + (size_t)j * 12288 + colb + 4); }
            if (s == 0) GDN_ROWS(1, 1); else if (s == 1) GDN_ROWS(2, 0);
            float xr[7][8];
#pragma unroll
            for (int jj = 0; jj < 7; ++jj) unpack8(raw[s & 1][jj], xr[jj]);
#pragma unroll
            for (int i = 0; i < 4; ++i) { const int t = 4 * rp + i; float y[8];
#pragma unroll
                for (int e = 0; e < 8; ++e) y[e] = 0.f;
#pragma unroll
                for (int j = 0; j < 4; ++j)
#pragma unroll
                    for (int e = 0; e < 4; ++e) { y[e] += w[j][0][e] * xr[i + j][e]; y[4 + e] += w[j][1][e] * xr[i + j][4 + e]; }
                float ss = 0.f;
#pragma unroll
                for (int e = 0; e < 8; ++e) { y[e] = siluf_(y[e]); ss += y[e] * y[e]; }
                float sc = 1.f;
                if (s < 2) { ss += __shfl_xor(ss, 1); ss += __shfl_xor(ss, 2); ss += __shfl_xor(ss, 4); ss += __shfl_xor(ss, 8);
                    sc = __builtin_amdgcn_rsqf(ss + NORM_EPS) * (s == 0 ? 0.08838834764831845f : 1.0f); }
                *(LAS bf16x8*)(gl + s * 17408 + t * PQ + cg * 16) = pack8((f32x4){y[0] * sc, y[1] * sc, y[2] * sc, y[3] * sc}, (f32x4){y[4] * sc, y[5] * sc, y[6] * sc, y[7] * sc}); }
        }
#undef GDN_ROWS
    }
    }
    if (gw == 0) { float g = g_ld;
#pragma unroll
        for (int o = 1; o < 64; o <<= 1) { const float t = __shfl_up(g, o); if (lane >= o) g += t; }
        gcs[lane] = g; bes[lane] = b_ld; egs[lane] = fexp(g);
        if (lane == 63) GL[uid] = fexp(g); }
    group_barrier(gbc, gbt);
    {
    {
        const int fr = lane & 15, fq = lane >> 4, mt = gw;
        bf16x8 kA[4], qA[4];
#pragma unroll
        for (int s = 0; s < 4; ++s) { kA[s] = *(const LAS bf16x8*)(gl + G_K + (16 * mt + fr) * PQ + (32 * s + 8 * fq) * 2); qA[s] = *(const LAS bf16x8*)(gl + G_Q + (16 * mt + fr) * PQ + (32 * s + 8 * fq) * 2); }
        bf16* intra = (bf16*)(rec + GR_IN);
#pragma unroll
        for (int nt = 0; nt < 4; ++nt) { f32x4 kk = {0.f, 0.f, 0.f, 0.f}, qk = {0.f, 0.f, 0.f, 0.f};
#pragma unroll
            for (int s = 0; s < 4; ++s) { const bf16x8 kB = *(const LAS bf16x8*)(gl + G_K + (16 * nt + fr) * PQ + (32 * s + 8 * fq) * 2);
                kk = __builtin_amdgcn_mfma_f32_16x16x32_bf16(kA[s], kB, kk, 0, 0, 0); qk = __builtin_amdgcn_mfma_f32_16x16x32_bf16(qA[s], kB, qk, 0, 0, 0); }
            const int j = 16 * nt + fr; const float gj = gcs[j];
#pragma unroll
            for (int e = 0; e < 4; ++e) { const int i = 16 * mt + 4 * fq + e; const float dec = (i >= j) ? fexp(gcs[i] - gj) : 0.f;
                Lm[i * PL + j] = (i > j) ? bes[i] * kk[e] * dec : 0.f;
                intra[i * 64 + j] = (bf16)(cvtpk(qk[e] * dec, 0.f) & 0xffffu); } }
    }
    {
        const int row = gt >> 2, seg = gt & 3; const float e = egs[row];
#pragma unroll
        for (int q4 = 0; q4 < 4; ++q4) { const u32x4 xw = *(const LAS u32x4*)(gl + G_Q + row * PQ + (seg * 32 + q4 * 8) * 2); float x[8]; unpack8(xw, x);
            *(bf16x8*)(rec + GR_QD + ((size_t)row * 128 + seg * 32 + q4 * 8) * 2) = pack8((f32x4){x[0] * e, x[1] * e, x[2] * e, x[3] * e}, (f32x4){x[4] * e, x[5] * e, x[6] * e, x[7] * e}); }
        const int d = gt & 127, half = gt >> 7; const float g63 = gcs[63];
#pragma unroll
        for (int q4 = 0; q4 < 4; ++q4) { float v[8];
#pragma unroll
            for (int e2 = 0; e2 < 8; ++e2) { const int i = 32 * half + 8 * q4 + e2; v[e2] = bf2f(*(const LAS bf16*)(gl + G_K + i * PQ + d * 2)) * fexp(g63 - gcs[i]); }
            *(bf16x8*)(rec + GR_KT + ((size_t)d * 64 + 32 * half + 8 * q4) * 2) = pack8((f32x4){v[0], v[1], v[2], v[3]}, (f32x4){v[4], v[5], v[6], v[7]}); }
    }
    }
    group_barrier(gbc, gbt);
    if (gt < 128) {
        LAS bf16* vp = (LAS bf16*)(gl + G_V) + gt; LAS bf16* kp = (LAS bf16*)(gl + G_K) + gt;
        f32x2 x[64];
#pragma unroll
        for (int i = 0; i < 64; ++i) {
            f32x4 lr[16];
#pragma unroll
            for (int j4 = 0; j4 < (i + 3) / 4; ++j4) lr[j4] = *(const LAS f32x4*)(Lm + i * PL + 4 * j4);
            const float be = bes[i];
            f32x2 a = {bf2f(vp[i * (PQ / 2)]) * be, bf2f(kp[i * (PQ / 2)]) * be * egs[i]};
            f32x2 acc[4] = {{0.f, 0.f}, {0.f, 0.f}, {0.f, 0.f}, {0.f, 0.f}};
#pragma unroll
            for (int j4 = 0; j4 < (i + 3) / 4; ++j4)
#pragma unroll
                for (int e = 0; e < 4; ++e) if (4 * j4 + e < i) acc[e] += x[4 * j4 + e] * lr[j4][e];
            a -= (acc[0] + acc[1]) + (acc[2] + acc[3]);
            x[i] = a;
        }
#pragma unroll
        for (int i = 0; i < 64; ++i) { const unsigned w = cvtpk(x[i].x, x[i].y);
            vp[i * (PQ / 2)] = (bf16)(w & 0xffffu); kp[i * (PQ / 2)] = (bf16)(w >> 16); }
    }
    group_barrier(gbc, gbt);
    {
        const int row = gt >> 2, seg = gt & 3;
#pragma unroll
        for (int q4 = 0; q4 < 4; ++q4) {
            *(u32x4*)(rec + GR_U + ((size_t)row * 128 + seg * 32 + q4 * 8) * 2) = *(const LAS u32x4*)(gl + G_V + row * PQ + (seg * 32 + q4 * 8) * 2);
            *(u32x4*)(rec + GR_W + ((size_t)row * 128 + seg * 32 + q4 * 8) * 2) = *(const LAS u32x4*)(gl + G_K + row * PQ + (seg * 32 + q4 * 8) * 2); }
    }
    group_barrier(gbc, gbt);
}

constexpr int SP = 272, SPT = 144, SPU = 80;
constexpr int L_QD = 0, L_W = 17408, L_KT = 34816, L_IN = 53248, L_U = 62464, L_BUF = 67584;
constexpr int L_ST = 2 * L_BUF, L_VT = L_ST + 32 * SP, SCAN_LDS = L_VT + 32 * SPT;
static_assert(SCAN_LDS <= 155648, "gdn scan LDS");
__device__ __forceinline__ bf16x8 pack_cc(const f32x4& lo, const f32x4& hi) { const u32x4 w = {cvtpk(lo[0], lo[1]), cvtpk(lo[2], lo[3]), cvtpk(hi[0], hi[1]), cvtpk(hi[2], hi[3])}; return __builtin_bit_cast(bf16x8, w); }
__device__ __forceinline__ void scan_unit(LAS unsigned char* lds, int unit, const unsigned char* REC, const float* GL, float* O32  , const int w0) {
    const int tid = otid(w0), wid = __builtin_amdgcn_readfirstlane(tid >> 6), lane = tid & 63, fr = lane & 15, fq = lane >> 4;
    const int bhh = unit >> 2, q4 = unit & 3, b = bhh >> 5, h = bhh & 31, nt = wid & 1, mt = wid >> 1;
    f32x4 S[2];
    S[0] = (f32x4){0.f, 0.f, 0.f, 0.f}; S[1] = (f32x4){0.f, 0.f, 0.f, 0.f};
    u32x4 st[8];
    int srcoff[8], dstoff[8];
#pragma unroll
    for (int i = 0; i < 8; ++i) { const int p = tid + 512 * i; int so, d;
        if (p < 1024) { so = (int)GR_QD + p * 16; d = L_QD + (p >> 4) * SP + (p & 15) * 16; }
        else if (p < 2048) { const int q = p - 1024; so = (int)GR_W + q * 16; d = L_W + (q >> 4) * SP + (q & 15) * 16; }
        else if (p < 3072) { const int q = p - 2048; so = (int)GR_KT + q * 16; d = L_KT + (q >> 3) * SPT + (q & 7) * 16; }
        else if (p < 3584) { const int q = p - 3072; so = (int)GR_IN + q * 16; d = L_IN + (q >> 3) * SPT + (q & 7) * 16; }
        else { const int q = (p - 3584) & 255; so = (int)GR_U + (q >> 2) * 256 + q4 * 64 + (q & 3) * 16; d = L_U + (q >> 2) * SPU + (q & 3) * 16; }
        srcoff[i] = so; dstoff[i] = d; }
    const bool has8 = tid < 256;
#define GDN_ISSUE(c_) do { const unsigned char* rec_ = REC + ((size_t)bhh * 128 + (c_)) * GR_BYTES; \
        _Pragma("unroll") for (int i = 0; i < 7; ++i) st[i] = *(const u32x4*)(rec_ + srcoff[i]); if (has8) st[7] = *(const u32x4*)(rec_ + srcoff[7]); } while (0)
#define GDN_STASH(buf_) do { LAS unsigned char* bp_ = lds + (buf_) * L_BUF; \
        _Pragma("unroll") for (int i = 0; i < 7; ++i) *(LAS u32x4*)(bp_ + dstoff[i]) = st[i]; if (has8) *(LAS u32x4*)(bp_ + dstoff[7]) = st[7]; } while (0)
    { const u32x4 z4 = ozero4(); for (int i = tid; i < (32 * SP) / 16; i += 512) *(LAS u32x4*)(lds + L_ST + i * 16) = z4; }
    GDN_ISSUE(0); GDN_STASH(0); __syncthreads();
    float gl_n = GL[bhh * 128]; asm volatile("" ::: "memory");
    GDN_ISSUE(1);
    float* orow = O32 + ((size_t)b * SEQ + 16 * mt + 4 * fq) * 4096 + h * 128 + 32 * q4 + 16 * nt + fr;
    const LAS unsigned char* stp = lds + L_ST + (16 * nt + fr) * SP + 16 * fq;
    const LAS unsigned char* vtp = lds + L_VT + (16 * nt + fr) * SPT + 16 * fq;
#pragma unroll 1
    for (int c = 0; c < GDN_NCHUNK; ++c) {
        const LAS unsigned char* bp = lds + (c & 1) * L_BUF;
        const float glast = gl_n;
        bf16x8 Sb[4];
#pragma unroll
        for (int s = 0; s < 4; ++s) Sb[s] = *(const LAS bf16x8*)(stp + 64 * s);
        f32x4 aw = {0.f, 0.f, 0.f, 0.f}, ao = {0.f, 0.f, 0.f, 0.f};
#pragma unroll
        for (int s = 0; s < 4; ++s) { aw = __builtin_amdgcn_mfma_f32_16x16x32_bf16(*(const LAS bf16x8*)(bp + L_W + (16 * mt + fr) * SP + 64 * s + 16 * fq), Sb[s], aw, 0, 0, 0);
            ao = __builtin_amdgcn_mfma_f32_16x16x32_bf16(*(const LAS bf16x8*)(bp + L_QD + (16 * mt + fr) * SP + 64 * s + 16 * fq), Sb[s], ao, 0, 0, 0); }
        f32x4 vn;
#pragma unroll
        for (int e = 0; e < 4; ++e) vn[e] = bf2f(*(const LAS bf16*)(bp + L_U + (16 * mt + 4 * fq + e) * SPU + (16 * nt + fr) * 2)) - aw[e];
        *(LAS u32x2*)(lds + L_VT + (16 * nt + fr) * SPT + (16 * mt + 4 * fq) * 2) = (u32x2){cvtpk(vn[0], vn[1]), cvtpk(vn[2], vn[3])};
        __syncthreads();
        bf16x8 vb[2];
        vb[0] = *(const LAS bf16x8*)vtp; vb[1] = *(const LAS bf16x8*)(vtp + 64);
#pragma unroll
        for (int s2 = 0; s2 < 2; ++s2) ao = __builtin_amdgcn_mfma_f32_16x16x32_bf16(*(const LAS bf16x8*)(bp + L_IN + (16 * mt + fr) * SPT + 64 * s2 + 16 * fq), vb[s2], ao, 0, 0, 0);
#pragma unroll
        for (int kk = 0; kk < 2; ++kk) { f32x4 a = S[kk] * glast;
#pragma unroll
            for (int s2 = 0; s2 < 2; ++s2) a = __builtin_amdgcn_mfma_f32_16x16x32_bf16(*(const LAS bf16x8*)(bp + L_KT + (16 * (2 * mt + kk) + fr) * SPT + 64 * s2 + 16 * fq), vb[s2], a, 0, 0, 0);
            S[kk] = a;
            *(LAS u32x2*)(lds + L_ST + (16 * nt + fr) * SP + (16 * (2 * mt + kk) + 4 * fq) * 2) = (u32x2){cvtpk(a[0], a[1]), cvtpk(a[2], a[3])}; }
#pragma unroll
        for (int e = 0; e < 4; ++e) orow[(size_t)(c * 64 + e) * 4096] = ao[e];
        if (c + 1 < GDN_NCHUNK) GDN_STASH((c + 1) & 1);
        __syncthreads();
        if (c + 1 < GDN_NCHUNK) { gl_n = GL[bhh * 128 + c + 1]; asm volatile("" ::: "memory"); }
        if (c + 2 < GDN_NCHUNK) GDN_ISSUE(c + 2);
    }
#undef GDN_ISSUE
#undef GDN_STASH
}
__device__ __forceinline__ void normgate(int gwv, int NGW, int lane, const float* O32, const bf16* PROJ, const float* normw, bf16* MIX) {
    const f32x4 n0 = *(const f32x4*)(normw + ((lane & 15) * 8)), n1 = *(const f32x4*)(normw + ((lane & 15) * 8) + 4);
#pragma unroll 2
    for (int it = gwv; it < M_TOK * 8; it += NGW) { const int row = it >> 3, c8 = (it & 7) * 512 + lane * 8;
        const f32x4 o0 = *(const f32x4*)(O32 + (size_t)row * 4096 + c8), o1 = *(const f32x4*)(O32 + (size_t)row * 4096 + c8 + 4);
        const u32x4 zw = *(const u32x4*)(PROJ + (size_t)row * LDP + ZCOL + c8); float z[8]; unpack8(zw, z);
        float q = (o0[0] * o0[0] + o0[1] * o0[1]) + (o0[2] * o0[2] + o0[3] * o0[3]) + (o1[0] * o1[0] + o1[1] * o1[1]) + (o1[2] * o1[2] + o1[3] * o1[3]);
        q += __shfl_xor(q, 1); q += __shfl_xor(q, 2); q += __shfl_xor(q, 4); q += __shfl_xor(q, 8);
        const float rs = __builtin_amdgcn_rsqf(q * (1.0f / 128.0f) + NORM_EPS);
        f32x4 r0, r1;
#pragma unroll
        for (int e = 0; e < 4; ++e) { r0[e] = o0[e] * rs * n0[e] * siluf_(z[e]); r1[e] = o1[e] * rs * n1[e] * siluf_(z[4 + e]); }
        *(bf16x8*)(MIX + (size_t)row * 4096 + c8) = pack8(r0, r1); }
}
}
namespace s5 {
__device__ __forceinline__ void sincos_cw(float x, float& s, float& c) {
    const float kf = rintf(x * 0.6366197723675814f); const int k = (int)kf;
    float r = fmaf(kf, -1.5703125f, x); r = fmaf(kf, -4.837512969970703125e-4f, r); r = fmaf(kf, -7.54978995489188e-8f, r);
    const float r2 = r * r;
    float c1 = -1.9515295891e-4f, c2 = 8.3321608736e-3f, c3 = 2.443315711809948e-5f, c4 = -1.388731625493765e-3f; asm volatile("" : "+v"(c1), "+v"(c2), "+v"(c3), "+v"(c4));
    const float sp = fmaf(r * r2, fmaf(r2, fmaf(r2, c1, c2), -1.6666654611e-1f), r);
    const float cp = fmaf(r2 * r2, fmaf(r2, fmaf(r2, c3, c4), 4.166664568298827e-2f), fmaf(r2, -0.5f, 1.0f));
    const int q = k & 3;
    s = (q == 0) ? sp : (q == 1) ? cp : (q == 2) ? -sp : -cp;
    c = (q == 0) ? cp : (q == 1) ? -sp : (q == 2) ? -cp : sp;
}
__device__ __forceinline__ void zoh_of(int g, int p, const float* LRE, const float* LIM, const float* LSTEP, float& lr, float& li, float& zr, float& zi) {
    const float lam_re = LRE[g * 64 + p], lam_im = LIM[g * 64 + p], step = fexp(LSTEP[g]);
    const float mag = fexp(lam_re * step); float sn, cs; sincos_cw(lam_im * step, sn, cs);
    lr = mag * cs; li = mag * sn;
    const float den = lam_re * lam_re + lam_im * lam_im, num_re = lr - 1.0f;
    zr = (num_re * lam_re + li * lam_im) / den; zi = (li * lam_re - num_re * lam_im) / den;
}
struct Disc { float lr, li; bf16x8 bh[8], bl[8]; };
__device__ __forceinline__ void discretise(Disc& d, int g, int lane, const float* LRE, const float* LIM, const float* BRE, const float* BIM, const float* LSTEP) {
    float zr, zi; zoh_of(g, lane, LRE, LIM, LSTEP, d.lr, d.li, zr, zi);
    const int fr = lane & 15, fq = lane >> 4, n0 = 8 * (fq & 1);
#pragma unroll
    for (int t = 0; t < 4; ++t) { const int p = 16 * t + fr; float lr, li; zoh_of(g, p, LRE, LIM, LSTEP, lr, li, zr, zi);
        const float* br = BRE + (size_t)(g * 64 + p) * 16 + n0; const float* bi = BIM + (size_t)(g * 64 + p) * 16 + n0;
        const f32x4 r0 = *(const f32x4*)br, r1 = *(const f32x4*)(br + 4), i0 = *(const f32x4*)bi, i1 = *(const f32x4*)(bi + 4);
        const f32x4 re0 = r0 * zr - i0 * zi, re1 = r1 * zr - i1 * zi, im0 = i0 * zr + r0 * zi, im1 = i1 * zr + r1 * zi;
        const u32x4 rh = __builtin_bit_cast(u32x4, pack8(re0, re1)), ih = __builtin_bit_cast(u32x4, pack8(im0, im1));
        float rhf[8], ihf[8]; unpack8(rh, rhf); unpack8(ih, ihf);
        const f32x4 rl0 = {re0[0] - rhf[0], re0[1] - rhf[1], re0[2] - rhf[2], re0[3] - rhf[3]}, rl1 = {re1[0] - rhf[4], re1[1] - rhf[5], re1[2] - rhf[6], re1[3] - rhf[7]};
        const f32x4 il0 = {im0[0] - ihf[0], im0[1] - ihf[1], im0[2] - ihf[2], im0[3] - ihf[3]}, il1 = {im1[0] - ihf[4], im1[1] - ihf[5], im1[2] - ihf[6], im1[3] - ihf[7]};
        const bf16x8 zero8 = {0, 0, 0, 0, 0, 0, 0, 0};
        d.bh[t] = __builtin_bit_cast(bf16x8, rh); d.bh[4 + t] = __builtin_bit_cast(bf16x8, ih);
        d.bl[t] = fq < 2 ? pack8(rl0, rl1) : zero8; d.bl[4 + t] = fq < 2 ? pack8(il0, il1) : zero8; }
}
constexpr int BUP = 20;
__device__ __forceinline__ void bu_tile(const Disc& d, const LAS float* us, LAS float* but, int t0, int lane) {
    const int fr = lane & 15, fq = lane >> 4;
    const f32x4 u0 = *(const LAS f32x4*)(us + (t0 + fr) * 16 + 8 * (fq & 1)), u1 = *(const LAS f32x4*)(us + (t0 + fr) * 16 + 8 * (fq & 1) + 4);
    const u32x4 uh = __builtin_bit_cast(u32x4, pack8(u0, u1)); float uhf[8]; unpack8(uh, uhf);
    const f32x4 l0 = {u0[0] - uhf[0], u0[1] - uhf[1], u0[2] - uhf[2], u0[3] - uhf[3]}, l1 = {u1[0] - uhf[4], u1[1] - uhf[5], u1[2] - uhf[6], u1[3] - uhf[7]};
    const bf16x8 af = fq < 2 ? __builtin_bit_cast(bf16x8, uh) : pack8(l0, l1);
    f32x4 accs[8];
#pragma unroll
    for (int ct = 0; ct < 8; ++ct) { f32x4 acc = {0.f, 0.f, 0.f, 0.f};
        acc = __builtin_amdgcn_mfma_f32_16x16x32_bf16(af, d.bh[ct], acc, 0, 0, 0);
        accs[ct] = __builtin_amdgcn_mfma_f32_16x16x32_bf16(af, d.bl[ct], acc, 0, 0, 0); }
    asm volatile("s_nop 15\n\ts_nop 15" : "+v"(accs[0]), "+v"(accs[1]), "+v"(accs[2]), "+v"(accs[3]), "+v"(accs[4]), "+v"(accs[5]), "+v"(accs[6]), "+v"(accs[7]));
#pragma unroll
    for (int ct = 0; ct < 8; ++ct) *(LAS f32x4*)(but + (16 * ct + fr) * BUP + 4 * fq) = accs[ct];
}
struct Slab { f32x4 r[4]; };
__device__ __forceinline__ void slab_issue(Slab& s, const float* up  , int lane) {
#pragma unroll
    for (int i = 0; i < 4; ++i) { const int pc = 64 * i + lane; s.r[i] = *(const f32x4*)(up + (size_t)(pc >> 2) * 4096 + (pc & 3) * 4); }
}
__device__ __forceinline__ void slab_store(const Slab& s, LAS float* us, int lane) {
#pragma unroll
    for (int i = 0; i < 4; ++i) { const int pc = 64 * i + lane; *(LAS f32x4*)(us + pc * 4) = s.r[i]; }
}
__device__ __forceinline__ void pass1(LAS float* us, LAS float* but, int gwv, int NGW, int lane, const float* U32, const float* LRE, const float* LIM, const float* BRE, const float* BIM, const float* LSTEP, f32x2* ENDST) {
#pragma unroll 1
    for (int wu = gwv; wu < BATCH * SSM_G * SSM_NSEG; wu += NGW) {
        const int g = wu & 255, seg = (wu >> 8) & (SSM_NSEG - 1), b = wu >> 13, bg = b * 256 + g;
        Disc d; discretise(d, g, lane, LRE, LIM, BRE, BIM, LSTEP);
        const float* up = U32 + ((size_t)b * SEQ + (size_t)seg * SSM_SL) * 4096 + 16 * g;
        float xr = 0.f, xi = 0.f;
        Slab sl; slab_issue(sl, up, lane);
#pragma unroll 1
        for (int tb = 0; tb < SSM_SL; tb += 64) {
            slab_store(sl, us, lane);
            if (tb + 64 < SSM_SL) slab_issue(sl, up + (size_t)(tb + 64) * 4096, lane);
#pragma unroll 1
            for (int t0 = 0; t0 < 64; t0 += 16) {
                bu_tile(d, us, but, t0, lane);
                f32x4 brv[4], biv[4];
#pragma unroll
                for (int q = 0; q < 4; ++q) { brv[q] = *(const LAS f32x4*)(but + lane * BUP + 4 * q); biv[q] = *(const LAS f32x4*)(but + (64 + lane) * BUP + 4 * q); }
#pragma unroll
                for (int t = 0; t < 16; ++t) { const float br = brv[t >> 2][t & 3], bi = biv[t >> 2][t & 3];
                    const float nr = fmaf(d.lr, xr, fmaf(-d.li, xi, br)), ni = fmaf(d.lr, xi, fmaf(d.li, xr, bi)); xr = nr; xi = ni; }
            }
        }
        ENDST[((size_t)bg * SSM_NSEG + seg) * 64 + lane] = (f32x2){xr, xi};
    }
}
__device__ __forceinline__ float gelu_tanh(float y) { const float a = 0.7978845608028654f * (y + 0.044715f * y * y * y); const float t = 1.0f - 2.0f * __builtin_amdgcn_rcpf(1.0f + fexp(2.0f * a)); return 0.5f * y * (1.0f + t); }
constexpr int XP = 272;
__device__ __forceinline__ void pass2(LAS unsigned char* xt  , int gwv, int NGW, int lane, const float* U32, const float* LRE, const float* LIM, const float* BRE, const float* BIM,
                                      const float* CRE, const float* CIM, const float* LSTEP, const float* DSK, const f32x2* ENDST, bf16* Y1) {
    const int fr = lane & 15, fq = lane >> 4;
    LAS float* us = (LAS float*)(xt + 16 * XP); LAS float* but = (LAS float*)(xt + 16 * XP + 4096);
#pragma unroll 1
    for (int wu = gwv; wu < BATCH * SSM_G * SSM_NSEG; wu += NGW) {
        const int g = wu & 255, seg = (wu >> 8) & (SSM_NSEG - 1), b = wu >> 13, bg = b * 256 + g;
        Disc d; discretise(d, g, lane, LRE, LIM, BRE, BIM, LSTEP);
        const size_t row0 = (size_t)b * SEQ + (size_t)seg * SSM_SL;
        const float* up = U32 + row0 * 4096 + 16 * g;
        Slab sl; slab_issue(sl, up, lane);
        float pr = d.lr, pi = d.li;
#pragma unroll
        for (int i = 0; i < 8; ++i) { const float a = pr * pr - pi * pi, c = 2.0f * pr * pi; pr = a; pi = c; }
        float xr = 0.f, xi = 0.f;
#pragma unroll 1
        for (int s = 0; s < seg; ++s) { const f32x2 e = ENDST[((size_t)bg * SSM_NSEG + s) * 64 + lane];
            const float nr = fmaf(pr, xr, fmaf(-pi, xi, e.x)), ni = fmaf(pr, xi, fmaf(pi, xr, e.y)); xr = nr; xi = ni; }
        bf16x8 cf[4];
#pragma unroll
        for (int s = 0; s < 4; ++s) { const float* cp = (s < 2 ? CRE : CIM) + (size_t)(g * 16 + fr) * 64 + 32 * (s & 1) + 8 * fq; const float sg = s < 2 ? 1.0f : -1.0f;
            const f32x4 a = *(const f32x4*)cp * sg, c = *(const f32x4*)(cp + 4) * sg; cf[s] = pack8(a, c); }
        const float dsk = DSK[16 * g + fr];
#pragma unroll 1
        for (int tb = 0; tb < SSM_SL; tb += 64) {
            slab_store(sl, us, lane);
            if (tb + 64 < SSM_SL) slab_issue(sl, up + (size_t)(tb + 64) * 4096, lane);
#pragma unroll 1
            for (int t0 = 0; t0 < 64; t0 += 16) {
                bu_tile(d, us, but, t0, lane);
                f32x4 brv[4], biv[4];
#pragma unroll
                for (int q = 0; q < 4; ++q) { brv[q] = *(const LAS f32x4*)(but + lane * BUP + 4 * q); biv[q] = *(const LAS f32x4*)(but + (64 + lane) * BUP + 4 * q); }
#pragma unroll
                for (int t = 0; t < 16; ++t) { const float br = brv[t >> 2][t & 3], bi = biv[t >> 2][t & 3];
                    const float nr = fmaf(d.lr, xr, fmaf(-d.li, xi, br)), ni = fmaf(d.lr, xi, fmaf(d.li, xr, bi)); xr = nr; xi = ni;
                    const unsigned w = cvtpk(xr, xi);
                    *(LAS bf16*)(xt + t * XP + lane * 2) = (bf16)(w & 0xffffu); *(LAS bf16*)(xt + t * XP + 128 + lane * 2) = (bf16)(w >> 16); }
                LDS_WAIT();
                f32x4 acc = {0.f, 0.f, 0.f, 0.f};
#pragma unroll
                for (int s = 0; s < 4; ++s) { const bf16x8 xa = *(const LAS bf16x8*)(xt + fr * XP + (32 * s + 8 * fq) * 2); acc = __builtin_amdgcn_mfma_f32_16x16x32_bf16(xa, cf[s], acc, 0, 0, 0); }
#pragma unroll
                for (int e = 0; e < 4; ++e) { const int tl = t0 + 4 * fq + e; const float u = us[tl * 16 + fr];
                    const float y = gelu_tanh(acc[e] + dsk * u);
                    Y1[(row0 + tb + tl) * 4096 + 16 * g + fr] = (bf16)(cvtpk(y, 0.f) & 0xffffu); }
                LDS_WAIT();
            }
        }
    }
}
}
constexpr int PH_PER_LAYER = 10, PH_FINAL = 40, PH_END = 41;
__host__ __device__ constexpr bool phase_exists(int ph) {
    if (ph == PH_FINAL) return true; if (ph < 0 || ph >= PH_FINAL) return false;
    const int L = ph / PH_PER_LAYER, k = ph % PH_PER_LAYER, kind = L % 3;
    if (k == 4) return kind != 0; return k <= 6;
}
typedef const __attribute__((address_space(4))) Args* kargs_t;
#define KARGS() ({ kargs_t p_ = (kargs_t)__builtin_amdgcn_kernarg_segment_ptr(); asm volatile("" : "+s"(p_)); p_; })
#define WSP(T, off) ((T*)(ws + (off)))
__global__ void __launch_bounds__(NTHR, 2) trunk_fwd(Args args_unused) {
    extern __shared__ __attribute__((aligned(16))) unsigned char lds_raw[];
    LAS unsigned char* lds = (LAS unsigned char*)lds_raw;
    const int w0 = __builtin_amdgcn_readfirstlane(threadIdx.x >> 6);
    const int G = gridDim.x, bx = blockIdx.x, vcu = (G % 8 == 0) ? (bx % 8) * (G / 8) + bx / 8 : bx, NGW = G * NWAVES;
#define TIDS() const int tid = otid(w0), lane = tid & 63, wid = __builtin_amdgcn_readfirstlane(tid >> 6), gwv = vcu * NWAVES + wid; (void)lane; (void)gwv
    { volatile LAS unsigned* MISC = (volatile LAS unsigned*)(lds + MISC_OFF); if (threadIdx.x < 32) MISC[threadIdx.x] = 0u; }
    __syncthreads();
    int lo, hi;
    { kargs_t ap = KARGS(); lo = ap->ph_lo; hi = ap->ph_hi;
      if (hi - lo > 1) (void)xcd_barrier_post((unsigned*)(ap->ws + WS_CTL) + CW_BAR + ap->li * XCD_BAR_WORDS, (volatile LAS unsigned*)(lds + MISC_OFF) + 8); }
#define IN(k) (lo <= (k) && (k) < hi)
#define SEAM(k) do { if ((k) + 1 < hi) { kargs_t ap_ = KARGS(); XcdBarrier b_; b_.bar = (unsigned*)(ap_->ws + WS_CTL) + CW_BAR + ap_->li * XCD_BAR_WORDS; b_.x = xb_xcc_id(); \
        b_.st = (volatile LAS unsigned*)(lds + MISC_OFF) + 8; b_.tid = (unsigned)otid(w0); xcd_barrier(b_); } } while (0)

#pragma unroll 1
    for (int L = 0; L < DEPTH; ++L) {
        const int base = L * PH_PER_LAYER, kind = L % 3, j = L / 3;

        if (IN(base + 0)) {
            kargs_t ap = KARGS(); unsigned char* ws = ap->ws; TIDS();
            LAS float* scr = (LAS float*)(lds + wid * 16384);
            const int n_in = kind == 0 ? 16416 : kind == 1 ? 16448 : 8192;
            const float* w_in = kind == 0 ? ap->in[I_FOX_WIN] + (size_t)j * 4096 * 16416 : kind == 1 ? ap->in[I_GDN_WIN] : ap->in[I_SSM_WIN];
            const float* w_out = kind == 0 ? ap->in[I_FOX_WOUT] + (size_t)j * 4096 * 4096 : kind == 1 ? ap->in[I_GDN_WOUT] : ap->in[I_SSM_WOUT];
            transpose_matrix(w_out, 4096, 4096, WSP(bf16, WS_WOUT), 4096, WSP(bf16, WS_WOUT), nullptr, scr, gwv, NGW, lane);
            transpose_matrix(ap->in[I_PLE_WGATE] + (size_t)L * 4096 * 4096, 4096, 4096, WSP(bf16, WS_WGATE), 4096, WSP(bf16, WS_WGATE), ap->in[I_NORM_PLE] + (size_t)L * D_MODEL, scr, gwv, NGW, lane);
            transpose_matrix(ap->in[I_PLE_WPROJ] + (size_t)L * 256 * 4096, 256, 4096, WSP(bf16, WS_WPP), 4096, WSP(bf16, WS_WPP), nullptr, scr, gwv, NGW, lane);
            if (kind == 2) transpose_matrix(ap->in[I_SSM_WGLU], 4096, 4096, WSP(bf16, WS_WGLU), 4096, WSP(bf16, WS_WGLU), nullptr, scr, gwv, NGW, lane);
            transpose_matrix(w_in, 4096, n_in, WSP(bf16, WS_WIN), 16384, WSP(bf16, WS_WSK), ap->in[I_NORM_MIX] + (size_t)L * D_MODEL, scr, gwv, NGW, lane);
            { const float* p = ap->in[I_P] + (size_t)L * M_TOK * PLE_DIM; bf16* P_BF = WSP(bf16, WS_PBF);
              for (size_t i = (size_t)bx * NTHR + tid; i < (size_t)M_TOK * PLE_DIM / 8; i += (size_t)G * NTHR) {
                  const f32x4 a = *(const f32x4*)(p + i * 8), b = *(const f32x4*)(p + i * 8 + 4); *(bf16x8*)(P_BF + i * 8) = pack8(a, b); } }
            if (L == 0) { const float* x = ap->in[I_X]; bf16* X0 = WSP(bf16, WS_X0); ssq_t* ssq_in = SSQ_PTR(0);
                for (int m = gwv; m < M_TOK; m += NGW) { const float s = row_to_bf16(x + (size_t)m * 4096, X0 + (size_t)m * 4096, lane); if (lane == 0) ssq_in[m] = ssq_fix(s); } }
            __syncthreads();
            SEAM(base + 0);
        }
        if (IN(base + 1)) {
            kargs_t ap = KARGS(); unsigned char* ws = ap->ws; TIDS();
            const bf16* A1 = WSP(bf16, WS_X0); const ssq_t* ssq_in = SSQ_PTR(2 * L);
            if (kind != 2) {
                LAS float* res = (LAS float*)lds; const bf16* W_SK = WSP(bf16, WS_WSK);
                for (int un = vcu; un < M_TOK / 64; un += G) {
                    const int r0 = un * 64;
                    if (kind == 0) {
                        float* CUML = WSP(float, WS_SMALL + SM_CUML); float* TTOT = WSP(float, WS_SMALL + SM_TTOT);
                        skinny_gemm<32>(A1, W_SK, ssq_in, r0, res, wid, lane);
                        __syncthreads();
                        if (tid < 32) { const int h = tid; const float bf = ap->in[I_FOX_BF][j * 32 + h]; float run = 0.f;
                            for (int r = 0; r < 64; ++r) { const float x = res[r * 32 + h] + bf; const float lf = fminf(x, 0.f) - flog(1.0f + fexp(-fabsf(x))); run += lf; CUML[(size_t)(r0 + r) * 32 + h] = run; }
                            TTOT[(size_t)un * 32 + h] = run; }
                    } else {
                        float* BETA = WSP(float, WS_SMALL + SM_BETA); float* GLOG = WSP(float, WS_SMALL + SM_GLOG);
                        const float* dtb = ap->in[I_GDN_DTB]; const float* alog = ap->in[I_GDN_ALOG];
                        skinny_gemm<64>(A1, W_SK, ssq_in, r0, res, wid, lane);
                        __syncthreads();
                        for (int e = tid; e < 64 * 32; e += NTHR) { const int r = e >> 5, h = e & 31;
                            BETA[(size_t)(r0 + r) * 32 + h] = sigmoidf_(res[r * 64 + h]);
                            const float x = res[r * 64 + 32 + h] + dtb[h]; const float sp = fmaxf(x, 0.f) + flog(1.0f + fexp(-fabsf(x)));
                            GLOG[(size_t)(r0 + r) * 32 + h] = -fexp(alog[h]) * sp; }
                    }
                    __syncthreads();
                }
            }
            const int n_main = kind == 2 ? 8192 : 16384;
            pg8::Gemm g{A1, WSP(bf16, WS_WIN), M_TOK, n_main, 4096}; pg8::StaticOrder S; S.init(M_TOK, n_main, G, bx);
            pg8::EpiProj E{kind == 2 ? WSP(bf16, WS_PROJ) + 8192 : WSP(bf16, WS_PROJ), LDP, ssq_in, WSP(float, WS_SCR + SS_U32), kind == 2 ? 4096 : 0};
            pg8::gemm_phase<pg8::EpiProj, pg8::StaticOrder, true, true>(lds, g, S, E, w0);
            SEAM(base + 1);
        }
        if (IN(base + 2)) {
            kargs_t ap = KARGS(); unsigned char* ws = ap->ws; TIDS();
            if (kind == 0) {
                { const bf16* PROJ = WSP(bf16, WS_PROJ); float* QN2 = WSP(float, WS_SMALL + SM_QN2); float* KN2 = WSP(float, WS_SMALL + SM_KN2);
                  for (int it = gwv; it < BATCH * NHEAD * 128; it += NGW) fox::norm_item(PROJ, QN2, KN2, it, lane); }
                { const float* CUML = WSP(float, WS_SMALL + SM_CUML); const float* TTOT = WSP(float, WS_SMALL + SM_TTOT); float* CUM = WSP(float, WS_SMALL + SM_CUM);
                  LAS float* ps = (LAS float*)lds; LAS float* ct = ps + 512; LAS float* pr = ct + 64 * 33;
                  for (int un = vcu; un < BATCH * 128; un += G) { const int b = un >> 7, tile = un & 127, h = tid & 31, part = tid >> 5;
                      float sum = 0.f;
                      for (int tp = part; tp < tile; tp += 16) sum += TTOT[(size_t)(b * 128 + tp) * 32 + h];
                      ps[part * 32 + h] = sum;
                      { const f32x4 cv = *(const f32x4*)(CUML + ((size_t)b * SEQ + 64 * tile) * 32 + tid * 4); const int t = (tid * 4) >> 5, hh = (tid * 4) & 31;
#pragma unroll
                        for (int e = 0; e < 4; ++e) ct[t * 33 + hh + e] = cv[e]; }
                      __syncthreads();
                      if (tid < 32) { float p = 0.f;
#pragma unroll
                          for (int q = 0; q < 16; ++q) p += ps[q * 32 + tid];
                          pr[tid] = p; }
                      __syncthreads();
                      { const int t = tid & 63, hg = tid >> 6;
#pragma unroll
                        for (int k = 0; k < 4; ++k) { const int hh = hg * 4 + k; CUM[(size_t)(b * 32 + hh) * SEQ + 64 * tile + t] = pr[hh] + ct[t * 33 + hh]; } }
                      __syncthreads(); } }
            } else if (kind == 1) {
                const bf16* PROJ = WSP(bf16, WS_PROJ); const float* convw = ap->in[I_GDN_CONV]; const float* BETA = WSP(float, WS_SMALL + SM_BETA); const float* GLOG = WSP(float, WS_SMALL + SM_GLOG);
                float* GLT = WSP(float, WS_SMALL + SM_GL); unsigned char* REC = ws + WS_SCR;
                if (tid < 2) *(LAS unsigned*)(lds + tid * gdn::GRP_BYTES + gdn::G_S + 768) = 0u;
                __syncthreads();
                unsigned gbt = 0u;
                for (int pi = vcu; pi < BATCH * NHEAD * GDN_NCHUNK / 2; pi += G) gdn::prep_pair(lds, 2 * pi, PROJ, convw, BETA, GLOG, GLT, REC, gbt, w0);
                __syncthreads();
            } else if (kind == 2) {
                s5::pass1((LAS float*)(lds + wid * 16384), (LAS float*)(lds + wid * 16384 + 4096), gwv, NGW, lane, WSP(float, WS_SCR + SS_U32), ap->in[I_SSM_LRE], ap->in[I_SSM_LIM], ap->in[I_SSM_BRE], ap->in[I_SSM_BIM], ap->in[I_SSM_LSTEP], WSP(f32x2, WS_ENDST));
            }
            SEAM(base + 2);
        }
        if (IN(base + 3)) {
            kargs_t ap = KARGS(); unsigned char* ws = ap->ws; TIDS();
            if (kind == 0) fox::attn_phase((char*)lds_raw, WSP(bf16, WS_PROJ), WSP(bf16, WS_MIX), WSP(float, WS_SMALL + SM_CUM), WSP(float, WS_SMALL + SM_QN2), WSP(float, WS_SMALL + SM_KN2), vcu, G, w0);
            else if (kind == 1) { for (int un = vcu; un < BATCH * NHEAD * 4; un += G) gdn::scan_unit(lds, un, ws + WS_SCR, WSP(float, WS_SMALL + SM_GL), ap->out, w0); }
            else if (kind == 2) s5::pass2(lds + wid * 18944, gwv, NGW, lane, WSP(float, WS_SCR + SS_U32), ap->in[I_SSM_LRE], ap->in[I_SSM_LIM], ap->in[I_SSM_BRE], ap->in[I_SSM_BIM], ap->in[I_SSM_CRE], ap->in[I_SSM_CIM],
                           ap->in[I_SSM_LSTEP], ap->in[I_SSM_D], WSP(f32x2, WS_ENDST), WSP(bf16, WS_SCR + SS_Y1));
            SEAM(base + 3);
        }
        if (IN(base + 4) && kind == 1) {
            kargs_t ap = KARGS(); unsigned char* ws = ap->ws; TIDS();
            if (kind == 1) gdn::normgate(gwv, NGW, lane, ap->out, WSP(bf16, WS_PROJ), ap->in[I_GDN_NORM], WSP(bf16, WS_MIX));
            SEAM(base + 4);
        }
        if (IN(base + 4) && kind == 2) {
            kargs_t ap = KARGS(); unsigned char* ws = ap->ws; TIDS();
            pg8::Gemm g{WSP(bf16, WS_SCR + SS_Y1), WSP(bf16, WS_WGLU), M_TOK, 4096, 4096}; pg8::StaticOrder S; S.init(M_TOK, 4096, G, bx);
            pg8::EpiGlu E{WSP(bf16, WS_MIX), WSP(bf16, WS_SCR + SS_Y1), WSP(bf16, WS_PROJ) + ZCOL, LDP, ap->in[I_SSM_BGLU]};
            if (kind == 2) pg8::gemm_phase<pg8::EpiGlu, pg8::StaticOrder, true, true>(lds, g, S, E, w0);
            SEAM(base + 4);
        }
        if (IN(base + 5)) {
            { kargs_t ap = KARGS(); unsigned char* ws = ap->ws;
                  pg8::Gemm g{WSP(bf16, WS_MIX), WSP(bf16, WS_WOUT), M_TOK, 4096, 4096}; pg8::StaticOrder S; S.init(M_TOK, 4096, G, bx);
                  pg8::EpiOut E{WSP(bf16, WS_X0), WSP(bf16, WS_X1), SSQ_PTR(2 * L + 1)};
                  pg8::gemm_phase<pg8::EpiOut, pg8::StaticOrder, true, true>(lds, g, S, E, w0); }
            { kargs_t ap = KARGS(); unsigned char* ws = ap->ws;
                  pg8::Gemm g{WSP(bf16, WS_PBF), WSP(bf16, WS_WPP), M_TOK, 4096, 256}; pg8::StaticOrder S; S.init(M_TOK, 4096, G, bx);
                  pg8::EpiProj E{WSP(bf16, WS_PP), 4096, nullptr, nullptr, 0};
                  pg8::gemm_phase<pg8::EpiProj, pg8::StaticOrder, true, true>(lds, g, S, E, w0); }
            SEAM(base + 5);
        }
        if (IN(base + 6)) {
            kargs_t ap = KARGS(); unsigned char* ws = ap->ws; TIDS();
            pg8::Gemm g{WSP(bf16, WS_X1), WSP(bf16, WS_WGATE), M_TOK, 4096, 4096}; pg8::StaticOrder S; S.init(M_TOK, 4096, G, bx);
            pg8::EpiGate E{WSP(bf16, WS_X1), WSP(bf16, WS_X0), WSP(bf16, WS_PP), SSQ_PTR(2 * L + 1), SSQ_PTR(2 * L + 2)};
            pg8::gemm_phase<pg8::EpiGate, pg8::StaticOrder, true, true>(lds, g, S, E, w0);
            SEAM(base + 6);
        }
    }
    if (IN(PH_FINAL)) {
        kargs_t ap = KARGS(); unsigned char* ws = ap->ws; float* H = ap->out; TIDS();
        const float* gf = ap->in[I_FINAL_NORM]; const ssq_t* ssq = SSQ_PTR(8); const bf16* X0 = WSP(bf16, WS_X0);
        const unsigned bad = __hip_atomic_load(WSP(unsigned, WS_CTL) + CW_BAR + XB_TMO, __ATOMIC_RELAXED, __HIP_MEMORY_SCOPE_AGENT);
        for (int m = gwv; m < M_TOK; m += NGW) { const float rs = bad ? __builtin_nanf("") : __builtin_amdgcn_rsqf(ssq_val(ssq[m]) * (1.0f / 4096.0f) + NORM_EPS); float* row = H + (size_t)m * 4096;
#pragma unroll
            for (int jj = 0; jj < 8; ++jj) { const int c = (jj * 64 + lane) * 8; const u32x4 w = *(const u32x4*)(X0 + (size_t)m * 4096 + c);
                const f32x4 g0 = *(const f32x4*)(gf + c), g1 = *(const f32x4*)(gf + c + 4);
                const f32x4 v0 = {bflo(w.x), bfhi(w.x), bflo(w.y), bfhi(w.y)}, v1 = {bflo(w.z), bfhi(w.z), bflo(w.w), bfhi(w.w)};
                *(f32x4*)(row + c) = v0 * rs * g0; *(f32x4*)(row + c + 4) = v1 * rs * g1; } }
    }
#undef IN
#undef SEAM
}

extern "C" void kernel_launch(void* const* d_in, const int* in_sizes, int n_in, void* d_out, int out_size, void* d_ws, size_t ws_size, hipStream_t stream) {
    static int grid = 0;
    if (grid == 0) {
        if (n_in != 28 || out_size != M_TOK * D_MODEL || ws_size < WS_END) { fprintf(stderr, "kernel_launch: unexpected shapes (n_in %d, out %d, ws %zu)\n", n_in, out_size, ws_size); grid = -1; return; }
        int dev = 0, cus = 0, per_cu = 0;
        if (hipGetDevice(&dev) != hipSuccess || hipDeviceGetAttribute(&cus, hipDeviceAttributeMultiprocessorCount, dev) != hipSuccess) { grid = -1; return; }
        if (hipFuncSetAttribute((const void*)trunk_fwd, hipFuncAttributeMaxDynamicSharedMemorySize, LDS_BYTES) != hipSuccess) { fprintf(stderr, "kernel_launch: hipFuncSetAttribute failed\n"); grid = -1; return; }
        if (hipOccupancyMaxActiveBlocksPerMultiprocessor(&per_cu, (const void*)trunk_fwd, NTHR, LDS_BYTES) != hipSuccess || per_cu < 1) { fprintf(stderr, "kernel_launch: occupancy query says %d\n", per_cu); per_cu = 1; }
        (void)hipGetLastError();
        grid = cus;
    }
    if (grid < 0) return;
    if (hipMemsetAsync((char*)d_ws + WS_CTL, 0, CTL_ZERO_BYTES, stream) != hipSuccess) return;
    Args a{};
    for (int i = 0; i < 28; ++i) a.in[i] = (const float*)d_in[i];
    a.out = (float*)d_out; a.ws = (unsigned char*)d_ws;
#if MK_PER_PHASE
    int li = 0;
    for (int ph = 0; ph < PH_END; ++ph) { if (!phase_exists(ph)) continue;
        a.ph_lo = ph; a.ph_hi = ph + 1; a.li = li++; a.pad = 0;
        hipLaunchKernelGGL(trunk_fwd, dim3(grid), dim3(NTHR), LDS_BYTES, stream, a); }
#elif defined(PROBE_PH)
    { int li = 0; const int cut = PROBE_PH + PROBE_LEN;
      a.ph_lo = 0; a.ph_hi = cut; a.li = li++; a.pad = 0; hipLaunchKernelGGL(trunk_fwd, dim3(grid), dim3(NTHR), LDS_BYTES, stream, a);
      a.pad = PROBE_MODE;
      for (int r = 0; r < PROBE_N; ++r) { a.ph_lo = PROBE_PH; a.ph_hi = cut; a.li = li++; hipLaunchKernelGGL(trunk_fwd, dim3(grid), dim3(NTHR), LDS_BYTES, stream, a); }
      a.pad = 0; a.ph_lo = cut; a.ph_hi = PH_END; a.li = li++; hipLaunchKernelGGL(trunk_fwd, dim3(grid), dim3(NTHR), LDS_BYTES, stream, a); }
#else
    a.ph_lo = 0; a.ph_hi = PH_END; a.li = 0; a.pad = 0;
    hipLaunchKernelGGL(trunk_fwd, dim3(grid), dim3(NTHR), LDS_BYTES, stream, a);
#endif
}
```

```cpp
#include <hip/hip_runtime.h>
#include <cstdio>
#include <cstdint>

#ifndef MK_PER_PHASE
#define MK_PER_PHASE 0
#endif

constexpr int D_MODEL = 4096, BATCH = 2, SEQ = 8192, DEPTH = 4, PLE_DIM = 256;
constexpr int M_TOK = BATCH * SEQ;
constexpr int NHEAD = 32, HDIM = 128;
constexpr float NORM_EPS = 1e-6f;
constexpr int LDP = 16384;
constexpr int ZCOL = 12288;
constexpr int GDN_CHUNK = 64, GDN_NCHUNK = SEQ / GDN_CHUNK;
constexpr int SSM_G = 256, SSM_N = 16, SSM_P = 64, SSM_SL = 256, SSM_NSEG = SEQ / SSM_SL;

constexpr size_t MiB = 1u << 20;
constexpr size_t WS_CTL = 0, CTL_ZERO_BYTES = 2 * MiB;
constexpr size_t WS_WIN = 2 * MiB;
constexpr size_t WS_WSK = 130 * MiB;
constexpr size_t WS_WOUT = 131 * MiB;
constexpr size_t WS_WGATE = 163 * MiB;
constexpr size_t WS_WPP = 195 * MiB;
constexpr size_t WS_WGLU = 197 * MiB;
constexpr size_t WS_PBF = 229 * MiB;
constexpr size_t WS_X0 = 237 * MiB;
constexpr size_t WS_X1 = 365 * MiB;
constexpr size_t WS_PROJ = 493 * MiB;
constexpr size_t WS_MIX = 1005 * MiB;
constexpr size_t WS_PP = 1133 * MiB;
constexpr size_t WS_SCR = 1261 * MiB;
constexpr size_t WS_SMALL = 1837 * MiB;
constexpr size_t WS_ENDST = 1846 * MiB;
constexpr size_t WS_END = 1854 * MiB;
constexpr size_t GR_QD = 0, GR_W = 16384, GR_KT = 32768, GR_U = 49152, GR_IN = 65536, GR_BYTES = 73728;
constexpr size_t SS_U32 = 0, SS_Y1 = 256 * MiB, SS_END = 384 * MiB;
constexpr size_t SM_CUML = 0;
constexpr size_t SM_TTOT = 2 * MiB;
constexpr size_t SM_CUM = 2 * MiB + 65536;
constexpr size_t SM_QN2 = 2 * MiB + 32768;
constexpr size_t SM_KN2 = 4 * MiB + 65536;
constexpr size_t SM_BETA = 5 * MiB;
constexpr size_t SM_GLOG = 7 * MiB;
constexpr size_t SM_SS = SM_CUM;
constexpr size_t SM_GL = 0;
static_assert(SM_CUM + 64 * 8192 * 4 <= SM_BETA && SM_GLOG + (size_t)M_TOK * 32 * 4 <= 9 * MiB, "small tables");
static_assert(WS_SMALL + 9 * MiB <= WS_ENDST && WS_ENDST + 8 * MiB <= WS_END, "ws end");
constexpr int CW_TMO = 0, CW_CODE = 1, CW_ERR = 1024  , CW_BAR = 16384  ;
typedef unsigned long long ssq_t;
constexpr size_t CTL_SUMSQ = 1 * MiB;
constexpr size_t WS_SSQ0 = 130 * MiB + 512 * 1024;
constexpr float SSQ_SCALE = 16777216.0f, SSQ_INV = 1.0f / 16777216.0f;
#define SSQ_PTR(i) ((ssq_t*)(ws + ((i) == 0 ? WS_SSQ0 : CTL_SUMSQ + (size_t)((i) - 1) * M_TOK * sizeof(ssq_t))))

#define LAS __attribute__((address_space(3)))
#define GAS __attribute__((address_space(1)))
typedef unsigned short bf16;
typedef short bf16x8 __attribute__((ext_vector_type(8)));
typedef short s16x4 __attribute__((ext_vector_type(4)));
typedef float f32x2 __attribute__((ext_vector_type(2)));
typedef float f32x4 __attribute__((ext_vector_type(4)));
typedef float f32x16 __attribute__((ext_vector_type(16)));
typedef unsigned u32x2 __attribute__((ext_vector_type(2)));
typedef unsigned u32x4 __attribute__((ext_vector_type(4)));
#define LDS_WAIT() asm volatile("s_waitcnt lgkmcnt(0)" ::: "memory")
#define VM_WAIT() asm volatile("s_waitcnt vmcnt(0)" ::: "memory")
typedef __bf16 bf16x2_t __attribute__((ext_vector_type(2)));
__device__ __forceinline__ unsigned cvtpk(float lo, float hi) { const f32x2 v = {lo, hi}; const bf16x2_t b = __builtin_convertvector(v, bf16x2_t); return __builtin_bit_cast(unsigned, b); }
__device__ __forceinline__ ssq_t ssq_fix(float s) { return (ssq_t)(s * 16777216.0f + 0.5f); }
__device__ __forceinline__ float ssq_val(ssq_t x) { return ((float)(unsigned)(x >> 32) * 4294967296.0f + (float)(unsigned)x) * (1.0f / 16777216.0f); }
__device__ __forceinline__ float bf2f(unsigned short b) { return __uint_as_float(((unsigned)b) << 16); }
__device__ __forceinline__ float bflo(unsigned w) { return __uint_as_float(w << 16); }
__device__ __forceinline__ float bfhi(unsigned w) { return __uint_as_float(w & 0xffff0000u); }
__device__ __forceinline__ float fexp(float x) { return __builtin_amdgcn_exp2f(x * 1.4426950408889634f); }
__device__ __forceinline__ float flog(float x) { return __builtin_amdgcn_logf(x) * 0.6931471805599453f; }
__device__ __forceinline__ float sigmoidf_(float x) { return __builtin_amdgcn_rcpf(1.0f + fexp(-x)); }
__device__ __forceinline__ float siluf_(float x) { return x * sigmoidf_(x); }
__device__ __forceinline__ bf16x8 pack8(f32x4 a, f32x4 b) { u32x4 w = {cvtpk(a[0], a[1]), cvtpk(a[2], a[3]), cvtpk(b[0], b[1]), cvtpk(b[2], b[3])}; return __builtin_bit_cast(bf16x8, w); }
__device__ __forceinline__ void unpack8(u32x4 w, float* f) { f[0] = bflo(w.x); f[1] = bfhi(w.x); f[2] = bflo(w.y); f[3] = bfhi(w.y); f[4] = bflo(w.z); f[5] = bfhi(w.z); f[6] = bflo(w.w); f[7] = bfhi(w.w); }
__device__ __forceinline__ float wave_sum(float v) {
#pragma unroll
    for (int o = 1; o < 64; o <<= 1) v += __shfl_xor(v, o);
    return v;
}
__device__ __forceinline__ int otid(int w0) { unsigned z = 0u; asm volatile("" : "+v"(z));
    int t = (w0 << 6) | (int)__builtin_amdgcn_mbcnt_hi(~0u, __builtin_amdgcn_mbcnt_lo(~0u, z)); asm volatile("" : "+v"(t)); return t; }
__device__ __forceinline__ u32x4 ozero4() { u32x4 z = {0u, 0u, 0u, 0u}; asm volatile("" : "+v"(z)); return z; }
namespace pg8 {
#define PG8_LAS __attribute__((address_space(3)))
typedef unsigned short bf16_t;
typedef short bf16x8 __attribute__((ext_vector_type(8)));
typedef float f32x4 __attribute__((ext_vector_type(4)));
typedef unsigned u32x4 __attribute__((ext_vector_type(4)));
constexpr int BM = 256, BK = 64, HALF = 128, HTB = HALF * BK * 2  , STAGE_BYTES = 8 * HTB, NXCD = 8, WGM = 8;

__host__ __device__ __forceinline__ int lds_byte(int r, int c) { const int st = (r >> 4) * 2 + (c >> 5), rr = r & 15, cc = c & 31, ob = rr * 64 + cc * 2; return st * 1024 + (ob ^ (((ob >> 9) & 1) << 5)); }
__host__ __device__ __forceinline__ void stage_rc(int b, int& R, int& C) { const int st = b / 1024, sb = b % 1024, swz = sb ^ (((sb >> 9) & 1) << 5); R = (st >> 1) * 16 + swz / 64; C = (st & 1) * 32 + (swz % 64) / 2; }
__host__ __device__ __forceinline__ int perm32(int rho) { const int n = rho >> 4, i = rho & 15; return 8 * (i >> 2) + 4 * n + (i & 3); }

struct Unit { int pm, pn; };
struct Gemm { const bf16_t* A; const bf16_t* Bt; int M, N, K; };

struct StaticOrder {
    int nM, nN, nwg, G, c;
    __host__ __device__ void init(int M, int N, int G_, int c_) { nM = M / BM; nN = N / BM; nwg = nM * nN; G = G_; c = c_; }
    __host__ __device__ bool next(int i, Unit& u) const {
        const long L = (long)i * G + c; if (L >= nwg) return false;
        int wgid = (int)L; { const int q = nwg / NXCD, r = nwg % NXCD, xcd = wgid % NXCD, off = wgid / NXCD; wgid = (xcd < r ? xcd * (q + 1) : r * (q + 1) + (xcd - r) * q) + off; }
        const int nig = WGM * nN, gid = wgid / nig, fm = gid * WGM, gsz = (nM - fm) < WGM ? (nM - fm) : WGM;
        u.pm = fm + ((wgid % nig) % gsz); u.pn = (wgid % nig) / gsz; return true;
    }
    __device__ __forceinline__ void a_ready(const Unit&) const {}
    __device__ __forceinline__ void done(const Unit&) const {}
};
__device__ __forceinline__ unsigned cvt_pk_bf16(float lo, float hi) { return ::cvtpk(lo, hi); }
__device__ __forceinline__ float sgm(float x) { return __builtin_amdgcn_rcpf(1.0f + __builtin_amdgcn_exp2f(x * -1.4426950408889634f)); }
__device__ __forceinline__ float bl(unsigned w) { return __uint_as_float(w << 16); }
__device__ __forceinline__ float bh(unsigned w) { return __uint_as_float(w & 0xffff0000u); }
constexpr float kEps = 1e-6f, kInvD = 1.0f / 4096.0f;
#ifndef EPI_RB
#define EPI_RB 4
#endif

struct EpiProj {
    static constexpr bool PERM = true, AFTER_DRAIN = false;
    bf16_t* O; int ldc; const ssq_t* sumsq; float* F32O; int f32cols;
    __device__ __forceinline__ void operator()(const f32x4 (&acc)[2][2][4][2], const Unit& u, int wr, int wc, int fr, int fq) const {
        const int row0 = u.pm * BM + wr * 64 + fr, colt = u.pn * BM, col0 = colt + wc * 32 + 8 * fq;
        const bool tof32 = colt < f32cols;
        ssq_t rsv[2][4];
#pragma unroll
        for (int ai = 0; ai < 2; ++ai)
#pragma unroll
            for (int m = 0; m < 4; ++m) rsv[ai][m] = sumsq ? sumsq[row0 + ai * HALF + m * 16] : 0ull;
#pragma unroll
        for (int ai = 0; ai < 2; ++ai)
#pragma unroll
            for (int m = 0; m < 4; ++m) { const int r = row0 + ai * HALF + m * 16;
                const float rs = sumsq ? __builtin_amdgcn_rsqf(ssq_val(rsv[ai][m]) * kInvD + kEps) : 1.0f;
#pragma unroll
                for (int bj = 0; bj < 2; ++bj) { const f32x4 v0 = acc[ai][bj][m][0] * rs, v1 = acc[ai][bj][m][1] * rs; const int c = col0 + bj * HALF;
                    if (tof32) { float* p = F32O + (size_t)r * f32cols + c; *(__attribute__((address_space(1))) f32x4*)p = v0; *(__attribute__((address_space(1))) f32x4*)(p + 4) = v1; }
                    else { u32x4 w; w.x = cvt_pk_bf16(v0[0], v0[1]); w.y = cvt_pk_bf16(v0[2], v0[3]); w.z = cvt_pk_bf16(v1[0], v1[1]); w.w = cvt_pk_bf16(v1[2], v1[3]);
                        *(u32x4*)(O + (size_t)r * ldc + c) = w; } } }
    }
};
struct EpiOut {
    static constexpr bool PERM = true, AFTER_DRAIN = false;
    const bf16_t* hin; bf16_t* hout; ssq_t* sumsq2;
    __device__ __forceinline__ void operator()(const f32x4 (&acc)[2][2][4][2], const Unit& u, int wr, int wc, int fr, int fq) const {
        const int row0 = u.pm * BM + wr * 64 + fr, col0 = u.pn * BM + wc * 32 + 8 * fq;
#pragma unroll
        for (int ai = 0; ai < 2; ++ai)
#pragma unroll
          for (int mp = 0; mp < 4 / EPI_RB; ++mp) {
            u32x4 hv[EPI_RB][2];
#pragma unroll
            for (int mm = 0; mm < EPI_RB; ++mm)
#pragma unroll
                for (int bj = 0; bj < 2; ++bj) hv[mm][bj] = *(const u32x4*)(hin + (size_t)(row0 + ai * HALF + (EPI_RB * mp + mm) * 16) * 4096 + col0 + bj * HALF);
#pragma unroll
            for (int mm = 0; mm < EPI_RB; ++mm) { const int m = EPI_RB * mp + mm, r = row0 + ai * HALF + m * 16; float s = 0.f;
#pragma unroll
                for (int bj = 0; bj < 2; ++bj) { const size_t off = (size_t)r * 4096 + col0 + bj * HALF; const u32x4 hw = hv[mm][bj];
                    const f32x4 v0 = f32x4{bl(hw.x), bh(hw.x), bl(hw.y), bh(hw.y)} + acc[ai][bj][m][0], v1 = f32x4{bl(hw.z), bh(hw.z), bl(hw.w), bh(hw.w)} + acc[ai][bj][m][1];
                    u32x4 w; w.x = cvt_pk_bf16(v0[0], v0[1]); w.y = cvt_pk_bf16(v0[2], v0[3]); w.z = cvt_pk_bf16(v1[0], v1[1]); w.w = cvt_pk_bf16(v1[2], v1[3]);
                    *(u32x4*)(hout + off) = w;
                    s += (bl(w.x) * bl(w.x) + bh(w.x) * bh(w.x)) + (bl(w.y) * bl(w.y) + bh(w.y) * bh(w.y)) + (bl(w.z) * bl(w.z) + bh(w.z) * bh(w.z)) + (bl(w.w) * bl(w.w) + bh(w.w) * bh(w.w)); }
                s += __shfl_xor(s, 16); s += __shfl_xor(s, 32);
                if (fq == 0) atomicAdd(sumsq2 + r, ssq_fix(s)); }
            asm volatile("" ::: "memory"); }
    }
};
struct EpiGate {
    static constexpr bool PERM = true, AFTER_DRAIN = false;
    const bf16_t* hin; bf16_t* hout; const bf16_t* PP; const ssq_t* sumsq2; ssq_t* sumsqn;
    __device__ __forceinline__ void operator()(const f32x4 (&acc)[2][2][4][2], const Unit& u, int wr, int wc, int fr, int fq) const {
        const int row0 = u.pm * BM + wr * 64 + fr, col0 = u.pn * BM + wc * 32 + 8 * fq;
        ssq_t rsv[2][4];
#pragma unroll
        for (int ai = 0; ai < 2; ++ai)
#pragma unroll
            for (int m = 0; m < 4; ++m) rsv[ai][m] = sumsq2[row0 + ai * HALF + m * 16];
#pragma unroll
        for (int ai = 0; ai < 2; ++ai)
#pragma unroll
            for (int mp = 0; mp < 4 / EPI_RB; ++mp) {
                u32x4 hv[EPI_RB][2], pv[EPI_RB][2];
#pragma unroll
                for (int mm = 0; mm < EPI_RB; ++mm)
#pragma unroll
                    for (int bj = 0; bj < 2; ++bj) { const size_t off = (size_t)(row0 + ai * HALF + (EPI_RB * mp + mm) * 16) * 4096 + col0 + bj * HALF;
                        pv[mm][bj] = *(const u32x4*)(PP + off); hv[mm][bj] = *(const u32x4*)(hin + off); }
#pragma unroll
                for (int mm = 0; mm < EPI_RB; ++mm) { const int m = EPI_RB * mp + mm, r = row0 + ai * HALF + m * 16; float s = 0.f;
                    const float rs = __builtin_amdgcn_rsqf(ssq_val(rsv[ai][m]) * kInvD + kEps);
#pragma unroll
                    for (int bj = 0; bj < 2; ++bj) { const size_t off = (size_t)r * 4096 + col0 + bj * HALF;
                        const u32x4 pw = pv[mm][bj], hw = hv[mm][bj];
                        const f32x4 p0 = {bl(pw.x), bh(pw.x), bl(pw.y), bh(pw.y)}, p1 = {bl(pw.z), bh(pw.z), bl(pw.w), bh(pw.w)};
                        f32x4 g0 = acc[ai][bj][m][0] * rs, g1 = acc[ai][bj][m][1] * rs;
#pragma unroll
                        for (int j = 0; j < 4; ++j) { g0[j] = sgm(g0[j]); g1[j] = sgm(g1[j]); }
                        const f32x4 v0 = f32x4{bl(hw.x), bh(hw.x), bl(hw.y), bh(hw.y)} + g0 * p0, v1 = f32x4{bl(hw.z), bh(hw.z), bl(hw.w), bh(hw.w)} + g1 * p1;
                        u32x4 w; w.x = cvt_pk_bf16(v0[0], v0[1]); w.y = cvt_pk_bf16(v0[2], v0[3]); w.z = cvt_pk_bf16(v1[0], v1[1]); w.w = cvt_pk_bf16(v1[2], v1[3]);
                        *(u32x4*)(hout + off) = w;
                        s += (bl(w.x) * bl(w.x) + bh(w.x) * bh(w.x)) + (bl(w.y) * bl(w.y) + bh(w.y) * bh(w.y)) + (bl(w.z) * bl(w.z) + bh(w.z) * bh(w.z)) + (bl(w.w) * bl(w.w) + bh(w.w) * bh(w.w)); }
                    s += __shfl_xor(s, 16); s += __shfl_xor(s, 32);
                    if (fq == 0) atomicAdd(sumsqn + r, ssq_fix(s)); }
                asm volatile("" ::: "memory"); }
    }
};
struct EpiGlu {
    static constexpr bool PERM = true, AFTER_DRAIN = false;
    bf16_t* O; const bf16_t* Y1; const bf16_t* Z; int ldz; const float* bias;
    __device__ __forceinline__ void operator()(const f32x4 (&acc)[2][2][4][2], const Unit& u, int wr, int wc, int fr, int fq) const {
        const int row0 = u.pm * BM + wr * 64 + fr, col0 = u.pn * BM + wc * 32 + 8 * fq;
        f32x4 bv[2][2];
#pragma unroll
        for (int bj = 0; bj < 2; ++bj) { bv[bj][0] = *(const f32x4*)(bias + col0 + bj * HALF); bv[bj][1] = *(const f32x4*)(bias + col0 + bj * HALF + 4); }
#pragma unroll
        for (int ai = 0; ai < 2; ++ai)
#pragma unroll
            for (int m = 0; m < 4; ++m) { const int r = row0 + ai * HALF + m * 16;
#pragma unroll
                for (int bj = 0; bj < 2; ++bj) { const int c = col0 + bj * HALF;
                    const u32x4 yw = *(const u32x4*)(Y1 + (size_t)r * 4096 + c), zw = *(const u32x4*)(Z + (size_t)r * ldz + c);
                    const f32x4 y0 = {bl(yw.x), bh(yw.x), bl(yw.y), bh(yw.y)}, y1 = {bl(yw.z), bh(yw.z), bl(yw.w), bh(yw.w)};
                    const f32x4 z0 = {bl(zw.x), bh(zw.x), bl(zw.y), bh(zw.y)}, z1 = {bl(zw.z), bh(zw.z), bl(zw.w), bh(zw.w)};
                    f32x4 g0 = acc[ai][bj][m][0] + bv[bj][0], g1 = acc[ai][bj][m][1] + bv[bj][1];
#pragma unroll
                    for (int j = 0; j < 4; ++j) { g0[j] = y0[j] * sgm(g0[j]) * (z0[j] * sgm(z0[j])); g1[j] = y1[j] * sgm(g1[j]) * (z1[j] * sgm(z1[j])); }
                    u32x4 w; w.x = cvt_pk_bf16(g0[0], g0[1]); w.y = cvt_pk_bf16(g0[2], g0[3]); w.z = cvt_pk_bf16(g1[0], g1[1]); w.w = cvt_pk_bf16(g1[2], g1[3]);
                    *(u32x4*)(O + (size_t)r * 4096 + c) = w; }
                asm volatile("" ::: "memory"); }
    }
};
template <class Epi, class Sched, bool ALIGN_EPI = false, bool SP2 = false>
__device__ __forceinline__ void gemm_phase(PG8_LAS unsigned char* lds, const Gemm g, const Sched& S, const Epi& E, const int w0) {
    const int tid = otid(w0), wid = __builtin_amdgcn_readfirstlane(tid >> 6), lane = tid & 63, wr = wid >> 2, wc = wid & 3, fr = lane & 15, fq = lane >> 4;
    const int K = g.K, nt = K / BK;
    unsigned voffA[2], voffB[2];
#pragma unroll
    for (int i = 0; i < 2; ++i) { int R, C; stage_rc(tid * 16 + i * 8192, R, C); const int Rb = Epi::PERM ? ((R & ~31) + perm32(R & 31)) : R;
        voffA[i] = (unsigned)(R * K + C) * 2u; voffB[i] = (unsigned)(Rb * K + C) * 2u; }
    const size_t kstep = (size_t)(BK * 2);
    const size_t hstep = (size_t)HALF * K * 2;
    const size_t tstep = 2 * hstep;
    const unsigned ldsw = (unsigned)wid * 1024u;
    const int aoff = lds_byte(wr * 64 + fr, fq * 8), boff = lds_byte(wc * 32 + fr, fq * 8);
#define PG8_SA(b, h) (((b) * 2 + (h)) * HTB)
#define PG8_SB(b, h) ((4 + (b) * 2 + (h)) * HTB)
#define PG8_STAGE(bufoff, gbase, voff) do { _Pragma("unroll") for (int _i = 0; _i < 2; ++_i) \
        __builtin_amdgcn_global_load_lds((const unsigned*)((const char*)(gbase) + (voff)[_i]), (PG8_LAS unsigned*)(lds + (bufoff) + ldsw + _i * 8192), 16, 0, 0); } while (0)
#define PG8_LDA(dst, b, h) do { _Pragma("unroll") for (int m = 0; m < 4; ++m) _Pragma("unroll") for (int k = 0; k < 2; ++k) dst[m][k] = *(const PG8_LAS bf16x8*)(lds + PG8_SA(b, h) + aoff + m * 2048 + k * 1024); } while (0)
#define PG8_LDB(dst, b, h) do { _Pragma("unroll") for (int n = 0; n < 2; ++n) _Pragma("unroll") for (int k = 0; k < 2; ++k) dst[n][k] = *(const PG8_LAS bf16x8*)(lds + PG8_SB(b, h) + boff + n * 2048 + k * 1024); } while (0)
#define PG8_MMA(ai, bj, At, Bt) do { __builtin_amdgcn_s_setprio(1); _Pragma("unroll") for (int m = 0; m < 4; ++m) _Pragma("unroll") for (int n = 0; n < 2; ++n) _Pragma("unroll") for (int k = 0; k < 2; ++k) \
        acc[ai][bj][m][n] = __builtin_amdgcn_mfma_f32_16x16x32_bf16(Bt[n][k], At[m][k], acc[ai][bj][m][n], 0, 0, 0); __builtin_amdgcn_s_setprio(0); } while (0)
#define PG8_WAIT_V(n) asm volatile("s_waitcnt vmcnt(" #n ")" ::: "memory")
#define PG8_WAIT_L(n) asm volatile("s_waitcnt lgkmcnt(" #n ")" ::: "memory")
#define PG8_BAR __builtin_amdgcn_s_barrier()
#define PG8_SCHED __builtin_amdgcn_sched_barrier(0)
    Unit cur, nxt; int ui = 0;
    if (!S.next(0, cur)) return;
    f32x4 acc[2][2][4][2];
#pragma unroll
    for (int a = 0; a < 2; ++a)
#pragma unroll
        for (int b = 0; b < 2; ++b)
#pragma unroll
            for (int m = 0; m < 4; ++m)
#pragma unroll
                for (int n = 0; n < 2; ++n) acc[a][b][m][n] = (f32x4){0.f, 0.f, 0.f, 0.f};
    bf16x8 At[4][2], B0[2][2], B1[2][2];
    const char* cA = (const char*)g.A + (size_t)cur.pm * tstep; const char* cB = (const char*)g.Bt + (size_t)cur.pn * tstep;
    S.a_ready(cur);
    if constexpr (SP2) {
        PG8_STAGE(PG8_SB(0, 0), cB, voffB); PG8_STAGE(PG8_SB(0, 1), cB + hstep, voffB); PG8_STAGE(PG8_SA(0, 0), cA, voffA); PG8_STAGE(PG8_SA(0, 1), cA + hstep, voffA);
        if (wr == 1) PG8_BAR;
        PG8_WAIT_V(2); PG8_BAR;
        PG8_STAGE(PG8_SB(1, 0), cB + kstep, voffB); PG8_STAGE(PG8_SA(1, 0), cA + kstep, voffA); PG8_STAGE(PG8_SB(1, 1), cB + hstep + kstep, voffB);
        PG8_WAIT_V(6); PG8_BAR;
    } else {
        PG8_STAGE(PG8_SB(0, 0), cB, voffB); PG8_STAGE(PG8_SA(0, 0), cA, voffA); PG8_STAGE(PG8_SB(0, 1), cB + hstep, voffB); PG8_STAGE(PG8_SA(0, 1), cA + hstep, voffA);
        if (wr == 1) PG8_BAR;
        PG8_WAIT_V(4); PG8_BAR;
        PG8_STAGE(PG8_SB(1, 0), cB + kstep, voffB); PG8_STAGE(PG8_SA(1, 0), cA + kstep, voffA); PG8_STAGE(PG8_SB(1, 1), cB + hstep + kstep, voffB);
        PG8_WAIT_V(6); PG8_BAR;
    }
    for (;;) {
        const bool has_next = S.next(ui + 1, nxt);
        const char* nA = has_next ? (const char*)g.A + (size_t)nxt.pm * tstep : cA; const char* nB = has_next ? (const char*)g.Bt + (size_t)nxt.pn * tstep : cB;
        for (int t = 0; t < nt; t += 2) {
            const bool last = (t == nt - 2);
            const char* a1 = cA + (size_t)(t + 1) * kstep;
            const char* a2 = last ? nA : cA + (size_t)(t + 2) * kstep; const char* b2 = last ? nB : cB + (size_t)(t + 2) * kstep;
            const char* a3 = a2 + kstep; const char* b3 = b2 + kstep;
            if (last && has_next) S.a_ready(nxt);
            if constexpr (SP2) {
            PG8_LDB(B0, 0, 0); PG8_LDB(B1, 0, 1); PG8_SCHED; PG8_LDA(At, 0, 0); PG8_STAGE(PG8_SA(1, 1), a1 + hstep, voffA);
            PG8_WAIT_V(8); PG8_WAIT_L(0); PG8_BAR; PG8_MMA(0, 0, At, B0); PG8_MMA(0, 1, At, B1); PG8_BAR; PG8_SCHED;
            PG8_LDA(At, 0, 1); PG8_STAGE(PG8_SB(0, 0), b2, voffB); PG8_STAGE(PG8_SB(0, 1), b2 + hstep, voffB); PG8_STAGE(PG8_SA(0, 0), a2, voffA);
            PG8_WAIT_V(8); PG8_WAIT_L(0); PG8_BAR; PG8_MMA(1, 0, At, B0); PG8_MMA(1, 1, At, B1); PG8_BAR; PG8_SCHED;
            PG8_LDB(B0, 1, 0); PG8_LDB(B1, 1, 1); PG8_SCHED; PG8_LDA(At, 1, 0); PG8_STAGE(PG8_SA(0, 1), a2 + hstep, voffA);
            PG8_WAIT_V(8); PG8_WAIT_L(0); PG8_BAR; PG8_MMA(0, 0, At, B0); PG8_MMA(0, 1, At, B1); PG8_BAR; PG8_SCHED;
            PG8_LDA(At, 1, 1); PG8_STAGE(PG8_SB(1, 0), b3, voffB); PG8_STAGE(PG8_SB(1, 1), b3 + hstep, voffB); PG8_STAGE(PG8_SA(1, 0), a3, voffA);
            PG8_WAIT_V(8); PG8_WAIT_L(0); PG8_BAR; PG8_MMA(1, 0, At, B0); PG8_MMA(1, 1, At, B1); PG8_BAR; PG8_SCHED;
            } else {
            PG8_LDB(B0, 0, 0); PG8_SCHED; PG8_LDA(At, 0, 0); PG8_STAGE(PG8_SA(1, 1), a1 + hstep, voffA);
            PG8_WAIT_L(8); PG8_BAR; PG8_WAIT_L(0); PG8_MMA(0, 0, At, B0); PG8_BAR; PG8_SCHED;
            PG8_LDB(B1, 0, 1); PG8_STAGE(PG8_SB(0, 0), b2, voffB);
            PG8_BAR; PG8_WAIT_L(0); PG8_MMA(0, 1, At, B1); PG8_BAR;
            PG8_LDA(At, 0, 1); PG8_STAGE(PG8_SA(0, 0), a2, voffA);
            PG8_BAR; PG8_WAIT_L(0); PG8_MMA(1, 0, At, B0); PG8_BAR; PG8_SCHED;
            PG8_STAGE(PG8_SB(0, 1), b2 + hstep, voffB);
            PG8_WAIT_V(6); PG8_BAR; PG8_MMA(1, 1, At, B1); PG8_BAR;
            PG8_LDB(B0, 1, 0); PG8_SCHED; PG8_LDA(At, 1, 0); PG8_STAGE(PG8_SA(0, 1), a2 + hstep, voffA);
            PG8_WAIT_L(8); PG8_BAR; PG8_WAIT_L(0); PG8_MMA(0, 0, At, B0); PG8_BAR; PG8_SCHED;
            PG8_LDB(B1, 1, 1); PG8_STAGE(PG8_SB(1, 0), b3, voffB);
            PG8_BAR; PG8_WAIT_L(0); PG8_MMA(0, 1, At, B1); PG8_BAR;
            PG8_LDA(At, 1, 1); PG8_STAGE(PG8_SA(1, 0), a3, voffA);
            PG8_BAR; PG8_WAIT_L(0); PG8_MMA(1, 0, At, B0); PG8_BAR; PG8_SCHED;
            PG8_STAGE(PG8_SB(1, 1), b3 + hstep, voffB);
            PG8_WAIT_V(6); PG8_BAR; PG8_MMA(1, 1, At, B1); PG8_BAR;
            }
        }
        if constexpr (ALIGN_EPI) { if (wr == 0) PG8_BAR; }
        if constexpr (!Epi::AFTER_DRAIN) { E(acc, cur, wr, wc, fr, fq); S.done(cur); }
        if (!has_next) break;
#pragma unroll
        for (int a = 0; a < 2; ++a)
#pragma unroll
            for (int b = 0; b < 2; ++b)
#pragma unroll
                for (int m = 0; m < 4; ++m)
#pragma unroll
                    for (int n = 0; n < 2; ++n) acc[a][b][m][n] = (f32x4){0.f, 0.f, 0.f, 0.f};
        cur = nxt; cA = nA; cB = nB; ++ui;
        if constexpr (ALIGN_EPI) { if (wr == 1) PG8_BAR; }
    }
    PG8_WAIT_V(0);
    if constexpr (!ALIGN_EPI) { if (wr == 0) PG8_BAR; }
    PG8_BAR;
    if constexpr (Epi::AFTER_DRAIN) { E.fused(acc, cur, wr, wc, fr, fq, lds, wid, lane); S.done(cur); }
#undef PG8_SA
#undef PG8_SB
#undef PG8_STAGE
#undef PG8_LDA
#undef PG8_LDB
#undef PG8_MMA
#undef PG8_WAIT_V
#undef PG8_WAIT_L
#undef PG8_BAR
#undef PG8_SCHED
}
}
#define XB_TMO      128
#define XB_XCNT(j)  (256  + 64 * (j))
#define XB_XSUB(j)  (1280 + 64 * (j))
#define XB_XGEN(j)  (2304 + 64 * (j))
#define XB_TOP      3328
#define XB_TOPGEN   3392
#define XCD_BAR_WORDS 3456
#define XB_SPIN_CAP (1u << 18)

__device__ __forceinline__ unsigned xb_ld(unsigned* p)              { return __hip_atomic_load(p, __ATOMIC_RELAXED, __HIP_MEMORY_SCOPE_AGENT); }
__device__ __forceinline__ unsigned xb_add(unsigned* p, unsigned v) { return __hip_atomic_fetch_add(p, v, __ATOMIC_RELAXED, __HIP_MEMORY_SCOPE_AGENT); }
__device__ __forceinline__ unsigned xb_xcc_id() { return (unsigned)__builtin_amdgcn_s_getreg((3 << 11) | 20) & 0xFu; }
#define XB_SPIN(cond, bar) do { unsigned _sp = 0; while (cond) { __builtin_amdgcn_s_sleep(1); \
    if ((++_sp & 255u) == 0u) { if (xb_ld(&(bar)[XB_TMO])) break; if (_sp > XB_SPIN_CAP) { atomicAdd(&(bar)[XB_TMO], 1u); break; } } } } while (0)

struct XcdBarrier {
    unsigned* bar; unsigned x;
    volatile LAS unsigned* st;
    unsigned tid;
};

__device__ __forceinline__ XcdBarrier xcd_barrier_post(unsigned* bar, volatile LAS unsigned* st) {
    XcdBarrier b; b.bar = bar; b.x = xb_xcc_id(); b.st = st;
    if (threadIdx.x == 0) (void)xb_add(&bar[XB_XCNT(b.x)], 1u);
    return b;
}
__device__ __forceinline__ void xcd_barrier_complete(unsigned* bar, unsigned x, unsigned& nloc, unsigned& nx) {
    const unsigned G = gridDim.x * gridDim.y * gridDim.z;
    unsigned sum, cnt, mine, sp = 0u;
    for (;;) {
        sum = 0u; cnt = 0u; mine = 0u;
#pragma unroll
        for (unsigned j = 0; j < 16; ++j) { const unsigned c = xb_ld(&bar[XB_XCNT(j)]); sum += c; cnt += (c > 0u) ? 1u : 0u; mine = (j == x) ? c : mine; }
        if (sum == G) break;
        __builtin_amdgcn_s_sleep(1);
        if ((++sp & 255u) == 0u) { if (xb_ld(&bar[XB_TMO])) break; if (sp > XB_SPIN_CAP) { atomicAdd(&bar[XB_TMO], 1u); break; } }
    }
    nloc = mine > 0u ? mine : 1u; nx = cnt > 0u ? cnt : 1u;
}

__device__ __forceinline__ void xcd_barrier(const XcdBarrier& b) {
    asm volatile("s_waitcnt vmcnt(0)" ::: "memory");
    __syncthreads();
    if (b.tid == 0) {
        unsigned* bar = b.bar;
        __builtin_amdgcn_s_waitcnt(0);
        unsigned nloc = b.st[0], nx = b.st[1];
        if (nloc == 0u) { xcd_barrier_complete(bar, b.x, nloc, nx); b.st[0] = nloc; b.st[1] = nx; }
        const unsigned old = xb_add(&bar[XB_XSUB(b.x)], 1u);
        const unsigned gen = old / nloc;
        if (old + 1u == (gen + 1u) * nloc) {
            __builtin_amdgcn_fence(__ATOMIC_RELEASE, "agent");
            asm volatile("s_waitcnt vmcnt(0)" ::: "memory");
            const unsigned og = xb_add(&bar[XB_TOP], 1u);
            const unsigned tg = og / nx;
            if (og + 1u == (tg + 1u) * nx) xb_add(&bar[XB_TOPGEN], 1u);
            else XB_SPIN(xb_ld(&bar[XB_TOPGEN]) == tg, bar);
            __builtin_amdgcn_fence(__ATOMIC_ACQUIRE, "agent");
            xb_add(&bar[XB_XGEN(b.x)], 1u);
            asm volatile("s_waitcnt vmcnt(0)" ::: "memory");
        } else {
            XB_SPIN(xb_ld(&bar[XB_XGEN(b.x)]) == gen, bar);
            __builtin_amdgcn_fence(__ATOMIC_ACQUIRE, "agent");
            asm volatile("s_waitcnt vmcnt(0)" ::: "memory");
        }
    }
    __syncthreads();
}
namespace fox {
constexpr int D = 128;
constexpr float SCALE = 0.08838834764831845f, INV_SCALE = 11.313708498984761f;
constexpr float THR = 8.f;
constexpr int NW = 8, QBLK = 32, KVBLK = 64, QB = NW * QBLK;
constexpr int SHM_V = KVBLK * D * 2, SHM_K = KVBLK * D * 2;
constexpr int KB_OFF = 2 * SHM_V + 2 * SHM_K + NW * 64 * 4;
constexpr int JL_OFF = KB_OFF + 2 * 64 * 4;
constexpr int OT_OFF = JL_OFF + 64, OT_PITCH = 272, OT_WAVE = 32 * OT_PITCH;
constexpr int LDS_BYTES = OT_OFF + NW * OT_WAVE;

#define KSWZ(row, colB) ((row) * 256 + ((colB) ^ (((row) & 7) << 4)))
#define SBAR() __builtin_amdgcn_sched_barrier(0)
__device__ __forceinline__ int v_st(int k, int c) { const int kk = (k & ~0xC) | ((k & 4) << 1) | ((k & 8) >> 1); return ((kk >> 3) * 4 + (c >> 5)) * 512 + ((kk & 7) * 32 + (c & 31)) * 2; }
__device__ __forceinline__ int v_rd_base(int lane) { return ((lane & 3) << 3) | (((lane >> 2) & 3) << 6) | (((lane >> 4) & 1) << 5) | (((lane >> 5) & 1) << 8); }
constexpr int v_rd_off(int d0, int ks, int half) { return d0 * 512 + ks * 4096 + half * 2048; }
__device__ __forceinline__ int crow(int r, int hi) { return (r & 3) + 8 * (r >> 2) + 4 * hi; }
__device__ __forceinline__ bf16x8 load8(const bf16* p) { return *reinterpret_cast<const bf16x8*>(p); }
__device__ __forceinline__ void mask_tile(f32x16& p0, f32x16& p1, int dq) {
    const float NEG = -__builtin_inff();
#pragma unroll
    for (int r = 0; r < 16; ++r) {
        const int c = (r & 3) + 8 * (r >> 2);
        if (dq - c < 0) p0[r] = NEG;
        if (dq - c - 32 < 0) p1[r] = NEG;
    }
}
__device__ __forceinline__ void bias_tile(f32x16& p0, f32x16& p1, const float* kb, int hi) {
#pragma unroll
    for (int g = 0; g < 4; ++g) {
        const f32x4 a = *(const f32x4*)(kb + 8 * g + 4 * hi), b = *(const f32x4*)(kb + 32 + 8 * g + 4 * hi);
#pragma unroll
        for (int j = 0; j < 4; ++j) { p0[4 * g + j] += a[j]; p1[4 * g + j] += b[j]; }
    }
}
__device__ __forceinline__ void partialSM(f32x16& p0, f32x16& p1, float& m_reg, float& mn, float& alpha) {
    float pmax = p0[0]; for (int r = 1; r < 16; ++r) pmax = fmaxf(pmax, p0[r]); for (int r = 0; r < 16; ++r) pmax = fmaxf(pmax, p1[r]);
    { auto rr = __builtin_amdgcn_permlane32_swap(__float_as_uint(pmax), __float_as_uint(pmax), false, false);
      pmax = fmaxf(__uint_as_float(rr[0]), __uint_as_float(rr[1])); }
    constexpr float C2 = 1.4426950408889634f * SCALE;
    if (__builtin_expect(__all((pmax - m_reg) * SCALE <= THR), 1)) { mn = m_reg; alpha = 1.f; }
    else { mn = fmaxf(m_reg, pmax); alpha = __builtin_amdgcn_exp2f((m_reg - mn) * C2); m_reg = mn; }
    const float mnL = -mn * C2;
    for (int r = 0; r < 16; ++r) p0[r] = fmaf(p0[r], C2, mnL); for (int r = 0; r < 16; ++r) p1[r] = fmaf(p1[r], C2, mnL);
    for (int r = 0; r < 16; ++r) p0[r] = __builtin_amdgcn_exp2f(p0[r]);
}
__device__ __forceinline__ void finishSM(f32x16& p0, f32x16& p1, float alpha, float& l_reg, bf16x8& pa0, bf16x8& pa1, bf16x8& pa2, bf16x8& pa3) {
    for (int r = 0; r < 16; ++r) p1[r] = __builtin_amdgcn_exp2f(p1[r]);
    float ps = 0; for (int r = 0; r < 16; ++r) ps += p0[r]; for (int r = 0; r < 16; ++r) ps += p1[r];
    { auto rr = __builtin_amdgcn_permlane32_swap(__float_as_uint(ps), __float_as_uint(ps), false, false);
      ps = __uint_as_float(rr[0]) + __uint_as_float(rr[1]); }
    l_reg = l_reg * alpha + ps;
#define PK4(P, B_, OUT) do { unsigned a0 = cvtpk(P[B_+0], P[B_+1]), a1 = cvtpk(P[B_+2], P[B_+3]);                          \
        unsigned b0 = cvtpk(P[B_+4], P[B_+5]), b1 = cvtpk(P[B_+6], P[B_+7]);                                             \
        auto r0 = __builtin_amdgcn_permlane32_swap(a0, b0, false, false); auto r1 = __builtin_amdgcn_permlane32_swap(a1, b1, false, false); \
        u32x4 w = {r0[0], r1[0], r0[1], r1[1]}; OUT = *reinterpret_cast<bf16x8*>(&w); } while (0)
    PK4(p0, 0, pa0); PK4(p0, 8, pa1); PK4(p1, 0, pa2); PK4(p1, 8, pa3);
#undef PK4
}
template <int KB>
__device__ __forceinline__ void qkt(f32x16& p0, f32x16& p1, const char* K_lds, int r32, int hi, const bf16x8* qr) {
    p0 = f32x16{}; p1 = f32x16{};
    const char* kb[4];
#pragma unroll
    for (int dd = 0; dd < 4; ++dd) kb[dd] = K_lds + KB * SHM_K + KSWZ(r32, (dd * 16 + hi * 8) * 2);
#pragma unroll
    for (int d0 = 0; d0 < 8; ++d0) { const char* a = kb[d0 & 3] + (d0 >> 2) * 128;
        bf16x8 b0 = *reinterpret_cast<const bf16x8*>(a);
        bf16x8 b1 = *reinterpret_cast<const bf16x8*>(a + 32 * 256);
        p0 = __builtin_amdgcn_mfma_f32_32x32x16_bf16(b0, qr[d0], p0, 0, 0, 0);
        p1 = __builtin_amdgcn_mfma_f32_32x32x16_bf16(b1, qr[d0], p1, 0, 0, 0); }
}
template <int VB>
__device__ __forceinline__ void pv_tile(f32x16* o, int vb0, bf16x8 pa0, bf16x8 pa1, bf16x8 pa2, bf16x8 pa3) {
#define TRRD(dst, off) asm volatile("ds_read_b64_tr_b16 %0, %1 offset:%2" : "=&v"(dst) : "v"(vb0), "i"(off) : "memory")
#define PV_D0(d0) do { s16x4 l0, l1, h0, h1; constexpr int b_ = VB * SHM_V + v_rd_off(d0, 0, 0);     \
        TRRD(l0, b_); TRRD(h0, b_ + 2048); TRRD(l1, b_ + 4096); TRRD(h1, b_ + 6144); \
        asm volatile("s_waitcnt lgkmcnt(0)" ::: "memory"); SBAR();   \
        o[d0] = __builtin_amdgcn_mfma_f32_32x32x16_bf16(pa0, (bf16x8){l0[0], l0[1], l0[2], l0[3], h0[0], h0[1], h0[2], h0[3]}, o[d0], 0, 0, 0);   \
        o[d0] = __builtin_amdgcn_mfma_f32_32x32x16_bf16(pa1, (bf16x8){l1[0], l1[1], l1[2], l1[3], h1[0], h1[1], h1[2], h1[3]}, o[d0], 0, 0, 0);   \
        SBAR(); TRRD(l0, b_ + 8192); TRRD(h0, b_ + 10240); TRRD(l1, b_ + 12288); TRRD(h1, b_ + 14336); \
        asm volatile("s_waitcnt lgkmcnt(0)" ::: "memory"); SBAR();   \
        o[d0] = __builtin_amdgcn_mfma_f32_32x32x16_bf16(pa2, (bf16x8){l0[0], l0[1], l0[2], l0[3], h0[0], h0[1], h0[2], h0[3]}, o[d0], 0, 0, 0);   \
        o[d0] = __builtin_amdgcn_mfma_f32_32x32x16_bf16(pa3, (bf16x8){l1[0], l1[1], l1[2], l1[3], h1[0], h1[1], h1[2], h1[3]}, o[d0], 0, 0, 0); } while (0)
    PV_D0(0); PV_D0(1); PV_D0(2); PV_D0(3);
#undef PV_D0
#undef TRRD
}
struct BlockRef { const bf16* Q; const bf16* K; const bf16* V; const bf16* Z; bf16* O; const float* C; const float* QN; const float* KN; int P0; };
constexpr float PRUNE_T = 30.0f;
__device__ __forceinline__ int compute_jlo(const BlockRef& b, int lane) {
    const int ntb = b.P0 / KVBLK;
    if (ntb == 0) return 0;
    float q2 = b.QN[ntb + (lane & 3)];
    q2 = fmaxf(q2, __shfl_xor(q2, 1)); q2 = fmaxf(q2, __shfl_xor(q2, 2));
    float k2 = fmaxf(lane < ntb + 4 ? b.KN[lane] : 0.f, lane + 64 < ntb + 4 ? b.KN[lane + 64] : 0.f);
#pragma unroll
    for (int o = 1; o < 64; o <<= 1) k2 = fmaxf(k2, __shfl_xor(k2, o));
    const float bnd = 2.0f * SCALE * __builtin_amdgcn_sqrtf(q2 * k2) * 1.0001f + b.C[b.P0];
    const bool s0 = lane < ntb && (bnd - b.C[64 * lane + 63] < -PRUNE_T);
    const bool s1 = lane + 64 < ntb && (bnd - b.C[64 * (lane + 64) + 63] < -PRUNE_T);
    const unsigned long long m0 = __ballot(s0), m1 = __ballot(s1);
    int jlo = 0;
    if (m1) jlo = 128 - __builtin_clzll(m1) + 1 - 1; else if (m0) jlo = 64 - __builtin_clzll(m0);
    return __builtin_amdgcn_readfirstlane(jlo);
}
__device__ __forceinline__ void norm_item(const bf16* PROJ, float* QN2, float* KN2, int item, int lane) {
    const int bhh = item >> 7, tile = item & 127, b = bhh >> 5, h = bhh & 31, rs = lane >> 4, cg = lane & 15;
    const bf16* base = PROJ + ((size_t)b * SEQ + (size_t)tile * 64) * LDP + h * HDIM + cg * 8;
    float qm = 0.f, km = 0.f;
#pragma unroll 4
    for (int i = 0; i < 16; ++i) { const bf16* rp = base + (size_t)(4 * i + rs) * LDP;
        const u32x4 qw = *(const u32x4*)rp, kw = *(const u32x4*)(rp + 4096); float q[8], k[8]; unpack8(qw, q); unpack8(kw, k);
        float sq = 0.f, sk = 0.f;
#pragma unroll
        for (int e = 0; e < 8; ++e) { sq += q[e] * q[e]; sk += k[e] * k[e]; }
#pragma unroll
        for (int o = 1; o < 16; o <<= 1) { sq += __shfl_xor(sq, o); sk += __shfl_xor(sk, o); }
        qm = fmaxf(qm, sq); km = fmaxf(km, sk); }
    qm = fmaxf(qm, __shfl_xor(qm, 16)); qm = fmaxf(qm, __shfl_xor(qm, 32)); km = fmaxf(km, __shfl_xor(km, 16)); km = fmaxf(km, __shfl_xor(km, 32));
    if (lane == 0) { QN2[item] = qm; KN2[item] = km; }
}
struct Seam { bf16x8 qr[8]; bf16x8 st_v0, st_v1, st_k0, st_k1; float cb0, cb1; };
#define ROWP(p, k0, rr) ((p) + (size_t)((k0) + (rr)) * LDP + sc)
#define VMWN(n) asm volatile("s_waitcnt vmcnt(%0)" :: "i"(n) : "memory")
#define SLOAD_H(Kp, Vp, Cp, k0) do { const bf16* vp_ = (Vp) + (size_t)(k0) * LDP; const bf16* kp_ = (Kp) + (size_t)(k0) * LDP; const float* cp_ = (Cp) + (k0); \
                         S.st_v0 = load8(vp_ + loff); S.st_v1 = load8(vp_ + 32 * LDP + loff);              \
                         S.st_k0 = load8(kp_ + loff); S.st_k1 = load8(kp_ + 32 * LDP + loff); S.cb0 = cp_[(unsigned)sr]; S.cb1 = (cp_ + 32)[(unsigned)sr]; } while (0)
#define SWRITE_HK(bf, ref) do { *(bf16x8*)(K_lds + (bf) * SHM_K + kws) = S.st_k0; *(bf16x8*)(K_lds + (bf) * SHM_K + kws + 32 * 256) = S.st_k1; \
                         if ((tid & 15) == 0) { kbias[(bf) * 64 + sr] = ((ref) - S.cb0) * INV_SCALE; kbias[(bf) * 64 + 32 + sr] = ((ref) - S.cb1) * INV_SCALE; } } while (0)
#define SWRITE_HV(bf) do { *(bf16x8*)(V_lds + (bf) * SHM_V + vst0) = S.st_v0; *(bf16x8*)(V_lds + (bf) * SHM_V + vst1) = S.st_v1; } while (0)
#define SWRITE_H(bf, ref) do { SWRITE_HV(bf); SWRITE_HK(bf, ref); } while (0)
__device__ __forceinline__ float blk_ref(const BlockRef& b) { const float v = b.P0 > 0 ? b.C[b.P0 - 1] : 0.f; return __uint_as_float(__builtin_amdgcn_readfirstlane(__float_as_uint(v))); }
__device__ __forceinline__ void prime(const BlockRef& cur, int j_lo, char* lds, Seam& S, const int w0) {
    const int tid = otid(w0), wid = __builtin_amdgcn_readfirstlane(tid >> 6), lane = tid & 63, r32 = lane & 31, hi = lane >> 5;
    const int sr = tid >> 4, sc = (tid & 15) * 8, kws = KSWZ(sr, sc * 2); char* K_lds = lds + 2 * SHM_V; float* kbias = (float*)(lds + KB_OFF);
    const unsigned loff = (unsigned)sr * LDP + sc, qoff = (unsigned)r32 * LDP + hi * 8;
    const float ref = blk_ref(cur);
    for (int d0 = 0; d0 < 8; ++d0) S.qr[d0] = load8(cur.Q + (size_t)(wid * QBLK) * LDP + d0 * 16 + qoff);
    SLOAD_H(cur.K, cur.V, cur.C, j_lo * KVBLK); VM_WAIT(); SWRITE_HK(0, ref);
    __syncthreads();
}
__device__ __forceinline__ void block(const BlockRef& cur, const BlockRef& nxt, int j_lo, int jlo_n, char* lds, Seam& S, const int w0) {
    const int tid = otid(w0), wid = __builtin_amdgcn_readfirstlane(tid >> 6), lane = tid & 63, r32 = lane & 31, hi = lane >> 5;
    const int NT = (cur.P0 + QB - 1) / KVBLK + 1 - j_lo;
    const int qlo = cur.P0 + wid * QBLK, qm = qlo + r32 - 4 * hi;
    char* V_lds = lds; char* K_lds = lds + 2 * SHM_V;
    float* ws = (float*)(lds + 2 * SHM_V + 2 * SHM_K) + wid * 64; float* li_l = ws, * al_l = ws + 32; float* kbias = (float*)(lds + KB_OFF);
    float m_reg = -1e30f, l_reg = 0; f32x16 o[4] = {};
    const int sr = tid >> 4, sc = (tid & 15) * 8, vst0 = v_st(sr, sc), vst1 = v_st(32 + sr, sc), kws = KSWZ(sr, sc * 2);
    const int vb0 = (int)(uintptr_t)V_lds + v_rd_base(lane);
    const unsigned loff = (unsigned)sr * LDP + sc, qoff = (unsigned)r32 * LDP + hi * 8;
    const bf16* Kh = cur.K; const bf16* Vh = cur.V; const float* Ch = cur.C;
    const float ref = blk_ref(cur), nref = blk_ref(nxt);
#define RESC(a) do { if (__any((a) < 1.f)) { if (hi == 0) al_l[r32] = (a); asm volatile("s_waitcnt lgkmcnt(0)" ::: "memory");              \
                     for (int d_ = 0; d_ < 4; ++d_) for (int r = 0; r < 16; ++r) o[d_][r] *= al_l[crow(r, hi)]; } } while (0)
#define KBASE(t) ((j_lo + (t)) * KVBLK)
#define BIASMASK(P0_, P1_, t, KB) do { const int kb_ = KBASE(t); bias_tile(P0_, P1_, kbias + (KB) * 64, hi); if (kb_ + KVBLK - 1 > qlo) mask_tile(P0_, P1_, qm - kb_); } while (0)
    constexpr int NQL = 8;
#define SEAM_K0() do { VMWN(NQL); SWRITE_HK(0, nref); SBAR(); } while (0)
    f32x16 pA0, pA1, pB0, pB1; float mnA, mnB, alA, alB; bf16x8 pa0, pa1, pa2, pa3;
    SWRITE_HV(0); SBAR();
    if (NT > 1) SLOAD_H(Kh, Vh, Ch, KBASE(1));
    SBAR(); qkt<0>(pA0, pA1, K_lds, r32, hi, S.qr);
    BIASMASK(pA0, pA1, 0, 0); partialSM(pA0, pA1, m_reg, mnA, alA);
    if (NT > 1) { VM_WAIT(); SWRITE_H(1, ref); }
    __syncthreads();
#define HALF_STEP(PX0, PX1, mnX, alX, PY0, PY1, alY, t, KB, VB, SB) do {                                                      \
        SBAR(); qkt<KB>(PX0, PX1, K_lds, r32, hi, S.qr);                                                                      \
        finishSM(PY0, PY1, alY, l_reg, pa0, pa1, pa2, pa3); SBAR();                                                           \
        if ((t) + 1 < NT) { SLOAD_H(Kh, Vh, Ch, KBASE((t) + 1)); SBAR(); }                                                    \
        pv_tile<VB>(o, vb0, pa0, pa1, pa2, pa3); BIASMASK(PX0, PX1, (t), KB); partialSM(PX0, PX1, m_reg, mnX, alX);           \
        __syncthreads();                                                                                                      \
        if ((t) + 1 < NT) { VM_WAIT(); SWRITE_H(SB, ref); }                                                                   \
        RESC(alX); __syncthreads(); } while (0)
    for (int t = 1; t + 1 < NT; t += 2) {
        HALF_STEP(pB0, pB1, mnB, alB, pA0, pA1, alA, t, 1, 0, 0);
        HALF_STEP(pA0, pA1, mnA, alA, pB0, pB1, alB, t + 1, 0, 1, 1);
    }
    const bool even = (NT & 1) == 0;
    if (even) { SBAR(); qkt<1>(pB0, pB1, K_lds, r32, hi, S.qr); SBAR(); }
    SLOAD_H(nxt.K, nxt.V, nxt.C, jlo_n * KVBLK); SBAR();
#pragma unroll
    for (int d0 = 0; d0 < 8; ++d0) S.qr[d0] = load8(nxt.Q + (size_t)(wid * QBLK) * LDP + d0 * 16 + qoff);
    SBAR();
    finishSM(pA0, pA1, alA, l_reg, pa0, pa1, pa2, pa3); SBAR();
    pv_tile<0>(o, vb0, pa0, pa1, pa2, pa3);
    if (even) { const int t2 = otid(w0), qm2 = qlo + (t2 & 31) - 4 * ((t2 >> 5) & 1), hi2 = (t2 >> 5) & 1;
      { const int kb_ = KBASE(NT - 1); bias_tile(pB0, pB1, kbias + 64, hi2); if (kb_ + KVBLK - 1 > qlo) mask_tile(pB0, pB1, qm2 - kb_); }
      partialSM(pB0, pB1, m_reg, mnB, alB); __syncthreads(); RESC(alB);
      finishSM(pB0, pB1, alB, l_reg, pa0, pa1, pa2, pa3); SBAR(); pv_tile<1>(o, vb0, pa0, pa1, pa2, pa3); }
    SBAR(); SEAM_K0();
    if (hi == 0) li_l[r32] = l_reg; asm volatile("s_waitcnt lgkmcnt(0)" ::: "memory");
    float rli[16];
#pragma unroll
    for (int r = 0; r < 16; ++r) rli[r] = __builtin_amdgcn_rcpf(li_l[crow(r, hi)]);
    bf16* Ow = cur.O + (size_t)(wid * QBLK) * 4096; const bf16* Zw = cur.Z + (size_t)(wid * QBLK) * LDP;
    const int t2 = otid(w0), l2 = t2 & 63;
    const unsigned zoff = (unsigned)(l2 >> 4) * LDP + (l2 & 15) * 8, ooff = (unsigned)(l2 >> 4) * 4096 + (l2 & 15) * 8;
    u32x4 zw[8];
#pragma unroll
    for (int i = 0; i < 8; ++i) zw[i] = *(const u32x4*)(Zw + (size_t)(4 * i) * LDP + zoff);
    char* ot = lds + OT_OFF + wid * OT_WAVE;
#pragma unroll
    for (int d0 = 0; d0 < 4; ++d0)
#pragma unroll
        for (int r = 0; r < 16; ++r) *(bf16*)(ot + crow(r, hi) * OT_PITCH + (d0 * 32 + r32) * 2) = (bf16)(cvtpk(o[d0][r] * rli[r], 0.f) & 0xffffu);
    asm volatile("s_waitcnt lgkmcnt(0)" ::: "memory");
#pragma unroll
    for (int i = 0; i < 8; ++i) { const u32x4 ow = *(const u32x4*)(ot + (4 * i + (l2 >> 4)) * OT_PITCH + (l2 & 15) * 16);
        float ov[8], zv[8]; unpack8(ow, ov); unpack8(zw[i], zv);
        f32x4 a, b;
#pragma unroll
        for (int e = 0; e < 4; ++e) { a[e] = ov[e] * siluf_(zv[e]); b[e] = ov[4 + e] * siluf_(zv[4 + e]); }
        *(bf16x8*)(Ow + (size_t)(4 * i) * 4096 + ooff) = pack8(a, b); }
    __syncthreads();
#undef RESC
#undef KBASE
#undef BIASMASK
#undef SEAM_K0
#undef HALF_STEP
}
#undef ROWP
#undef VMWN
#undef SLOAD_H
#undef SWRITE_HK
#undef SWRITE_HV
#undef SWRITE_H
#undef KSWZ
#undef SBAR
__device__ __forceinline__ void attn_phase(char* lds, const bf16* PROJ, bf16* MIX, const float* CUM, const float* QN2, const float* KN2, int vcu, int G, const int w0) {
    constexpr int NQB = SEQ / QB  , NX = NQB / 2, TOTAL = NX * BATCH * NHEAD;
    auto ref_of = [&](int L, int pass) { const int bhh = L / NX, x = L % NX, qb = pass ? NQB - 1 - x : x, b = bhh / NHEAD, h = bhh % NHEAD;
        BlockRef r; const bf16* base = PROJ + (size_t)b * SEQ * LDP + h * HDIM;
        r.Q = base + (size_t)qb * QB * LDP; r.K = base + 4096; r.V = base + 8192; r.Z = base + (size_t)qb * QB * LDP + ZCOL;
        r.O = MIX + ((size_t)b * SEQ + (size_t)qb * QB) * 4096 + h * HDIM; r.C = CUM + (size_t)bhh * SEQ; r.QN = QN2 + bhh * 128; r.KN = KN2 + bhh * 128; r.P0 = qb * QB; return r; };
    int L = vcu; if (L >= TOTAL) return;
    int pass = 0; BlockRef cur = ref_of(L, 0); Seam S;
    int* jl = (int*)(lds + JL_OFF);
    { const int tid = otid(w0), w = __builtin_amdgcn_readfirstlane(tid >> 6), Lw = vcu + (w >> 1) * G;
      if (Lw < TOTAL) { const BlockRef r = ref_of(Lw, w & 1); const int j = compute_jlo(r, tid & 63); if ((tid & 63) == 0) jl[w] = j; } }
    __syncthreads();
    int bi = 0;
    prime(cur, jl[0], lds, S, w0);
    for (;;) {
        const bool more_pass = pass == 0, more_item = L + G < TOTAL, last = !more_pass && !more_item;
        int passn = pass + 1, Ln = L; if (!more_pass) { passn = 0; Ln = more_item ? L + G : L; }
        const BlockRef nxt = last ? cur : ref_of(Ln, passn);
        { const int ja = __builtin_amdgcn_readfirstlane(jl[bi]), jb = __builtin_amdgcn_readfirstlane(jl[last ? bi : bi + 1]); block(cur, nxt, ja, jb, lds, S, w0); ++bi; }
        if (last) break;
        cur = nxt; pass = passn; L = Ln;
    }
}
}
constexpr int NWAVES = 8, NTHR = 512;
constexpr int RING_BYTES = 131072;
constexpr int MISC_OFF = RING_BYTES + 24576;
constexpr int LDS_BYTES = MISC_OFF + 128;

struct Args {
    const float* in[28]; float* out; unsigned char* ws;
    int ph_lo, ph_hi, li, pad;
};
enum { I_X = 0, I_P, I_NORM_MIX, I_FOX_WIN, I_FOX_BF, I_FOX_WOUT, I_GDN_WIN, I_GDN_CONV, I_GDN_ALOG, I_GDN_DTB, I_GDN_NORM, I_GDN_WOUT,
       I_SSM_WIN, I_SSM_LRE, I_SSM_LIM, I_SSM_BRE, I_SSM_BIM, I_SSM_CRE, I_SSM_CIM, I_SSM_LSTEP, I_SSM_D, I_SSM_WGLU, I_SSM_BGLU, I_SSM_WOUT,
       I_NORM_PLE, I_PLE_WPROJ, I_PLE_WGATE, I_FINAL_NORM };

__device__ __forceinline__ void transpose_item(const float* W, int K, int N, bf16* dst, const float* gk, LAS float* scr, int k0, int n0, int lane) {
#pragma unroll 8
    for (int i = 0; i < 32; ++i) { const int kk = 2 * i + (lane >> 5); scr[kk * 33 + (lane & 31)] = W[(size_t)(k0 + kk) * N + n0 + (lane & 31)]; }
    const int c = lane & 7;
    f32x4 ga = {1.f, 1.f, 1.f, 1.f}, gb = ga;
    if (gk) { ga = *(const f32x4*)(gk + k0 + 8 * c); gb = *(const f32x4*)(gk + k0 + 8 * c + 4); }
    LDS_WAIT(); asm volatile("" ::: "memory");
#pragma unroll
    for (int j = 0; j < 4; ++j) { const int n = (lane >> 3) + 8 * j; const LAS float* s = scr + (8 * c) * 33 + n;
        u32x4 o; o.x = cvtpk(s[0 * 33] * ga[0], s[1 * 33] * ga[1]); o.y = cvtpk(s[2 * 33] * ga[2], s[3 * 33] * ga[3]); o.z = cvtpk(s[4 * 33] * gb[0], s[5 * 33] * gb[1]); o.w = cvtpk(s[6 * 33] * gb[2], s[7 * 33] * gb[3]);
        *(u32x4*)(dst + (size_t)n * K + k0 + 8 * c) = o; }
    LDS_WAIT(); asm volatile("" ::: "memory");
}
__device__ __forceinline__ void transpose_matrix(const float* W, int K, int N, bf16* WT, int nsplit, bf16* WT2, const float* gk, LAS float* scr, int gw, int NGW, int lane) {
    const int nblk = N / 32, nitems = (K / 64) * nblk;
    for (int it = gw; it < nitems; it += NGW) { const int kb = it / nblk, nb = it - kb * nblk, n0 = 32 * nb;
        bf16* dst = n0 < nsplit ? WT + (size_t)n0 * K : WT2 + (size_t)(n0 - nsplit) * K;
        transpose_item(W, K, N, dst, gk, scr, 64 * kb, n0, lane); }
}
__device__ __forceinline__ float row_to_bf16(const float* xrow, bf16* orow, int lane) {
    float s = 0.f;
#pragma unroll
    for (int j = 0; j < 8; ++j) { const int c = (j * 64 + lane) * 8;
        const f32x4 a = *(const f32x4*)(xrow + c), b = *(const f32x4*)(xrow + c + 4);
        const bf16x8 o = pack8(a, b); const u32x4 w = __builtin_bit_cast(u32x4, o);
        s += (bflo(w.x) * bflo(w.x) + bfhi(w.x) * bfhi(w.x)) + (bflo(w.y) * bflo(w.y) + bfhi(w.y) * bfhi(w.y)) + (bflo(w.z) * bflo(w.z) + bfhi(w.z) * bfhi(w.z)) + (bflo(w.w) * bflo(w.w) + bfhi(w.w) * bfhi(w.w));
        *(bf16x8*)(orow + c) = o; }
    return wave_sum(s);
}

template <int NS>
__device__ __forceinline__ void skinny_gemm(const bf16* A1, const bf16* WSK, const ssq_t* sumsq, int r0, LAS float* res, int wid, int lane) {
    constexpr int NT = NS / 32;
    const int mt = wid & 3, ng = wid >> 2, fr = lane & 15, fq = lane >> 4;
    f32x4 acc[NT];
#pragma unroll
    for (int t = 0; t < NT; ++t) acc[t] = (f32x4){0.f, 0.f, 0.f, 0.f};
    const bf16* ap = A1 + (size_t)(r0 + 16 * mt + fr) * 4096 + 8 * fq;
    const bf16* bp = WSK + (size_t)(16 * ng * NT + fr) * 4096 + 8 * fq;
#pragma unroll 8
    for (int k = 0; k < 4096; k += 32) {
        const bf16x8 a = *(const bf16x8*)(ap + k);
#pragma unroll
        for (int t = 0; t < NT; ++t) { const bf16x8 b = *(const bf16x8*)(bp + (size_t)t * 16 * 4096 + k); acc[t] = __builtin_amdgcn_mfma_f32_16x16x32_bf16(a, b, acc[t], 0, 0, 0); }
    }
#pragma unroll
    for (int i = 0; i < 4; ++i) { const int row = 16 * mt + 4 * fq + i; const float rs = __builtin_amdgcn_rsqf(ssq_val(sumsq[r0 + row]) * (1.0f / 4096.0f) + NORM_EPS);
#pragma unroll
        for (int t = 0; t < NT; ++t) res[row * NS + 16 * (ng * NT + t) + fr] = acc[t][i] * rs; }
}
namespace gdn {
constexpr int PQ = 272;
constexpr int PL = 68;
constexpr int G_Q = 0, G_K = 17408, G_V = 34816, G_L = 52224, G_S = 69632, GRP_BYTES = 70656;
static_assert(2 * GRP_BYTES <= 147456, "gdn prep LDS");

__device__ __forceinline__ void group_barrier(LAS unsigned* cnt, unsigned& target) {
    target += 4u;
    asm volatile("s_waitcnt lgkmcnt(0)" ::: "memory");
    if (__builtin_amdgcn_mbcnt_hi(~0u, __builtin_amdgcn_mbcnt_lo(~0u, 0u)) == 0u) __hip_atomic_fetch_add(cnt, 1u, __ATOMIC_RELAXED, __HIP_MEMORY_SCOPE_WORKGROUP);
    while (__hip_atomic_load(cnt, __ATOMIC_RELAXED, __HIP_MEMORY_SCOPE_WORKGROUP) < target) __builtin_amdgcn_s_sleep(1);
    asm volatile("" ::: "memory");
}
__device__ __forceinline__ void prep_pair(LAS unsigned char* lds, int uid0, const bf16* PROJ, const float* convw, const float* BETA, const float* GLOG, float* GL, unsigned char* REC, unsigned& gbt, const int w0) {
    const int tid = otid(w0), wid = __builtin_amdgcn_readfirstlane(tid >> 6), lane = tid & 63, grp = wid >> 2, gw = wid & 3, gt = tid & 255;
    const int uid = uid0 + grp, bhh = uid >> 7, c = uid & 127, b = bhh >> 5, h = bhh & 31;
    LAS unsigned char* gl = lds + grp * GRP_BYTES;
    LAS float* Lm = (LAS float*)(gl + G_L); LAS float* gcs = (LAS float*)(gl + G_S); LAS float* bes = gcs + 64; LAS float* egs = gcs + 128;
    unsigned char* rec = REC + (size_t)uid * GR_BYTES;
    LAS unsigned* gbc = (LAS unsigned*)(gl + G_S + 768);
    const size_t row0 = (size_t)b * SEQ + (size_t)c * 64;
    float g_ld = 0.f, b_ld = 0.f;
    if (gw == 0) { g_ld = GLOG[(row0 + lane) * 32 + h]; b_ld = BETA[(row0 + lane) * 32 + h]; }
    {
    {
        const int cg = gt & 15, rp = gt >> 4;
        u32x4 raw[2][7];
#define GDN_ROWS(s_, buf_) do { const bf16* bp_ = PROJ + (row0 + 4 * rp - 3) * LDP + (s_) * 4096 + h * 128 + 8 * cg; \
            _Pragma("unroll") for (int jj = 0; jj < 7; ++jj) raw[buf_][jj] = (c * 64 + 4 * rp - 3 + jj >= 0) ? *(const u32x4*)(bp_ + (size_t)jj * LDP) : (u32x4){0u, 0u, 0u, 0u}; } while (0)
        GDN_ROWS(0, 0);
#pragma unroll
        for (int s = 0; s < 3; ++s) {
            const int colb = s * 4096 + h * 128 + 8 * cg;
            f32x4 w[4][2];
#pragma unroll
            for (int j = 0; j < 4; ++j) { w[j][0] = *(const f32x4*)(convw + (size_t)j * 12288 + colb); w[j][1] = *(const f32x4*)(convw + (size_t)j * 12288 + colb + 4); }
            if (s == 0) GDN_ROWS(1, 1); else if (s == 1) GDN_ROWS(2, 0);
            float xr[7][8];
#pragma unroll
            for (int jj = 0; jj < 7; ++jj) unpack8(raw[s & 1][jj], xr[jj]);
#pragma unroll
            for (int i = 0; i < 4; ++i) { const int t = 4 * rp + i; float y[8];
#pragma unroll
                for (int e = 0; e < 8; ++e) y[e] = 0.f;
#pragma unroll
                for (int j = 0; j < 4; ++j)
#pragma unroll
                    for (int e = 0; e < 4; ++e) { y[e] += w[j][0][e] * xr[i + j][e]; y[4 + e] += w[j][1][e] * xr[i + j][4 + e]; }
                float ss = 0.f;
#pragma unroll
                for (int e = 0; e < 8; ++e) { y[e] = siluf_(y[e]); ss += y[e] * y[e]; }
                float sc = 1.f;
                if (s < 2) { ss += __shfl_xor(ss, 1); ss += __shfl_xor(ss, 2); ss += __shfl_xor(ss, 4); ss += __shfl_xor(ss, 8);
                    sc = __builtin_amdgcn_rsqf(ss + NORM_EPS) * (s == 0 ? 0.08838834764831845f : 1.0f); }
                *(LAS bf16x8*)(gl + s * 17408 + t * PQ + cg * 16) = pack8((f32x4){y[0] * sc, y[1] * sc, y[2] * sc, y[3] * sc}, (f32x4){y[4] * sc, y[5] * sc, y[6] * sc, y[7] * sc}); }
        }
#undef GDN_ROWS
    }
    }
    if (gw == 0) { float g = g_ld;
#pragma unroll
        for (int o = 1; o < 64; o <<= 1) { const float t = __shfl_up(g, o); if (lane >= o) g += t; }
        gcs[lane] = g; bes[lane] = b_ld; egs[lane] = fexp(g);
        if (lane == 63) GL[uid] = fexp(g); }
    group_barrier(gbc, gbt);
    {
    {
        const int fr = lane & 15, fq = lane >> 4, mt = gw;
        bf16x8 kA[4], qA[4];
#pragma unroll
        for (int s = 0; s < 4; ++s) { kA[s] = *(const LAS bf16x8*)(gl + G_K + (16 * mt + fr) * PQ + (32 * s + 8 * fq) * 2); qA[s] = *(const LAS bf16x8*)(gl + G_Q + (16 * mt + fr) * PQ + (32 * s + 8 * fq) * 2); }
        bf16* intra = (bf16*)(rec + GR_IN);
#pragma unroll
        for (int nt = 0; nt < 4; ++nt) { f32x4 kk = {0.f, 0.f, 0.f, 0.f}, qk = {0.f, 0.f, 0.f, 0.f};
#pragma unroll
            for (int s = 0; s < 4; ++s) { const bf16x8 kB = *(const LAS bf16x8*)(gl + G_K + (16 * nt + fr) * PQ + (32 * s + 8 * fq) * 2);
                kk = __builtin_amdgcn_mfma_f32_16x16x32_bf16(kA[s], kB, kk, 0, 0, 0); qk = __builtin_amdgcn_mfma_f32_16x16x32_bf16(qA[s], kB, qk, 0, 0, 0); }
            const int j = 16 * nt + fr; const float gj = gcs[j];
#pragma unroll
            for (int e = 0; e < 4; ++e) { const int i = 16 * mt + 4 * fq + e; const float dec = (i >= j) ? fexp(gcs[i] - gj) : 0.f;
                Lm[i * PL + j] = (i > j) ? bes[i] * kk[e] * dec : 0.f;
                intra[i * 64 + j] = (bf16)(cvtpk(qk[e] * dec, 0.f) & 0xffffu); } }
    }
    {
        const int row = gt >> 2, seg = gt & 3; const float e = egs[row];
#pragma unroll
        for (int q4 = 0; q4 < 4; ++q4) { const u32x4 xw = *(const LAS u32x4*)(gl + G_Q + row * PQ + (seg * 32 + q4 * 8) * 2); float x[8]; unpack8(xw, x);
            *(bf16x8*)(rec + GR_QD + ((size_t)row * 128 + seg * 32 + q4 * 8) * 2) = pack8((f32x4){x[0] * e, x[1] * e, x[2] * e, x[3] * e}, (f32x4){x[4] * e, x[5] * e, x[6] * e, x[7] * e}); }
        const int d = gt & 127, half = gt >> 7; const float g63 = gcs[63];
#pragma unroll
        for (int q4 = 0; q4 < 4; ++q4) { float v[8];
#pragma unroll
            for (int e2 = 0; e2 < 8; ++e2) { const int i = 32 * half + 8 * q4 + e2; v[e2] = bf2f(*(const LAS bf16*)(gl + G_K + i * PQ + d * 2)) * fexp(g63 - gcs[i]); }
            *(bf16x8*)(rec + GR_KT + ((size_t)d * 64 + 32 * half + 8 * q4) * 2) = pack8((f32x4){v[0], v[1], v[2], v[3]}, (f32x4){v[4], v[5], v[6], v[7]}); }
    }
    }
    group_barrier(gbc, gbt);
    if (gt < 128) {
        LAS bf16* vp = (LAS bf16*)(gl + G_V) + gt; LAS bf16* kp = (LAS bf16*)(gl + G_K) + gt;
        f32x2 x[64];
#pragma unroll
        for (int i = 0; i < 64; ++i) {
            f32x4 lr[16];
#pragma unroll
            for (int j4 = 0; j4 < (i + 3) / 4; ++j4) lr[j4] = *(const LAS f32x4*)(Lm + i * PL + 4 * j4);
            const float be = bes[i];
            f32x2 a = {bf2f(vp[i * (PQ / 2)]) * be, bf2f(kp[i * (PQ / 2)]) * be * egs[i]};
            f32x2 acc[4] = {{0.f, 0.f}, {0.f, 0.f}, {0.f, 0.f}, {0.f, 0.f}};
#pragma unroll
            for (int j4 = 0; j4 < (i + 3) / 4; ++j4)
#pragma unroll
                for (int e = 0; e < 4; ++e) if (4 * j4 + e < i) acc[e] += x[4 * j4 + e] * lr[j4][e];
            a -= (acc[0] + acc[1]) + (acc[2] + acc[3]);
            x[i] = a;
        }
#pragma unroll
        for (int i = 0; i < 64; ++i) { const unsigned w = cvtpk(x[i].x, x[i].y);
            vp[i * (PQ / 2)] = (bf16)(w & 0xffffu); kp[i * (PQ / 2)] = (bf16)(w >> 16); }
    }
    group_barrier(gbc, gbt);
    {
        const int row = gt >> 2, seg = gt & 3;
#pragma unroll
        for (int q4 = 0; q4 < 4; ++q4) {
            *(u32x4*)(rec + GR_U + ((size_t)row * 128 + seg * 32 + q4 * 8) * 2) = *(const LAS u32x4*)(gl + G_V + row * PQ + (seg * 32 + q4 * 8) * 2);
            *(u32x4*)(rec + GR_W + ((size_t)row * 128 + seg * 32 + q4 * 8) * 2) = *(const LAS u32x4*)(gl + G_K + row * PQ + (seg * 32 + q4 * 8) * 2); }
    }
    group_barrier(gbc, gbt);
}

constexpr int SP = 272, SPT = 144, SPU = 80;
constexpr int L_QD = 0, L_W = 17408, L_KT = 34816, L_IN = 53248, L_U = 62464, L_BUF = 67584;
constexpr int L_ST = 2 * L_BUF, L_VT = L_ST + 32 * SP, SCAN_LDS = L_VT + 32 * SPT;
static_assert(SCAN_LDS <= 155648, "gdn scan LDS");
__device__ __forceinline__ bf16x8 pack_cc(const f32x4& lo, const f32x4& hi) { const u32x4 w = {cvtpk(lo[0], lo[1]), cvtpk(lo[2], lo[3]), cvtpk(hi[0], hi[1]), cvtpk(hi[2], hi[3])}; return __builtin_bit_cast(bf16x8, w); }
__device__ __forceinline__ void scan_unit(LAS unsigned char* lds, int unit, const unsigned char* REC, const float* GL, bf16* O16  , const int w0) {
    const int tid = otid(w0), wid = __builtin_amdgcn_readfirstlane(tid >> 6), lane = tid & 63, fr = lane & 15, fq = lane >> 4;
    const int bhh = unit >> 2, q4 = unit & 3, b = bhh >> 5, h = bhh & 31, nt = wid & 1, mt = wid >> 1;
    f32x4 S[2];
    S[0] = (f32x4){0.f, 0.f, 0.f, 0.f}; S[1] = (f32x4){0.f, 0.f, 0.f, 0.f};
    u32x4 st[8];
    int srcoff[8], dstoff[8];
#pragma unroll
    for (int i = 0; i < 8; ++i) { const int p = tid + 512 * i; int so, d;
        if (p < 1024) { so = (int)GR_QD + p * 16; d = L_QD + (p >> 4) * SP + (p & 15) * 16; }
        else if (p < 2048) { const int q = p - 1024; so = (int)GR_W + q * 16; d = L_W + (q >> 4) * SP + (q & 15) * 16; }
        else if (p < 3072) { const int q = p - 2048; so = (int)GR_KT + q * 16; d = L_KT + (q >> 3) * SPT + (q & 7) * 16; }
        else if (p < 3584) { const int q = p - 3072; so = (int)GR_IN + q * 16; d = L_IN + (q >> 3) * SPT + (q & 7) * 16; }
        else { const int q = (p - 3584) & 255; so = (int)GR_U + (q >> 2) * 256 + q4 * 64 + (q & 3) * 16; d = L_U + (q >> 2) * SPU + (q & 3) * 16; }
        srcoff[i] = so; dstoff[i] = d; }
    const bool has8 = tid < 256;
#define GDN_ISSUE(c_) do { const unsigned char* rec_ = REC + ((size_t)bhh * 128 + (c_)) * GR_BYTES; \
        _Pragma("unroll") for (int i = 0; i < 7; ++i) st[i] = *(const u32x4*)(rec_ + srcoff[i]); if (has8) st[7] = *(const u32x4*)(rec_ + srcoff[7]); } while (0)
#define GDN_STASH(buf_) do { LAS unsigned char* bp_ = lds + (buf_) * L_BUF; \
        _Pragma("unroll") for (int i = 0; i < 7; ++i) *(LAS u32x4*)(bp_ + dstoff[i]) = st[i]; if (has8) *(LAS u32x4*)(bp_ + dstoff[7]) = st[7]; } while (0)
    { const u32x4 z4 = ozero4(); for (int i = tid; i < (32 * SP) / 16; i += 512) *(LAS u32x4*)(lds + L_ST + i * 16) = z4; }
    GDN_ISSUE(0); GDN_STASH(0); __syncthreads();
    float gl_n = GL[bhh * 128]; asm volatile("" ::: "memory");
    GDN_ISSUE(1);
    bf16* orow = O16 + ((size_t)b * SEQ + 16 * mt + 4 * fq) * 4096 + h * 128 + 32 * q4 + 16 * nt + fr;
    const LAS unsigned char* stp = lds + L_ST + (16 * nt + fr) * SP + 16 * fq;
    const LAS unsigned char* vtp = lds + L_VT + (16 * nt + fr) * SPT + 16 * fq;
#pragma unroll 1
    for (int c = 0; c < GDN_NCHUNK; ++c) {
        const LAS unsigned char* bp = lds + (c & 1) * L_BUF;
        const float glast = gl_n;
        bf16x8 Sb[4];
#pragma unroll
        for (int s = 0; s < 4; ++s) Sb[s] = *(const LAS bf16x8*)(stp + 64 * s);
        f32x4 aw = {0.f, 0.f, 0.f, 0.f}, ao = {0.f, 0.f, 0.f, 0.f};
#pragma unroll
        for (int s = 0; s < 4; ++s) { aw = __builtin_amdgcn_mfma_f32_16x16x32_bf16(*(const LAS bf16x8*)(bp + L_W + (16 * mt + fr) * SP + 64 * s + 16 * fq), Sb[s], aw, 0, 0, 0);
            ao = __builtin_amdgcn_mfma_f32_16x16x32_bf16(*(const LAS bf16x8*)(bp + L_QD + (16 * mt + fr) * SP + 64 * s + 16 * fq), Sb[s], ao, 0, 0, 0); }
        f32x4 vn;
#pragma unroll
        for (int e = 0; e < 4; ++e) vn[e] = bf2f(*(const LAS bf16*)(bp + L_U + (16 * mt + 4 * fq + e) * SPU + (16 * nt + fr) * 2)) - aw[e];
        *(LAS u32x2*)(lds + L_VT + (16 * nt + fr) * SPT + (16 * mt + 4 * fq) * 2) = (u32x2){cvtpk(vn[0], vn[1]), cvtpk(vn[2], vn[3])};
        __syncthreads();
        bf16x8 vb[2];
        vb[0] = *(const LAS bf16x8*)vtp; vb[1] = *(const LAS bf16x8*)(vtp + 64);
#pragma unroll
        for (int s2 = 0; s2 < 2; ++s2) ao = __builtin_amdgcn_mfma_f32_16x16x32_bf16(*(const LAS bf16x8*)(bp + L_IN + (16 * mt + fr) * SPT + 64 * s2 + 16 * fq), vb[s2], ao, 0, 0, 0);
#pragma unroll
        for (int kk = 0; kk < 2; ++kk) { f32x4 a = S[kk] * glast;
#pragma unroll
            for (int s2 = 0; s2 < 2; ++s2) a = __builtin_amdgcn_mfma_f32_16x16x32_bf16(*(const LAS bf16x8*)(bp + L_KT + (16 * (2 * mt + kk) + fr) * SPT + 64 * s2 + 16 * fq), vb[s2], a, 0, 0, 0);
            S[kk] = a;
            *(LAS u32x2*)(lds + L_ST + (16 * nt + fr) * SP + (16 * (2 * mt + kk) + 4 * fq) * 2) = (u32x2){cvtpk(a[0], a[1]), cvtpk(a[2], a[3])}; }
#pragma unroll
        for (int e = 0; e < 4; ++e) orow[(size_t)(c * 64 + e) * 4096] = (bf16)(cvtpk(ao[e], 0.f) & 0xffffu);
        if (c + 1 < GDN_NCHUNK) GDN_STASH((c + 1) & 1);
        __syncthreads();
        if (c + 1 < GDN_NCHUNK) { gl_n = GL[bhh * 128 + c + 1]; asm volatile("" ::: "memory"); }
        if (c + 2 < GDN_NCHUNK) GDN_ISSUE(c + 2);
    }
#undef GDN_ISSUE
#undef GDN_STASH
}
__device__ __forceinline__ void normgate(int gwv, int NGW, int lane, const bf16* O16, const bf16* PROJ, const float* normw, bf16* MIX) {
    const f32x4 n0 = *(const f32x4*)(normw + ((lane & 15) * 8)), n1 = *(const f32x4*)(normw + ((lane & 15) * 8) + 4);
#pragma unroll 2
    for (int it = gwv; it < M_TOK * 8; it += NGW) { const int row = it >> 3, c8 = (it & 7) * 512 + lane * 8;
        const u32x4 ow = *(const u32x4*)(O16 + (size_t)row * 4096 + c8); const f32x4 o0 = {bflo(ow.x), bfhi(ow.x), bflo(ow.y), bfhi(ow.y)}, o1 = {bflo(ow.z), bfhi(ow.z), bflo(ow.w), bfhi(ow.w)};
        const u32x4 zw = *(const u32x4*)(PROJ + (size_t)row * LDP + ZCOL + c8); float z[8]; unpack8(zw, z);
        float q = (o0[0] * o0[0] + o0[1] * o0[1]) + (o0[2] * o0[2] + o0[3] * o0[3]) + (o1[0] * o1[0] + o1[1] * o1[1]) + (o1[2] * o1[2] + o1[3] * o1[3]);
        q += __shfl_xor(q, 1); q += __shfl_xor(q, 2); q += __shfl_xor(q, 4); q += __shfl_xor(q, 8);
        const float rs = __builtin_amdgcn_rsqf(q * (1.0f / 128.0f) + NORM_EPS);
        f32x4 r0, r1;
#pragma unroll
        for (int e = 0; e < 4; ++e) { r0[e] = o0[e] * rs * n0[e] * siluf_(z[e]); r1[e] = o1[e] * rs * n1[e] * siluf_(z[4 + e]); }
        *(bf16x8*)(MIX + (size_t)row * 4096 + c8) = pack8(r0, r1); }
}
}
namespace s5 {
__device__ __forceinline__ void sincos_cw(float x, float& s, float& c) {
    const float kf = rintf(x * 0.6366197723675814f); const int k = (int)kf;
    float r = fmaf(kf, -1.5703125f, x); r = fmaf(kf, -4.837512969970703125e-4f, r); r = fmaf(kf, -7.54978995489188e-8f, r);
    const float r2 = r * r;
    float c1 = -1.9515295891e-4f, c2 = 8.3321608736e-3f, c3 = 2.443315711809948e-5f, c4 = -1.388731625493765e-3f; asm volatile("" : "+v"(c1), "+v"(c2), "+v"(c3), "+v"(c4));
    const float sp = fmaf(r * r2, fmaf(r2, fmaf(r2, c1, c2), -1.6666654611e-1f), r);
    const float cp = fmaf(r2 * r2, fmaf(r2, fmaf(r2, c3, c4), 4.166664568298827e-2f), fmaf(r2, -0.5f, 1.0f));
    const int q = k & 3;
    s = (q == 0) ? sp : (q == 1) ? cp : (q == 2) ? -sp : -cp;
    c = (q == 0) ? cp : (q == 1) ? -sp : (q == 2) ? -cp : sp;
}
__device__ __forceinline__ void zoh_of(int g, int p, const float* LRE, const float* LIM, const float* LSTEP, float& lr, float& li, float& zr, float& zi) {
    const float lam_re = LRE[g * 64 + p], lam_im = LIM[g * 64 + p], step = fexp(LSTEP[g]);
    const float mag = fexp(lam_re * step); float sn, cs; sincos_cw(lam_im * step, sn, cs);
    lr = mag * cs; li = mag * sn;
    const float den = lam_re * lam_re + lam_im * lam_im, num_re = lr - 1.0f;
    zr = (num_re * lam_re + li * lam_im) / den; zi = (li * lam_re - num_re * lam_im) / den;
}
struct Disc { float lr, li; bf16x8 bh[8], bl[8]; };
__device__ __forceinline__ void discretise(Disc& d, int g, int lane, const float* LRE, const float* LIM, const float* BRE, const float* BIM, const float* LSTEP) {
    float zr, zi; zoh_of(g, lane, LRE, LIM, LSTEP, d.lr, d.li, zr, zi);
    const int fr = lane & 15, fq = lane >> 4, n0 = 8 * (fq & 1);
#pragma unroll
    for (int t = 0; t < 4; ++t) { const int p = 16 * t + fr; float lr, li; zoh_of(g, p, LRE, LIM, LSTEP, lr, li, zr, zi);
        const float* br = BRE + (size_t)(g * 64 + p) * 16 + n0; const float* bi = BIM + (size_t)(g * 64 + p) * 16 + n0;
        const f32x4 r0 = *(const f32x4*)br, r1 = *(const f32x4*)(br + 4), i0 = *(const f32x4*)bi, i1 = *(const f32x4*)(bi + 4);
        const f32x4 re0 = r0 * zr - i0 * zi, re1 = r1 * zr - i1 * zi, im0 = i0 * zr + r0 * zi, im1 = i1 * zr + r1 * zi;
        const u32x4 rh = __builtin_bit_cast(u32x4, pack8(re0, re1)), ih = __builtin_bit_cast(u32x4, pack8(im0, im1));
        float rhf[8], ihf[8]; unpack8(rh, rhf); unpack8(ih, ihf);
        const f32x4 rl0 = {re0[0] - rhf[0], re0[1] - rhf[1], re0[2] - rhf[2], re0[3] - rhf[3]}, rl1 = {re1[0] - rhf[4], re1[1] - rhf[5], re1[2] - rhf[6], re1[3] - rhf[7]};
        const f32x4 il0 = {im0[0] - ihf[0], im0[1] - ihf[1], im0[2] - ihf[2], im0[3] - ihf[3]}, il1 = {im1[0] - ihf[4], im1[1] - ihf[5], im1[2] - ihf[6], im1[3] - ihf[7]};
        const bf16x8 zero8 = {0, 0, 0, 0, 0, 0, 0, 0};
        d.bh[t] = __builtin_bit_cast(bf16x8, rh); d.bh[4 + t] = __builtin_bit_cast(bf16x8, ih);
        d.bl[t] = fq < 2 ? pack8(rl0, rl1) : zero8; d.bl[4 + t] = fq < 2 ? pack8(il0, il1) : zero8; }
}
constexpr int BUP = 20;
__device__ __forceinline__ void bu_tile(const Disc& d, const LAS float* us, LAS float* but, int t0, int lane) {
    const int fr = lane & 15, fq = lane >> 4;
    const f32x4 u0 = *(const LAS f32x4*)(us + (t0 + fr) * 16 + 8 * (fq & 1)), u1 = *(const LAS f32x4*)(us + (t0 + fr) * 16 + 8 * (fq & 1) + 4);
    const u32x4 uh = __builtin_bit_cast(u32x4, pack8(u0, u1)); float uhf[8]; unpack8(uh, uhf);
    const f32x4 l0 = {u0[0] - uhf[0], u0[1] - uhf[1], u0[2] - uhf[2], u0[3] - uhf[3]}, l1 = {u1[0] - uhf[4], u1[1] - uhf[5], u1[2] - uhf[6], u1[3] - uhf[7]};
    const bf16x8 af = fq < 2 ? __builtin_bit_cast(bf16x8, uh) : pack8(l0, l1);
    f32x4 accs[8];
#pragma unroll
    for (int ct = 0; ct < 8; ++ct) { f32x4 acc = {0.f, 0.f, 0.f, 0.f};
        acc = __builtin_amdgcn_mfma_f32_16x16x32_bf16(af, d.bh[ct], acc, 0, 0, 0);
        accs[ct] = __builtin_amdgcn_mfma_f32_16x16x32_bf16(af, d.bl[ct], acc, 0, 0, 0); }
    asm volatile("s_nop 15\n\ts_nop 15" : "+v"(accs[0]), "+v"(accs[1]), "+v"(accs[2]), "+v"(accs[3]), "+v"(accs[4]), "+v"(accs[5]), "+v"(accs[6]), "+v"(accs[7]));
#pragma unroll
    for (int ct = 0; ct < 8; ++ct) *(LAS f32x4*)(but + (16 * ct + fr) * BUP + 4 * fq) = accs[ct];
}
struct Slab { f32x4 r[4]; };
__device__ __forceinline__ void slab_issue(Slab& s, const float* up  , int lane) {
#pragma unroll
    for (int i = 0; i < 4; ++i) { const int pc = 64 * i + lane; s.r[i] = *(const f32x4*)(up + (size_t)(pc >> 2) * 4096 + (pc & 3) * 4); }
}
__device__ __forceinline__ void slab_store(const Slab& s, LAS float* us, int lane) {
#pragma unroll
    for (int i = 0; i < 4; ++i) { const int pc = 64 * i + lane; *(LAS f32x4*)(us + pc * 4) = s.r[i]; }
}
__device__ __forceinline__ void pass1(LAS float* us, LAS float* but, int gwv, int NGW, int lane, const float* U32, const float* LRE, const float* LIM, const float* BRE, const float* BIM, const float* LSTEP, f32x2* ENDST) {
#pragma unroll 1
    for (int wu = gwv; wu < BATCH * SSM_G * SSM_NSEG; wu += NGW) {
        const int g = wu & 255, seg = (wu >> 8) & (SSM_NSEG - 1), b = wu >> 13, bg = b * 256 + g;
        Disc d; discretise(d, g, lane, LRE, LIM, BRE, BIM, LSTEP);
        const float* up = U32 + ((size_t)b * SEQ + (size_t)seg * SSM_SL) * 4096 + 16 * g;
        float xr = 0.f, xi = 0.f;
        Slab sl; slab_issue(sl, up, lane);
#pragma unroll 1
        for (int tb = 0; tb < SSM_SL; tb += 64) {
            slab_store(sl, us, lane);
            if (tb + 64 < SSM_SL) slab_issue(sl, up + (size_t)(tb + 64) * 4096, lane);
#pragma unroll 1
            for (int t0 = 0; t0 < 64; t0 += 16) {
                bu_tile(d, us, but, t0, lane);
                f32x4 brv[4], biv[4];
#pragma unroll
                for (int q = 0; q < 4; ++q) { brv[q] = *(const LAS f32x4*)(but + lane * BUP + 4 * q); biv[q] = *(const LAS f32x4*)(but + (64 + lane) * BUP + 4 * q); }
#pragma unroll
                for (int t = 0; t < 16; ++t) { const float br = brv[t >> 2][t & 3], bi = biv[t >> 2][t & 3];
                    const float nr = fmaf(d.lr, xr, fmaf(-d.li, xi, br)), ni = fmaf(d.lr, xi, fmaf(d.li, xr, bi)); xr = nr; xi = ni; }
            }
        }
        ENDST[((size_t)bg * SSM_NSEG + seg) * 64 + lane] = (f32x2){xr, xi};
    }
}
__device__ __forceinline__ float gelu_tanh(float y) { const float a = 0.7978845608028654f * (y + 0.044715f * y * y * y); const float t = 1.0f - 2.0f * __builtin_amdgcn_rcpf(1.0f + fexp(2.0f * a)); return 0.5f * y * (1.0f + t); }
constexpr int XP = 272;
__device__ __forceinline__ void pass2(LAS unsigned char* xt  , int gwv, int NGW, int lane, const float* U32, const float* LRE, const float* LIM, const float* BRE, const float* BIM,
                                      const float* CRE, const float* CIM, const float* LSTEP, const float* DSK, const f32x2* ENDST, bf16* Y1) {
    const int fr = lane & 15, fq = lane >> 4;
    LAS float* us = (LAS float*)(xt + 16 * XP); LAS float* but = (LAS float*)(xt + 16 * XP + 4096);
#pragma unroll 1
    for (int wu = gwv; wu < BATCH * SSM_G * SSM_NSEG; wu += NGW) {
        const int g = wu & 255, seg = (wu >> 8) & (SSM_NSEG - 1), b = wu >> 13, bg = b * 256 + g;
        Disc d; discretise(d, g, lane, LRE, LIM, BRE, BIM, LSTEP);
        const size_t row0 = (size_t)b * SEQ + (size_t)seg * SSM_SL;
        const float* up = U32 + row0 * 4096 + 16 * g;
        Slab sl; slab_issue(sl, up, lane);
        float pr = d.lr, pi = d.li;
#pragma unroll
        for (int i = 0; i < 8; ++i) { const float a = pr * pr - pi * pi, c = 2.0f * pr * pi; pr = a; pi = c; }
        float xr = 0.f, xi = 0.f;
#pragma unroll 1
        for (int s = 0; s < seg; ++s) { const f32x2 e = ENDST[((size_t)bg * SSM_NSEG + s) * 64 + lane];
            const float nr = fmaf(pr, xr, fmaf(-pi, xi, e.x)), ni = fmaf(pr, xi, fmaf(pi, xr, e.y)); xr = nr; xi = ni; }
        bf16x8 cf[4];
#pragma unroll
        for (int s = 0; s < 4; ++s) { const float* cp = (s < 2 ? CRE : CIM) + (size_t)(g * 16 + fr) * 64 + 32 * (s & 1) + 8 * fq; const float sg = s < 2 ? 1.0f : -1.0f;
            const f32x4 a = *(const f32x4*)cp * sg, c = *(const f32x4*)(cp + 4) * sg; cf[s] = pack8(a, c); }
        const float dsk = DSK[16 * g + fr];
#pragma unroll 1
        for (int tb = 0; tb < SSM_SL; tb += 64) {
            slab_store(sl, us, lane);
            if (tb + 64 < SSM_SL) slab_issue(sl, up + (size_t)(tb + 64) * 4096, lane);
#pragma unroll 1
            for (int t0 = 0; t0 < 64; t0 += 16) {
                bu_tile(d, us, but, t0, lane);
                f32x4 brv[4], biv[4];
#pragma unroll
                for (int q = 0; q < 4; ++q) { brv[q] = *(const LAS f32x4*)(but + lane * BUP + 4 * q); biv[q] = *(const LAS f32x4*)(but + (64 + lane) * BUP + 4 * q); }
#pragma unroll
                for (int t = 0; t < 16; ++t) { const float br = brv[t >> 2][t & 3], bi = biv[t >> 2][t & 3];
                    const float nr = fmaf(d.lr, xr, fmaf(-d.li, xi, br)), ni = fmaf(d.lr, xi, fmaf(d.li, xr, bi)); xr = nr; xi = ni;
                    const unsigned w = cvtpk(xr, xi);
                    *(LAS bf16*)(xt + t * XP + lane * 2) = (bf16)(w & 0xffffu); *(LAS bf16*)(xt + t * XP + 128 + lane * 2) = (bf16)(w >> 16); }
                LDS_WAIT();
                f32x4 acc = {0.f, 0.f, 0.f, 0.f};
#pragma unroll
                for (int s = 0; s < 4; ++s) { const bf16x8 xa = *(const LAS bf16x8*)(xt + fr * XP + (32 * s + 8 * fq) * 2); acc = __builtin_amdgcn_mfma_f32_16x16x32_bf16(xa, cf[s], acc, 0, 0, 0); }
#pragma unroll
                for (int e = 0; e < 4; ++e) { const int tl = t0 + 4 * fq + e; const float u = us[tl * 16 + fr];
                    const float y = gelu_tanh(acc[e] + dsk * u);
                    Y1[(row0 + tb + tl) * 4096 + 16 * g + fr] = (bf16)(cvtpk(y, 0.f) & 0xffffu); }
                LDS_WAIT();
            }
        }
    }
}
}
constexpr int PH_PER_LAYER = 10, PH_FINAL = 40, PH_END = 41;
__host__ __device__ constexpr bool phase_exists(int ph) {
    if (ph == PH_FINAL) return true; if (ph < 0 || ph >= PH_FINAL) return false;
    const int L = ph / PH_PER_LAYER, k = ph % PH_PER_LAYER, kind = L % 3;
    if (k == 4) return kind != 0; return k <= 6;
}
typedef const __attribute__((address_space(4))) Args* kargs_t;
#define KARGS() ({ kargs_t p_ = (kargs_t)__builtin_amdgcn_kernarg_segment_ptr(); asm volatile("" : "+s"(p_)); p_; })
#define WSP(T, off) ((T*)(ws + (off)))
__global__ void __launch_bounds__(NTHR, 2) trunk_fwd(Args args_unused) {
    extern __shared__ __attribute__((aligned(16))) unsigned char lds_raw[];
    LAS unsigned char* lds = (LAS unsigned char*)lds_raw;
    const int w0 = __builtin_amdgcn_readfirstlane(threadIdx.x >> 6);
    const int G = gridDim.x, bx = blockIdx.x, vcu = (G % 8 == 0) ? (bx % 8) * (G / 8) + bx / 8 : bx, NGW = G * NWAVES;
#define TIDS() const int tid = otid(w0), lane = tid & 63, wid = __builtin_amdgcn_readfirstlane(tid >> 6), gwv = vcu * NWAVES + wid; (void)lane; (void)gwv
    { volatile LAS unsigned* MISC = (volatile LAS unsigned*)(lds + MISC_OFF); if (threadIdx.x < 32) MISC[threadIdx.x] = 0u; }
    __syncthreads();
    int lo, hi;
    { kargs_t ap = KARGS(); lo = ap->ph_lo; hi = ap->ph_hi;
      if (hi - lo > 1) (void)xcd_barrier_post((unsigned*)(ap->ws + WS_CTL) + CW_BAR + ap->li * XCD_BAR_WORDS, (volatile LAS unsigned*)(lds + MISC_OFF) + 8); }
#define IN(k) (lo <= (k) && (k) < hi)
#define SEAM(k) do { if ((k) + 1 < hi) { kargs_t ap_ = KARGS(); XcdBarrier b_; b_.bar = (unsigned*)(ap_->ws + WS_CTL) + CW_BAR + ap_->li * XCD_BAR_WORDS; b_.x = xb_xcc_id(); \
        b_.st = (volatile LAS unsigned*)(lds + MISC_OFF) + 8; b_.tid = (unsigned)otid(w0); xcd_barrier(b_); } } while (0)

#pragma unroll 1
    for (int L = 0; L < DEPTH; ++L) {
        const int base = L * PH_PER_LAYER, kind = L % 3, j = L / 3;

        if (IN(base + 0)) {
            kargs_t ap = KARGS(); unsigned char* ws = ap->ws; TIDS();
            LAS float* scr = (LAS float*)(lds + wid * 16384);
            const int n_in = kind == 0 ? 16416 : kind == 1 ? 16448 : 8192;
            const float* w_in = kind == 0 ? ap->in[I_FOX_WIN] + (size_t)j * 4096 * 16416 : kind == 1 ? ap->in[I_GDN_WIN] : ap->in[I_SSM_WIN];
            const float* w_out = kind == 0 ? ap->in[I_FOX_WOUT] + (size_t)j * 4096 * 4096 : kind == 1 ? ap->in[I_GDN_WOUT] : ap->in[I_SSM_WOUT];
            transpose_matrix(w_out, 4096, 4096, WSP(bf16, WS_WOUT), 4096, WSP(bf16, WS_WOUT), nullptr, scr, gwv, NGW, lane);
            transpose_matrix(ap->in[I_PLE_WGATE] + (size_t)L * 4096 * 4096, 4096, 4096, WSP(bf16, WS_WGATE), 4096, WSP(bf16, WS_WGATE), ap->in[I_NORM_PLE] + (size_t)L * D_MODEL, scr, gwv, NGW, lane);
            transpose_matrix(ap->in[I_PLE_WPROJ] + (size_t)L * 256 * 4096, 256, 4096, WSP(bf16, WS_WPP), 4096, WSP(bf16, WS_WPP), nullptr, scr, gwv, NGW, lane);
            if (kind == 2) transpose_matrix(ap->in[I_SSM_WGLU], 4096, 4096, WSP(bf16, WS_WGLU), 4096, WSP(bf16, WS_WGLU), nullptr, scr, gwv, NGW, lane);
            transpose_matrix(w_in, 4096, n_in, WSP(bf16, WS_WIN), 16384, WSP(bf16, WS_WSK), ap->in[I_NORM_MIX] + (size_t)L * D_MODEL, scr, gwv, NGW, lane);
            { const float* p = ap->in[I_P] + (size_t)L * M_TOK * PLE_DIM; bf16* P_BF = WSP(bf16, WS_PBF);
              for (size_t i = (size_t)bx * NTHR + tid; i < (size_t)M_TOK * PLE_DIM / 8; i += (size_t)G * NTHR) {
                  const f32x4 a = *(const f32x4*)(p + i * 8), b = *(const f32x4*)(p + i * 8 + 4); *(bf16x8*)(P_BF + i * 8) = pack8(a, b); } }
            if (L == 0) { const float* x = ap->in[I_X]; bf16* X0 = WSP(bf16, WS_X0); ssq_t* ssq_in = SSQ_PTR(0);
                for (int m = gwv; m < M_TOK; m += NGW) { const float s = row_to_bf16(x + (size_t)m * 4096, X0 + (size_t)m * 4096, lane); if (lane == 0) ssq_in[m] = ssq_fix(s); } }
            __syncthreads();
            SEAM(base + 0);
        }
        if (IN(base + 1)) {
            kargs_t ap = KARGS(); unsigned char* ws = ap->ws; TIDS();
            const bf16* A1 = WSP(bf16, WS_X0); const ssq_t* ssq_in = SSQ_PTR(2 * L);
            if (kind != 2) {
                LAS float* res = (LAS float*)lds; const bf16* W_SK = WSP(bf16, WS_WSK);
                for (int un = vcu; un < M_TOK / 64; un += G) {
                    const int r0 = un * 64;
                    if (kind == 0) {
                        float* CUML = WSP(float, WS_SMALL + SM_CUML); float* TTOT = WSP(float, WS_SMALL + SM_TTOT);
                        skinny_gemm<32>(A1, W_SK, ssq_in, r0, res, wid, lane);
                        __syncthreads();
                        if (tid < 32) { const int h = tid; const float bf = ap->in[I_FOX_BF][j * 32 + h]; float run = 0.f;
                            for (int r = 0; r < 64; ++r) { const float x = res[r * 32 + h] + bf; const float lf = fminf(x, 0.f) - flog(1.0f + fexp(-fabsf(x))); run += lf; CUML[(size_t)(r0 + r) * 32 + h] = run; }
                            TTOT[(size_t)un * 32 + h] = run; }
                    } else {
                        float* BETA = WSP(float, WS_SMALL + SM_BETA); float* GLOG = WSP(float, WS_SMALL + SM_GLOG);
                        const float* dtb = ap->in[I_GDN_DTB]; const float* alog = ap->in[I_GDN_ALOG];
                        skinny_gemm<64>(A1, W_SK, ssq_in, r0, res, wid, lane);
                        __syncthreads();
                        for (int e = tid; e < 64 * 32; e += NTHR) { const int r = e >> 5, h = e & 31;
                            BETA[(size_t)(r0 + r) * 32 + h] = sigmoidf_(res[r * 64 + h]);
                            const float x = res[r * 64 + 32 + h] + dtb[h]; const float sp = fmaxf(x, 0.f) + flog(1.0f + fexp(-fabsf(x)));
                            GLOG[(size_t)(r0 + r) * 32 + h] = -fexp(alog[h]) * sp; }
                    }
                    __syncthreads();
                }
            }
            const int n_main = kind == 2 ? 8192 : 16384;
            pg8::Gemm g{A1, WSP(bf16, WS_WIN), M_TOK, n_main, 4096}; pg8::StaticOrder S; S.init(M_TOK, n_main, G, bx);
            pg8::EpiProj E{kind == 2 ? WSP(bf16, WS_PROJ) + 8192 : WSP(bf16, WS_PROJ), LDP, ssq_in, WSP(float, WS_SCR + SS_U32), kind == 2 ? 4096 : 0};
            pg8::gemm_phase<pg8::EpiProj, pg8::StaticOrder, true, true>(lds, g, S, E, w0);
            SEAM(base + 1);
        }
        if (IN(base + 2)) {
            kargs_t ap = KARGS(); unsigned char* ws = ap->ws; TIDS();
            if (kind == 0) {
                { const bf16* PROJ = WSP(bf16, WS_PROJ); float* QN2 = WSP(float, WS_SMALL + SM_QN2); float* KN2 = WSP(float, WS_SMALL + SM_KN2);
                  for (int it = gwv; it < BATCH * NHEAD * 128; it += NGW) fox::norm_item(PROJ, QN2, KN2, it, lane); }
                { const float* CUML = WSP(float, WS_SMALL + SM_CUML); const float* TTOT = WSP(float, WS_SMALL + SM_TTOT); float* CUM = WSP(float, WS_SMALL + SM_CUM);
                  LAS float* ps = (LAS float*)lds; LAS float* ct = ps + 512; LAS float* pr = ct + 64 * 33;
                  for (int un = vcu; un < BATCH * 128; un += G) { const int b = un >> 7, tile = un & 127, h = tid & 31, part = tid >> 5;
                      float sum = 0.f;
                      for (int tp = part; tp < tile; tp += 16) sum += TTOT[(size_t)(b * 128 + tp) * 32 + h];
                      ps[part * 32 + h] = sum;
                      { const f32x4 cv = *(const f32x4*)(CUML + ((size_t)b * SEQ + 64 * tile) * 32 + tid * 4); const int t = (tid * 4) >> 5, hh = (tid * 4) & 31;
#pragma unroll
                        for (int e = 0; e < 4; ++e) ct[t * 33 + hh + e] = cv[e]; }
                      __syncthreads();
                      if (tid < 32) { float p = 0.f;
#pragma unroll
                          for (int q = 0; q < 16; ++q) p += ps[q * 32 + tid];
                          pr[tid] = p; }
                      __syncthreads();
                      { const int t = tid & 63, hg = tid >> 6;
#pragma unroll
                        for (int k = 0; k < 4; ++k) { const int hh = hg * 4 + k; CUM[(size_t)(b * 32 + hh) * SEQ + 64 * tile + t] = pr[hh] + ct[t * 33 + hh]; } }
                      __syncthreads(); } }
            } else if (kind == 1) {
                const bf16* PROJ = WSP(bf16, WS_PROJ); const float* convw = ap->in[I_GDN_CONV]; const float* BETA = WSP(float, WS_SMALL + SM_BETA); const float* GLOG = WSP(float, WS_SMALL + SM_GLOG);
                float* GLT = WSP(float, WS_SMALL + SM_GL); unsigned char* REC = ws + WS_SCR;
                if (tid < 2) *(LAS unsigned*)(lds + tid * gdn::GRP_BYTES + gdn::G_S + 768) = 0u;
                __syncthreads();
                unsigned gbt = 0u;
                for (int pi = vcu; pi < BATCH * NHEAD * GDN_NCHUNK / 2; pi += G) gdn::prep_pair(lds, 2 * pi, PROJ, convw, BETA, GLOG, GLT, REC, gbt, w0);
                __syncthreads();
            } else if (kind == 2) {
                s5::pass1((LAS float*)(lds + wid * 16384), (LAS float*)(lds + wid * 16384 + 4096), gwv, NGW, lane, WSP(float, WS_SCR + SS_U32), ap->in[I_SSM_LRE], ap->in[I_SSM_LIM], ap->in[I_SSM_BRE], ap->in[I_SSM_BIM], ap->in[I_SSM_LSTEP], WSP(f32x2, WS_ENDST));
            }
            SEAM(base + 2);
        }
        if (IN(base + 3)) {
            kargs_t ap = KARGS(); unsigned char* ws = ap->ws; TIDS();
            if (kind == 0) fox::attn_phase((char*)lds_raw, WSP(bf16, WS_PROJ), WSP(bf16, WS_MIX), WSP(float, WS_SMALL + SM_CUM), WSP(float, WS_SMALL + SM_QN2), WSP(float, WS_SMALL + SM_KN2), vcu, G, w0);
            else if (kind == 1) { for (int un = vcu; un < BATCH * NHEAD * 4; un += G) gdn::scan_unit(lds, un, ws + WS_SCR, WSP(float, WS_SMALL + SM_GL), (bf16*)ap->out, w0); }
            else if (kind == 2) s5::pass2(lds + wid * 18944, gwv, NGW, lane, WSP(float, WS_SCR + SS_U32), ap->in[I_SSM_LRE], ap->in[I_SSM_LIM], ap->in[I_SSM_BRE], ap->in[I_SSM_BIM], ap->in[I_SSM_CRE], ap->in[I_SSM_CIM],
                           ap->in[I_SSM_LSTEP], ap->in[I_SSM_D], WSP(f32x2, WS_ENDST), WSP(bf16, WS_SCR + SS_Y1));
            SEAM(base + 3);
        }
        if (IN(base + 4) && kind == 1) {
            kargs_t ap = KARGS(); unsigned char* ws = ap->ws; TIDS();
            if (kind == 1) gdn::normgate(gwv, NGW, lane, (const bf16*)ap->out, WSP(bf16, WS_PROJ), ap->in[I_GDN_NORM], WSP(bf16, WS_MIX));
            SEAM(base + 4);
        }
        if (IN(base + 4) && kind == 2) {
            kargs_t ap = KARGS(); unsigned char* ws = ap->ws; TIDS();
            pg8::Gemm g{WSP(bf16, WS_SCR + SS_Y1), WSP(bf16, WS_WGLU), M_TOK, 4096, 4096}; pg8::StaticOrder S; S.init(M_TOK, 4096, G, bx);
            pg8::EpiGlu E{WSP(bf16, WS_MIX), WSP(bf16, WS_SCR + SS_Y1), WSP(bf16, WS_PROJ) + ZCOL, LDP, ap->in[I_SSM_BGLU]};
            if (kind == 2) pg8::gemm_phase<pg8::EpiGlu, pg8::StaticOrder, true, true>(lds, g, S, E, w0);
            SEAM(base + 4);
        }
        if (IN(base + 5)) {
            { kargs_t ap = KARGS(); unsigned char* ws = ap->ws;
                  pg8::Gemm g{WSP(bf16, WS_MIX), WSP(bf16, WS_WOUT), M_TOK, 4096, 4096}; pg8::StaticOrder S; S.init(M_TOK, 4096, G, bx);
                  pg8::EpiOut E{WSP(bf16, WS_X0), WSP(bf16, WS_X1), SSQ_PTR(2 * L + 1)};
                  pg8::gemm_phase<pg8::EpiOut, pg8::StaticOrder, true, true>(lds, g, S, E, w0); }
            { kargs_t ap = KARGS(); unsigned char* ws = ap->ws;
                  pg8::Gemm g{WSP(bf16, WS_PBF), WSP(bf16, WS_WPP), M_TOK, 4096, 256}; pg8::StaticOrder S; S.init(M_TOK, 4096, G, bx);
                  pg8::EpiProj E{WSP(bf16, WS_PP), 4096, nullptr, nullptr, 0};
                  pg8::gemm_phase<pg8::EpiProj, pg8::StaticOrder, true, true>(lds, g, S, E, w0); }
            SEAM(base + 5);
        }
        if (IN(base + 6)) {
            kargs_t ap = KARGS(); unsigned char* ws = ap->ws; TIDS();
            pg8::Gemm g{WSP(bf16, WS_X1), WSP(bf16, WS_WGATE), M_TOK, 4096, 4096}; pg8::StaticOrder S; S.init(M_TOK, 4096, G, bx);
            pg8::EpiGate E{WSP(bf16, WS_X1), WSP(bf16, WS_X0), WSP(bf16, WS_PP), SSQ_PTR(2 * L + 1), SSQ_PTR(2 * L + 2)};
            pg8::gemm_phase<pg8::EpiGate, pg8::StaticOrder, true, true>(lds, g, S, E, w0);
            SEAM(base + 6);
        }
    }
    if (IN(PH_FINAL)) {
        kargs_t ap = KARGS(); unsigned char* ws = ap->ws; float* H = ap->out; TIDS();
        const float* gf = ap->in[I_FINAL_NORM]; const ssq_t* ssq = SSQ_PTR(8); const bf16* X0 = WSP(bf16, WS_X0);
        const unsigned bad = __hip_atomic_load(WSP(unsigned, WS_CTL) + CW_BAR + XB_TMO, __ATOMIC_RELAXED, __HIP_MEMORY_SCOPE_AGENT);
        for (int m = gwv; m < M_TOK; m += NGW) { const float rs = bad ? __builtin_nanf("") : __builtin_amdgcn_rsqf(ssq_val(ssq[m]) * (1.0f / 4096.0f) + NORM_EPS); float* row = H + (size_t)m * 4096;
#pragma unroll
            for (int jj = 0; jj < 8; ++jj) { const int c = (jj * 64 + lane) * 8; const u32x4 w = *(const u32x4*)(X0 + (size_t)m * 4096 + c);
                const f32x4 g0 = *(const f32x4*)(gf + c), g1 = *(const f32x4*)(gf + c + 4);
                const f32x4 v0 = {bflo(w.x), bfhi(w.x), bflo(w.y), bfhi(w.y)}, v1 = {bflo(w.z), bfhi(w.z), bflo(w.w), bfhi(w.w)};
                *(f32x4*)(row + c) = v0 * rs * g0; *(f32x4*)(row + c + 4) = v1 * rs * g1; } }
    }
#undef IN
#undef SEAM
}

extern "C" void kernel_launch(void* const* d_in, const int* in_sizes, int n_in, void* d_out, int out_size, void* d_ws, size_t ws_size, hipStream_t stream) {
    static int grid = 0;
    if (grid == 0) {
        if (n_in != 28 || out_size != M_TOK * D_MODEL || ws_size < WS_END) { fprintf(stderr, "kernel_launch: unexpected shapes (n_in %d, out %d, ws %zu)\n", n_in, out_size, ws_size); grid = -1; return; }
        int dev = 0, cus = 0, per_cu = 0;
        if (hipGetDevice(&dev) != hipSuccess || hipDeviceGetAttribute(&cus, hipDeviceAttributeMultiprocessorCount, dev) != hipSuccess) { grid = -1; return; }
        if (hipFuncSetAttribute((const void*)trunk_fwd, hipFuncAttributeMaxDynamicSharedMemorySize, LDS_BYTES) != hipSuccess) { fprintf(stderr, "kernel_launch: hipFuncSetAttribute failed\n"); grid = -1; return; }
        if (hipOccupancyMaxActiveBlocksPerMultiprocessor(&per_cu, (const void*)trunk_fwd, NTHR, LDS_BYTES) != hipSuccess || per_cu < 1) { fprintf(stderr, "kernel_launch: occupancy query says %d\n", per_cu); per_cu = 1; }
        (void)hipGetLastError();
        grid = cus;
    }
    if (grid < 0) return;
    if (hipMemsetAsync((char*)d_ws + WS_CTL, 0, CTL_ZERO_BYTES, stream) != hipSuccess) return;
    Args a{};
    for (int i = 0; i < 28; ++i) a.in[i] = (const float*)d_in[i];
    a.out = (float*)d_out; a.ws = (unsigned char*)d_ws;
#if MK_PER_PHASE
    int li = 0;
    for (int ph = 0; ph < PH_END; ++ph) { if (!phase_exists(ph)) continue;
        a.ph_lo = ph; a.ph_hi = ph + 1; a.li = li++; a.pad = 0;
        hipLaunchKernelGGL(trunk_fwd, dim3(grid), dim3(NTHR), LDS_BYTES, stream, a); }
#elif defined(PROBE_PH)
    { int li = 0; const int cut = PROBE_PH + PROBE_LEN;
      a.ph_lo = 0; a.ph_hi = cut; a.li = li++; a.pad = 0; hipLaunchKernelGGL(trunk_fwd, dim3(grid), dim3(NTHR), LDS_BYTES, stream, a);
      a.pad = PROBE_MODE;
      for (int r = 0; r < PROBE_N; ++r) { a.ph_lo = PROBE_PH; a.ph_hi = cut; a.li = li++; hipLaunchKernelGGL(trunk_fwd, dim3(grid), dim3(NTHR), LDS_BYTES, stream, a); }
      a.pad = 0; a.ph_lo = cut; a.ph_hi = PH_END; a.li = li++; hipLaunchKernelGGL(trunk_fwd, dim3(grid), dim3(NTHR), LDS_BYTES, stream, a); }
#else
    a.ph_lo = 0; a.ph_hi = PH_END; a.li = 0; a.pad = 0;
    hipLaunchKernelGGL(trunk_fwd, dim3(grid), dim3(NTHR), LDS_BYTES, stream, a);
#endif
}
```

```cpp
#include <hip/hip_runtime.h>
#include <cstdio>
#include <cstdint>

#ifndef MK_PER_PHASE
#define MK_PER_PHASE 0
#endif

constexpr int D_MODEL = 4096, BATCH = 2, SEQ = 8192, DEPTH = 4, PLE_DIM = 256;
constexpr int M_TOK = BATCH * SEQ;
constexpr int NHEAD = 32, HDIM = 128;
constexpr float NORM_EPS = 1e-6f;
constexpr int LDP = 16384;
constexpr int ZCOL = 12288;
constexpr int GDN_CHUNK = 64, GDN_NCHUNK = SEQ / GDN_CHUNK;
constexpr int SSM_G = 256, SSM_N = 16, SSM_P = 64, SSM_SL = 256, SSM_NSEG = SEQ / SSM_SL;

constexpr size_t MiB = 1u << 20;
constexpr size_t WS_CTL = 0, CTL_ZERO_BYTES = 2 * MiB;
constexpr size_t WS_WIN = 2 * MiB;
constexpr size_t WS_WSK = 130 * MiB;
constexpr size_t WS_WOUT = 131 * MiB;
constexpr size_t WS_WGATE = 163 * MiB;
constexpr size_t WS_WPP = 195 * MiB;
constexpr size_t WS_WGLU = 197 * MiB;
constexpr size_t WS_PBF = 229 * MiB;
constexpr size_t WS_X0 = 237 * MiB;
constexpr size_t WS_X1 = 365 * MiB;
constexpr size_t WS_PROJ = 493 * MiB;
constexpr size_t WS_MIX = 1005 * MiB;
constexpr size_t WS_PP = 1133 * MiB;
constexpr size_t WS_SCR = 1261 * MiB;
constexpr size_t WS_SMALL = 1837 * MiB;
constexpr size_t WS_ENDST = 1846 * MiB;
constexpr size_t WS_END = 1854 * MiB;
constexpr size_t GR_QD = 0, GR_W = 16384, GR_KT = 32768, GR_U = 49152, GR_IN = 65536, GR_BYTES = 73728;
constexpr size_t SS_U32 = 0, SS_Y1 = 256 * MiB, SS_END = 384 * MiB;
constexpr size_t SM_CUML = 0;
constexpr size_t SM_TTOT = 2 * MiB;
constexpr size_t SM_CUM = 2 * MiB + 65536;
constexpr size_t SM_QN2 = 2 * MiB + 32768;
constexpr size_t SM_KN2 = 4 * MiB + 65536;
constexpr size_t SM_BETA = 5 * MiB;
constexpr size_t SM_GLOG = 7 * MiB;
constexpr size_t SM_SS = SM_CUM;
constexpr size_t SM_GL = 0;
static_assert(SM_CUM + 64 * 8192 * 4 <= SM_BETA && SM_GLOG + (size_t)M_TOK * 32 * 4 <= 9 * MiB, "small tables");
static_assert(WS_SMALL + 9 * MiB <= WS_ENDST && WS_ENDST + 8 * MiB <= WS_END, "ws end");
constexpr int CW_TMO = 0, CW_CODE = 1, CW_ERR = 1024  , CW_BAR = 16384  ;
typedef unsigned long long ssq_t;
constexpr size_t CTL_SUMSQ = 1 * MiB;
constexpr size_t WS_SSQ0 = 130 * MiB + 512 * 1024;
constexpr float SSQ_SCALE = 16777216.0f, SSQ_INV = 1.0f / 16777216.0f;
#define SSQ_PTR(i) ((ssq_t*)(ws + ((i) == 0 ? WS_SSQ0 : CTL_SUMSQ + (size_t)((i) - 1) * M_TOK * sizeof(ssq_t))))

#define LAS __attribute__((address_space(3)))
#define GAS __attribute__((address_space(1)))
typedef unsigned short bf16;
typedef short bf16x8 __attribute__((ext_vector_type(8)));
typedef short s16x4 __attribute__((ext_vector_type(4)));
typedef float f32x2 __attribute__((ext_vector_type(2)));
typedef float f32x4 __attribute__((ext_vector_type(4)));
typedef float f32x16 __attribute__((ext_vector_type(16)));
typedef unsigned u32x2 __attribute__((ext_vector_type(2)));
typedef unsigned u32x4 __attribute__((ext_vector_type(4)));
#define LDS_WAIT() asm volatile("s_waitcnt lgkmcnt(0)" ::: "memory")
#define VM_WAIT() asm volatile("s_waitcnt vmcnt(0)" ::: "memory")
typedef __bf16 bf16x2_t __attribute__((ext_vector_type(2)));
__device__ __forceinline__ unsigned cvtpk(float lo, float hi) { const f32x2 v = {lo, hi}; const bf16x2_t b = __builtin_convertvector(v, bf16x2_t); return __builtin_bit_cast(unsigned, b); }
__device__ __forceinline__ ssq_t ssq_fix(float s) { return (ssq_t)(s * 16777216.0f + 0.5f); }
__device__ __forceinline__ float ssq_val(ssq_t x) { return ((float)(unsigned)(x >> 32) * 4294967296.0f + (float)(unsigned)x) * (1.0f / 16777216.0f); }
__device__ __forceinline__ float bf2f(unsigned short b) { return __uint_as_float(((unsigned)b) << 16); }
__device__ __forceinline__ float bflo(unsigned w) { return __uint_as_float(w << 16); }
__device__ __forceinline__ float bfhi(unsigned w) { return __uint_as_float(w & 0xffff0000u); }
__device__ __forceinline__ float fexp(float x) { return __builtin_amdgcn_exp2f(x * 1.4426950408889634f); }
__device__ __forceinline__ float flog(float x) { return __builtin_amdgcn_logf(x) * 0.6931471805599453f; }
__device__ __forceinline__ float sigmoidf_(float x) { return __builtin_amdgcn_rcpf(1.0f + fexp(-x)); }
__device__ __forceinline__ float siluf_(float x) { return x * sigmoidf_(x); }
__device__ __forceinline__ bf16x8 pack8(f32x4 a, f32x4 b) { u32x4 w = {cvtpk(a[0], a[1]), cvtpk(a[2], a[3]), cvtpk(b[0], b[1]), cvtpk(b[2], b[3])}; return __builtin_bit_cast(bf16x8, w); }
__device__ __forceinline__ void unpack8(u32x4 w, float* f) { f[0] = bflo(w.x); f[1] = bfhi(w.x); f[2] = bflo(w.y); f[3] = bfhi(w.y); f[4] = bflo(w.z); f[5] = bfhi(w.z); f[6] = bflo(w.w); f[7] = bfhi(w.w); }
__device__ __forceinline__ float wave_sum(float v) {
#pragma unroll
    for (int o = 1; o < 64; o <<= 1) v += __shfl_xor(v, o);
    return v;
}
__device__ __forceinline__ int otid(int w0) { unsigned z = 0u; asm volatile("" : "+v"(z));
    int t = (w0 << 6) | (int)__builtin_amdgcn_mbcnt_hi(~0u, __builtin_amdgcn_mbcnt_lo(~0u, z)); asm volatile("" : "+v"(t)); return t; }
__device__ __forceinline__ u32x4 ozero4() { u32x4 z = {0u, 0u, 0u, 0u}; asm volatile("" : "+v"(z)); return z; }
namespace pg8 {
#define PG8_LAS __attribute__((address_space(3)))
typedef unsigned short bf16_t;
typedef short bf16x8 __attribute__((ext_vector_type(8)));
typedef float f32x4 __attribute__((ext_vector_type(4)));
typedef unsigned u32x4 __attribute__((ext_vector_type(4)));
constexpr int BM = 256, BK = 64, HALF = 128, HTB = HALF * BK * 2  , STAGE_BYTES = 8 * HTB, NXCD = 8, WGM = 8;

__host__ __device__ __forceinline__ int lds_byte(int r, int c) { const int st = (r >> 4) * 2 + (c >> 5), rr = r & 15, cc = c & 31, ob = rr * 64 + cc * 2; return st * 1024 + (ob ^ (((ob >> 9) & 1) << 5)); }
__host__ __device__ __forceinline__ void stage_rc(int b, int& R, int& C) { const int st = b / 1024, sb = b % 1024, swz = sb ^ (((sb >> 9) & 1) << 5); R = (st >> 1) * 16 + swz / 64; C = (st & 1) * 32 + (swz % 64) / 2; }
__host__ __device__ __forceinline__ int perm32(int rho) { const int n = rho >> 4, i = rho & 15; return 8 * (i >> 2) + 4 * n + (i & 3); }

struct Unit { int pm, pn; };
struct Gemm { const bf16_t* A; const bf16_t* Bt; int M, N, K; };

struct StaticOrder {
    int nM, nN, nwg, G, c;
    __host__ __device__ void init(int M, int N, int G_, int c_) { nM = M / BM; nN = N / BM; nwg = nM * nN; G = G_; c = c_; }
    __host__ __device__ bool next(int i, Unit& u) const {
        const long L = (long)i * G + c; if (L >= nwg) return false;
        int wgid = (int)L; { const int q = nwg / NXCD, r = nwg % NXCD, xcd = wgid % NXCD, off = wgid / NXCD; wgid = (xcd < r ? xcd * (q + 1) : r * (q + 1) + (xcd - r) * q) + off; }
        const int nig = WGM * nN, gid = wgid / nig, fm = gid * WGM, gsz = (nM - fm) < WGM ? (nM - fm) : WGM;
        u.pm = fm + ((wgid % nig) % gsz); u.pn = (wgid % nig) / gsz; return true;
    }
    __device__ __forceinline__ void a_ready(const Unit&) const {}
    __device__ __forceinline__ void done(const Unit&) const {}
};
__device__ __forceinline__ unsigned cvt_pk_bf16(float lo, float hi) { return ::cvtpk(lo, hi); }
__device__ __forceinline__ float sgm(float x) { return __builtin_amdgcn_rcpf(1.0f + __builtin_amdgcn_exp2f(x * -1.4426950408889634f)); }
__device__ __forceinline__ float bl(unsigned w) { return __uint_as_float(w << 16); }
__device__ __forceinline__ float bh(unsigned w) { return __uint_as_float(w & 0xffff0000u); }
constexpr float kEps = 1e-6f, kInvD = 1.0f / 4096.0f;
#ifndef EPI_RB
#define EPI_RB 4
#endif

struct EpiProj {
    static constexpr bool PERM = true, AFTER_DRAIN = false;
    bf16_t* O; int ldc; const ssq_t* sumsq; float* F32O; int f32cols;
    __device__ __forceinline__ void operator()(const f32x4 (&acc)[2][2][4][2], const Unit& u, int wr, int wc, int fr, int fq) const {
        const int row0 = u.pm * BM + wr * 64 + fr, colt = u.pn * BM, col0 = colt + wc * 32 + 8 * fq;
        const bool tof32 = colt < f32cols;
        ssq_t rsv[2][4];
#pragma unroll
        for (int ai = 0; ai < 2; ++ai)
#pragma unroll
            for (int m = 0; m < 4; ++m) rsv[ai][m] = sumsq ? sumsq[row0 + ai * HALF + m * 16] : 0ull;
#pragma unroll
        for (int ai = 0; ai < 2; ++ai)
#pragma unroll
            for (int m = 0; m < 4; ++m) { const int r = row0 + ai * HALF + m * 16;
                const float rs = sumsq ? __builtin_amdgcn_rsqf(ssq_val(rsv[ai][m]) * kInvD + kEps) : 1.0f;
#pragma unroll
                for (int bj = 0; bj < 2; ++bj) { const f32x4 v0 = acc[ai][bj][m][0] * rs, v1 = acc[ai][bj][m][1] * rs; const int c = col0 + bj * HALF;
                    if (tof32) { float* p = F32O + (size_t)r * f32cols + c; *(__attribute__((address_space(1))) f32x4*)p = v0; *(__attribute__((address_space(1))) f32x4*)(p + 4) = v1; }
                    else { u32x4 w; w.x = cvt_pk_bf16(v0[0], v0[1]); w.y = cvt_pk_bf16(v0[2], v0[3]); w.z = cvt_pk_bf16(v1[0], v1[1]); w.w = cvt_pk_bf16(v1[2], v1[3]);
                        *(u32x4*)(O + (size_t)r * ldc + c) = w; } } }
    }
};
struct EpiOut {
    static constexpr bool PERM = true, AFTER_DRAIN = false;
    const bf16_t* hin; bf16_t* hout; ssq_t* sumsq2;
    __device__ __forceinline__ void operator()(const f32x4 (&acc)[2][2][4][2], const Unit& u, int wr, int wc, int fr, int fq) const {
        const int row0 = u.pm * BM + wr * 64 + fr, col0 = u.pn * BM + wc * 32 + 8 * fq;
#pragma unroll
        for (int ai = 0; ai < 2; ++ai)
#pragma unroll
          for (int mp = 0; mp < 4 / EPI_RB; ++mp) {
            u32x4 hv[EPI_RB][2];
#pragma unroll
            for (int mm = 0; mm < EPI_RB; ++mm)
#pragma unroll
                for (int bj = 0; bj < 2; ++bj) hv[mm][bj] = *(const u32x4*)(hin + (size_t)(row0 + ai * HALF + (EPI_RB * mp + mm) * 16) * 4096 + col0 + bj * HALF);
#pragma unroll
            for (int mm = 0; mm < EPI_RB; ++mm) { const int m = EPI_RB * mp + mm, r = row0 + ai * HALF + m * 16; float s = 0.f;
#pragma unroll
                for (int bj = 0; bj < 2; ++bj) { const size_t off = (size_t)r * 4096 + col0 + bj * HALF; const u32x4 hw = hv[mm][bj];
                    const f32x4 v0 = f32x4{bl(hw.x), bh(hw.x), bl(hw.y), bh(hw.y)} + acc[ai][bj][m][0], v1 = f32x4{bl(hw.z), bh(hw.z), bl(hw.w), bh(hw.w)} + acc[ai][bj][m][1];
                    u32x4 w; w.x = cvt_pk_bf16(v0[0], v0[1]); w.y = cvt_pk_bf16(v0[2], v0[3]); w.z = cvt_pk_bf16(v1[0], v1[1]); w.w = cvt_pk_bf16(v1[2], v1[3]);
                    *(u32x4*)(hout + off) = w;
                    s += (bl(w.x) * bl(w.x) + bh(w.x) * bh(w.x)) + (bl(w.y) * bl(w.y) + bh(w.y) * bh(w.y)) + (bl(w.z) * bl(w.z) + bh(w.z) * bh(w.z)) + (bl(w.w) * bl(w.w) + bh(w.w) * bh(w.w)); }
                s += __shfl_xor(s, 16); s += __shfl_xor(s, 32);
                if (fq == 0) atomicAdd(sumsq2 + r, ssq_fix(s)); }
            asm volatile("" ::: "memory"); }
    }
};
struct EpiGate {
    static constexpr bool PERM = true, AFTER_DRAIN = false;
    const bf16_t* hin; bf16_t* hout; const bf16_t* PP; const ssq_t* sumsq2; ssq_t* sumsqn;
    __device__ __forceinline__ void operator()(const f32x4 (&acc)[2][2][4][2], const Unit& u, int wr, int wc, int fr, int fq) const {
        const int row0 = u.pm * BM + wr * 64 + fr, col0 = u.pn * BM + wc * 32 + 8 * fq;
        ssq_t rsv[2][4];
#pragma unroll
        for (int ai = 0; ai < 2; ++ai)
#pragma unroll
            for (int m = 0; m < 4; ++m) rsv[ai][m] = sumsq2[row0 + ai * HALF + m * 16];
#pragma unroll
        for (int ai = 0; ai < 2; ++ai)
#pragma unroll
            for (int mp = 0; mp < 4 / EPI_RB; ++mp) {
                u32x4 hv[EPI_RB][2], pv[EPI_RB][2];
#pragma unroll
                for (int mm = 0; mm < EPI_RB; ++mm)
#pragma unroll
                    for (int bj = 0; bj < 2; ++bj) { const size_t off = (size_t)(row0 + ai * HALF + (EPI_RB * mp + mm) * 16) * 4096 + col0 + bj * HALF;
                        pv[mm][bj] = *(const u32x4*)(PP + off); hv[mm][bj] = *(const u32x4*)(hin + off); }
#pragma unroll
                for (int mm = 0; mm < EPI_RB; ++mm) { const int m = EPI_RB * mp + mm, r = row0 + ai * HALF + m * 16; float s = 0.f;
                    const float rs = __builtin_amdgcn_rsqf(ssq_val(rsv[ai][m]) * kInvD + kEps);
#pragma unroll
                    for (int bj = 0; bj < 2; ++bj) { const size_t off = (size_t)r * 4096 + col0 + bj * HALF;
                        const u32x4 pw = pv[mm][bj], hw = hv[mm][bj];
                        const f32x4 p0 = {bl(pw.x), bh(pw.x), bl(pw.y), bh(pw.y)}, p1 = {bl(pw.z), bh(pw.z), bl(pw.w), bh(pw.w)};
                        f32x4 g0 = acc[ai][bj][m][0] * rs, g1 = acc[ai][bj][m][1] * rs;
#pragma unroll
                        for (int j = 0; j < 4; ++j) { g0[j] = sgm(g0[j]); g1[j] = sgm(g1[j]); }
                        const f32x4 v0 = f32x4{bl(hw.x), bh(hw.x), bl(hw.y), bh(hw.y)} + g0 * p0, v1 = f32x4{bl(hw.z), bh(hw.z), bl(hw.w), bh(hw.w)} + g1 * p1;
                        u32x4 w; w.x = cvt_pk_bf16(v0[0], v0[1]); w.y = cvt_pk_bf16(v0[2], v0[3]); w.z = cvt_pk_bf16(v1[0], v1[1]); w.w = cvt_pk_bf16(v1[2], v1[3]);
                        *(u32x4*)(hout + off) = w;
                        s += (bl(w.x) * bl(w.x) + bh(w.x) * bh(w.x)) + (bl(w.y) * bl(w.y) + bh(w.y) * bh(w.y)) + (bl(w.z) * bl(w.z) + bh(w.z) * bh(w.z)) + (bl(w.w) * bl(w.w) + bh(w.w) * bh(w.w)); }
                    s += __shfl_xor(s, 16); s += __shfl_xor(s, 32);
                    if (fq == 0) atomicAdd(sumsqn + r, ssq_fix(s)); }
                asm volatile("" ::: "memory"); }
    }
};
struct EpiGlu {
    static constexpr bool PERM = true, AFTER_DRAIN = false;
    bf16_t* O; const bf16_t* Y1; const bf16_t* Z; int ldz; const float* bias;
    __device__ __forceinline__ void operator()(const f32x4 (&acc)[2][2][4][2], const Unit& u, int wr, int wc, int fr, int fq) const {
        const int row0 = u.pm * BM + wr * 64 + fr, col0 = u.pn * BM + wc * 32 + 8 * fq;
        f32x4 bv[2][2];
#pragma unroll
        for (int bj = 0; bj < 2; ++bj) { bv[bj][0] = *(const f32x4*)(bias + col0 + bj * HALF); bv[bj][1] = *(const f32x4*)(bias + col0 + bj * HALF + 4); }
#pragma unroll
        for (int ai = 0; ai < 2; ++ai)
#pragma unroll
            for (int m = 0; m < 4; ++m) { const int r = row0 + ai * HALF + m * 16;
#pragma unroll
                for (int bj = 0; bj < 2; ++bj) { const int c = col0 + bj * HALF;
                    const u32x4 yw = *(const u32x4*)(Y1 + (size_t)r * 4096 + c), zw = *(const u32x4*)(Z + (size_t)r * ldz + c);
                    const f32x4 y0 = {bl(yw.x), bh(yw.x), bl(yw.y), bh(yw.y)}, y1 = {bl(yw.z), bh(yw.z), bl(yw.w), bh(yw.w)};
                    const f32x4 z0 = {bl(zw.x), bh(zw.x), bl(zw.y), bh(zw.y)}, z1 = {bl(zw.z), bh(zw.z), bl(zw.w), bh(zw.w)};
                    f32x4 g0 = acc[ai][bj][m][0] + bv[bj][0], g1 = acc[ai][bj][m][1] + bv[bj][1];
#pragma unroll
                    for (int j = 0; j < 4; ++j) { g0[j] = y0[j] * sgm(g0[j]) * (z0[j] * sgm(z0[j])); g1[j] = y1[j] * sgm(g1[j]) * (z1[j] * sgm(z1[j])); }
                    u32x4 w; w.x = cvt_pk_bf16(g0[0], g0[1]); w.y = cvt_pk_bf16(g0[2], g0[3]); w.z = cvt_pk_bf16(g1[0], g1[1]); w.w = cvt_pk_bf16(g1[2], g1[3]);
                    *(u32x4*)(O + (size_t)r * 4096 + c) = w; }
                asm volatile("" ::: "memory"); }
    }
};
template <class Epi, class Sched, bool ALIGN_EPI = false, bool SP2 = false>
__device__ __forceinline__ void gemm_phase(PG8_LAS unsigned char* lds, const Gemm g, const Sched& S, const Epi& E, const int w0) {
    const int tid = otid(w0), wid = __builtin_amdgcn_readfirstlane(tid >> 6), lane = tid & 63, wr = wid >> 2, wc = wid & 3, fr = lane & 15, fq = lane >> 4;
    const int K = g.K, nt = K / BK;
    unsigned voffA[2], voffB[2];
#pragma unroll
    for (int i = 0; i < 2; ++i) { int R, C; stage_rc(tid * 16 + i * 8192, R, C); const int Rb = Epi::PERM ? ((R & ~31) + perm32(R & 31)) : R;
        voffA[i] = (unsigned)(R * K + C) * 2u; voffB[i] = (unsigned)(Rb * K + C) * 2u; }
    const size_t kstep = (size_t)(BK * 2);
    const size_t hstep = (size_t)HALF * K * 2;
    const size_t tstep = 2 * hstep;
    const unsigned ldsw = (unsigned)wid * 1024u;
    const int aoff = lds_byte(wr * 64 + fr, fq * 8), boff = lds_byte(wc * 32 + fr, fq * 8);
#define PG8_SA(b, h) (((b) * 2 + (h)) * HTB)
#define PG8_SB(b, h) ((4 + (b) * 2 + (h)) * HTB)
#define PG8_STAGE(bufoff, gbase, voff) do { _Pragma("unroll") for (int _i = 0; _i < 2; ++_i) \
        __builtin_amdgcn_global_load_lds((const unsigned*)((const char*)(gbase) + (voff)[_i]), (PG8_LAS unsigned*)(lds + (bufoff) + ldsw + _i * 8192), 16, 0, 0); } while (0)
#define PG8_LDA(dst, b, h) do { _Pragma("unroll") for (int m = 0; m < 4; ++m) _Pragma("unroll") for (int k = 0; k < 2; ++k) dst[m][k] = *(const PG8_LAS bf16x8*)(lds + PG8_SA(b, h) + aoff + m * 2048 + k * 1024); } while (0)
#define PG8_LDB(dst, b, h) do { _Pragma("unroll") for (int n = 0; n < 2; ++n) _Pragma("unroll") for (int k = 0; k < 2; ++k) dst[n][k] = *(const PG8_LAS bf16x8*)(lds + PG8_SB(b, h) + boff + n * 2048 + k * 1024); } while (0)
#define PG8_MMA(ai, bj, At, Bt) do { __builtin_amdgcn_s_setprio(1); _Pragma("unroll") for (int m = 0; m < 4; ++m) _Pragma("unroll") for (int n = 0; n < 2; ++n) _Pragma("unroll") for (int k = 0; k < 2; ++k) \
        acc[ai][bj][m][n] = __builtin_amdgcn_mfma_f32_16x16x32_bf16(Bt[n][k], At[m][k], acc[ai][bj][m][n], 0, 0, 0); __builtin_amdgcn_s_setprio(0); } while (0)
#define PG8_WAIT_V(n) asm volatile("s_waitcnt vmcnt(" #n ")" ::: "memory")
#define PG8_WAIT_L(n) asm volatile("s_waitcnt lgkmcnt(" #n ")" ::: "memory")
#define PG8_BAR __builtin_amdgcn_s_barrier()
#define PG8_SCHED __builtin_amdgcn_sched_barrier(0)
    Unit cur, nxt; int ui = 0;
    if (!S.next(0, cur)) return;
    f32x4 acc[2][2][4][2];
#pragma unroll
    for (int a = 0; a < 2; ++a)
#pragma unroll
        for (int b = 0; b < 2; ++b)
#pragma unroll
            for (int m = 0; m < 4; ++m)
#pragma unroll
                for (int n = 0; n < 2; ++n) acc[a][b][m][n] = (f32x4){0.f, 0.f, 0.f, 0.f};
    bf16x8 At[4][2], B0[2][2], B1[2][2];
    const char* cA = (const char*)g.A + (size_t)cur.pm * tstep; const char* cB = (const char*)g.Bt + (size_t)cur.pn * tstep;
    S.a_ready(cur);
    if constexpr (SP2) {
        PG8_STAGE(PG8_SB(0, 0), cB, voffB); PG8_STAGE(PG8_SB(0, 1), cB + hstep, voffB); PG8_STAGE(PG8_SA(0, 0), cA, voffA); PG8_STAGE(PG8_SA(0, 1), cA + hstep, voffA);
        if (wr == 1) PG8_BAR;
        PG8_WAIT_V(2); PG8_BAR;
        PG8_STAGE(PG8_SB(1, 0), cB + kstep, voffB); PG8_STAGE(PG8_SA(1, 0), cA + kstep, voffA); PG8_STAGE(PG8_SB(1, 1), cB + hstep + kstep, voffB);
        PG8_WAIT_V(6); PG8_BAR;
    } else {
        PG8_STAGE(PG8_SB(0, 0), cB, voffB); PG8_STAGE(PG8_SA(0, 0), cA, voffA); PG8_STAGE(PG8_SB(0, 1), cB + hstep, voffB); PG8_STAGE(PG8_SA(0, 1), cA + hstep, voffA);
        if (wr == 1) PG8_BAR;
        PG8_WAIT_V(4); PG8_BAR;
        PG8_STAGE(PG8_SB(1, 0), cB + kstep, voffB); PG8_STAGE(PG8_SA(1, 0), cA + kstep, voffA); PG8_STAGE(PG8_SB(1, 1), cB + hstep + kstep, voffB);
        PG8_WAIT_V(6); PG8_BAR;
    }
    for (;;) {
        const bool has_next = S.next(ui + 1, nxt);
        const char* nA = has_next ? (const char*)g.A + (size_t)nxt.pm * tstep : cA; const char* nB = has_next ? (const char*)g.Bt + (size_t)nxt.pn * tstep : cB;
        for (int t = 0; t < nt; t += 2) {
            const bool last = (t == nt - 2);
            const char* a1 = cA + (size_t)(t + 1) * kstep;
            const char* a2 = last ? nA : cA + (size_t)(t + 2) * kstep; const char* b2 = last ? nB : cB + (size_t)(t + 2) * kstep;
            const char* a3 = a2 + kstep; const char* b3 = b2 + kstep;
            if (last && has_next) S.a_ready(nxt);
            if constexpr (SP2) {
            PG8_LDB(B0, 0, 0); PG8_LDB(B1, 0, 1); PG8_SCHED; PG8_LDA(At, 0, 0); PG8_STAGE(PG8_SA(1, 1), a1 + hstep, voffA);
            PG8_WAIT_V(8); PG8_WAIT_L(0); PG8_BAR; PG8_MMA(0, 0, At, B0); PG8_MMA(0, 1, At, B1); PG8_BAR; PG8_SCHED;
            PG8_LDA(At, 0, 1); PG8_STAGE(PG8_SB(0, 0), b2, voffB); PG8_STAGE(PG8_SB(0, 1), b2 + hstep, voffB); PG8_STAGE(PG8_SA(0, 0), a2, voffA);
            PG8_WAIT_V(8); PG8_WAIT_L(0); PG8_BAR; PG8_MMA(1, 0, At, B0); PG8_MMA(1, 1, At, B1); PG8_BAR; PG8_SCHED;
            PG8_LDB(B0, 1, 0); PG8_LDB(B1, 1, 1); PG8_SCHED; PG8_LDA(At, 1, 0); PG8_STAGE(PG8_SA(0, 1), a2 + hstep, voffA);
            PG8_WAIT_V(8); PG8_WAIT_L(0); PG8_BAR; PG8_MMA(0, 0, At, B0); PG8_MMA(0, 1, At, B1); PG8_BAR; PG8_SCHED;
            PG8_LDA(At, 1, 1); PG8_STAGE(PG8_SB(1, 0), b3, voffB); PG8_STAGE(PG8_SB(1, 1), b3 + hstep, voffB); PG8_STAGE(PG8_SA(1, 0), a3, voffA);
            PG8_WAIT_V(8); PG8_WAIT_L(0); PG8_BAR; PG8_MMA(1, 0, At, B0); PG8_MMA(1, 1, At, B1); PG8_BAR; PG8_SCHED;
            } else {
            PG8_LDB(B0, 0, 0); PG8_SCHED; PG8_LDA(At, 0, 0); PG8_STAGE(PG8_SA(1, 1), a1 + hstep, voffA);
            PG8_WAIT_L(8); PG8_BAR; PG8_WAIT_L(0); PG8_MMA(0, 0, At, B0); PG8_BAR; PG8_SCHED;
            PG8_LDB(B1, 0, 1); PG8_STAGE(PG8_SB(0, 0), b2, voffB);
            PG8_BAR; PG8_WAIT_L(0); PG8_MMA(0, 1, At, B1); PG8_BAR;
            PG8_LDA(At, 0, 1); PG8_STAGE(PG8_SA(0, 0), a2, voffA);
            PG8_BAR; PG8_WAIT_L(0); PG8_MMA(1, 0, At, B0); PG8_BAR; PG8_SCHED;
            PG8_STAGE(PG8_SB(0, 1), b2 + hstep, voffB);
            PG8_WAIT_V(6); PG8_BAR; PG8_MMA(1, 1, At, B1); PG8_BAR;
            PG8_LDB(B0, 1, 0); PG8_SCHED; PG8_LDA(At, 1, 0); PG8_STAGE(PG8_SA(0, 1), a2 + hstep, voffA);
            PG8_WAIT_L(8); PG8_BAR; PG8_WAIT_L(0); PG8_MMA(0, 0, At, B0); PG8_BAR; PG8_SCHED;
            PG8_LDB(B1, 1, 1); PG8_STAGE(PG8_SB(1, 0), b3, voffB);
            PG8_BAR; PG8_WAIT_L(0); PG8_MMA(0, 1, At, B1); PG8_BAR;
            PG8_LDA(At, 1, 1); PG8_STAGE(PG8_SA(1, 0), a3, voffA);
            PG8_BAR; PG8_WAIT_L(0); PG8_MMA(1, 0, At, B0); PG8_BAR; PG8_SCHED;
            PG8_STAGE(PG8_SB(1, 1), b3 + hstep, voffB);
            PG8_WAIT_V(6); PG8_BAR; PG8_MMA(1, 1, At, B1); PG8_BAR;
            }
        }
        if constexpr (ALIGN_EPI) { if (wr == 0) PG8_BAR; }
        if constexpr (!Epi::AFTER_DRAIN) { E(acc, cur, wr, wc, fr, fq); S.done(cur); }
        if (!has_next) break;
#pragma unroll
        for (int a = 0; a < 2; ++a)
#pragma unroll
            for (int b = 0; b < 2; ++b)
#pragma unroll
                for (int m = 0; m < 4; ++m)
#pragma unroll
                    for (int n = 0; n < 2; ++n) acc[a][b][m][n] = (f32x4){0.f, 0.f, 0.f, 0.f};
        cur = nxt; cA = nA; cB = nB; ++ui;
        if constexpr (ALIGN_EPI) { if (wr == 1) PG8_BAR; }
    }
    PG8_WAIT_V(0);
    if constexpr (!ALIGN_EPI) { if (wr == 0) PG8_BAR; }
    PG8_BAR;
    if constexpr (Epi::AFTER_DRAIN) { E.fused(acc, cur, wr, wc, fr, fq, lds, wid, lane); S.done(cur); }
#undef PG8_SA
#undef PG8_SB
#undef PG8_STAGE
#undef PG8_LDA
#undef PG8_LDB
#undef PG8_MMA
#undef PG8_WAIT_V
#undef PG8_WAIT_L
#undef PG8_BAR
#undef PG8_SCHED
}
}
#define XB_TMO      128
#define XB_XCNT(j)  (256  + 64 * (j))
#define XB_XSUB(j)  (1280 + 64 * (j))
#define XB_XGEN(j)  (2304 + 64 * (j))
#define XB_TOP      3328
#define XB_TOPGEN   3392
#define XCD_BAR_WORDS 3456
#define XB_SPIN_CAP (1u << 18)

__device__ __forceinline__ unsigned xb_ld(unsigned* p)              { return __hip_atomic_load(p, __ATOMIC_RELAXED, __HIP_MEMORY_SCOPE_AGENT); }
__device__ __forceinline__ unsigned xb_add(unsigned* p, unsigned v) { return __hip_atomic_fetch_add(p, v, __ATOMIC_RELAXED, __HIP_MEMORY_SCOPE_AGENT); }
__device__ __forceinline__ unsigned xb_xcc_id() { return (unsigned)__builtin_amdgcn_s_getreg((3 << 11) | 20) & 0xFu; }
#define XB_SPIN(cond, bar) do { unsigned _sp = 0; while (cond) { __builtin_amdgcn_s_sleep(1); \
    if ((++_sp & 255u) == 0u) { if (xb_ld(&(bar)[XB_TMO])) break; if (_sp > XB_SPIN_CAP) { atomicAdd(&(bar)[XB_TMO], 1u); break; } } } } while (0)

struct XcdBarrier {
    unsigned* bar; unsigned x;
    volatile LAS unsigned* st;
    unsigned tid;
};

__device__ __forceinline__ XcdBarrier xcd_barrier_post(unsigned* bar, volatile LAS unsigned* st) {
    XcdBarrier b; b.bar = bar; b.x = xb_xcc_id(); b.st = st;
    if (threadIdx.x == 0) (void)xb_add(&bar[XB_XCNT(b.x)], 1u);
    return b;
}
__device__ __forceinline__ void xcd_barrier_complete(unsigned* bar, unsigned x, unsigned& nloc, unsigned& nx) {
    const unsigned G = gridDim.x * gridDim.y * gridDim.z;
    unsigned sum, cnt, mine, sp = 0u;
    for (;;) {
        sum = 0u; cnt = 0u; mine = 0u;
#pragma unroll
        for (unsigned j = 0; j < 16; ++j) { const unsigned c = xb_ld(&bar[XB_XCNT(j)]); sum += c; cnt += (c > 0u) ? 1u : 0u; mine = (j == x) ? c : mine; }
        if (sum == G) break;
        __builtin_amdgcn_s_sleep(1);
        if ((++sp & 255u) == 0u) { if (xb_ld(&bar[XB_TMO])) break; if (sp > XB_SPIN_CAP) { atomicAdd(&bar[XB_TMO], 1u); break; } }
    }
    nloc = mine > 0u ? mine : 1u; nx = cnt > 0u ? cnt : 1u;
}

__device__ __forceinline__ void xcd_barrier(const XcdBarrier& b) {
    asm volatile("s_waitcnt vmcnt(0)" ::: "memory");
    __syncthreads();
    if (b.tid == 0) {
        unsigned* bar = b.bar;
        __builtin_amdgcn_s_waitcnt(0);
        unsigned nloc = b.st[0], nx = b.st[1];
        if (nloc == 0u) { xcd_barrier_complete(bar, b.x, nloc, nx); b.st[0] = nloc; b.st[1] = nx; }
        const unsigned old = xb_add(&bar[XB_XSUB(b.x)], 1u);
        const unsigned gen = old / nloc;
        if (old + 1u == (gen + 1u) * nloc) {
            __builtin_amdgcn_fence(__ATOMIC_RELEASE, "agent");
            asm volatile("s_waitcnt vmcnt(0)" ::: "memory");
            const unsigned og = xb_add(&bar[XB_TOP], 1u);
            const unsigned tg = og / nx;
            if (og + 1u == (tg + 1u) * nx) xb_add(&bar[XB_TOPGEN], 1u);
            else XB_SPIN(xb_ld(&bar[XB_TOPGEN]) == tg, bar);
            __builtin_amdgcn_fence(__ATOMIC_ACQUIRE, "agent");
            xb_add(&bar[XB_XGEN(b.x)], 1u);
            asm volatile("s_waitcnt vmcnt(0)" ::: "memory");
        } else {
            XB_SPIN(xb_ld(&bar[XB_XGEN(b.x)]) == gen, bar);
            __builtin_amdgcn_fence(__ATOMIC_ACQUIRE, "agent");
            asm volatile("s_waitcnt vmcnt(0)" ::: "memory");
        }
    }
    __syncthreads();
}
namespace fox {
constexpr int D = 128;
constexpr float SCALE = 0.08838834764831845f, INV_SCALE = 11.313708498984761f;
constexpr float THR = 8.f;
constexpr int NW = 8, QBLK = 32, KVBLK = 64, QB = NW * QBLK;
constexpr int SHM_V = KVBLK * D * 2, SHM_K = KVBLK * D * 2;
constexpr int KB_OFF = 2 * SHM_V + 2 * SHM_K + NW * 64 * 4;
constexpr int JL_OFF = KB_OFF + 2 * 64 * 4;
constexpr int OT_OFF = JL_OFF + 64, OT_PITCH = 272, OT_WAVE = 32 * OT_PITCH;
constexpr int LDS_BYTES = OT_OFF + NW * OT_WAVE;

#define KSWZ(row, colB) ((row) * 256 + ((colB) ^ (((row) & 7) << 4)))
#define SBAR() __builtin_amdgcn_sched_barrier(0)
__device__ __forceinline__ int v_st(int k, int c) { const int kk = (k & ~0xC) | ((k & 4) << 1) | ((k & 8) >> 1); return ((kk >> 3) * 4 + (c >> 5)) * 512 + ((kk & 7) * 32 + (c & 31)) * 2; }
__device__ __forceinline__ int v_rd_base(int lane) { return ((lane & 3) << 3) | (((lane >> 2) & 3) << 6) | (((lane >> 4) & 1) << 5) | (((lane >> 5) & 1) << 8); }
constexpr int v_rd_off(int d0, int ks, int half) { return d0 * 512 + ks * 4096 + half * 2048; }
__device__ __forceinline__ int crow(int r, int hi) { return (r & 3) + 8 * (r >> 2) + 4 * hi; }
__device__ __forceinline__ bf16x8 load8(const bf16* p) { return *reinterpret_cast<const bf16x8*>(p); }
__device__ __forceinline__ void mask_tile(f32x16& p0, f32x16& p1, int dq) {
    const float NEG = -__builtin_inff();
#pragma unroll
    for (int r = 0; r < 16; ++r) {
        const int c = (r & 3) + 8 * (r >> 2);
        if (dq - c < 0) p0[r] = NEG;
        if (dq - c - 32 < 0) p1[r] = NEG;
    }
}
__device__ __forceinline__ void bias_tile(f32x16& p0, f32x16& p1, const float* kb, int hi) {
#pragma unroll
    for (int g = 0; g < 4; ++g) {
        const f32x4 a = *(const f32x4*)(kb + 8 * g + 4 * hi), b = *(const f32x4*)(kb + 32 + 8 * g + 4 * hi);
#pragma unroll
        for (int j = 0; j < 4; ++j) { p0[4 * g + j] += a[j]; p1[4 * g + j] += b[j]; }
    }
}
__device__ __forceinline__ void partialSM(f32x16& p0, f32x16& p1, float& m_reg, float& mn, float& alpha) {
    float pmax = p0[0]; for (int r = 1; r < 16; ++r) pmax = fmaxf(pmax, p0[r]); for (int r = 0; r < 16; ++r) pmax = fmaxf(pmax, p1[r]);
    { auto rr = __builtin_amdgcn_permlane32_swap(__float_as_uint(pmax), __float_as_uint(pmax), false, false);
      pmax = fmaxf(__uint_as_float(rr[0]), __uint_as_float(rr[1])); }
    constexpr float C2 = 1.4426950408889634f * SCALE;
    if (__builtin_expect(__all((pmax - m_reg) * SCALE <= THR), 1)) { mn = m_reg; alpha = 1.f; }
    else { mn = fmaxf(m_reg, pmax); alpha = __builtin_amdgcn_exp2f((m_reg - mn) * C2); m_reg = mn; }
    const float mnL = -mn * C2;
    for (int r = 0; r < 16; ++r) p0[r] = fmaf(p0[r], C2, mnL); for (int r = 0; r < 16; ++r) p1[r] = fmaf(p1[r], C2, mnL);
    for (int r = 0; r < 16; ++r) p0[r] = __builtin_amdgcn_exp2f(p0[r]);
}
__device__ __forceinline__ void finishSM(f32x16& p0, f32x16& p1, float alpha, float& l_reg, bf16x8& pa0, bf16x8& pa1, bf16x8& pa2, bf16x8& pa3) {
    for (int r = 0; r < 16; ++r) p1[r] = __builtin_amdgcn_exp2f(p1[r]);
    float ps = 0; for (int r = 0; r < 16; ++r) ps += p0[r]; for (int r = 0; r < 16; ++r) ps += p1[r];
    { auto rr = __builtin_amdgcn_permlane32_swap(__float_as_uint(ps), __float_as_uint(ps), false, false);
      ps = __uint_as_float(rr[0]) + __uint_as_float(rr[1]); }
    l_reg = l_reg * alpha + ps;
#define PK4(P, B_, OUT) do { unsigned a0 = cvtpk(P[B_+0], P[B_+1]), a1 = cvtpk(P[B_+2], P[B_+3]);                          \
        unsigned b0 = cvtpk(P[B_+4], P[B_+5]), b1 = cvtpk(P[B_+6], P[B_+7]);                                             \
        auto r0 = __builtin_amdgcn_permlane32_swap(a0, b0, false, false); auto r1 = __builtin_amdgcn_permlane32_swap(a1, b1, false, false); \
        u32x4 w = {r0[0], r1[0], r0[1], r1[1]}; OUT = *reinterpret_cast<bf16x8*>(&w); } while (0)
    PK4(p0, 0, pa0); PK4(p0, 8, pa1); PK4(p1, 0, pa2); PK4(p1, 8, pa3);
#undef PK4
}
template <int KB>
__device__ __forceinline__ void qkt(f32x16& p0, f32x16& p1, const char* K_lds, int r32, int hi, const bf16x8* qr) {
    p0 = f32x16{}; p1 = f32x16{};
    const char* kb[4];
#pragma unroll
    for (int dd = 0; dd < 4; ++dd) kb[dd] = K_lds + KB * SHM_K + KSWZ(r32, (dd * 16 + hi * 8) * 2);
#pragma unroll
    for (int d0 = 0; d0 < 8; ++d0) { const char* a = kb[d0 & 3] + (d0 >> 2) * 128;
        bf16x8 b0 = *reinterpret_cast<const bf16x8*>(a);
        bf16x8 b1 = *reinterpret_cast<const bf16x8*>(a + 32 * 256);
        p0 = __builtin_amdgcn_mfma_f32_32x32x16_bf16(b0, qr[d0], p0, 0, 0, 0);
        p1 = __builtin_amdgcn_mfma_f32_32x32x16_bf16(b1, qr[d0], p1, 0, 0, 0); }
}
template <int VB>
__device__ __forceinline__ void pv_tile(f32x16* o, int vb0, bf16x8 pa0, bf16x8 pa1, bf16x8 pa2, bf16x8 pa3) {
#define TRRD(dst, off) asm volatile("ds_read_b64_tr_b16 %0, %1 offset:%2" : "=&v"(dst) : "v"(vb0), "i"(off) : "memory")
#define PV_D0(d0) do { s16x4 l0, l1, h0, h1; constexpr int b_ = VB * SHM_V + v_rd_off(d0, 0, 0);     \
        TRRD(l0, b_); TRRD(h0, b_ + 2048); TRRD(l1, b_ + 4096); TRRD(h1, b_ + 6144); \
        asm volatile("s_waitcnt lgkmcnt(0)" ::: "memory"); SBAR();   \
        o[d0] = __builtin_amdgcn_mfma_f32_32x32x16_bf16(pa0, (bf16x8){l0[0], l0[1], l0[2], l0[3], h0[0], h0[1], h0[2], h0[3]}, o[d0], 0, 0, 0);   \
        o[d0] = __builtin_amdgcn_mfma_f32_32x32x16_bf16(pa1, (bf16x8){l1[0], l1[1], l1[2], l1[3], h1[0], h1[1], h1[2], h1[3]}, o[d0], 0, 0, 0);   \
        SBAR(); TRRD(l0, b_ + 8192); TRRD(h0, b_ + 10240); TRRD(l1, b_ + 12288); TRRD(h1, b_ + 14336); \
        asm volatile("s_waitcnt lgkmcnt(0)" ::: "memory"); SBAR();   \
        o[d0] = __builtin_amdgcn_mfma_f32_32x32x16_bf16(pa2, (bf16x8){l0[0], l0[1], l0[2], l0[3], h0[0], h0[1], h0[2], h0[3]}, o[d0], 0, 0, 0);   \
        o[d0] = __builtin_amdgcn_mfma_f32_32x32x16_bf16(pa3, (bf16x8){l1[0], l1[1], l1[2], l1[3], h1[0], h1[1], h1[2], h1[3]}, o[d0], 0, 0, 0); } while (0)
    PV_D0(0); PV_D0(1); PV_D0(2); PV_D0(3);
#undef PV_D0
#undef TRRD
}
struct BlockRef { const bf16* Q; const bf16* K; const bf16* V; const bf16* Z; bf16* O; const float* C; const float* QN; const float* KN; int P0; };
constexpr float PRUNE_T = 30.0f;
__device__ __forceinline__ int compute_jlo(const BlockRef& b, int lane) {
    const int ntb = b.P0 / KVBLK;
    if (ntb == 0) return 0;
    float q2 = b.QN[ntb + (lane & 3)];
    q2 = fmaxf(q2, __shfl_xor(q2, 1)); q2 = fmaxf(q2, __shfl_xor(q2, 2));
    float k2 = fmaxf(lane < ntb + 4 ? b.KN[lane] : 0.f, lane + 64 < ntb + 4 ? b.KN[lane + 64] : 0.f);
#pragma unroll
    for (int o = 1; o < 64; o <<= 1) k2 = fmaxf(k2, __shfl_xor(k2, o));
    const float bnd = 2.0f * SCALE * __builtin_amdgcn_sqrtf(q2 * k2) * 1.0001f + b.C[b.P0];
    const bool s0 = lane < ntb && (bnd - b.C[64 * lane + 63] < -PRUNE_T);
    const bool s1 = lane + 64 < ntb && (bnd - b.C[64 * (lane + 64) + 63] < -PRUNE_T);
    const unsigned long long m0 = __ballot(s0), m1 = __ballot(s1);
    int jlo = 0;
    if (m1) jlo = 128 - __builtin_clzll(m1) + 1 - 1; else if (m0) jlo = 64 - __builtin_clzll(m0);
    return __builtin_amdgcn_readfirstlane(jlo);
}
__device__ __forceinline__ void norm_item(const bf16* PROJ, float* QN2, float* KN2, int item, int lane) {
    const int bhh = item >> 7, tile = item & 127, b = bhh >> 5, h = bhh & 31, rs = lane >> 4, cg = lane & 15;
    const bf16* base = PROJ + ((size_t)b * SEQ + (size_t)tile * 64) * LDP + h * HDIM + cg * 8;
    float qm = 0.f, km = 0.f;
#pragma unroll 4
    for (int i = 0; i < 16; ++i) { const bf16* rp = base + (size_t)(4 * i + rs) * LDP;
        const u32x4 qw = *(const u32x4*)rp, kw = *(const u32x4*)(rp + 4096); float q[8], k[8]; unpack8(qw, q); unpack8(kw, k);
        float sq = 0.f, sk = 0.f;
#pragma unroll
        for (int e = 0; e < 8; ++e) { sq += q[e] * q[e]; sk += k[e] * k[e]; }
#pragma unroll
        for (int o = 1; o < 16; o <<= 1) { sq += __shfl_xor(sq, o); sk += __shfl_xor(sk, o); }
        qm = fmaxf(qm, sq); km = fmaxf(km, sk); }
    qm = fmaxf(qm, __shfl_xor(qm, 16)); qm = fmaxf(qm, __shfl_xor(qm, 32)); km = fmaxf(km, __shfl_xor(km, 16)); km = fmaxf(km, __shfl_xor(km, 32));
    if (lane == 0) { QN2[item] = qm; KN2[item] = km; }
}
struct Seam { bf16x8 qr[8]; bf16x8 st_v0, st_v1, st_k0, st_k1; float cb0, cb1; };
#define ROWP(p, k0, rr) ((p) + (size_t)((k0) + (rr)) * LDP + sc)
#define VMWN(n) asm volatile("s_waitcnt vmcnt(%0)" :: "i"(n) : "memory")
#define SLOAD_H(Kp, Vp, Cp, k0) do { const bf16* vp_ = (Vp) + (size_t)(k0) * LDP; const bf16* kp_ = (Kp) + (size_t)(k0) * LDP; const float* cp_ = (Cp) + (k0); \
                         S.st_v0 = load8(vp_ + loff); S.st_v1 = load8(vp_ + 32 * LDP + loff);              \
                         S.st_k0 = load8(kp_ + loff); S.st_k1 = load8(kp_ + 32 * LDP + loff); S.cb0 = cp_[(unsigned)sr]; S.cb1 = (cp_ + 32)[(unsigned)sr]; } while (0)
#define SWRITE_HK(bf, ref) do { *(bf16x8*)(K_lds + (bf) * SHM_K + kws) = S.st_k0; *(bf16x8*)(K_lds + (bf) * SHM_K + kws + 32 * 256) = S.st_k1; \
                         if ((tid & 15) == 0) { kbias[(bf) * 64 + sr] = ((ref) - S.cb0) * INV_SCALE; kbias[(bf) * 64 + 32 + sr] = ((ref) - S.cb1) * INV_SCALE; } } while (0)
#define SWRITE_HV(bf) do { *(bf16x8*)(V_lds + (bf) * SHM_V + vst0) = S.st_v0; *(bf16x8*)(V_lds + (bf) * SHM_V + vst1) = S.st_v1; } while (0)
#define SWRITE_H(bf, ref) do { SWRITE_HV(bf); SWRITE_HK(bf, ref); } while (0)
__device__ __forceinline__ float blk_ref(const BlockRef& b) { const float v = b.P0 > 0 ? b.C[b.P0 - 1] : 0.f; return __uint_as_float(__builtin_amdgcn_readfirstlane(__float_as_uint(v))); }
__device__ __forceinline__ void prime(const BlockRef& cur, int j_lo, char* lds, Seam& S, const int w0) {
    const int tid = otid(w0), wid = __builtin_amdgcn_readfirstlane(tid >> 6), lane = tid & 63, r32 = lane & 31, hi = lane >> 5;
    const int sr = tid >> 4, sc = (tid & 15) * 8, kws = KSWZ(sr, sc * 2); char* K_lds = lds + 2 * SHM_V; float* kbias = (float*)(lds + KB_OFF);
    const unsigned loff = (unsigned)sr * LDP + sc, qoff = (unsigned)r32 * LDP + hi * 8;
    const float ref = blk_ref(cur);
    for (int d0 = 0; d0 < 8; ++d0) S.qr[d0] = load8(cur.Q + (size_t)(wid * QBLK) * LDP + d0 * 16 + qoff);
    SLOAD_H(cur.K, cur.V, cur.C, j_lo * KVBLK); VM_WAIT(); SWRITE_HK(0, ref);
    __syncthreads();
}
__device__ __forceinline__ void block(const BlockRef& cur, const BlockRef& nxt, int j_lo, int jlo_n, char* lds, Seam& S, const int w0) {
    const int tid = otid(w0), wid = __builtin_amdgcn_readfirstlane(tid >> 6), lane = tid & 63, r32 = lane & 31, hi = lane >> 5;
    const int NT = (cur.P0 + QB - 1) / KVBLK + 1 - j_lo;
    const int qlo = cur.P0 + wid * QBLK, qm = qlo + r32 - 4 * hi;
    char* V_lds = lds; char* K_lds = lds + 2 * SHM_V;
    float* ws = (float*)(lds + 2 * SHM_V + 2 * SHM_K) + wid * 64; float* li_l = ws, * al_l = ws + 32; float* kbias = (float*)(lds + KB_OFF);
    float m_reg = -1e30f, l_reg = 0; f32x16 o[4] = {};
    const int sr = tid >> 4, sc = (tid & 15) * 8, vst0 = v_st(sr, sc), vst1 = v_st(32 + sr, sc), kws = KSWZ(sr, sc * 2);
    const int vb0 = (int)(uintptr_t)V_lds + v_rd_base(lane);
    const unsigned loff = (unsigned)sr * LDP + sc, qoff = (unsigned)r32 * LDP + hi * 8;
    const bf16* Kh = cur.K; const bf16* Vh = cur.V; const float* Ch = cur.C;
    const float ref = blk_ref(cur), nref = blk_ref(nxt);
#define RESC(a) do { if (__any((a) < 1.f)) { if (hi == 0) al_l[r32] = (a); asm volatile("s_waitcnt lgkmcnt(0)" ::: "memory");              \
                     for (int d_ = 0; d_ < 4; ++d_) for (int r = 0; r < 16; ++r) o[d_][r] *= al_l[crow(r, hi)]; } } while (0)
#define KBASE(t) ((j_lo + (t)) * KVBLK)
#define BIASMASK(P0_, P1_, t, KB) do { const int kb_ = KBASE(t); bias_tile(P0_, P1_, kbias + (KB) * 64, hi); if (kb_ + KVBLK - 1 > qlo) mask_tile(P0_, P1_, qm - kb_); } while (0)
    constexpr int NQL = 8;
#define SEAM_K0() do { VMWN(NQL); SWRITE_HK(0, nref); SBAR(); } while (0)
    f32x16 pA0, pA1, pB0, pB1; float mnA, mnB, alA, alB; bf16x8 pa0, pa1, pa2, pa3;
    SWRITE_HV(0); SBAR();
    if (NT > 1) SLOAD_H(Kh, Vh, Ch, KBASE(1));
    SBAR(); qkt<0>(pA0, pA1, K_lds, r32, hi, S.qr);
    BIASMASK(pA0, pA1, 0, 0); partialSM(pA0, pA1, m_reg, mnA, alA);
    if (NT > 1) { VM_WAIT(); SWRITE_H(1, ref); }
    __syncthreads();
#define HALF_STEP(PX0, PX1, mnX, alX, PY0, PY1, alY, t, KB, VB, SB) do {                                                      \
        SBAR(); qkt<KB>(PX0, PX1, K_lds, r32, hi, S.qr);                                                                      \
        finishSM(PY0, PY1, alY, l_reg, pa0, pa1, pa2, pa3); SBAR();                                                           \
        if ((t) + 1 < NT) { SLOAD_H(Kh, Vh, Ch, KBASE((t) + 1)); SBAR(); }                                                    \
        pv_tile<VB>(o, vb0, pa0, pa1, pa2, pa3); BIASMASK(PX0, PX1, (t), KB); partialSM(PX0, PX1, m_reg, mnX, alX);           \
        __syncthreads();                                                                                                      \
        if ((t) + 1 < NT) { VM_WAIT(); SWRITE_H(SB, ref); }                                                                   \
        RESC(alX); __syncthreads(); } while (0)
    for (int t = 1; t + 1 < NT; t += 2) {
        HALF_STEP(pB0, pB1, mnB, alB, pA0, pA1, alA, t, 1, 0, 0);
        HALF_STEP(pA0, pA1, mnA, alA, pB0, pB1, alB, t + 1, 0, 1, 1);
    }
    const bool even = (NT & 1) == 0;
    if (even) { SBAR(); qkt<1>(pB0, pB1, K_lds, r32, hi, S.qr); SBAR(); }
    SLOAD_H(nxt.K, nxt.V, nxt.C, jlo_n * KVBLK); SBAR();
#pragma unroll
    for (int d0 = 0; d0 < 8; ++d0) S.qr[d0] = load8(nxt.Q + (size_t)(wid * QBLK) * LDP + d0 * 16 + qoff);
    SBAR();
    finishSM(pA0, pA1, alA, l_reg, pa0, pa1, pa2, pa3); SBAR();
    pv_tile<0>(o, vb0, pa0, pa1, pa2, pa3);
    if (even) { const int t2 = otid(w0), qm2 = qlo + (t2 & 31) - 4 * ((t2 >> 5) & 1), hi2 = (t2 >> 5) & 1;
      { const int kb_ = KBASE(NT - 1); bias_tile(pB0, pB1, kbias + 64, hi2); if (kb_ + KVBLK - 1 > qlo) mask_tile(pB0, pB1, qm2 - kb_); }
      partialSM(pB0, pB1, m_reg, mnB, alB); __syncthreads(); RESC(alB);
      finishSM(pB0, pB1, alB, l_reg, pa0, pa1, pa2, pa3); SBAR(); pv_tile<1>(o, vb0, pa0, pa1, pa2, pa3); }
    SBAR(); SEAM_K0();
    if (hi == 0) li_l[r32] = l_reg; asm volatile("s_waitcnt lgkmcnt(0)" ::: "memory");
    float rli[16];
#pragma unroll
    for (int r = 0; r < 16; ++r) rli[r] = __builtin_amdgcn_rcpf(li_l[crow(r, hi)]);
    bf16* Ow = cur.O + (size_t)(wid * QBLK) * 4096; const bf16* Zw = cur.Z + (size_t)(wid * QBLK) * LDP;
    const int t2 = otid(w0), l2 = t2 & 63;
    const unsigned zoff = (unsigned)(l2 >> 4) * LDP + (l2 & 15) * 8, ooff = (unsigned)(l2 >> 4) * 4096 + (l2 & 15) * 8;
    u32x4 zw[8];
#pragma unroll
    for (int i = 0; i < 8; ++i) zw[i] = *(const u32x4*)(Zw + (size_t)(4 * i) * LDP + zoff);
    char* ot = lds + OT_OFF + wid * OT_WAVE;
#pragma unroll
    for (int d0 = 0; d0 < 4; ++d0)
#pragma unroll
        for (int r = 0; r < 16; ++r) *(bf16*)(ot + crow(r, hi) * OT_PITCH + (d0 * 32 + r32) * 2) = (bf16)(cvtpk(o[d0][r] * rli[r], 0.f) & 0xffffu);
    asm volatile("s_waitcnt lgkmcnt(0)" ::: "memory");
#pragma unroll
    for (int i = 0; i < 8; ++i) { const u32x4 ow = *(const u32x4*)(ot + (4 * i + (l2 >> 4)) * OT_PITCH + (l2 & 15) * 16);
        float ov[8], zv[8]; unpack8(ow, ov); unpack8(zw[i], zv);
        f32x4 a, b;
#pragma unroll
        for (int e = 0; e < 4; ++e) { a[e] = ov[e] * siluf_(zv[e]); b[e] = ov[4 + e] * siluf_(zv[4 + e]); }
        *(bf16x8*)(Ow + (size_t)(4 * i) * 4096 + ooff) = pack8(a, b); }
    __syncthreads();
#undef RESC
#undef KBASE
#undef BIASMASK
#undef SEAM_K0
#undef HALF_STEP
}
#undef ROWP
#undef VMWN
#undef SLOAD_H
#undef SWRITE_HK
#undef SWRITE_HV
#undef SWRITE_H
#undef KSWZ
#undef SBAR
__device__ __forceinline__ void attn_phase(char* lds, const bf16* PROJ, bf16* MIX, const float* CUM, const float* QN2, const float* KN2, int vcu, int G, const int w0) {
    constexpr int NQB = SEQ / QB  , NX = NQB / 2, TOTAL = NX * BATCH * NHEAD;
    auto ref_of = [&](int L, int pass) { const int bhh = L / NX, x = L % NX, qb = pass ? NQB - 1 - x : x, b = bhh / NHEAD, h = bhh % NHEAD;
        BlockRef r; const bf16* base = PROJ + (size_t)b * SEQ * LDP + h * HDIM;
        r.Q = base + (size_t)qb * QB * LDP; r.K = base + 4096; r.V = base + 8192; r.Z = base + (size_t)qb * QB * LDP + ZCOL;
        r.O = MIX + ((size_t)b * SEQ + (size_t)qb * QB) * 4096 + h * HDIM; r.C = CUM + (size_t)bhh * SEQ; r.QN = QN2 + bhh * 128; r.KN = KN2 + bhh * 128; r.P0 = qb * QB; return r; };
    int L = vcu; if (L >= TOTAL) return;
    int pass = 0; BlockRef cur = ref_of(L, 0); Seam S;
    int* jl = (int*)(lds + JL_OFF);
    { const int tid = otid(w0), w = __builtin_amdgcn_readfirstlane(tid >> 6), Lw = vcu + (w >> 1) * G;
      if (Lw < TOTAL) { const BlockRef r = ref_of(Lw, w & 1); const int j = compute_jlo(r, tid & 63); if ((tid & 63) == 0) jl[w] = j; } }
    __syncthreads();
    int bi = 0;
    prime(cur, jl[0], lds, S, w0);
    for (;;) {
        const bool more_pass = pass == 0, more_item = L + G < TOTAL, last = !more_pass && !more_item;
        int passn = pass + 1, Ln = L; if (!more_pass) { passn = 0; Ln = more_item ? L + G : L; }
        const BlockRef nxt = last ? cur : ref_of(Ln, passn);
        { const int ja = __builtin_amdgcn_readfirstlane(jl[bi]), jb = __builtin_amdgcn_readfirstlane(jl[last ? bi : bi + 1]); block(cur, nxt, ja, jb, lds, S, w0); ++bi; }
        if (last) break;
        cur = nxt; pass = passn; L = Ln;
    }
}
}
constexpr int NWAVES = 8, NTHR = 512;
constexpr int RING_BYTES = 131072;
constexpr int MISC_OFF = RING_BYTES + 24576;
constexpr int LDS_BYTES = MISC_OFF + 128;

struct Args {
    const float* in[28]; float* out; unsigned char* ws;
    int ph_lo, ph_hi, li, pad;
};
enum { I_X = 0, I_P, I_NORM_MIX, I_FOX_WIN, I_FOX_BF, I_FOX_WOUT, I_GDN_WIN, I_GDN_CONV, I_GDN_ALOG, I_GDN_DTB, I_GDN_NORM, I_GDN_WOUT,
       I_SSM_WIN, I_SSM_LRE, I_SSM_LIM, I_SSM_BRE, I_SSM_BIM, I_SSM_CRE, I_SSM_CIM, I_SSM_LSTEP, I_SSM_D, I_SSM_WGLU, I_SSM_BGLU, I_SSM_WOUT,
       I_NORM_PLE, I_PLE_WPROJ, I_PLE_WGATE, I_FINAL_NORM };

__device__ __forceinline__ void transpose_item(const float* W, int K, int N, bf16* dst, const float* gk, LAS float* scr, int k0, int n0, int lane) {
#pragma unroll 8
    for (int i = 0; i < 32; ++i) { const int kk = 2 * i + (lane >> 5); scr[kk * 33 + (lane & 31)] = W[(size_t)(k0 + kk) * N + n0 + (lane & 31)]; }
    const int c = lane & 7;
    f32x4 ga = {1.f, 1.f, 1.f, 1.f}, gb = ga;
    if (gk) { ga = *(const f32x4*)(gk + k0 + 8 * c); gb = *(const f32x4*)(gk + k0 + 8 * c + 4); }
    LDS_WAIT(); asm volatile("" ::: "memory");
#pragma unroll
    for (int j = 0; j < 4; ++j) { const int n = (lane >> 3) + 8 * j; const LAS float* s = scr + (8 * c) * 33 + n;
        u32x4 o; o.x = cvtpk(s[0 * 33] * ga[0], s[1 * 33] * ga[1]); o.y = cvtpk(s[2 * 33] * ga[2], s[3 * 33] * ga[3]); o.z = cvtpk(s[4 * 33] * gb[0], s[5 * 33] * gb[1]); o.w = cvtpk(s[6 * 33] * gb[2], s[7 * 33] * gb[3]);
        *(u32x4*)(dst + (size_t)n * K + k0 + 8 * c) = o; }
    LDS_WAIT(); asm volatile("" ::: "memory");
}
__device__ __forceinline__ void transpose_matrix(const float* W, int K, int N, bf16* WT, int nsplit, bf16* WT2, const float* gk, LAS float* scr, int gw, int NGW, int lane) {
    const int nblk = N / 32, nitems = (K / 64) * nblk;
    for (int it = gw; it < nitems; it += NGW) { const int kb = it / nblk, nb = it - kb * nblk, n0 = 32 * nb;
        bf16* dst = n0 < nsplit ? WT + (size_t)n0 * K : WT2 + (size_t)(n0 - nsplit) * K;
        transpose_item(W, K, N, dst, gk, scr, 64 * kb, n0, lane); }
}
__device__ __forceinline__ float row_to_bf16(const float* xrow, bf16* orow, int lane) {
    float s = 0.f;
#pragma unroll
    for (int j = 0; j < 8; ++j) { const int c = (j * 64 + lane) * 8;
        const f32x4 a = *(const f32x4*)(xrow + c), b = *(const f32x4*)(xrow + c + 4);
        const bf16x8 o = pack8(a, b); const u32x4 w = __builtin_bit_cast(u32x4, o);
        s += (bflo(w.x) * bflo(w.x) + bfhi(w.x) * bfhi(w.x)) + (bflo(w.y) * bflo(w.y) + bfhi(w.y) * bfhi(w.y)) + (bflo(w.z) * bflo(w.z) + bfhi(w.z) * bfhi(w.z)) + (bflo(w.w) * bflo(w.w) + bfhi(w.w) * bfhi(w.w));
        *(bf16x8*)(orow + c) = o; }
    return wave_sum(s);
}

template <int NS>
__device__ __forceinline__ void skinny_gemm(const bf16* A1, const bf16* WSK, const ssq_t* sumsq, int r0, LAS float* res, int wid, int lane) {
    constexpr int NT = NS / 32;
    const int mt = wid & 3, ng = wid >> 2, fr = lane & 15, fq = lane >> 4;
    f32x4 acc[NT];
#pragma unroll
    for (int t = 0; t < NT; ++t) acc[t] = (f32x4){0.f, 0.f, 0.f, 0.f};
    const bf16* ap = A1 + (size_t)(r0 + 16 * mt + fr) * 4096 + 8 * fq;
    const bf16* bp = WSK + (size_t)(16 * ng * NT + fr) * 4096 + 8 * fq;
#pragma unroll 8
    for (int k = 0; k < 4096; k += 32) {
        const bf16x8 a = *(const bf16x8*)(ap + k);
#pragma unroll
        for (int t = 0; t < NT; ++t) { const bf16x8 b = *(const bf16x8*)(bp + (size_t)t * 16 * 4096 + k); acc[t] = __builtin_amdgcn_mfma_f32_16x16x32_bf16(a, b, acc[t], 0, 0, 0); }
    }
#pragma unroll
    for (int i = 0; i < 4; ++i) { const int row = 16 * mt + 4 * fq + i; const float rs = __builtin_amdgcn_rsqf(ssq_val(sumsq[r0 + row]) * (1.0f / 4096.0f) + NORM_EPS);
#pragma unroll
        for (int t = 0; t < NT; ++t) res[row * NS + 16 * (ng * NT + t) + fr] = acc[t][i] * rs; }
}
namespace gdn {
constexpr int PQ = 272;
constexpr int PL = 68;
constexpr int G_Q = 0, G_K = 17408, G_V = 34816, G_L = 52224, G_S = 69632, GRP_BYTES = 70656;
static_assert(2 * GRP_BYTES <= 147456, "gdn prep LDS");

__device__ __forceinline__ void group_barrier(LAS unsigned* cnt, unsigned& target) {
    target += 4u;
    asm volatile("s_waitcnt lgkmcnt(0)" ::: "memory");
    if (__builtin_amdgcn_mbcnt_hi(~0u, __builtin_amdgcn_mbcnt_lo(~0u, 0u)) == 0u) __hip_atomic_fetch_add(cnt, 1u, __ATOMIC_RELAXED, __HIP_MEMORY_SCOPE_WORKGROUP);
    while (__hip_atomic_load(cnt, __ATOMIC_RELAXED, __HIP_MEMORY_SCOPE_WORKGROUP) < target) __builtin_amdgcn_s_sleep(1);
    asm volatile("" ::: "memory");
}
__device__ __forceinline__ void prep_pair(LAS unsigned char* lds, int uid0, const bf16* PROJ, const float* convw, const float* BETA, const float* GLOG, float* GL, unsigned char* REC, unsigned& gbt, const int w0) {
    const int tid = otid(w0), wid = __builtin_amdgcn_readfirstlane(tid >> 6), lane = tid & 63, grp = wid >> 2, gw = wid & 3, gt = tid & 255;
    const int uid = uid0 + grp, bhh = uid >> 7, c = uid & 127, b = bhh >> 5, h = bhh & 31;
    LAS unsigned char* gl = lds + grp * GRP_BYTES;
    LAS float* Lm = (LAS float*)(gl + G_L); LAS float* gcs = (LAS float*)(gl + G_S); LAS float* bes = gcs + 64; LAS float* egs = gcs + 128;
    unsigned char* rec = REC + (size_t)uid * GR_BYTES;
    LAS unsigned* gbc = (LAS unsigned*)(gl + G_S + 768);
    const size_t row0 = (size_t)b * SEQ + (size_t)c * 64;
    float g_ld = 0.f, b_ld = 0.f;
    if (gw == 0) { g_ld = GLOG[(row0 + lane) * 32 + h]; b_ld = BETA[(row0 + lane) * 32 + h]; }
    {
    {
        const int cg = gt & 15, rp = gt >> 4;
        u32x4 raw[2][7];
#define GDN_ROWS(s_, buf_) do { const bf16* bp_ = PROJ + (row0 + 4 * rp - 3) * LDP + (s_) * 4096 + h * 128 + 8 * cg; \
            _Pragma("unroll") for (int jj = 0; jj < 7; ++jj) raw[buf_][jj] = (c * 64 + 4 * rp - 3 + jj >= 0) ? *(const u32x4*)(bp_ + (size_t)jj * LDP) : (u32x4){0u, 0u, 0u, 0u}; } while (0)
        GDN_ROWS(0, 0);
#pragma unroll
        for (int s = 0; s < 3; ++s) {
            const int colb = s * 4096 + h * 128 + 8 * cg;
            f32x4 w[4][2];
#pragma unroll
            for (int j = 0; j < 4; ++j) { w[j][0] = *(const f32x4*)(convw + (size_t)j * 12288 + colb); w[j][1] = *(const f32x4*)(convw + (size_t)j * 12288 + colb + 4); }
            if (s == 0) GDN_ROWS(1, 1); else if (s == 1) GDN_ROWS(2, 0);
            float xr[7][8];
#pragma unroll
            for (int jj = 0; jj < 7; ++jj) unpack8(raw[s & 1][jj], xr[jj]);
#pragma unroll
            for (int i = 0; i < 4; ++i) { const int t = 4 * rp + i; float y[8];
#pragma unroll
                for (int e = 0; e < 8; ++e) y[e] = 0.f;
#pragma unroll
                for (int j = 0; j < 4; ++j)
#pragma unroll
                    for (int e = 0; e < 4; ++e) { y[e] += w[j][0][e] * xr[i + j][e]; y[4 + e] += w[j][1][e] * xr[i + j][4 + e]; }
                float ss = 0.f;
#pragma unroll
                for (int e = 0; e < 8; ++e) { y[e] = siluf_(y[e]); ss += y[e] * y[e]; }
                float sc = 1.f;
                if (s < 2) { ss += __shfl_xor(ss, 1); ss += __shfl_xor(ss, 2); ss += __shfl_xor(ss, 4); ss += __shfl_xor(ss, 8);
                    sc = __builtin_amdgcn_rsqf(ss + NORM_EPS) * (s == 0 ? 0.08838834764831845f : 1.0f); }
                *(LAS bf16x8*)(gl + s * 17408 + t * PQ + cg * 16) = pack8((f32x4){y[0] * sc, y[1] * sc, y[2] * sc, y[3] * sc}, (f32x4){y[4] * sc, y[5] * sc, y[6] * sc, y[7] * sc}); }
        }
#undef GDN_ROWS
    }
    }
    if (gw == 0) { float g = g_ld;
#pragma unroll
        for (int o = 1; o < 64; o <<= 1) { const float t = __shfl_up(g, o); if (lane >= o) g += t; }
        gcs[lane] = g; bes[lane] = b_ld; egs[lane] = fexp(g);
        if (lane == 63) GL[uid] = fexp(g); }
    group_barrier(gbc, gbt);
    {
    {
        const int fr = lane & 15, fq = lane >> 4, mt = gw;
        bf16x8 kA[4], qA[4];
#pragma unroll
        for (int s = 0; s < 4; ++s) { kA[s] = *(const LAS bf16x8*)(gl + G_K + (16 * mt + fr) * PQ + (32 * s + 8 * fq) * 2); qA[s] = *(const LAS bf16x8*)(gl + G_Q + (16 * mt + fr) * PQ + (32 * s + 8 * fq) * 2); }
        bf16* intra = (bf16*)(rec + GR_IN);
#pragma unroll
        for (int nt = 0; nt < 4; ++nt) { f32x4 kk = {0.f, 0.f, 0.f, 0.f}, qk = {0.f, 0.f, 0.f, 0.f};
#pragma unroll
            for (int s = 0; s < 4; ++s) { const bf16x8 kB = *(const LAS bf16x8*)(gl + G_K + (16 * nt + fr) * PQ + (32 * s + 8 * fq) * 2);
                kk = __builtin_amdgcn_mfma_f32_16x16x32_bf16(kA[s], kB, kk, 0, 0, 0); qk = __builtin_amdgcn_mfma_f32_16x16x32_bf16(qA[s], kB, qk, 0, 0, 0); }
            const int j = 16 * nt + fr; const float gj = gcs[j];
#pragma unroll
            for (int e = 0; e < 4; ++e) { const int i = 16 * mt + 4 * fq + e; const float dec = (i >= j) ? fexp(gcs[i] - gj) : 0.f;
                Lm[i * PL + j] = (i > j) ? bes[i] * kk[e] * dec : 0.f;
                intra[i * 64 + j] = (bf16)(cvtpk(qk[e] * dec, 0.f) & 0xffffu); } }
    }
    {
        const int row = gt >> 2, seg = gt & 3; const float e = egs[row];
#pragma unroll
        for (int q4 = 0; q4 < 4; ++q4) { const u32x4 xw = *(const LAS u32x4*)(gl + G_Q + row * PQ + (seg * 32 + q4 * 8) * 2); float x[8]; unpack8(xw, x);
            *(bf16x8*)(rec + GR_QD + ((size_t)row * 128 + seg * 32 + q4 * 8) * 2) = pack8((f32x4){x[0] * e, x[1] * e, x[2] * e, x[3] * e}, (f32x4){x[4] * e, x[5] * e, x[6] * e, x[7] * e}); }
        const int d = gt & 127, half = gt >> 7; const float g63 = gcs[63];
#pragma unroll
        for (int q4 = 0; q4 < 4; ++q4) { float v[8];
#pragma unroll
            for (int e2 = 0; e2 < 8; ++e2) { const int i = 32 * half + 8 * q4 + e2; v[e2] = bf2f(*(const LAS bf16*)(gl + G_K + i * PQ + d * 2)) * fexp(g63 - gcs[i]); }
            *(bf16x8*)(rec + GR_KT + ((size_t)d * 64 + 32 * half + 8 * q4) * 2) = pack8((f32x4){v[0], v[1], v[2], v[3]}, (f32x4){v[4], v[5], v[6], v[7]}); }
    }
    }
    group_barrier(gbc, gbt);
    if (gt < 128) {
        LAS bf16* vp = (LAS bf16*)(gl + G_V) + gt; LAS bf16* kp = (LAS bf16*)(gl + G_K) + gt;
        f32x2 x[64];
#pragma unroll
        for (int i = 0; i < 64; ++i) {
            f32x4 lr[16];
#pragma unroll
            for (int j4 = 0; j4 < (i + 3) / 4; ++j4) lr[j4] = *(const LAS f32x4*)(Lm + i * PL + 4 * j4);
            const float be = bes[i];
            f32x2 a = {bf2f(vp[i * (PQ / 2)]) * be, bf2f(kp[i * (PQ / 2)]) * be * egs[i]};
            f32x2 acc[4] = {{0.f, 0.f}, {0.f, 0.f}, {0.f, 0.f}, {0.f, 0.f}};
#pragma unroll
            for (int j4 = 0; j4 < (i + 3) / 4; ++j4)
#pragma unroll
                for (int e = 0; e < 4; ++e) if (4 * j4 + e < i) acc[e] += x[4 * j4 + e] * lr[j4][e];
            a -= (acc[0] + acc[1]) + (acc[2] + acc[3]);
            x[i] = a;
        }
#pragma unroll
        for (int i = 0; i < 64; ++i) { const unsigned w = cvtpk(x[i].x, x[i].y);
            vp[i * (PQ / 2)] = (bf16)(w & 0xffffu); kp[i * (PQ / 2)] = (bf16)(w >> 16); }
    }
    group_barrier(gbc, gbt);
    {
        const int row = gt >> 2, seg = gt & 3;
#pragma unroll
        for (int q4 = 0; q4 < 4; ++q4) {
            *(u32x4*)(rec + GR_U + ((size_t)row * 128 + seg * 32 + q4 * 8) * 2) = *(const LAS u32x4*)(gl + G_V + row * PQ + (seg * 32 + q4 * 8) * 2);
            *(u32x4*)(rec + GR_W + ((size_t)row * 128 + seg * 32 + q4 * 8) * 2) = *(const LAS u32x4*)(gl + G_K + row * PQ + (seg * 32 + q4 * 8) * 2); }
    }
    group_barrier(gbc, gbt);
}

constexpr int SP = 272, SPT = 144, SPU = 80;
constexpr int L_QD = 0, L_W = 17408, L_KT = 34816, L_IN = 53248, L_U = 62464, L_BUF = 67584;
constexpr int L_ST = 2 * L_BUF, L_VT = L_ST + 32 * SP, SCAN_LDS = L_VT + 32 * SPT;
static_assert(SCAN_LDS <= 155648, "gdn scan LDS");
__device__ __forceinline__ bf16x8 pack_cc(const f32x4& lo, const f32x4& hi) { const u32x4 w = {cvtpk(lo[0], lo[1]), cvtpk(lo[2], lo[3]), cvtpk(hi[0], hi[1]), cvtpk(hi[2], hi[3])}; return __builtin_bit_cast(bf16x8, w); }
__device__ __forceinline__ void scan_unit(LAS unsigned char* lds, int unit, const unsigned char* REC, const float* GL, bf16* O16  , const int w0) {
    const int tid = otid(w0), wid = __builtin_amdgcn_readfirstlane(tid >> 6), lane = tid & 63, fr = lane & 15, fq = lane >> 4;
    const int bhh = unit >> 2, q4 = unit & 3, b = bhh >> 5, h = bhh & 31, nt = wid & 1, mt = wid >> 1;
    f32x4 S[2];
    S[0] = (f32x4){0.f, 0.f, 0.f, 0.f}; S[1] = (f32x4){0.f, 0.f, 0.f, 0.f};
    u32x4 st[8];
    int srcoff[8], dstoff[8];
#pragma unroll
    for (int i = 0; i < 8; ++i) { const int p = tid + 512 * i; int so, d;
        if (p < 1024) { so = (int)GR_QD + p * 16; d = L_QD + (p >> 4) * SP + (p & 15) * 16; }
        else if (p < 2048) { const int q = p - 1024; so = (int)GR_W + q * 16; d = L_W + (q >> 4) * SP + (q & 15) * 16; }
        else if (p < 3072) { const int q = p - 2048; so = (int)GR_KT + q * 16; d = L_KT + (q >> 3) * SPT + (q & 7) * 16; }
        else if (p < 3584) { const int q = p - 3072; so = (int)GR_IN + q * 16; d = L_IN + (q >> 3) * SPT + (q & 7) * 16; }
        else { const int q = (p - 3584) & 255; so = (int)GR_U + (q >> 2) * 256 + q4 * 64 + (q & 3) * 16; d = L_U + (q >> 2) * SPU + (q & 3) * 16; }
        srcoff[i] = so; dstoff[i] = d; }
    const bool has8 = tid < 256;
#define GDN_ISSUE(c_) do { const unsigned char* rec_ = REC + ((size_t)bhh * 128 + (c_)) * GR_BYTES; \
        _Pragma("unroll") for (int i = 0; i < 7; ++i) st[i] = *(const u32x4*)(rec_ + srcoff[i]); if (has8) st[7] = *(const u32x4*)(rec_ + srcoff[7]); } while (0)
#define GDN_STASH(buf_) do { LAS unsigned char* bp_ = lds + (buf_) * L_BUF; \
        _Pragma("unroll") for (int i = 0; i < 7; ++i) *(LAS u32x4*)(bp_ + dstoff[i]) = st[i]; if (has8) *(LAS u32x4*)(bp_ + dstoff[7]) = st[7]; } while (0)
    { const u32x4 z4 = ozero4(); for (int i = tid; i < (32 * SP) / 16; i += 512) *(LAS u32x4*)(lds + L_ST + i * 16) = z4; }
    GDN_ISSUE(0); GDN_STASH(0); __syncthreads();
    float gl_n = GL[bhh * 128]; asm volatile("" ::: "memory");
    GDN_ISSUE(1);
    bf16* orow = O16 + ((size_t)b * SEQ + 16 * mt + 4 * fq) * 4096 + h * 128 + 32 * q4 + 16 * nt + fr;
    const LAS unsigned char* stp = lds + L_ST + (16 * nt + fr) * SP + 16 * fq;
    const LAS unsigned char* vtp = lds + L_VT + (16 * nt + fr) * SPT + 16 * fq;
#pragma unroll 1
    for (int c = 0; c < GDN_NCHUNK; ++c) {
        const LAS unsigned char* bp = lds + (c & 1) * L_BUF;
        const float glast = gl_n;
        bf16x8 Sb[4];
#pragma unroll
        for (int s = 0; s < 4; ++s) Sb[s] = *(const LAS bf16x8*)(stp + 64 * s);
        f32x4 aw = {0.f, 0.f, 0.f, 0.f}, ao = {0.f, 0.f, 0.f, 0.f};
#pragma unroll
        for (int s = 0; s < 4; ++s) { aw = __builtin_amdgcn_mfma_f32_16x16x32_bf16(*(const LAS bf16x8*)(bp + L_W + (16 * mt + fr) * SP + 64 * s + 16 * fq), Sb[s], aw, 0, 0, 0);
            ao = __builtin_amdgcn_mfma_f32_16x16x32_bf16(*(const LAS bf16x8*)(bp + L_QD + (16 * mt + fr) * SP + 64 * s + 16 * fq), Sb[s], ao, 0, 0, 0); }
        f32x4 vn;
#pragma unroll
        for (int e = 0; e < 4; ++e) vn[e] = bf2f(*(const LAS bf16*)(bp + L_U + (16 * mt + 4 * fq + e) * SPU + (16 * nt + fr) * 2)) - aw[e];
        *(LAS u32x2*)(lds + L_VT + (16 * nt + fr) * SPT + (16 * mt + 4 * fq) * 2) = (u32x2){cvtpk(vn[0], vn[1]), cvtpk(vn[2], vn[3])};
        __syncthreads();
        bf16x8 vb[2];
        vb[0] = *(const LAS bf16x8*)vtp; vb[1] = *(const LAS bf16x8*)(vtp + 64);
#pragma unroll
        for (int s2 = 0; s2 < 2; ++s2) ao = __builtin_amdgcn_mfma_f32_16x16x32_bf16(*(const LAS bf16x8*)(bp + L_IN + (16 * mt + fr) * SPT + 64 * s2 + 16 * fq), vb[s2], ao, 0, 0, 0);
#pragma unroll
        for (int kk = 0; kk < 2; ++kk) { f32x4 a = S[kk] * glast;
#pragma unroll
            for (int s2 = 0; s2 < 2; ++s2) a = __builtin_amdgcn_mfma_f32_16x16x32_bf16(*(const LAS bf16x8*)(bp + L_KT + (16 * (2 * mt + kk) + fr) * SPT + 64 * s2 + 16 * fq), vb[s2], a, 0, 0, 0);
            S[kk] = a;
            *(LAS u32x2*)(lds + L_ST + (16 * nt + fr) * SP + (16 * (2 * mt + kk) + 4 * fq) * 2) = (u32x2){cvtpk(a[0], a[1]), cvtpk(a[2], a[3])}; }
#pragma unroll
        for (int e = 0; e < 4; ++e) orow[(size_t)(c * 64 + e) * 4096] = (bf16)(cvtpk(ao[e], 0.f) & 0xffffu);
        if (c + 1 < GDN_NCHUNK) GDN_STASH((c + 1) & 1);
        __syncthreads();
        if (c + 1 < GDN_NCHUNK) { gl_n = GL[bhh * 128 + c + 1]; asm volatile("" ::: "memory"); }
        if (c + 2 < GDN_NCHUNK) GDN_ISSUE(c + 2);
    }
#undef GDN_ISSUE
#undef GDN_STASH
}
__device__ __forceinline__ void normgate(int gwv, int NGW, int lane, const bf16* O16, const bf16* PROJ, const float* normw, bf16* MIX) {
    const f32x4 n0 = *(const f32x4*)(normw + ((lane & 15) * 8)), n1 = *(const f32x4*)(normw + ((lane & 15) * 8) + 4);
#pragma unroll 2
    for (int it = gwv; it < M_TOK * 8; it += NGW) { const int row = it >> 3, c8 = (it & 7) * 512 + lane * 8;
        const u32x4 ow = *(const u32x4*)(O16 + (size_t)row * 4096 + c8); const f32x4 o0 = {bflo(ow.x), bfhi(ow.x), bflo(ow.y), bfhi(ow.y)}, o1 = {bflo(ow.z), bfhi(ow.z), bflo(ow.w), bfhi(ow.w)};
        const u32x4 zw = *(const u32x4*)(PROJ + (size_t)row * LDP + ZCOL + c8); float z[8]; unpack8(zw, z);
        float q = (o0[0] * o0[0] + o0[1] * o0[1]) + (o0[2] * o0[2] + o0[3] * o0[3]) + (o1[0] * o1[0] + o1[1] * o1[1]) + (o1[2] * o1[2] + o1[3] * o1[3]);
        q += __shfl_xor(q, 1); q += __shfl_xor(q, 2); q += __shfl_xor(q, 4); q += __shfl_xor(q, 8);
        const float rs = __builtin_amdgcn_rsqf(q * (1.0f / 128.0f) + NORM_EPS);
        f32x4 r0, r1;
#pragma unroll
        for (int e = 0; e < 4; ++e) { r0[e] = o0[e] * rs * n0[e] * siluf_(z[e]); r1[e] = o1[e] * rs * n1[e] * siluf_(z[4 + e]); }
        *(bf16x8*)(MIX + (size_t)row * 4096 + c8) = pack8(r0, r1); }
}
}
namespace s5 {
__device__ __forceinline__ void sincos_cw(float x, float& s, float& c) {
    const float kf = rintf(x * 0.6366197723675814f); const int k = (int)kf;
    float r = fmaf(kf, -1.5703125f, x); r = fmaf(kf, -4.837512969970703125e-4f, r); r = fmaf(kf, -7.54978995489188e-8f, r);
    const float r2 = r * r;
    float c1 = -1.9515295891e-4f, c2 = 8.3321608736e-3f, c3 = 2.443315711809948e-5f, c4 = -1.388731625493765e-3f; asm volatile("" : "+v"(c1), "+v"(c2), "+v"(c3), "+v"(c4));
    const float sp = fmaf(r * r2, fmaf(r2, fmaf(r2, c1, c2), -1.6666654611e-1f), r);
    const float cp = fmaf(r2 * r2, fmaf(r2, fmaf(r2, c3, c4), 4.166664568298827e-2f), fmaf(r2, -0.5f, 1.0f));
    const int q = k & 3;
    s = (q == 0) ? sp : (q == 1) ? cp : (q == 2) ? -sp : -cp;
    c = (q == 0) ? cp : (q == 1) ? -sp : (q == 2) ? -cp : sp;
}
__device__ __forceinline__ void zoh_of(int g, int p, const float* LRE, const float* LIM, const float* LSTEP, float& lr, float& li, float& zr, float& zi) {
    const float lam_re = LRE[g * 64 + p], lam_im = LIM[g * 64 + p], step = fexp(LSTEP[g]);
    const float mag = fexp(lam_re * step); float sn, cs; sincos_cw(lam_im * step, sn, cs);
    lr = mag * cs; li = mag * sn;
    const float den = lam_re * lam_re + lam_im * lam_im, num_re = lr - 1.0f;
    zr = (num_re * lam_re + li * lam_im) / den; zi = (li * lam_re - num_re * lam_im) / den;
}
struct Disc { float lr, li; bf16x8 bh[8], bl[8]; };
__device__ __forceinline__ void discretise(Disc& d, int g, int lane, const float* LRE, const float* LIM, const float* BRE, const float* BIM, const float* LSTEP) {
    float zr, zi; zoh_of(g, lane, LRE, LIM, LSTEP, d.lr, d.li, zr, zi);
    const int fr = lane & 15, fq = lane >> 4, n0 = 8 * (fq & 1);
#pragma unroll
    for (int t = 0; t < 4; ++t) { const int p = 16 * t + fr; float lr, li; zoh_of(g, p, LRE, LIM, LSTEP, lr, li, zr, zi);
        const float* br = BRE + (size_t)(g * 64 + p) * 16 + n0; const float* bi = BIM + (size_t)(g * 64 + p) * 16 + n0;
        const f32x4 r0 = *(const f32x4*)br, r1 = *(const f32x4*)(br + 4), i0 = *(const f32x4*)bi, i1 = *(const f32x4*)(bi + 4);
        const f32x4 re0 = r0 * zr - i0 * zi, re1 = r1 * zr - i1 * zi, im0 = i0 * zr + r0 * zi, im1 = i1 * zr + r1 * zi;
        const u32x4 rh = __builtin_bit_cast(u32x4, pack8(re0, re1)), ih = __builtin_bit_cast(u32x4, pack8(im0, im1));
        float rhf[8], ihf[8]; unpack8(rh, rhf); unpack8(ih, ihf);
        const f32x4 rl0 = {re0[0] - rhf[0], re0[1] - rhf[1], re0[2] - rhf[2], re0[3] - rhf[3]}, rl1 = {re1[0] - rhf[4], re1[1] - rhf[5], re1[2] - rhf[6], re1[3] - rhf[7]};
        const f32x4 il0 = {im0[0] - ihf[0], im0[1] - ihf[1], im0[2] - ihf[2], im0[3] - ihf[3]}, il1 = {im1[0] - ihf[4], im1[1] - ihf[5], im1[2] - ihf[6], im1[3] - ihf[7]};
        const bf16x8 zero8 = {0, 0, 0, 0, 0, 0, 0, 0};
        d.bh[t] = __builtin_bit_cast(bf16x8, rh); d.bh[4 + t] = __builtin_bit_cast(bf16x8, ih);
        d.bl[t] = fq < 2 ? pack8(rl0, rl1) : zero8; d.bl[4 + t] = fq < 2 ? pack8(il0, il1) : zero8; }
}
constexpr int BUP = 20;
__device__ __forceinline__ void bu_tile(const Disc& d, const LAS float* us, LAS float* but, int t0, int lane) {
    const int fr = lane & 15, fq = lane >> 4;
    const f32x4 u0 = *(const LAS f32x4*)(us + (t0 + fr) * 16 + 8 * (fq & 1)), u1 = *(const LAS f32x4*)(us + (t0 + fr) * 16 + 8 * (fq & 1) + 4);
    const u32x4 uh = __builtin_bit_cast(u32x4, pack8(u0, u1)); float uhf[8]; unpack8(uh, uhf);
    const f32x4 l0 = {u0[0] - uhf[0], u0[1] - uhf[1], u0[2] - uhf[2], u0[3] - uhf[3]}, l1 = {u1[0] - uhf[4], u1[1] - uhf[5], u1[2] - uhf[6], u1[3] - uhf[7]};
    const bf16x8 af = fq < 2 ? __builtin_bit_cast(bf16x8, uh) : pack8(l0, l1);
    f32x4 accs[8];
#pragma unroll
    for (int ct = 0; ct < 8; ++ct) { f32x4 acc = {0.f, 0.f, 0.f, 0.f};
        acc = __builtin_amdgcn_mfma_f32_16x16x32_bf16(af, d.bh[ct], acc, 0, 0, 0);
        accs[ct] = __builtin_amdgcn_mfma_f32_16x16x32_bf16(af, d.bl[ct], acc, 0, 0, 0); }
    asm volatile("s_nop 15\n\ts_nop 15" : "+v"(accs[0]), "+v"(accs[1]), "+v"(accs[2]), "+v"(accs[3]), "+v"(accs[4]), "+v"(accs[5]), "+v"(accs[6]), "+v"(accs[7]));
#pragma unroll
    for (int ct = 0; ct < 8; ++ct) *(LAS f32x4*)(but + (16 * ct + fr) * BUP + 4 * fq) = accs[ct];
}
struct Slab { u32x4 r[2]; };
__device__ __forceinline__ void slab_issue(Slab& s, const bf16* up  , int lane) {
#pragma unroll
    for (int i = 0; i < 2; ++i) { const int pc = 64 * i + lane; s.r[i] = *(const u32x4*)(up + (size_t)(pc >> 1) * LDP + (pc & 1) * 8); }
}
__device__ __forceinline__ void slab_store(const Slab& s, LAS float* us, int lane) {
#pragma unroll
    for (int i = 0; i < 2; ++i) { const int pc = 64 * i + lane; const u32x4 w = s.r[i];
        *(LAS f32x4*)(us + pc * 8) = (f32x4){bflo(w.x), bfhi(w.x), bflo(w.y), bfhi(w.y)}; *(LAS f32x4*)(us + pc * 8 + 4) = (f32x4){bflo(w.z), bfhi(w.z), bflo(w.w), bfhi(w.w)}; }
}
__device__ __forceinline__ void pass1(LAS float* us, LAS float* but, int gwv, int NGW, int lane, const bf16* U, const float* LRE, const float* LIM, const float* BRE, const float* BIM, const float* LSTEP, f32x2* ENDST) {
#pragma unroll 1
    for (int wu = gwv; wu < BATCH * SSM_G * SSM_NSEG; wu += NGW) {
        const int g = wu & 255, seg = (wu >> 8) & (SSM_NSEG - 1), b = wu >> 13, bg = b * 256 + g;
        Disc d; discretise(d, g, lane, LRE, LIM, BRE, BIM, LSTEP);
        const bf16* up = U + ((size_t)b * SEQ + (size_t)seg * SSM_SL) * LDP + 16 * g;
        float xr = 0.f, xi = 0.f;
        Slab sl; slab_issue(sl, up, lane);
#pragma unroll 1
        for (int tb = 0; tb < SSM_SL; tb += 64) {
            slab_store(sl, us, lane);
            if (tb + 64 < SSM_SL) slab_issue(sl, up + (size_t)(tb + 64) * LDP, lane);
#pragma unroll 1
            for (int t0 = 0; t0 < 64; t0 += 16) {
                bu_tile(d, us, but, t0, lane);
                f32x4 brv[4], biv[4];
#pragma unroll
                for (int q = 0; q < 4; ++q) { brv[q] = *(const LAS f32x4*)(but + lane * BUP + 4 * q); biv[q] = *(const LAS f32x4*)(but + (64 + lane) * BUP + 4 * q); }
#pragma unroll
                for (int t = 0; t < 16; ++t) { const float br = brv[t >> 2][t & 3], bi = biv[t >> 2][t & 3];
                    const float nr = fmaf(d.lr, xr, fmaf(-d.li, xi, br)), ni = fmaf(d.lr, xi, fmaf(d.li, xr, bi)); xr = nr; xi = ni; }
            }
        }
        ENDST[((size_t)bg * SSM_NSEG + seg) * 64 + lane] = (f32x2){xr, xi};
    }
}
__device__ __forceinline__ float gelu_tanh(float y) { const float a = 0.7978845608028654f * (y + 0.044715f * y * y * y); const float t = 1.0f - 2.0f * __builtin_amdgcn_rcpf(1.0f + fexp(2.0f * a)); return 0.5f * y * (1.0f + t); }
constexpr int XP = 272;
__device__ __forceinline__ void pass2(LAS unsigned char* xt  , int gwv, int NGW, int lane, const bf16* U, const float* LRE, const float* LIM, const float* BRE, const float* BIM,
                                      const float* CRE, const float* CIM, const float* LSTEP, const float* DSK, const f32x2* ENDST, bf16* Y1) {
    const int fr = lane & 15, fq = lane >> 4;
    LAS float* us = (LAS float*)(xt + 16 * XP); LAS float* but = (LAS float*)(xt + 16 * XP + 4096);
#pragma unroll 1
    for (int wu = gwv; wu < BATCH * SSM_G * SSM_NSEG; wu += NGW) {
        const int g = wu & 255, seg = (wu >> 8) & (SSM_NSEG - 1), b = wu >> 13, bg = b * 256 + g;
        Disc d; discretise(d, g, lane, LRE, LIM, BRE, BIM, LSTEP);
        const size_t row0 = (size_t)b * SEQ + (size_t)seg * SSM_SL;
        const bf16* up = U + row0 * LDP + 16 * g;
        Slab sl; slab_issue(sl, up, lane);
        float pr = d.lr, pi = d.li;
#pragma unroll
        for (int i = 0; i < 8; ++i) { const float a = pr * pr - pi * pi, c = 2.0f * pr * pi; pr = a; pi = c; }
        float xr = 0.f, xi = 0.f;
#pragma unroll 1
        for (int s = 0; s < seg; ++s) { const f32x2 e = ENDST[((size_t)bg * SSM_NSEG + s) * 64 + lane];
            const float nr = fmaf(pr, xr, fmaf(-pi, xi, e.x)), ni = fmaf(pr, xi, fmaf(pi, xr, e.y)); xr = nr; xi = ni; }
        bf16x8 cf[4];
#pragma unroll
        for (int s = 0; s < 4; ++s) { const float* cp = (s < 2 ? CRE : CIM) + (size_t)(g * 16 + fr) * 64 + 32 * (s & 1) + 8 * fq; const float sg = s < 2 ? 1.0f : -1.0f;
            const f32x4 a = *(const f32x4*)cp * sg, c = *(const f32x4*)(cp + 4) * sg; cf[s] = pack8(a, c); }
        const float dsk = DSK[16 * g + fr];
#pragma unroll 1
        for (int tb = 0; tb < SSM_SL; tb += 64) {
            slab_store(sl, us, lane);
            if (tb + 64 < SSM_SL) slab_issue(sl, up + (size_t)(tb + 64) * LDP, lane);
#pragma unroll 1
            for (int t0 = 0; t0 < 64; t0 += 16) {
                bu_tile(d, us, but, t0, lane);
                f32x4 brv[4], biv[4];
#pragma unroll
                for (int q = 0; q < 4; ++q) { brv[q] = *(const LAS f32x4*)(but + lane * BUP + 4 * q); biv[q] = *(const LAS f32x4*)(but + (64 + lane) * BUP + 4 * q); }
#pragma unroll
                for (int t = 0; t < 16; ++t) { const float br = brv[t >> 2][t & 3], bi = biv[t >> 2][t & 3];
                    const float nr = fmaf(d.lr, xr, fmaf(-d.li, xi, br)), ni = fmaf(d.lr, xi, fmaf(d.li, xr, bi)); xr = nr; xi = ni;
                    const unsigned w = cvtpk(xr, xi);
                    *(LAS bf16*)(xt + t * XP + lane * 2) = (bf16)(w & 0xffffu); *(LAS bf16*)(xt + t * XP + 128 + lane * 2) = (bf16)(w >> 16); }
                LDS_WAIT();
                f32x4 acc = {0.f, 0.f, 0.f, 0.f};
#pragma unroll
                for (int s = 0; s < 4; ++s) { const bf16x8 xa = *(const LAS bf16x8*)(xt + fr * XP + (32 * s + 8 * fq) * 2); acc = __builtin_amdgcn_mfma_f32_16x16x32_bf16(xa, cf[s], acc, 0, 0, 0); }
#pragma unroll
                for (int e = 0; e < 4; ++e) { const int tl = t0 + 4 * fq + e; const float u = us[tl * 16 + fr];
                    const float y = gelu_tanh(acc[e] + dsk * u);
                    Y1[(row0 + tb + tl) * 4096 + 16 * g + fr] = (bf16)(cvtpk(y, 0.f) & 0xffffu); }
                LDS_WAIT();
            }
        }
    }
}
}
constexpr int PH_PER_LAYER = 10, PH_FINAL = 40, PH_END = 41;
__host__ __device__ constexpr bool phase_exists(int ph) {
    if (ph == PH_FINAL) return true; if (ph < 0 || ph >= PH_FINAL) return false;
    const int L = ph / PH_PER_LAYER, k = ph % PH_PER_LAYER, kind = L % 3;
    if (k == 4) return kind != 0; return k <= 6;
}
typedef const __attribute__((address_space(4))) Args* kargs_t;
#define KARGS() ({ kargs_t p_ = (kargs_t)__builtin_amdgcn_kernarg_segment_ptr(); asm volatile("" : "+s"(p_)); p_; })
#define WSP(T, off) ((T*)(ws + (off)))
__global__ void __launch_bounds__(NTHR, 2) trunk_fwd(Args args_unused) {
    extern __shared__ __attribute__((aligned(16))) unsigned char lds_raw[];
    LAS unsigned char* lds = (LAS unsigned char*)lds_raw;
    const int w0 = __builtin_amdgcn_readfirstlane(threadIdx.x >> 6);
    const int G = gridDim.x, bx = blockIdx.x, vcu = (G % 8 == 0) ? (bx % 8) * (G / 8) + bx / 8 : bx, NGW = G * NWAVES;
#define TIDS() const int tid = otid(w0), lane = tid & 63, wid = __builtin_amdgcn_readfirstlane(tid >> 6), gwv = vcu * NWAVES + wid; (void)lane; (void)gwv
    { volatile LAS unsigned* MISC = (volatile LAS unsigned*)(lds + MISC_OFF); if (threadIdx.x < 32) MISC[threadIdx.x] = 0u; }
    __syncthreads();
    int lo, hi;
    { kargs_t ap = KARGS(); lo = ap->ph_lo; hi = ap->ph_hi;
      if (hi - lo > 1) (void)xcd_barrier_post((unsigned*)(ap->ws + WS_CTL) + CW_BAR + ap->li * XCD_BAR_WORDS, (volatile LAS unsigned*)(lds + MISC_OFF) + 8); }
#define IN(k) (lo <= (k) && (k) < hi)
#define SEAM(k) do { if ((k) + 1 < hi) { kargs_t ap_ = KARGS(); XcdBarrier b_; b_.bar = (unsigned*)(ap_->ws + WS_CTL) + CW_BAR + ap_->li * XCD_BAR_WORDS; b_.x = xb_xcc_id(); \
        b_.st = (volatile LAS unsigned*)(lds + MISC_OFF) + 8; b_.tid = (unsigned)otid(w0); xcd_barrier(b_); } } while (0)

#pragma unroll 1
    for (int L = 0; L < DEPTH; ++L) {
        const int base = L * PH_PER_LAYER, kind = L % 3, j = L / 3;

        if (IN(base + 0)) {
            kargs_t ap = KARGS(); unsigned char* ws = ap->ws; TIDS();
            LAS float* scr = (LAS float*)(lds + wid * 16384);
            const int n_in = kind == 0 ? 16416 : kind == 1 ? 16448 : 8192;
            const float* w_in = kind == 0 ? ap->in[I_FOX_WIN] + (size_t)j * 4096 * 16416 : kind == 1 ? ap->in[I_GDN_WIN] : ap->in[I_SSM_WIN];
            const float* w_out = kind == 0 ? ap->in[I_FOX_WOUT] + (size_t)j * 4096 * 4096 : kind == 1 ? ap->in[I_GDN_WOUT] : ap->in[I_SSM_WOUT];
            transpose_matrix(w_out, 4096, 4096, WSP(bf16, WS_WOUT), 4096, WSP(bf16, WS_WOUT), nullptr, scr, gwv, NGW, lane);
            transpose_matrix(ap->in[I_PLE_WGATE] + (size_t)L * 4096 * 4096, 4096, 4096, WSP(bf16, WS_WGATE), 4096, WSP(bf16, WS_WGATE), ap->in[I_NORM_PLE] + (size_t)L * D_MODEL, scr, gwv, NGW, lane);
            transpose_matrix(ap->in[I_PLE_WPROJ] + (size_t)L * 256 * 4096, 256, 4096, WSP(bf16, WS_WPP), 4096, WSP(bf16, WS_WPP), nullptr, scr, gwv, NGW, lane);
            if (kind == 2) transpose_matrix(ap->in[I_SSM_WGLU], 4096, 4096, WSP(bf16, WS_WGLU), 4096, WSP(bf16, WS_WGLU), nullptr, scr, gwv, NGW, lane);
            transpose_matrix(w_in, 4096, n_in, WSP(bf16, WS_WIN), 16384, WSP(bf16, WS_WSK), ap->in[I_NORM_MIX] + (size_t)L * D_MODEL, scr, gwv, NGW, lane);
            { const float* p = ap->in[I_P] + (size_t)L * M_TOK * PLE_DIM; bf16* P_BF = WSP(bf16, WS_PBF);
              for (size_t i = (size_t)bx * NTHR + tid; i < (size_t)M_TOK * PLE_DIM / 8; i += (size_t)G * NTHR) {
                  const f32x4 a = *(const f32x4*)(p + i * 8), b = *(const f32x4*)(p + i * 8 + 4); *(bf16x8*)(P_BF + i * 8) = pack8(a, b); } }
            if (L == 0) { const float* x = ap->in[I_X]; bf16* X0 = WSP(bf16, WS_X0); ssq_t* ssq_in = SSQ_PTR(0);
                for (int m = gwv; m < M_TOK; m += NGW) { const float s = row_to_bf16(x + (size_t)m * 4096, X0 + (size_t)m * 4096, lane); if (lane == 0) ssq_in[m] = ssq_fix(s); } }
            __syncthreads();
            SEAM(base + 0);
        }
        if (IN(base + 1)) {
            kargs_t ap = KARGS(); unsigned char* ws = ap->ws; TIDS();
            const bf16* A1 = WSP(bf16, WS_X0); const ssq_t* ssq_in = SSQ_PTR(2 * L);
            if (kind != 2) {
                LAS float* res = (LAS float*)lds; const bf16* W_SK = WSP(bf16, WS_WSK);
                for (int un = vcu; un < M_TOK / 64; un += G) {
                    const int r0 = un * 64;
                    if (kind == 0) {
                        float* CUML = WSP(float, WS_SMALL + SM_CUML); float* TTOT = WSP(float, WS_SMALL + SM_TTOT);
                        skinny_gemm<32>(A1, W_SK, ssq_in, r0, res, wid, lane);
                        __syncthreads();
                        if (tid < 32) { const int h = tid; const float bf = ap->in[I_FOX_BF][j * 32 + h]; float run = 0.f;
                            for (int r = 0; r < 64; ++r) { const float x = res[r * 32 + h] + bf; const float lf = fminf(x, 0.f) - flog(1.0f + fexp(-fabsf(x))); run += lf; CUML[(size_t)(r0 + r) * 32 + h] = run; }
                            TTOT[(size_t)un * 32 + h] = run; }
                    } else {
                        float* BETA = WSP(float, WS_SMALL + SM_BETA); float* GLOG = WSP(float, WS_SMALL + SM_GLOG);
                        const float* dtb = ap->in[I_GDN_DTB]; const float* alog = ap->in[I_GDN_ALOG];
                        skinny_gemm<64>(A1, W_SK, ssq_in, r0, res, wid, lane);
                        __syncthreads();
                        for (int e = tid; e < 64 * 32; e += NTHR) { const int r = e >> 5, h = e & 31;
                            BETA[(size_t)(r0 + r) * 32 + h] = sigmoidf_(res[r * 64 + h]);
                            const float x = res[r * 64 + 32 + h] + dtb[h]; const float sp = fmaxf(x, 0.f) + flog(1.0f + fexp(-fabsf(x)));
                            GLOG[(size_t)(r0 + r) * 32 + h] = -fexp(alog[h]) * sp; }
                    }
                    __syncthreads();
                }
            }
            const int n_main = kind == 2 ? 8192 : 16384;
            pg8::Gemm g{A1, WSP(bf16, WS_WIN), M_TOK, n_main, 4096}; pg8::StaticOrder S; S.init(M_TOK, n_main, G, bx);
            pg8::EpiProj E{kind == 2 ? WSP(bf16, WS_PROJ) + 8192 : WSP(bf16, WS_PROJ), LDP, ssq_in, nullptr, 0};
            pg8::gemm_phase<pg8::EpiProj, pg8::StaticOrder, true, true>(lds, g, S, E, w0);
            SEAM(base + 1);
        }
        if (IN(base + 2)) {
            kargs_t ap = KARGS(); unsigned char* ws = ap->ws; TIDS();
            if (kind == 0) {
                { const bf16* PROJ = WSP(bf16, WS_PROJ); float* QN2 = WSP(float, WS_SMALL + SM_QN2); float* KN2 = WSP(float, WS_SMALL + SM_KN2);
                  for (int it = gwv; it < BATCH * NHEAD * 128; it += NGW) fox::norm_item(PROJ, QN2, KN2, it, lane); }
                { const float* CUML = WSP(float, WS_SMALL + SM_CUML); const float* TTOT = WSP(float, WS_SMALL + SM_TTOT); float* CUM = WSP(float, WS_SMALL + SM_CUM);
                  LAS float* ps = (LAS float*)lds; LAS float* ct = ps + 512; LAS float* pr = ct + 64 * 33;
                  for (int un = vcu; un < BATCH * 128; un += G) { const int b = un >> 7, tile = un & 127, h = tid & 31, part = tid >> 5;
                      float sum = 0.f;
                      for (int tp = part; tp < tile; tp += 16) sum += TTOT[(size_t)(b * 128 + tp) * 32 + h];
                      ps[part * 32 + h] = sum;
                      { const f32x4 cv = *(const f32x4*)(CUML + ((size_t)b * SEQ + 64 * tile) * 32 + tid * 4); const int t = (tid * 4) >> 5, hh = (tid * 4) & 31;
#pragma unroll
                        for (int e = 0; e < 4; ++e) ct[t * 33 + hh + e] = cv[e]; }
                      __syncthreads();
                      if (tid < 32) { float p = 0.f;
#pragma unroll
                          for (int q = 0; q < 16; ++q) p += ps[q * 32 + tid];
                          pr[tid] = p; }
                      __syncthreads();
                      { const int t = tid & 63, hg = tid >> 6;
#pragma unroll
                        for (int k = 0; k < 4; ++k) { const int hh = hg * 4 + k; CUM[(size_t)(b * 32 + hh) * SEQ + 64 * tile + t] = pr[hh] + ct[t * 33 + hh]; } }
                      __syncthreads(); } }
            } else if (kind == 1) {
                const bf16* PROJ = WSP(bf16, WS_PROJ); const float* convw = ap->in[I_GDN_CONV]; const float* BETA = WSP(float, WS_SMALL + SM_BETA); const float* GLOG = WSP(float, WS_SMALL + SM_GLOG);
                float* GLT = WSP(float, WS_SMALL + SM_GL); unsigned char* REC = ws + WS_SCR;
                if (tid < 2) *(LAS unsigned*)(lds + tid * gdn::GRP_BYTES + gdn::G_S + 768) = 0u;
                __syncthreads();
                unsigned gbt = 0u;
                for (int pi = vcu; pi < BATCH * NHEAD * GDN_NCHUNK / 2; pi += G) gdn::prep_pair(lds, 2 * pi, PROJ, convw, BETA, GLOG, GLT, REC, gbt, w0);
                __syncthreads();
            } else if (kind == 2) {
                s5::pass1((LAS float*)(lds + wid * 16384), (LAS float*)(lds + wid * 16384 + 4096), gwv, NGW, lane, WSP(bf16, WS_PROJ) + 8192, ap->in[I_SSM_LRE], ap->in[I_SSM_LIM], ap->in[I_SSM_BRE], ap->in[I_SSM_BIM], ap->in[I_SSM_LSTEP], WSP(f32x2, WS_ENDST));
            }
            SEAM(base + 2);
        }
        if (IN(base + 3)) {
            kargs_t ap = KARGS(); unsigned char* ws = ap->ws; TIDS();
            if (kind == 0) fox::attn_phase((char*)lds_raw, WSP(bf16, WS_PROJ), WSP(bf16, WS_MIX), WSP(float, WS_SMALL + SM_CUM), WSP(float, WS_SMALL + SM_QN2), WSP(float, WS_SMALL + SM_KN2), vcu, G, w0);
            else if (kind == 1) { for (int un = vcu; un < BATCH * NHEAD * 4; un += G) gdn::scan_unit(lds, un, ws + WS_SCR, WSP(float, WS_SMALL + SM_GL), (bf16*)ap->out, w0); }
            else if (kind == 2) s5::pass2(lds + wid * 18944, gwv, NGW, lane, WSP(bf16, WS_PROJ) + 8192, ap->in[I_SSM_LRE], ap->in[I_SSM_LIM], ap->in[I_SSM_BRE], ap->in[I_SSM_BIM], ap->in[I_SSM_CRE], ap->in[I_SSM_CIM],
                           ap->in[I_SSM_LSTEP], ap->in[I_SSM_D], WSP(f32x2, WS_ENDST), WSP(bf16, WS_SCR + SS_Y1));
            SEAM(base + 3);
        }
        if (IN(base + 4) && kind == 1) {
            kargs_t ap = KARGS(); unsigned char* ws = ap->ws; TIDS();
            if (kind == 1) gdn::normgate(gwv, NGW, lane, (const bf16*)ap->out, WSP(bf16, WS_PROJ), ap->in[I_GDN_NORM], WSP(bf16, WS_MIX));
            SEAM(base + 4);
        }
        if (IN(base + 4) && kind == 2) {
            kargs_t ap = KARGS(); unsigned char* ws = ap->ws; TIDS();
            pg8::Gemm g{WSP(bf16, WS_SCR + SS_Y1), WSP(bf16, WS_WGLU), M_TOK, 4096, 4096}; pg8::StaticOrder S; S.init(M_TOK, 4096, G, bx);
            pg8::EpiGlu E{WSP(bf16, WS_MIX), WSP(bf16, WS_SCR + SS_Y1), WSP(bf16, WS_PROJ) + ZCOL, LDP, ap->in[I_SSM_BGLU]};
            if (kind == 2) pg8::gemm_phase<pg8::EpiGlu, pg8::StaticOrder, true, true>(lds, g, S, E, w0);
            SEAM(base + 4);
        }
        if (IN(base + 5)) {
            { kargs_t ap = KARGS(); unsigned char* ws = ap->ws;
                  pg8::Gemm g{WSP(bf16, WS_MIX), WSP(bf16, WS_WOUT), M_TOK, 4096, 4096}; pg8::StaticOrder S; S.init(M_TOK, 4096, G, bx);
                  pg8::EpiOut E{WSP(bf16, WS_X0), WSP(bf16, WS_X1), SSQ_PTR(2 * L + 1)};
                  pg8::gemm_phase<pg8::EpiOut, pg8::StaticOrder, true, true>(lds, g, S, E, w0); }
            { kargs_t ap = KARGS(); unsigned char* ws = ap->ws;
                  pg8::Gemm g{WSP(bf16, WS_PBF), WSP(bf16, WS_WPP), M_TOK, 4096, 256}; pg8::StaticOrder S; S.init(M_TOK, 4096, G, bx);
                  pg8::EpiProj E{WSP(bf16, WS_PP), 4096, nullptr, nullptr, 0};
                  pg8::gemm_phase<pg8::EpiProj, pg8::StaticOrder, true, true>(lds, g, S, E, w0); }
            SEAM(base + 5);
        }
        if (IN(base + 6)) {
            kargs_t ap = KARGS(); unsigned char* ws = ap->ws; TIDS();
            pg8::Gemm g{WSP(bf16, WS_X1), WSP(bf16, WS_WGATE), M_TOK, 4096, 4096}; pg8::StaticOrder S; S.init(M_TOK, 4096, G, bx);
            pg8::EpiGate E{WSP(bf16, WS_X1), WSP(bf16, WS_X0), WSP(bf16, WS_PP), SSQ_PTR(2 * L + 1), SSQ_PTR(2 * L + 2)};
            pg8::gemm_phase<pg8::EpiGate, pg8::StaticOrder, true, true>(lds, g, S, E, w0);
            SEAM(base + 6);
        }
    }
    if (IN(PH_FINAL)) {
        kargs_t ap = KARGS(); unsigned char* ws = ap->ws; float* H = ap->out; TIDS();
        const float* gf = ap->in[I_FINAL_NORM]; const ssq_t* ssq = SSQ_PTR(8); const bf16* X0 = WSP(bf16, WS_X0);
        const unsigned bad = __hip_atomic_load(WSP(unsigned, WS_CTL) + CW_BAR + XB_TMO, __ATOMIC_RELAXED, __HIP_MEMORY_SCOPE_AGENT);
        for (int m = gwv; m < M_TOK; m += NGW) { const float rs = bad ? __builtin_nanf("") : __builtin_amdgcn_rsqf(ssq_val(ssq[m]) * (1.0f / 4096.0f) + NORM_EPS); float* row = H + (size_t)m * 4096;
#pragma unroll
            for (int jj = 0; jj < 8; ++jj) { const int c = (jj * 64 + lane) * 8; const u32x4 w = *(const u32x4*)(X0 + (size_t)m * 4096 + c);
                const f32x4 g0 = *(const f32x4*)(gf + c), g1 = *(const f32x4*)(gf + c + 4);
                const f32x4 v0 = {bflo(w.x), bfhi(w.x), bflo(w.y), bfhi(w.y)}, v1 = {bflo(w.z), bfhi(w.z), bflo(w.w), bfhi(w.w)};
                *(f32x4*)(row + c) = v0 * rs * g0; *(f32x4*)(row + c + 4) = v1 * rs * g1; } }
    }
#undef IN
#undef SEAM
}

extern "C" void kernel_launch(void* const* d_in, const int* in_sizes, int n_in, void* d_out, int out_size, void* d_ws, size_t ws_size, hipStream_t stream) {
    static int grid = 0;
    if (grid == 0) {
        if (n_in != 28 || out_size != M_TOK * D_MODEL || ws_size < WS_END) { fprintf(stderr, "kernel_launch: unexpected shapes (n_in %d, out %d, ws %zu)\n", n_in, out_size, ws_size); grid = -1; return; }
        int dev = 0, cus = 0, per_cu = 0;
        if (hipGetDevice(&dev) != hipSuccess || hipDeviceGetAttribute(&cus, hipDeviceAttributeMultiprocessorCount, dev) != hipSuccess) { grid = -1; return; }
        if (hipFuncSetAttribute((const void*)trunk_fwd, hipFuncAttributeMaxDynamicSharedMemorySize, LDS_BYTES) != hipSuccess) { fprintf(stderr, "kernel_launch: hipFuncSetAttribute failed\n"); grid = -1; return; }
        if (hipOccupancyMaxActiveBlocksPerMultiprocessor(&per_cu, (const void*)trunk_fwd, NTHR, LDS_BYTES) != hipSuccess || per_cu < 1) { fprintf(stderr, "kernel_launch: occupancy query says %d\n", per_cu); per_cu = 1; }
        (void)hipGetLastError();
        grid = cus;
    }
    if (grid < 0) return;
    if (hipMemsetAsync((char*)d_ws + WS_CTL, 0, CTL_ZERO_BYTES, stream) != hipSuccess) return;
    Args a{};
    for (int i = 0; i < 28; ++i) a.in[i] = (const float*)d_in[i];
    a.out = (float*)d_out; a.ws = (unsigned char*)d_ws;
#if MK_PER_PHASE
    int li = 0;
    for (int ph = 0; ph < PH_END; ++ph) { if (!phase_exists(ph)) continue;
        a.ph_lo = ph; a.ph_hi = ph + 1; a.li = li++; a.pad = 0;
        hipLaunchKernelGGL(trunk_fwd, dim3(grid), dim3(NTHR), LDS_BYTES, stream, a); }
#elif defined(PROBE_PH)
    { int li = 0; const int cut = PROBE_PH + PROBE_LEN;
      a.ph_lo = 0; a.ph_hi = cut; a.li = li++; a.pad = 0; hipLaunchKernelGGL(trunk_fwd, dim3(grid), dim3(NTHR), LDS_BYTES, stream, a);
      a.pad = PROBE_MODE;
      for (int r = 0; r < PROBE_N; ++r) { a.ph_lo = PROBE_PH; a.ph_hi = cut; a.li = li++; hipLaunchKernelGGL(trunk_fwd, dim3(grid), dim3(NTHR), LDS_BYTES, stream, a); }
      a.pad = 0; a.ph_lo = cut; a.ph_hi = PH_END; a.li = li++; hipLaunchKernelGGL(trunk_fwd, dim3(grid), dim3(NTHR), LDS_BYTES, stream, a); }
#else
    a.ph_lo = 0; a.ph_hi = PH_END; a.li = 0; a.pad = 0;
    hipLaunchKernelGGL(trunk_fwd, dim3(grid), dim3(NTHR), LDS_BYTES, stream, a);
#endif
}
```

```cpp
#include <hip/hip_runtime.h>
#include <cstdio>
#include <cstdint>

#ifndef MK_PER_PHASE
#define MK_PER_PHASE 0
#endif

constexpr int D_MODEL = 4096, BATCH = 2, SEQ = 8192, DEPTH = 4, PLE_DIM = 256;
constexpr int M_TOK = BATCH * SEQ;
constexpr int NHEAD = 32, HDIM = 128;
constexpr float NORM_EPS = 1e-6f;
constexpr int LDP = 16384;
constexpr int ZCOL = 12288;
constexpr int GDN_CHUNK = 64, GDN_NCHUNK = SEQ / GDN_CHUNK;
constexpr int SSM_G = 256, SSM_N = 16, SSM_P = 64, SSM_SL = 256, SSM_NSEG = SEQ / SSM_SL;

constexpr size_t MiB = 1u << 20;
constexpr size_t WS_CTL = 0, CTL_ZERO_BYTES = 2 * MiB;
constexpr size_t WS_WIN = 2 * MiB;
constexpr size_t WS_WSK = 130 * MiB;
constexpr size_t WS_WOUT = 131 * MiB;
constexpr size_t WS_WGATE = 163 * MiB;
constexpr size_t WS_WPP = 195 * MiB;
constexpr size_t WS_WGLU = 197 * MiB;
constexpr size_t WS_PBF = 229 * MiB;
constexpr size_t WS_X0 = 237 * MiB;
constexpr size_t WS_X1 = 365 * MiB;
constexpr size_t WS_PROJ = 493 * MiB;
constexpr size_t WS_MIX = 1005 * MiB;
constexpr size_t WS_PP = 1133 * MiB;
constexpr size_t WS_SCR = 1261 * MiB;
constexpr size_t WS_SMALL = 1837 * MiB;
constexpr size_t WS_ENDST = 1846 * MiB;
constexpr size_t WS_END = 1854 * MiB;
constexpr size_t GR_QD = 0, GR_W = 16384, GR_KT = 32768, GR_U = 49152, GR_IN = 65536, GR_BYTES = 73728;
constexpr size_t SS_U32 = 0, SS_Y1 = 256 * MiB, SS_END = 384 * MiB;
constexpr size_t SM_CUML = 0;
constexpr size_t SM_TTOT = 2 * MiB;
constexpr size_t SM_CUM = 2 * MiB + 65536;
constexpr size_t SM_QN2 = 2 * MiB + 32768;
constexpr size_t SM_KN2 = 4 * MiB + 65536;
constexpr size_t SM_BETA = 5 * MiB;
constexpr size_t SM_GLOG = 7 * MiB;
constexpr size_t SM_SS = SM_CUM;
constexpr size_t SM_GL = 0;
static_assert(SM_CUM + 64 * 8192 * 4 <= SM_BETA && SM_GLOG + (size_t)M_TOK * 32 * 4 <= 9 * MiB, "small tables");
static_assert(WS_SMALL + 9 * MiB <= WS_ENDST && WS_ENDST + 8 * MiB <= WS_END, "ws end");
constexpr int CW_TMO = 0, CW_CODE = 1, CW_ERR = 1024  , CW_BAR = 16384  ;
typedef unsigned long long ssq_t;
constexpr size_t CTL_SUMSQ = 1 * MiB;
constexpr size_t WS_SSQ0 = 130 * MiB + 512 * 1024;
constexpr float SSQ_SCALE = 16777216.0f, SSQ_INV = 1.0f / 16777216.0f;
#define SSQ_PTR(i) ((ssq_t*)(ws + ((i) == 0 ? WS_SSQ0 : CTL_SUMSQ + (size_t)((i) - 1) * M_TOK * sizeof(ssq_t))))

#define LAS __attribute__((address_space(3)))
#define GAS __attribute__((address_space(1)))
typedef unsigned short bf16;
typedef short bf16x8 __attribute__((ext_vector_type(8)));
typedef short s16x4 __attribute__((ext_vector_type(4)));
typedef float f32x2 __attribute__((ext_vector_type(2)));
typedef float f32x4 __attribute__((ext_vector_type(4)));
typedef float f32x16 __attribute__((ext_vector_type(16)));
typedef unsigned u32x2 __attribute__((ext_vector_type(2)));
typedef unsigned u32x4 __attribute__((ext_vector_type(4)));
#define LDS_WAIT() asm volatile("s_waitcnt lgkmcnt(0)" ::: "memory")
#define VM_WAIT() asm volatile("s_waitcnt vmcnt(0)" ::: "memory")
typedef __bf16 bf16x2_t __attribute__((ext_vector_type(2)));
__device__ __forceinline__ unsigned cvtpk(float lo, float hi) { const f32x2 v = {lo, hi}; const bf16x2_t b = __builtin_convertvector(v, bf16x2_t); return __builtin_bit_cast(unsigned, b); }
__device__ __forceinline__ ssq_t ssq_fix(float s) { return (ssq_t)(s * 16777216.0f + 0.5f); }
__device__ __forceinline__ float ssq_val(ssq_t x) { return ((float)(unsigned)(x >> 32) * 4294967296.0f + (float)(unsigned)x) * (1.0f / 16777216.0f); }
__device__ __forceinline__ float bf2f(unsigned short b) { return __uint_as_float(((unsigned)b) << 16); }
__device__ __forceinline__ float bflo(unsigned w) { return __uint_as_float(w << 16); }
__device__ __forceinline__ float bfhi(unsigned w) { return __uint_as_float(w & 0xffff0000u); }
__device__ __forceinline__ float fexp(float x) { return __builtin_amdgcn_exp2f(x * 1.4426950408889634f); }
__device__ __forceinline__ float flog(float x) { return __builtin_amdgcn_logf(x) * 0.6931471805599453f; }
__device__ __forceinline__ float sigmoidf_(float x) { return __builtin_amdgcn_rcpf(1.0f + fexp(-x)); }
__device__ __forceinline__ float siluf_(float x) { return x * sigmoidf_(x); }
__device__ __forceinline__ bf16x8 pack8(f32x4 a, f32x4 b) { u32x4 w = {cvtpk(a[0], a[1]), cvtpk(a[2], a[3]), cvtpk(b[0], b[1]), cvtpk(b[2], b[3])}; return __builtin_bit_cast(bf16x8, w); }
__device__ __forceinline__ void unpack8(u32x4 w, float* f) { f[0] = bflo(w.x); f[1] = bfhi(w.x); f[2] = bflo(w.y); f[3] = bfhi(w.y); f[4] = bflo(w.z); f[5] = bfhi(w.z); f[6] = bflo(w.w); f[7] = bfhi(w.w); }
__device__ __forceinline__ float wave_sum(float v) {
#pragma unroll
    for (int o = 1; o < 64; o <<= 1) v += __shfl_xor(v, o);
    return v;
}
__device__ __forceinline__ int otid(int w0) { unsigned z = 0u; asm volatile("" : "+v"(z));
    int t = (w0 << 6) | (int)__builtin_amdgcn_mbcnt_hi(~0u, __builtin_amdgcn_mbcnt_lo(~0u, z)); asm volatile("" : "+v"(t)); return t; }
__device__ __forceinline__ u32x4 ozero4() { u32x4 z = {0u, 0u, 0u, 0u}; asm volatile("" : "+v"(z)); return z; }
namespace pg8 {
#define PG8_LAS __attribute__((address_space(3)))
typedef unsigned short bf16_t;
typedef short bf16x8 __attribute__((ext_vector_type(8)));
typedef float f32x4 __attribute__((ext_vector_type(4)));
typedef unsigned u32x4 __attribute__((ext_vector_type(4)));
constexpr int BM = 256, BK = 64, HALF = 128, HTB = HALF * BK * 2  , STAGE_BYTES = 8 * HTB, NXCD = 8, WGM = 8;

__host__ __device__ __forceinline__ int lds_byte(int r, int c) { const int st = (r >> 4) * 2 + (c >> 5), rr = r & 15, cc = c & 31, ob = rr * 64 + cc * 2; return st * 1024 + (ob ^ (((ob >> 9) & 1) << 5)); }
__host__ __device__ __forceinline__ void stage_rc(int b, int& R, int& C) { const int st = b / 1024, sb = b % 1024, swz = sb ^ (((sb >> 9) & 1) << 5); R = (st >> 1) * 16 + swz / 64; C = (st & 1) * 32 + (swz % 64) / 2; }
__host__ __device__ __forceinline__ int perm32(int rho) { const int n = rho >> 4, i = rho & 15; return 8 * (i >> 2) + 4 * n + (i & 3); }

struct Unit { int pm, pn; };
struct Gemm { const bf16_t* A; const bf16_t* Bt; int M, N, K; };

struct StaticOrder {
    int nM, nN, nwg, G, c;
    __host__ __device__ void init(int M, int N, int G_, int c_) { nM = M / BM; nN = N / BM; nwg = nM * nN; G = G_; c = c_; }
    __host__ __device__ bool next(int i, Unit& u) const {
        const long L = (long)i * G + c; if (L >= nwg) return false;
        int wgid = (int)L; { const int q = nwg / NXCD, r = nwg % NXCD, xcd = wgid % NXCD, off = wgid / NXCD; wgid = (xcd < r ? xcd * (q + 1) : r * (q + 1) + (xcd - r) * q) + off; }
        const int nig = WGM * nN, gid = wgid / nig, fm = gid * WGM, gsz = (nM - fm) < WGM ? (nM - fm) : WGM;
        u.pm = fm + ((wgid % nig) % gsz); u.pn = (wgid % nig) / gsz; return true;
    }
    __device__ __forceinline__ void a_ready(const Unit&) const {}
    __device__ __forceinline__ void done(const Unit&) const {}
};
__device__ __forceinline__ unsigned cvt_pk_bf16(float lo, float hi) { return ::cvtpk(lo, hi); }
__device__ __forceinline__ float sgm(float x) { return __builtin_amdgcn_rcpf(1.0f + __builtin_amdgcn_exp2f(x * -1.4426950408889634f)); }
__device__ __forceinline__ float bl(unsigned w) { return __uint_as_float(w << 16); }
__device__ __forceinline__ float bh(unsigned w) { return __uint_as_float(w & 0xffff0000u); }
constexpr float kEps = 1e-6f, kInvD = 1.0f / 4096.0f;
#ifndef EPI_RB
#define EPI_RB 4
#endif

struct EpiProj {
    static constexpr bool PERM = true, AFTER_DRAIN = false;
    bf16_t* O; int ldc; const ssq_t* sumsq; float* F32O; int f32cols;
    __device__ __forceinline__ void operator()(const f32x4 (&acc)[2][2][4][2], const Unit& u, int wr, int wc, int fr, int fq) const {
        const int row0 = u.pm * BM + wr * 64 + fr, colt = u.pn * BM, col0 = colt + wc * 32 + 8 * fq;
        const bool tof32 = colt < f32cols;
        ssq_t rsv[2][4];
#pragma unroll
        for (int ai = 0; ai < 2; ++ai)
#pragma unroll
            for (int m = 0; m < 4; ++m) rsv[ai][m] = sumsq ? sumsq[row0 + ai * HALF + m * 16] : 0ull;
#pragma unroll
        for (int ai = 0; ai < 2; ++ai)
#pragma unroll
            for (int m = 0; m < 4; ++m) { const int r = row0 + ai * HALF + m * 16;
                const float rs = sumsq ? __builtin_amdgcn_rsqf(ssq_val(rsv[ai][m]) * kInvD + kEps) : 1.0f;
#pragma unroll
                for (int bj = 0; bj < 2; ++bj) { const f32x4 v0 = acc[ai][bj][m][0] * rs, v1 = acc[ai][bj][m][1] * rs; const int c = col0 + bj * HALF;
                    if (tof32) { float* p = F32O + (size_t)r * f32cols + c; *(__attribute__((address_space(1))) f32x4*)p = v0; *(__attribute__((address_space(1))) f32x4*)(p + 4) = v1; }
                    else { u32x4 w; w.x = cvt_pk_bf16(v0[0], v0[1]); w.y = cvt_pk_bf16(v0[2], v0[3]); w.z = cvt_pk_bf16(v1[0], v1[1]); w.w = cvt_pk_bf16(v1[2], v1[3]);
                        *(u32x4*)(O + (size_t)r * ldc + c) = w; } } }
    }
};
struct EpiOut {
    static constexpr bool PERM = true, AFTER_DRAIN = false;
    const bf16_t* hin; bf16_t* hout; ssq_t* sumsq2;
    __device__ __forceinline__ void operator()(const f32x4 (&acc)[2][2][4][2], const Unit& u, int wr, int wc, int fr, int fq) const {
        const int row0 = u.pm * BM + wr * 64 + fr, col0 = u.pn * BM + wc * 32 + 8 * fq;
#pragma unroll
        for (int ai = 0; ai < 2; ++ai)
#pragma unroll
          for (int mp = 0; mp < 4 / EPI_RB; ++mp) {
            u32x4 hv[EPI_RB][2];
#pragma unroll
            for (int mm = 0; mm < EPI_RB; ++mm)
#pragma unroll
                for (int bj = 0; bj < 2; ++bj) hv[mm][bj] = *(const u32x4*)(hin + (size_t)(row0 + ai * HALF + (EPI_RB * mp + mm) * 16) * 4096 + col0 + bj * HALF);
#pragma unroll
            for (int mm = 0; mm < EPI_RB; ++mm) { const int m = EPI_RB * mp + mm, r = row0 + ai * HALF + m * 16; float s = 0.f;
#pragma unroll
                for (int bj = 0; bj < 2; ++bj) { const size_t off = (size_t)r * 4096 + col0 + bj * HALF; const u32x4 hw = hv[mm][bj];
                    const f32x4 v0 = f32x4{bl(hw.x), bh(hw.x), bl(hw.y), bh(hw.y)} + acc[ai][bj][m][0], v1 = f32x4{bl(hw.z), bh(hw.z), bl(hw.w), bh(hw.w)} + acc[ai][bj][m][1];
                    u32x4 w; w.x = cvt_pk_bf16(v0[0], v0[1]); w.y = cvt_pk_bf16(v0[2], v0[3]); w.z = cvt_pk_bf16(v1[0], v1[1]); w.w = cvt_pk_bf16(v1[2], v1[3]);
                    *(u32x4*)(hout + off) = w;
                    s += (bl(w.x) * bl(w.x) + bh(w.x) * bh(w.x)) + (bl(w.y) * bl(w.y) + bh(w.y) * bh(w.y)) + (bl(w.z) * bl(w.z) + bh(w.z) * bh(w.z)) + (bl(w.w) * bl(w.w) + bh(w.w) * bh(w.w)); }
                s += __shfl_xor(s, 16); s += __shfl_xor(s, 32);
                if (fq == 0) atomicAdd(sumsq2 + r, ssq_fix(s)); }
            asm volatile("" ::: "memory"); }
    }
};
struct EpiGate {
    static constexpr bool PERM = true, AFTER_DRAIN = false;
    const bf16_t* hin; bf16_t* hout; const bf16_t* PP; const ssq_t* sumsq2; ssq_t* sumsqn;
    __device__ __forceinline__ void operator()(const f32x4 (&acc)[2][2][4][2], const Unit& u, int wr, int wc, int fr, int fq) const {
        const int row0 = u.pm * BM + wr * 64 + fr, col0 = u.pn * BM + wc * 32 + 8 * fq;
        ssq_t rsv[2][4];
#pragma unroll
        for (int ai = 0; ai < 2; ++ai)
#pragma unroll
            for (int m = 0; m < 4; ++m) rsv[ai][m] = sumsq2[row0 + ai * HALF + m * 16];
#pragma unroll
        for (int ai = 0; ai < 2; ++ai)
#pragma unroll
            for (int mp = 0; mp < 4 / EPI_RB; ++mp) {
                u32x4 hv[EPI_RB][2], pv[EPI_RB][2];
#pragma unroll
                for (int mm = 0; mm < EPI_RB; ++mm)
#pragma unroll
                    for (int bj = 0; bj < 2; ++bj) { const size_t off = (size_t)(row0 + ai * HALF + (EPI_RB * mp + mm) * 16) * 4096 + col0 + bj * HALF;
                        pv[mm][bj] = *(const u32x4*)(PP + off); hv[mm][bj] = *(const u32x4*)(hin + off); }
#pragma unroll
                for (int mm = 0; mm < EPI_RB; ++mm) { const int m = EPI_RB * mp + mm, r = row0 + ai * HALF + m * 16; float s = 0.f;
                    const float rs = __builtin_amdgcn_rsqf(ssq_val(rsv[ai][m]) * kInvD + kEps);
#pragma unroll
                    for (int bj = 0; bj < 2; ++bj) { const size_t off = (size_t)r * 4096 + col0 + bj * HALF;
                        const u32x4 pw = pv[mm][bj], hw = hv[mm][bj];
                        const f32x4 p0 = {bl(pw.x), bh(pw.x), bl(pw.y), bh(pw.y)}, p1 = {bl(pw.z), bh(pw.z), bl(pw.w), bh(pw.w)};
                        f32x4 g0 = acc[ai][bj][m][0] * rs, g1 = acc[ai][bj][m][1] * rs;
#pragma unroll
                        for (int j = 0; j < 4; ++j) { g0[j] = sgm(g0[j]); g1[j] = sgm(g1[j]); }
                        const f32x4 v0 = f32x4{bl(hw.x), bh(hw.x), bl(hw.y), bh(hw.y)} + g0 * p0, v1 = f32x4{bl(hw.z), bh(hw.z), bl(hw.w), bh(hw.w)} + g1 * p1;
                        u32x4 w; w.x = cvt_pk_bf16(v0[0], v0[1]); w.y = cvt_pk_bf16(v0[2], v0[3]); w.z = cvt_pk_bf16(v1[0], v1[1]); w.w = cvt_pk_bf16(v1[2], v1[3]);
                        *(u32x4*)(hout + off) = w;
                        s += (bl(w.x) * bl(w.x) + bh(w.x) * bh(w.x)) + (bl(w.y) * bl(w.y) + bh(w.y) * bh(w.y)) + (bl(w.z) * bl(w.z) + bh(w.z) * bh(w.z)) + (bl(w.w) * bl(w.w) + bh(w.w) * bh(w.w)); }
                    s += __shfl_xor(s, 16); s += __shfl_xor(s, 32);
                    if (fq == 0) atomicAdd(sumsqn + r, ssq_fix(s)); }
                asm volatile("" ::: "memory"); }
    }
};
struct EpiGlu {
    static constexpr bool PERM = true, AFTER_DRAIN = false;
    bf16_t* O; const bf16_t* Y1; const bf16_t* Z; int ldz; const float* bias;
    __device__ __forceinline__ void operator()(const f32x4 (&acc)[2][2][4][2], const Unit& u, int wr, int wc, int fr, int fq) const {
        const int row0 = u.pm * BM + wr * 64 + fr, col0 = u.pn * BM + wc * 32 + 8 * fq;
        f32x4 bv[2][2];
#pragma unroll
        for (int bj = 0; bj < 2; ++bj) { bv[bj][0] = *(const f32x4*)(bias + col0 + bj * HALF); bv[bj][1] = *(const f32x4*)(bias + col0 + bj * HALF + 4); }
#pragma unroll
        for (int ai = 0; ai < 2; ++ai)
#pragma unroll
            for (int m = 0; m < 4; ++m) { const int r = row0 + ai * HALF + m * 16;
#pragma unroll
                for (int bj = 0; bj < 2; ++bj) { const int c = col0 + bj * HALF;
                    const u32x4 yw = *(const u32x4*)(Y1 + (size_t)r * 4096 + c), zw = *(const u32x4*)(Z + (size_t)r * ldz + c);
                    const f32x4 y0 = {bl(yw.x), bh(yw.x), bl(yw.y), bh(yw.y)}, y1 = {bl(yw.z), bh(yw.z), bl(yw.w), bh(yw.w)};
                    const f32x4 z0 = {bl(zw.x), bh(zw.x), bl(zw.y), bh(zw.y)}, z1 = {bl(zw.z), bh(zw.z), bl(zw.w), bh(zw.w)};
                    f32x4 g0 = acc[ai][bj][m][0] + bv[bj][0], g1 = acc[ai][bj][m][1] + bv[bj][1];
#pragma unroll
                    for (int j = 0; j < 4; ++j) { g0[j] = y0[j] * sgm(g0[j]) * (z0[j] * sgm(z0[j])); g1[j] = y1[j] * sgm(g1[j]) * (z1[j] * sgm(z1[j])); }
                    u32x4 w; w.x = cvt_pk_bf16(g0[0], g0[1]); w.y = cvt_pk_bf16(g0[2], g0[3]); w.z = cvt_pk_bf16(g1[0], g1[1]); w.w = cvt_pk_bf16(g1[2], g1[3]);
                    *(u32x4*)(O + (size_t)r * 4096 + c) = w; }
                asm volatile("" ::: "memory"); }
    }
};
template <class Epi, class Sched, bool ALIGN_EPI = false, bool SP2 = false>
__device__ __forceinline__ void gemm_phase(PG8_LAS unsigned char* lds, const Gemm g, const Sched& S, const Epi& E, const int w0) {
    const int tid = otid(w0), wid = __builtin_amdgcn_readfirstlane(tid >> 6), lane = tid & 63, wr = wid >> 2, wc = wid & 3, fr = lane & 15, fq = lane >> 4;
    const int K = g.K, nt = K / BK;
    unsigned voffA[2], voffB[2];
#pragma unroll
    for (int i = 0; i < 2; ++i) { int R, C; stage_rc(tid * 16 + i * 8192, R, C); const int Rb = Epi::PERM ? ((R & ~31) + perm32(R & 31)) : R;
        voffA[i] = (unsigned)(R * K + C) * 2u; voffB[i] = (unsigned)(Rb * K + C) * 2u; }
    const size_t kstep = (size_t)(BK * 2);
    const size_t hstep = (size_t)HALF * K * 2;
    const size_t tstep = 2 * hstep;
    const unsigned ldsw = (unsigned)wid * 1024u;
    const int aoff = lds_byte(wr * 64 + fr, fq * 8), boff = lds_byte(wc * 32 + fr, fq * 8);
#define PG8_SA(b, h) (((b) * 2 + (h)) * HTB)
#define PG8_SB(b, h) ((4 + (b) * 2 + (h)) * HTB)
#define PG8_STAGE(bufoff, gbase, voff) do { _Pragma("unroll") for (int _i = 0; _i < 2; ++_i) \
        __builtin_amdgcn_global_load_lds((const unsigned*)((const char*)(gbase) + (voff)[_i]), (PG8_LAS unsigned*)(lds + (bufoff) + ldsw + _i * 8192), 16, 0, 0); } while (0)
#define PG8_LDA(dst, b, h) do { _Pragma("unroll") for (int m = 0; m < 4; ++m) _Pragma("unroll") for (int k = 0; k < 2; ++k) dst[m][k] = *(const PG8_LAS bf16x8*)(lds + PG8_SA(b, h) + aoff + m * 2048 + k * 1024); } while (0)
#define PG8_LDB(dst, b, h) do { _Pragma("unroll") for (int n = 0; n < 2; ++n) _Pragma("unroll") for (int k = 0; k < 2; ++k) dst[n][k] = *(const PG8_LAS bf16x8*)(lds + PG8_SB(b, h) + boff + n * 2048 + k * 1024); } while (0)
#define PG8_MMA(ai, bj, At, Bt) do { __builtin_amdgcn_s_setprio(1); _Pragma("unroll") for (int m = 0; m < 4; ++m) _Pragma("unroll") for (int n = 0; n < 2; ++n) _Pragma("unroll") for (int k = 0; k < 2; ++k) \
        acc[ai][bj][m][n] = __builtin_amdgcn_mfma_f32_16x16x32_bf16(Bt[n][k], At[m][k], acc[ai][bj][m][n], 0, 0, 0); __builtin_amdgcn_s_setprio(0); } while (0)
#define PG8_WAIT_V(n) asm volatile("s_waitcnt vmcnt(" #n ")" ::: "memory")
#define PG8_WAIT_L(n) asm volatile("s_waitcnt lgkmcnt(" #n ")" ::: "memory")
#define PG8_BAR __builtin_amdgcn_s_barrier()
#define PG8_SCHED __builtin_amdgcn_sched_barrier(0)
    Unit cur, nxt; int ui = 0;
    if (!S.next(0, cur)) return;
    f32x4 acc[2][2][4][2];
#pragma unroll
    for (int a = 0; a < 2; ++a)
#pragma unroll
        for (int b = 0; b < 2; ++b)
#pragma unroll
            for (int m = 0; m < 4; ++m)
#pragma unroll
                for (int n = 0; n < 2; ++n) acc[a][b][m][n] = (f32x4){0.f, 0.f, 0.f, 0.f};
    bf16x8 At[4][2], B0[2][2], B1[2][2];
    const char* cA = (const char*)g.A + (size_t)cur.pm * tstep; const char* cB = (const char*)g.Bt + (size_t)cur.pn * tstep;
    S.a_ready(cur);
    if constexpr (SP2) {
        PG8_STAGE(PG8_SB(0, 0), cB, voffB); PG8_STAGE(PG8_SB(0, 1), cB + hstep, voffB); PG8_STAGE(PG8_SA(0, 0), cA, voffA); PG8_STAGE(PG8_SA(0, 1), cA + hstep, voffA);
        if (wr == 1) PG8_BAR;
        PG8_WAIT_V(2); PG8_BAR;
        PG8_STAGE(PG8_SB(1, 0), cB + kstep, voffB); PG8_STAGE(PG8_SA(1, 0), cA + kstep, voffA); PG8_STAGE(PG8_SB(1, 1), cB + hstep + kstep, voffB);
        PG8_WAIT_V(6); PG8_BAR;
    } else {
        PG8_STAGE(PG8_SB(0, 0), cB, voffB); PG8_STAGE(PG8_SA(0, 0), cA, voffA); PG8_STAGE(PG8_SB(0, 1), cB + hstep, voffB); PG8_STAGE(PG8_SA(0, 1), cA + hstep, voffA);
        if (wr == 1) PG8_BAR;
        PG8_WAIT_V(4); PG8_BAR;
        PG8_STAGE(PG8_SB(1, 0), cB + kstep, voffB); PG8_STAGE(PG8_SA(1, 0), cA + kstep, voffA); PG8_STAGE(PG8_SB(1, 1), cB + hstep + kstep, voffB);
        PG8_WAIT_V(6); PG8_BAR;
    }
    for (;;) {
        const bool has_next = S.next(ui + 1, nxt);
        const char* nA = has_next ? (const char*)g.A + (size_t)nxt.pm * tstep : cA; const char* nB = has_next ? (const char*)g.Bt + (size_t)nxt.pn * tstep : cB;
        for (int t = 0; t < nt; t += 2) {
            const bool last = (t == nt - 2);
            const char* a1 = cA + (size_t)(t + 1) * kstep;
            const char* a2 = last ? nA : cA + (size_t)(t + 2) * kstep; const char* b2 = last ? nB : cB + (size_t)(t + 2) * kstep;
            const char* a3 = a2 + kstep; const char* b3 = b2 + kstep;
            if (last && has_next) S.a_ready(nxt);
            if constexpr (SP2) {
            PG8_LDB(B0, 0, 0); PG8_LDB(B1, 0, 1); PG8_SCHED; PG8_LDA(At, 0, 0); PG8_STAGE(PG8_SA(1, 1), a1 + hstep, voffA);
            PG8_WAIT_V(8); PG8_WAIT_L(0); PG8_BAR; PG8_MMA(0, 0, At, B0); PG8_MMA(0, 1, At, B1); PG8_BAR; PG8_SCHED;
            PG8_LDA(At, 0, 1); PG8_STAGE(PG8_SB(0, 0), b2, voffB); PG8_STAGE(PG8_SB(0, 1), b2 + hstep, voffB); PG8_STAGE(PG8_SA(0, 0), a2, voffA);
            PG8_WAIT_V(8); PG8_WAIT_L(0); PG8_BAR; PG8_MMA(1, 0, At, B0); PG8_MMA(1, 1, At, B1); PG8_BAR; PG8_SCHED;
            PG8_LDB(B0, 1, 0); PG8_LDB(B1, 1, 1); PG8_SCHED; PG8_LDA(At, 1, 0); PG8_STAGE(PG8_SA(0, 1), a2 + hstep, voffA);
            PG8_WAIT_V(8); PG8_WAIT_L(0); PG8_BAR; PG8_MMA(0, 0, At, B0); PG8_MMA(0, 1, At, B1); PG8_BAR; PG8_SCHED;
            PG8_LDA(At, 1, 1); PG8_STAGE(PG8_SB(1, 0), b3, voffB); PG8_STAGE(PG8_SB(1, 1), b3 + hstep, voffB); PG8_STAGE(PG8_SA(1, 0), a3, voffA);
            PG8_WAIT_V(8); PG8_WAIT_L(0); PG8_BAR; PG8_MMA(1, 0, At, B0); PG8_MMA(1, 1, At, B1); PG8_BAR; PG8_SCHED;
            } else {
            PG8_LDB(B0, 0, 0); PG8_SCHED; PG8_LDA(At, 0, 0); PG8_STAGE(PG8_SA(1, 1), a1 + hstep, voffA);
            PG8_WAIT_L(8); PG8_BAR; PG8_WAIT_L(0); PG8_MMA(0, 0, At, B0); PG8_BAR; PG8_SCHED;
            PG8_LDB(B1, 0, 1); PG8_STAGE(PG8_SB(0, 0), b2, voffB);
            PG8_BAR; PG8_WAIT_L(0); PG8_MMA(0, 1, At, B1); PG8_BAR;
            PG8_LDA(At, 0, 1); PG8_STAGE(PG8_SA(0, 0), a2, voffA);
            PG8_BAR; PG8_WAIT_L(0); PG8_MMA(1, 0, At, B0); PG8_BAR; PG8_SCHED;
            PG8_STAGE(PG8_SB(0, 1), b2 + hstep, voffB);
            PG8_WAIT_V(6); PG8_BAR; PG8_MMA(1, 1, At, B1); PG8_BAR;
            PG8_LDB(B0, 1, 0); PG8_SCHED; PG8_LDA(At, 1, 0); PG8_STAGE(PG8_SA(0, 1), a2 + hstep, voffA);
            PG8_WAIT_L(8); PG8_BAR; PG8_WAIT_L(0); PG8_MMA(0, 0, At, B0); PG8_BAR; PG8_SCHED;
            PG8_LDB(B1, 1, 1); PG8_STAGE(PG8_SB(1, 0), b3, voffB);
            PG8_BAR; PG8_WAIT_L(0); PG8_MMA(0, 1, At, B1); PG8_BAR;
            PG8_LDA(At, 1, 1); PG8_STAGE(PG8_SA(1, 0), a3, voffA);
            PG8_BAR; PG8_WAIT_L(0); PG8_MMA(1, 0, At, B0); PG8_BAR; PG8_SCHED;
            PG8_STAGE(PG8_SB(1, 1), b3 + hstep, voffB);
            PG8_WAIT_V(6); PG8_BAR; PG8_MMA(1, 1, At, B1); PG8_BAR;
            }
        }
        if constexpr (ALIGN_EPI) { if (wr == 0) PG8_BAR; }
        if constexpr (!Epi::AFTER_DRAIN) { E(acc, cur, wr, wc, fr, fq); S.done(cur); }
        if (!has_next) break;
#pragma unroll
        for (int a = 0; a < 2; ++a)
#pragma unroll
            for (int b = 0; b < 2; ++b)
#pragma unroll
                for (int m = 0; m < 4; ++m)
#pragma unroll
                    for (int n = 0; n < 2; ++n) acc[a][b][m][n] = (f32x4){0.f, 0.f, 0.f, 0.f};
        cur = nxt; cA = nA; cB = nB; ++ui;
        if constexpr (ALIGN_EPI) { if (wr == 1) PG8_BAR; }
    }
    PG8_WAIT_V(0);
    if constexpr (!ALIGN_EPI) { if (wr == 0) PG8_BAR; }
    PG8_BAR;
    if constexpr (Epi::AFTER_DRAIN) { E.fused(acc, cur, wr, wc, fr, fq, lds, wid, lane); S.done(cur); }
#undef PG8_SA
#undef PG8_SB
#undef PG8_STAGE
#undef PG8_LDA
#undef PG8_LDB
#undef PG8_MMA
#undef PG8_WAIT_V
#undef PG8_WAIT_L
#undef PG8_BAR
#undef PG8_SCHED
}
}
#define XB_TMO      128
#define XB_XCNT(j)  (256  + 64 * (j))
#define XB_XSUB(j)  (1280 + 64 * (j))
#define XB_XGEN(j)  (2304 + 64 * (j))
#define XB_TOP      3328
#define XB_TOPGEN   3392
#define XCD_BAR_WORDS 3456
#define XB_SPIN_CAP (1u << 18)

__device__ __forceinline__ unsigned xb_ld(unsigned* p)              { return __hip_atomic_load(p, __ATOMIC_RELAXED, __HIP_MEMORY_SCOPE_AGENT); }
__device__ __forceinline__ unsigned xb_add(unsigned* p, unsigned v) { return __hip_atomic_fetch_add(p, v, __ATOMIC_RELAXED, __HIP_MEMORY_SCOPE_AGENT); }
__device__ __forceinline__ unsigned xb_xcc_id() { return (unsigned)__builtin_amdgcn_s_getreg((3 << 11) | 20) & 0xFu; }
#define XB_SPIN(cond, bar) do { unsigned _sp = 0; while (cond) { __builtin_amdgcn_s_sleep(1); \
    if ((++_sp & 255u) == 0u) { if (xb_ld(&(bar)[XB_TMO])) break; if (_sp > XB_SPIN_CAP) { atomicAdd(&(bar)[XB_TMO], 1u); break; } } } } while (0)

struct XcdBarrier {
    unsigned* bar; unsigned x;
    volatile LAS unsigned* st;
    unsigned tid;
};

__device__ __forceinline__ XcdBarrier xcd_barrier_post(unsigned* bar, volatile LAS unsigned* st) {
    XcdBarrier b; b.bar = bar; b.x = xb_xcc_id(); b.st = st;
    if (threadIdx.x == 0) (void)xb_add(&bar[XB_XCNT(b.x)], 1u);
    return b;
}
__device__ __forceinline__ void xcd_barrier_complete(unsigned* bar, unsigned x, unsigned& nloc, unsigned& nx) {
    const unsigned G = gridDim.x * gridDim.y * gridDim.z;
    unsigned sum, cnt, mine, sp = 0u;
    for (;;) {
        sum = 0u; cnt = 0u; mine = 0u;
#pragma unroll
        for (unsigned j = 0; j < 16; ++j) { const unsigned c = xb_ld(&bar[XB_XCNT(j)]); sum += c; cnt += (c > 0u) ? 1u : 0u; mine = (j == x) ? c : mine; }
        if (sum == G) break;
        __builtin_amdgcn_s_sleep(1);
        if ((++sp & 255u) == 0u) { if (xb_ld(&bar[XB_TMO])) break; if (sp > XB_SPIN_CAP) { atomicAdd(&bar[XB_TMO], 1u); break; } }
    }
    nloc = mine > 0u ? mine : 1u; nx = cnt > 0u ? cnt : 1u;
}

__device__ __forceinline__ void xcd_barrier(const XcdBarrier& b) {
    asm volatile("s_waitcnt vmcnt(0)" ::: "memory");
    __syncthreads();
    if (b.tid == 0) {
        unsigned* bar = b.bar;
        __builtin_amdgcn_s_waitcnt(0);
        unsigned nloc = b.st[0], nx = b.st[1];
        if (nloc == 0u) { xcd_barrier_complete(bar, b.x, nloc, nx); b.st[0] = nloc; b.st[1] = nx; }
        const unsigned old = xb_add(&bar[XB_XSUB(b.x)], 1u);
        const unsigned gen = old / nloc;
        if (old + 1u == (gen + 1u) * nloc) {
            __builtin_amdgcn_fence(__ATOMIC_RELEASE, "agent");
            asm volatile("s_waitcnt vmcnt(0)" ::: "memory");
            const unsigned og = xb_add(&bar[XB_TOP], 1u);
            const unsigned tg = og / nx;
            if (og + 1u == (tg + 1u) * nx) xb_add(&bar[XB_TOPGEN], 1u);
            else XB_SPIN(xb_ld(&bar[XB_TOPGEN]) == tg, bar);
            __builtin_amdgcn_fence(__ATOMIC_ACQUIRE, "agent");
            xb_add(&bar[XB_XGEN(b.x)], 1u);
            asm volatile("s_waitcnt vmcnt(0)" ::: "memory");
        } else {
            XB_SPIN(xb_ld(&bar[XB_XGEN(b.x)]) == gen, bar);
            __builtin_amdgcn_fence(__ATOMIC_ACQUIRE, "agent");
            asm volatile("s_waitcnt vmcnt(0)" ::: "memory");
        }
    }
    __syncthreads();
}
namespace fox {
constexpr int D = 128;
constexpr float SCALE = 0.08838834764831845f, INV_SCALE = 11.313708498984761f;
constexpr float THR = 8.f;
constexpr int NW = 8, QBLK = 32, KVBLK = 64, QB = NW * QBLK;
constexpr int SHM_V = KVBLK * D * 2, SHM_K = KVBLK * D * 2;
constexpr int KB_OFF = 2 * SHM_V + 2 * SHM_K + NW * 64 * 4;
constexpr int JL_OFF = KB_OFF + 2 * 64 * 4;
constexpr int OT_OFF = JL_OFF + 64, OT_PITCH = 272, OT_WAVE = 32 * OT_PITCH;
constexpr int LDS_BYTES = OT_OFF + NW * OT_WAVE;

#define KSWZ(row, colB) ((row) * 256 + ((colB) ^ (((row) & 7) << 4)))
#define SBAR() __builtin_amdgcn_sched_barrier(0)
__device__ __forceinline__ int v_st(int k, int c) { const int kk = (k & ~0xC) | ((k & 4) << 1) | ((k & 8) >> 1); return ((kk >> 3) * 4 + (c >> 5)) * 512 + ((kk & 7) * 32 + (c & 31)) * 2; }
__device__ __forceinline__ int v_rd_base(int lane) { return ((lane & 3) << 3) | (((lane >> 2) & 3) << 6) | (((lane >> 4) & 1) << 5) | (((lane >> 5) & 1) << 8); }
constexpr int v_rd_off(int d0, int ks, int half) { return d0 * 512 + ks * 4096 + half * 2048; }
__device__ __forceinline__ int crow(int r, int hi) { return (r & 3) + 8 * (r >> 2) + 4 * hi; }
__device__ __forceinline__ bf16x8 load8(const bf16* p) { return *reinterpret_cast<const bf16x8*>(p); }
__device__ __forceinline__ void mask_tile(f32x16& p0, f32x16& p1, int dq) {
    const float NEG = -__builtin_inff();
#pragma unroll
    for (int r = 0; r < 16; ++r) {
        const int c = (r & 3) + 8 * (r >> 2);
        if (dq - c < 0) p0[r] = NEG;
        if (dq - c - 32 < 0) p1[r] = NEG;
    }
}
__device__ __forceinline__ void bias_tile(f32x16& p0, f32x16& p1, const float* kb, int hi) {
#pragma unroll
    for (int g = 0; g < 4; ++g) {
        const f32x4 a = *(const f32x4*)(kb + 8 * g + 4 * hi), b = *(const f32x4*)(kb + 32 + 8 * g + 4 * hi);
#pragma unroll
        for (int j = 0; j < 4; ++j) { p0[4 * g + j] += a[j]; p1[4 * g + j] += b[j]; }
    }
}
__device__ __forceinline__ void partialSM(f32x16& p0, f32x16& p1, float& m_reg, float& mn, float& alpha) {
    float pmax = p0[0]; for (int r = 1; r < 16; ++r) pmax = fmaxf(pmax, p0[r]); for (int r = 0; r < 16; ++r) pmax = fmaxf(pmax, p1[r]);
    { auto rr = __builtin_amdgcn_permlane32_swap(__float_as_uint(pmax), __float_as_uint(pmax), false, false);
      pmax = fmaxf(__uint_as_float(rr[0]), __uint_as_float(rr[1])); }
    constexpr float C2 = 1.4426950408889634f * SCALE;
    if (__builtin_expect(__all((pmax - m_reg) * SCALE <= THR), 1)) { mn = m_reg; alpha = 1.f; }
    else { mn = fmaxf(m_reg, pmax); alpha = __builtin_amdgcn_exp2f((m_reg - mn) * C2); m_reg = mn; }
    const float mnL = -mn * C2;
    for (int r = 0; r < 16; ++r) p0[r] = fmaf(p0[r], C2, mnL); for (int r = 0; r < 16; ++r) p1[r] = fmaf(p1[r], C2, mnL);
    for (int r = 0; r < 16; ++r) p0[r] = __builtin_amdgcn_exp2f(p0[r]);
}
__device__ __forceinline__ void finishSM(f32x16& p0, f32x16& p1, float alpha, float& l_reg, bf16x8& pa0, bf16x8& pa1, bf16x8& pa2, bf16x8& pa3) {
    for (int r = 0; r < 16; ++r) p1[r] = __builtin_amdgcn_exp2f(p1[r]);
    float ps = 0; for (int r = 0; r < 16; ++r) ps += p0[r]; for (int r = 0; r < 16; ++r) ps += p1[r];
    { auto rr = __builtin_amdgcn_permlane32_swap(__float_as_uint(ps), __float_as_uint(ps), false, false);
      ps = __uint_as_float(rr[0]) + __uint_as_float(rr[1]); }
    l_reg = l_reg * alpha + ps;
#define PK4(P, B_, OUT) do { unsigned a0 = cvtpk(P[B_+0], P[B_+1]), a1 = cvtpk(P[B_+2], P[B_+3]);                          \
        unsigned b0 = cvtpk(P[B_+4], P[B_+5]), b1 = cvtpk(P[B_+6], P[B_+7]);                                             \
        auto r0 = __builtin_amdgcn_permlane32_swap(a0, b0, false, false); auto r1 = __builtin_amdgcn_permlane32_swap(a1, b1, false, false); \
        u32x4 w = {r0[0], r1[0], r0[1], r1[1]}; OUT = *reinterpret_cast<bf16x8*>(&w); } while (0)
    PK4(p0, 0, pa0); PK4(p0, 8, pa1); PK4(p1, 0, pa2); PK4(p1, 8, pa3);
#undef PK4
}
template <int KB>
__device__ __forceinline__ void qkt(f32x16& p0, f32x16& p1, const char* K_lds, int r32, int hi, const bf16x8* qr) {
    p0 = f32x16{}; p1 = f32x16{};
    const char* kb[4];
#pragma unroll
    for (int dd = 0; dd < 4; ++dd) kb[dd] = K_lds + KB * SHM_K + KSWZ(r32, (dd * 16 + hi * 8) * 2);
#pragma unroll
    for (int d0 = 0; d0 < 8; ++d0) { const char* a = kb[d0 & 3] + (d0 >> 2) * 128;
        bf16x8 b0 = *reinterpret_cast<const bf16x8*>(a);
        bf16x8 b1 = *reinterpret_cast<const bf16x8*>(a + 32 * 256);
        p0 = __builtin_amdgcn_mfma_f32_32x32x16_bf16(b0, qr[d0], p0, 0, 0, 0);
        p1 = __builtin_amdgcn_mfma_f32_32x32x16_bf16(b1, qr[d0], p1, 0, 0, 0); }
}
template <int VB>
__device__ __forceinline__ void pv_tile(f32x16* o, int vb0, bf16x8 pa0, bf16x8 pa1, bf16x8 pa2, bf16x8 pa3) {
#define TRRD(dst, off) asm volatile("ds_read_b64_tr_b16 %0, %1 offset:%2" : "=&v"(dst) : "v"(vb0), "i"(off) : "memory")
#define PV_D0(d0) do { s16x4 l0, l1, h0, h1; constexpr int b_ = VB * SHM_V + v_rd_off(d0, 0, 0);     \
        TRRD(l0, b_); TRRD(h0, b_ + 2048); TRRD(l1, b_ + 4096); TRRD(h1, b_ + 6144); \
        asm volatile("s_waitcnt lgkmcnt(0)" ::: "memory"); SBAR();   \
        o[d0] = __builtin_amdgcn_mfma_f32_32x32x16_bf16(pa0, (bf16x8){l0[0], l0[1], l0[2], l0[3], h0[0], h0[1], h0[2], h0[3]}, o[d0], 0, 0, 0);   \
        o[d0] = __builtin_amdgcn_mfma_f32_32x32x16_bf16(pa1, (bf16x8){l1[0], l1[1], l1[2], l1[3], h1[0], h1[1], h1[2], h1[3]}, o[d0], 0, 0, 0);   \
        SBAR(); TRRD(l0, b_ + 8192); TRRD(h0, b_ + 10240); TRRD(l1, b_ + 12288); TRRD(h1, b_ + 14336); \
        asm volatile("s_waitcnt lgkmcnt(0)" ::: "memory"); SBAR();   \
        o[d0] = __builtin_amdgcn_mfma_f32_32x32x16_bf16(pa2, (bf16x8){l0[0], l0[1], l0[2], l0[3], h0[0], h0[1], h0[2], h0[3]}, o[d0], 0, 0, 0);   \
        o[d0] = __builtin_amdgcn_mfma_f32_32x32x16_bf16(pa3, (bf16x8){l1[0], l1[1], l1[2], l1[3], h1[0], h1[1], h1[2], h1[3]}, o[d0], 0, 0, 0); } while (0)
    PV_D0(0); PV_D0(1); PV_D0(2); PV_D0(3);
#undef PV_D0
#undef TRRD
}
struct BlockRef { const bf16* Q; const bf16* K; const bf16* V; const bf16* Z; bf16* O; const float* C; const float* QN; const float* KN; int P0; };
constexpr float PRUNE_T = 30.0f;
__device__ __forceinline__ int compute_jlo(const BlockRef& b, int lane) {
    const int ntb = b.P0 / KVBLK;
    if (ntb == 0) return 0;
    float q2 = b.QN[ntb + (lane & 3)];
    q2 = fmaxf(q2, __shfl_xor(q2, 1)); q2 = fmaxf(q2, __shfl_xor(q2, 2));
    float k2 = fmaxf(lane < ntb + 4 ? b.KN[lane] : 0.f, lane + 64 < ntb + 4 ? b.KN[lane + 64] : 0.f);
#pragma unroll
    for (int o = 1; o < 64; o <<= 1) k2 = fmaxf(k2, __shfl_xor(k2, o));
    const float bnd = 2.0f * SCALE * __builtin_amdgcn_sqrtf(q2 * k2) * 1.0001f + b.C[b.P0];
    const bool s0 = lane < ntb && (bnd - b.C[64 * lane + 63] < -PRUNE_T);
    const bool s1 = lane + 64 < ntb && (bnd - b.C[64 * (lane + 64) + 63] < -PRUNE_T);
    const unsigned long long m0 = __ballot(s0), m1 = __ballot(s1);
    int jlo = 0;
    if (m1) jlo = 128 - __builtin_clzll(m1) + 1 - 1; else if (m0) jlo = 64 - __builtin_clzll(m0);
    return __builtin_amdgcn_readfirstlane(jlo);
}
__device__ __forceinline__ void norm_item(const bf16* PROJ, float* QN2, float* KN2, int item, int lane) {
    const int bhh = item >> 7, tile = item & 127, b = bhh >> 5, h = bhh & 31, rs = lane >> 4, cg = lane & 15;
    const bf16* base = PROJ + ((size_t)b * SEQ + (size_t)tile * 64) * LDP + h * HDIM + cg * 8;
    float qm = 0.f, km = 0.f;
#pragma unroll 4
    for (int i = 0; i < 16; ++i) { const bf16* rp = base + (size_t)(4 * i + rs) * LDP;
        const u32x4 qw = *(const u32x4*)rp, kw = *(const u32x4*)(rp + 4096); float q[8], k[8]; unpack8(qw, q); unpack8(kw, k);
        float sq = 0.f, sk = 0.f;
#pragma unroll
        for (int e = 0; e < 8; ++e) { sq += q[e] * q[e]; sk += k[e] * k[e]; }
#pragma unroll
        for (int o = 1; o < 16; o <<= 1) { sq += __shfl_xor(sq, o); sk += __shfl_xor(sk, o); }
        qm = fmaxf(qm, sq); km = fmaxf(km, sk); }
    qm = fmaxf(qm, __shfl_xor(qm, 16)); qm = fmaxf(qm, __shfl_xor(qm, 32)); km = fmaxf(km, __shfl_xor(km, 16)); km = fmaxf(km, __shfl_xor(km, 32));
    if (lane == 0) { QN2[item] = qm; KN2[item] = km; }
}
struct Seam { bf16x8 qr[8]; bf16x8 st_v0, st_v1, st_k0, st_k1; float cb0, cb1; };
#define ROWP(p, k0, rr) ((p) + (size_t)((k0) + (rr)) * LDP + sc)
#define VMWN(n) asm volatile("s_waitcnt vmcnt(%0)" :: "i"(n) : "memory")
#define SLOAD_H(Kp, Vp, Cp, k0) do { const bf16* vp_ = (Vp) + (size_t)(k0) * LDP; const bf16* kp_ = (Kp) + (size_t)(k0) * LDP; const float* cp_ = (Cp) + (k0); \
                         S.st_v0 = load8(vp_ + loff); S.st_v1 = load8(vp_ + 32 * LDP + loff);              \
                         S.st_k0 = load8(kp_ + loff); S.st_k1 = load8(kp_ + 32 * LDP + loff); S.cb0 = cp_[(unsigned)sr]; S.cb1 = (cp_ + 32)[(unsigned)sr]; } while (0)
#define SWRITE_HK(bf, ref) do { *(bf16x8*)(K_lds + (bf) * SHM_K + kws) = S.st_k0; *(bf16x8*)(K_lds + (bf) * SHM_K + kws + 32 * 256) = S.st_k1; \
                         if ((tid & 15) == 0) { kbias[(bf) * 64 + sr] = ((ref) - S.cb0) * INV_SCALE; kbias[(bf) * 64 + 32 + sr] = ((ref) - S.cb1) * INV_SCALE; } } while (0)
#define SWRITE_HV(bf) do { *(bf16x8*)(V_lds + (bf) * SHM_V + vst0) = S.st_v0; *(bf16x8*)(V_lds + (bf) * SHM_V + vst1) = S.st_v1; } while (0)
#define SWRITE_H(bf, ref) do { SWRITE_HV(bf); SWRITE_HK(bf, ref); } while (0)
__device__ __forceinline__ float blk_ref(const BlockRef& b) { const float v = b.P0 > 0 ? b.C[b.P0 - 1] : 0.f; return __uint_as_float(__builtin_amdgcn_readfirstlane(__float_as_uint(v))); }
__device__ __forceinline__ void prime(const BlockRef& cur, int j_lo, char* lds, Seam& S, const int w0) {
    const int tid = otid(w0), wid = __builtin_amdgcn_readfirstlane(tid >> 6), lane = tid & 63, r32 = lane & 31, hi = lane >> 5;
    const int sr = tid >> 4, sc = (tid & 15) * 8, kws = KSWZ(sr, sc * 2); char* K_lds = lds + 2 * SHM_V; float* kbias = (float*)(lds + KB_OFF);
    const unsigned loff = (unsigned)sr * LDP + sc, qoff = (unsigned)r32 * LDP + hi * 8;
    const float ref = blk_ref(cur);
    for (int d0 = 0; d0 < 8; ++d0) S.qr[d0] = load8(cur.Q + (size_t)(wid * QBLK) * LDP + d0 * 16 + qoff);
    SLOAD_H(cur.K, cur.V, cur.C, j_lo * KVBLK); VM_WAIT(); SWRITE_HK(0, ref);
    __syncthreads();
}
__device__ __forceinline__ void block(const BlockRef& cur, const BlockRef& nxt, int j_lo, int jlo_n, char* lds, Seam& S, const int w0) {
    const int tid = otid(w0), wid = __builtin_amdgcn_readfirstlane(tid >> 6), lane = tid & 63, r32 = lane & 31, hi = lane >> 5;
    const int NT = (cur.P0 + QB - 1) / KVBLK + 1 - j_lo;
    const int qlo = cur.P0 + wid * QBLK, qm = qlo + r32 - 4 * hi;
    char* V_lds = lds; char* K_lds = lds + 2 * SHM_V;
    float* ws = (float*)(lds + 2 * SHM_V + 2 * SHM_K) + wid * 64; float* li_l = ws, * al_l = ws + 32; float* kbias = (float*)(lds + KB_OFF);
    float m_reg = -1e30f, l_reg = 0; f32x16 o[4] = {};
    const int sr = tid >> 4, sc = (tid & 15) * 8, vst0 = v_st(sr, sc), vst1 = v_st(32 + sr, sc), kws = KSWZ(sr, sc * 2);
    const int vb0 = (int)(uintptr_t)V_lds + v_rd_base(lane);
    const unsigned loff = (unsigned)sr * LDP + sc, qoff = (unsigned)r32 * LDP + hi * 8;
    const bf16* Kh = cur.K; const bf16* Vh = cur.V; const float* Ch = cur.C;
    const float ref = blk_ref(cur), nref = blk_ref(nxt);
#define RESC(a) do { if (__any((a) < 1.f)) { if (hi == 0) al_l[r32] = (a); asm volatile("s_waitcnt lgkmcnt(0)" ::: "memory");              \
                     for (int d_ = 0; d_ < 4; ++d_) for (int r = 0; r < 16; ++r) o[d_][r] *= al_l[crow(r, hi)]; } } while (0)
#define KBASE(t) ((j_lo + (t)) * KVBLK)
#define BIASMASK(P0_, P1_, t, KB) do { const int kb_ = KBASE(t); bias_tile(P0_, P1_, kbias + (KB) * 64, hi); if (kb_ + KVBLK - 1 > qlo) mask_tile(P0_, P1_, qm - kb_); } while (0)
    constexpr int NQL = 8;
#define SEAM_K0() do { VMWN(NQL); SWRITE_HK(0, nref); SBAR(); } while (0)
    f32x16 pA0, pA1, pB0, pB1; float mnA, mnB, alA, alB; bf16x8 pa0, pa1, pa2, pa3;
    SWRITE_HV(0); SBAR();
    if (NT > 1) SLOAD_H(Kh, Vh, Ch, KBASE(1));
    SBAR(); qkt<0>(pA0, pA1, K_lds, r32, hi, S.qr);
    BIASMASK(pA0, pA1, 0, 0); partialSM(pA0, pA1, m_reg, mnA, alA);
    if (NT > 1) { VM_WAIT(); SWRITE_H(1, ref); }
    __syncthreads();
#define HALF_STEP(PX0, PX1, mnX, alX, PY0, PY1, alY, t, KB, VB, SB) do {                                                      \
        SBAR(); qkt<KB>(PX0, PX1, K_lds, r32, hi, S.qr);                                                                      \
        finishSM(PY0, PY1, alY, l_reg, pa0, pa1, pa2, pa3); SBAR();                                                           \
        if ((t) + 1 < NT) { SLOAD_H(Kh, Vh, Ch, KBASE((t) + 1)); SBAR(); }                                                    \
        pv_tile<VB>(o, vb0, pa0, pa1, pa2, pa3); BIASMASK(PX0, PX1, (t), KB); partialSM(PX0, PX1, m_reg, mnX, alX);           \
        __syncthreads();                                                                                                      \
        if ((t) + 1 < NT) { VM_WAIT(); SWRITE_H(SB, ref); }                                                                   \
        RESC(alX); __syncthreads(); } while (0)
    for (int t = 1; t + 1 < NT; t += 2) {
        HALF_STEP(pB0, pB1, mnB, alB, pA0, pA1, alA, t, 1, 0, 0);
        HALF_STEP(pA0, pA1, mnA, alA, pB0, pB1, alB, t + 1, 0, 1, 1);
    }
    const bool even = (NT & 1) == 0;
    if (even) { SBAR(); qkt<1>(pB0, pB1, K_lds, r32, hi, S.qr); SBAR(); }
    SLOAD_H(nxt.K, nxt.V, nxt.C, jlo_n * KVBLK); SBAR();
#pragma unroll
    for (int d0 = 0; d0 < 8; ++d0) S.qr[d0] = load8(nxt.Q + (size_t)(wid * QBLK) * LDP + d0 * 16 + qoff);
    SBAR();
    finishSM(pA0, pA1, alA, l_reg, pa0, pa1, pa2, pa3); SBAR();
    pv_tile<0>(o, vb0, pa0, pa1, pa2, pa3);
    if (even) { const int t2 = otid(w0), qm2 = qlo + (t2 & 31) - 4 * ((t2 >> 5) & 1), hi2 = (t2 >> 5) & 1;
      { const int kb_ = KBASE(NT - 1); bias_tile(pB0, pB1, kbias + 64, hi2); if (kb_ + KVBLK - 1 > qlo) mask_tile(pB0, pB1, qm2 - kb_); }
      partialSM(pB0, pB1, m_reg, mnB, alB); __syncthreads(); RESC(alB);
      finishSM(pB0, pB1, alB, l_reg, pa0, pa1, pa2, pa3); SBAR(); pv_tile<1>(o, vb0, pa0, pa1, pa2, pa3); }
    SBAR(); SEAM_K0();
    if (hi == 0) li_l[r32] = l_reg; asm volatile("s_waitcnt lgkmcnt(0)" ::: "memory");
    float rli[16];
#pragma unroll
    for (int r = 0; r < 16; ++r) rli[r] = __builtin_amdgcn_rcpf(li_l[crow(r, hi)]);
    bf16* Ow = cur.O + (size_t)(wid * QBLK) * 4096; const bf16* Zw = cur.Z + (size_t)(wid * QBLK) * LDP;
    const int t2 = otid(w0), l2 = t2 & 63;
    const unsigned zoff = (unsigned)(l2 >> 4) * LDP + (l2 & 15) * 8, ooff = (unsigned)(l2 >> 4) * 4096 + (l2 & 15) * 8;
    u32x4 zw[8];
#pragma unroll
    for (int i = 0; i < 8; ++i) zw[i] = *(const u32x4*)(Zw + (size_t)(4 * i) * LDP + zoff);
    char* ot = lds + OT_OFF + wid * OT_WAVE;
#pragma unroll
    for (int d0 = 0; d0 < 4; ++d0)
#pragma unroll
        for (int r = 0; r < 16; ++r) *(bf16*)(ot + crow(r, hi) * OT_PITCH + (d0 * 32 + r32) * 2) = (bf16)(cvtpk(o[d0][r] * rli[r], 0.f) & 0xffffu);
    asm volatile("s_waitcnt lgkmcnt(0)" ::: "memory");
#pragma unroll
    for (int i = 0; i < 8; ++i) { const u32x4 ow = *(const u32x4*)(ot + (4 * i + (l2 >> 4)) * OT_PITCH + (l2 & 15) * 16);
        float ov[8], zv[8]; unpack8(ow, ov); unpack8(zw[i], zv);
        f32x4 a, b;
#pragma unroll
        for (int e = 0; e < 4; ++e) { a[e] = ov[e] * siluf_(zv[e]); b[e] = ov[4 + e] * siluf_(zv[4 + e]); }
        *(bf16x8*)(Ow + (size_t)(4 * i) * 4096 + ooff) = pack8(a, b); }
    __syncthreads();
#undef RESC
#undef KBASE
#undef BIASMASK
#undef SEAM_K0
#undef HALF_STEP
}
#undef ROWP
#undef VMWN
#undef SLOAD_H
#undef SWRITE_HK
#undef SWRITE_HV
#undef SWRITE_H
#undef KSWZ
#undef SBAR
__device__ __forceinline__ void attn_phase(char* lds, const bf16* PROJ, bf16* MIX, const float* CUM, const float* QN2, const float* KN2, int vcu, int G, const int w0) {
    constexpr int NQB = SEQ / QB  , NX = NQB / 2, TOTAL = NX * BATCH * NHEAD;
    auto ref_of = [&](int L, int pass) { const int bhh = L / NX, x = L % NX, qb = pass ? NQB - 1 - x : x, b = bhh / NHEAD, h = bhh % NHEAD;
        BlockRef r; const bf16* base = PROJ + (size_t)b * SEQ * LDP + h * HDIM;
        r.Q = base + (size_t)qb * QB * LDP; r.K = base + 4096; r.V = base + 8192; r.Z = base + (size_t)qb * QB * LDP + ZCOL;
        r.O = MIX + ((size_t)b * SEQ + (size_t)qb * QB) * 4096 + h * HDIM; r.C = CUM + (size_t)bhh * SEQ; r.QN = QN2 + bhh * 128; r.KN = KN2 + bhh * 128; r.P0 = qb * QB; return r; };
    int L = vcu; if (L >= TOTAL) return;
    int pass = 0; BlockRef cur = ref_of(L, 0); Seam S;
    int* jl = (int*)(lds + JL_OFF);
    { const int tid = otid(w0), w = __builtin_amdgcn_readfirstlane(tid >> 6), Lw = vcu + (w >> 1) * G;
      if (Lw < TOTAL) { const BlockRef r = ref_of(Lw, w & 1); const int j = compute_jlo(r, tid & 63); if ((tid & 63) == 0) jl[w] = j; } }
    __syncthreads();
    int bi = 0;
    prime(cur, jl[0], lds, S, w0);
    for (;;) {
        const bool more_pass = pass == 0, more_item = L + G < TOTAL, last = !more_pass && !more_item;
        int passn = pass + 1, Ln = L; if (!more_pass) { passn = 0; Ln = more_item ? L + G : L; }
        const BlockRef nxt = last ? cur : ref_of(Ln, passn);
        { const int ja = __builtin_amdgcn_readfirstlane(jl[bi]), jb = __builtin_amdgcn_readfirstlane(jl[last ? bi : bi + 1]); block(cur, nxt, ja, jb, lds, S, w0); ++bi; }
        if (last) break;
        cur = nxt; pass = passn; L = Ln;
    }
}
}
constexpr int NWAVES = 8, NTHR = 512;
constexpr int RING_BYTES = 131072;
constexpr int MISC_OFF = RING_BYTES + 24576;
constexpr int LDS_BYTES = MISC_OFF + 128;

struct Args {
    const float* in[28]; float* out; unsigned char* ws;
    int ph_lo, ph_hi, li, pad;
};
enum { I_X = 0, I_P, I_NORM_MIX, I_FOX_WIN, I_FOX_BF, I_FOX_WOUT, I_GDN_WIN, I_GDN_CONV, I_GDN_ALOG, I_GDN_DTB, I_GDN_NORM, I_GDN_WOUT,
       I_SSM_WIN, I_SSM_LRE, I_SSM_LIM, I_SSM_BRE, I_SSM_BIM, I_SSM_CRE, I_SSM_CIM, I_SSM_LSTEP, I_SSM_D, I_SSM_WGLU, I_SSM_BGLU, I_SSM_WOUT,
       I_NORM_PLE, I_PLE_WPROJ, I_PLE_WGATE, I_FINAL_NORM };

__device__ __forceinline__ void transpose_item(const float* W, int K, int N, bf16* dst, const float* gk, LAS float* scr, int k0, int n0, int lane) {
#pragma unroll 8
    for (int i = 0; i < 32; ++i) { const int kk = 2 * i + (lane >> 5); scr[kk * 33 + (lane & 31)] = W[(size_t)(k0 + kk) * N + n0 + (lane & 31)]; }
    const int c = lane & 7;
    f32x4 ga = {1.f, 1.f, 1.f, 1.f}, gb = ga;
    if (gk) { ga = *(const f32x4*)(gk + k0 + 8 * c); gb = *(const f32x4*)(gk + k0 + 8 * c + 4); }
    LDS_WAIT(); asm volatile("" ::: "memory");
#pragma unroll
    for (int j = 0; j < 4; ++j) { const int n = (lane >> 3) + 8 * j; const LAS float* s = scr + (8 * c) * 33 + n;
        u32x4 o; o.x = cvtpk(s[0 * 33] * ga[0], s[1 * 33] * ga[1]); o.y = cvtpk(s[2 * 33] * ga[2], s[3 * 33] * ga[3]); o.z = cvtpk(s[4 * 33] * gb[0], s[5 * 33] * gb[1]); o.w = cvtpk(s[6 * 33] * gb[2], s[7 * 33] * gb[3]);
        *(u32x4*)(dst + (size_t)n * K + k0 + 8 * c) = o; }
    LDS_WAIT(); asm volatile("" ::: "memory");
}
__device__ __forceinline__ void transpose_matrix(const float* W, int K, int N, bf16* WT, int nsplit, bf16* WT2, const float* gk, LAS float* scr, int gw, int NGW, int lane) {
    const int nblk = N / 32, nitems = (K / 64) * nblk;
    for (int it = gw; it < nitems; it += NGW) { const int kb = it / nblk, nb = it - kb * nblk, n0 = 32 * nb;
        bf16* dst = n0 < nsplit ? WT + (size_t)n0 * K : WT2 + (size_t)(n0 - nsplit) * K;
        transpose_item(W, K, N, dst, gk, scr, 64 * kb, n0, lane); }
}
__device__ __forceinline__ float row_to_bf16(const float* xrow, bf16* orow, int lane) {
    float s = 0.f;
#pragma unroll
    for (int j = 0; j < 8; ++j) { const int c = (j * 64 + lane) * 8;
        const f32x4 a = *(const f32x4*)(xrow + c), b = *(const f32x4*)(xrow + c + 4);
        const bf16x8 o = pack8(a, b); const u32x4 w = __builtin_bit_cast(u32x4, o);
        s += (bflo(w.x) * bflo(w.x) + bfhi(w.x) * bfhi(w.x)) + (bflo(w.y) * bflo(w.y) + bfhi(w.y) * bfhi(w.y)) + (bflo(w.z) * bflo(w.z) + bfhi(w.z) * bfhi(w.z)) + (bflo(w.w) * bflo(w.w) + bfhi(w.w) * bfhi(w.w));
        *(bf16x8*)(orow + c) = o; }
    return wave_sum(s);
}

template <int NS>
__device__ __forceinline__ void skinny_gemm(const bf16* A1, const bf16* WSK, const ssq_t* sumsq, int r0, LAS float* res, int wid, int lane) {
    constexpr int NT = NS / 32;
    const int mt = wid & 3, ng = wid >> 2, fr = lane & 15, fq = lane >> 4;
    f32x4 acc[NT];
#pragma unroll
    for (int t = 0; t < NT; ++t) acc[t] = (f32x4){0.f, 0.f, 0.f, 0.f};
    const bf16* ap = A1 + (size_t)(r0 + 16 * mt + fr) * 4096 + 8 * fq;
    const bf16* bp = WSK + (size_t)(16 * ng * NT + fr) * 4096 + 8 * fq;
#pragma unroll 8
    for (int k = 0; k < 4096; k += 32) {
        const bf16x8 a = *(const bf16x8*)(ap + k);
#pragma unroll
        for (int t = 0; t < NT; ++t) { const bf16x8 b = *(const bf16x8*)(bp + (size_t)t * 16 * 4096 + k); acc[t] = __builtin_amdgcn_mfma_f32_16x16x32_bf16(a, b, acc[t], 0, 0, 0); }
    }
#pragma unroll
    for (int i = 0; i < 4; ++i) { const int row = 16 * mt + 4 * fq + i; const float rs = __builtin_amdgcn_rsqf(ssq_val(sumsq[r0 + row]) * (1.0f / 4096.0f) + NORM_EPS);
#pragma unroll
        for (int t = 0; t < NT; ++t) res[row * NS + 16 * (ng * NT + t) + fr] = acc[t][i] * rs; }
}
namespace gdn {
constexpr int PQ = 272;
constexpr int PL = 68;
constexpr int G_Q = 0, G_K = 17408, G_V = 34816, G_L = 52224, G_S = 69632, GRP_BYTES = 70656;
static_assert(2 * GRP_BYTES <= 147456, "gdn prep LDS");

__device__ __forceinline__ void group_barrier(LAS unsigned* cnt, unsigned& target) {
    target += 4u;
    asm volatile("s_waitcnt lgkmcnt(0)" ::: "memory");
    if (__builtin_amdgcn_mbcnt_hi(~0u, __builtin_amdgcn_mbcnt_lo(~0u, 0u)) == 0u) __hip_atomic_fetch_add(cnt, 1u, __ATOMIC_RELAXED, __HIP_MEMORY_SCOPE_WORKGROUP);
    while (__hip_atomic_load(cnt, __ATOMIC_RELAXED, __HIP_MEMORY_SCOPE_WORKGROUP) < target) __builtin_amdgcn_s_sleep(1);
    asm volatile("" ::: "memory");
}
__device__ __forceinline__ void prep_pair(LAS unsigned char* lds, int uid0, const bf16* PROJ, const float* convw, const float* BETA, const float* GLOG, float* GL, unsigned char* REC, unsigned& gbt, const int w0) {
    const int tid = otid(w0), wid = __builtin_amdgcn_readfirstlane(tid >> 6), lane = tid & 63, grp = wid >> 2, gw = wid & 3, gt = tid & 255;
    const int uid = uid0 + grp, bhh = uid >> 7, c = uid & 127, b = bhh >> 5, h = bhh & 31;
    LAS unsigned char* gl = lds + grp * GRP_BYTES;
    LAS float* Lm = (LAS float*)(gl + G_L); LAS float* gcs = (LAS float*)(gl + G_S); LAS float* bes = gcs + 64; LAS float* egs = gcs + 128;
    unsigned char* rec = REC + (size_t)uid * GR_BYTES;
    LAS unsigned* gbc = (LAS unsigned*)(gl + G_S + 768);
    const size_t row0 = (size_t)b * SEQ + (size_t)c * 64;
    float g_ld = 0.f, b_ld = 0.f;
    if (gw == 0) { g_ld = GLOG[(row0 + lane) * 32 + h]; b_ld = BETA[(row0 + lane) * 32 + h]; }
    {
    {
        const int cg = gt & 15, rp = gt >> 4;
        u32x4 raw[2][7];
#define GDN_ROWS(s_, buf_) do { const bf16* bp_ = PROJ + (row0 + 4 * rp - 3) * LDP + (s_) * 4096 + h * 128 + 8 * cg; \
            _Pragma("unroll") for (int jj = 0; jj < 7; ++jj) raw[buf_][jj] = (c * 64 + 4 * rp - 3 + jj >= 0) ? *(const u32x4*)(bp_ + (size_t)jj * LDP) : (u32x4){0u, 0u, 0u, 0u}; } while (0)
        GDN_ROWS(0, 0);
#pragma unroll
        for (int s = 0; s < 3; ++s) {
            const int colb = s * 4096 + h * 128 + 8 * cg;
            f32x4 w[4][2];
#pragma unroll
            for (int j = 0; j < 4; ++j) { w[j][0] = *(const f32x4*)(convw + (size_t)j * 12288 + colb); w[j][1] = *(const f32x4*)(convw + (size_t)j * 12288 + colb + 4); }
            if (s == 0) GDN_ROWS(1, 1); else if (s == 1) GDN_ROWS(2, 0);
            float xr[7][8];
#pragma unroll
            for (int jj = 0; jj < 7; ++jj) unpack8(raw[s & 1][jj], xr[jj]);
#pragma unroll
            for (int i = 0; i < 4; ++i) { const int t = 4 * rp + i; float y[8];
#pragma unroll
                for (int e = 0; e < 8; ++e) y[e] = 0.f;
#pragma unroll
                for (int j = 0; j < 4; ++j)
#pragma unroll
                    for (int e = 0; e < 4; ++e) { y[e] += w[j][0][e] * xr[i + j][e]; y[4 + e] += w[j][1][e] * xr[i + j][4 + e]; }
                float ss = 0.f;
#pragma unroll
                for (int e = 0; e < 8; ++e) { y[e] = siluf_(y[e]); ss += y[e] * y[e]; }
                float sc = 1.f;
                if (s < 2) { ss += __shfl_xor(ss, 1); ss += __shfl_xor(ss, 2); ss += __shfl_xor(ss, 4); ss += __shfl_xor(ss, 8);
                    sc = __builtin_amdgcn_rsqf(ss + NORM_EPS) * (s == 0 ? 0.08838834764831845f : 1.0f); }
                *(LAS bf16x8*)(gl + s * 17408 + t * PQ + cg * 16) = pack8((f32x4){y[0] * sc, y[1] * sc, y[2] * sc, y[3] * sc}, (f32x4){y[4] * sc, y[5] * sc, y[6] * sc, y[7] * sc}); }
        }
#undef GDN_ROWS
    }
    }
    if (gw == 0) { float g = g_ld;
#pragma unroll
        for (int o = 1; o < 64; o <<= 1) { const float t = __shfl_up(g, o); if (lane >= o) g += t; }
        gcs[lane] = g; bes[lane] = b_ld; egs[lane] = fexp(g);
        if (lane == 63) GL[uid] = fexp(g); }
    group_barrier(gbc, gbt);
    {
    {
        const int fr = lane & 15, fq = lane >> 4, mt = gw;
        bf16x8 kA[4], qA[4];
#pragma unroll
        for (int s = 0; s < 4; ++s) { kA[s] = *(const LAS bf16x8*)(gl + G_K + (16 * mt + fr) * PQ + (32 * s + 8 * fq) * 2); qA[s] = *(const LAS bf16x8*)(gl + G_Q + (16 * mt + fr) * PQ + (32 * s + 8 * fq) * 2); }
        bf16* intra = (bf16*)(rec + GR_IN);
#pragma unroll
        for (int nt = 0; nt < 4; ++nt) { f32x4 kk = {0.f, 0.f, 0.f, 0.f}, qk = {0.f, 0.f, 0.f, 0.f};
#pragma unroll
            for (int s = 0; s < 4; ++s) { const bf16x8 kB = *(const LAS bf16x8*)(gl + G_K + (16 * nt + fr) * PQ + (32 * s + 8 * fq) * 2);
                kk = __builtin_amdgcn_mfma_f32_16x16x32_bf16(kA[s], kB, kk, 0, 0, 0); qk = __builtin_amdgcn_mfma_f32_16x16x32_bf16(qA[s], kB, qk, 0, 0, 0); }
            const int j = 16 * nt + fr; const float gj = gcs[j];
#pragma unroll
            for (int e = 0; e < 4; ++e) { const int i = 16 * mt + 4 * fq + e; const float dec = (i >= j) ? fexp(gcs[i] - gj) : 0.f;
                Lm[i * PL + j] = (i > j) ? bes[i] * kk[e] * dec : 0.f;
                intra[i * 64 + j] = (bf16)(cvtpk(qk[e] * dec, 0.f) & 0xffffu); } }
    }
    {
        const int row = gt >> 2, seg = gt & 3; const float e = egs[row];
#pragma unroll
        for (int q4 = 0; q4 < 4; ++q4) { const u32x4 xw = *(const LAS u32x4*)(gl + G_Q + row * PQ + (seg * 32 + q4 * 8) * 2); float x[8]; unpack8(xw, x);
            *(bf16x8*)(rec + GR_QD + ((size_t)row * 128 + seg * 32 + q4 * 8) * 2) = pack8((f32x4){x[0] * e, x[1] * e, x[2] * e, x[3] * e}, (f32x4){x[4] * e, x[5] * e, x[6] * e, x[7] * e}); }
        const int d = gt & 127, half = gt >> 7; const float g63 = gcs[63];
#pragma unroll
        for (int q4 = 0; q4 < 4; ++q4) { float v[8];
#pragma unroll
            for (int e2 = 0; e2 < 8; ++e2) { const int i = 32 * half + 8 * q4 + e2; v[e2] = bf2f(*(const LAS bf16*)(gl + G_K + i * PQ + d * 2)) * fexp(g63 - gcs[i]); }
            *(bf16x8*)(rec + GR_KT + ((size_t)d * 64 + 32 * half + 8 * q4) * 2) = pack8((f32x4){v[0], v[1], v[2], v[3]}, (f32x4){v[4], v[5], v[6], v[7]}); }
    }
    }
    group_barrier(gbc, gbt);
    if (gt < 128) {
        LAS bf16* vp = (LAS bf16*)(gl + G_V) + gt; LAS bf16* kp = (LAS bf16*)(gl + G_K) + gt;
        f32x2 x[64];
#pragma unroll
        for (int i = 0; i < 64; ++i) {
            f32x4 lr[16];
#pragma unroll
            for (int j4 = 0; j4 < (i + 3) / 4; ++j4) lr[j4] = *(const LAS f32x4*)(Lm + i * PL + 4 * j4);
            const float be = bes[i];
            f32x2 a = {bf2f(vp[i * (PQ / 2)]) * be, bf2f(kp[i * (PQ / 2)]) * be * egs[i]};
            f32x2 acc[4] = {{0.f, 0.f}, {0.f, 0.f}, {0.f, 0.f}, {0.f, 0.f}};
#pragma unroll
            for (int j4 = 0; j4 < (i + 3) / 4; ++j4)
#pragma unroll
                for (int e = 0; e < 4; ++e) if (4 * j4 + e < i) acc[e] += x[4 * j4 + e] * lr[j4][e];
            a -= (acc[0] + acc[1]) + (acc[2] + acc[3]);
            x[i] = a;
        }
#pragma unroll
        for (int i = 0; i < 64; ++i) { const unsigned w = cvtpk(x[i].x, x[i].y);
            vp[i * (PQ / 2)] = (bf16)(w & 0xffffu); kp[i * (PQ / 2)] = (bf16)(w >> 16); }
    }
    group_barrier(gbc, gbt);
    {
        const int row = gt >> 2, seg = gt & 3;
#pragma unroll
        for (int q4 = 0; q4 < 4; ++q4) {
            *(u32x4*)(rec + GR_U + ((size_t)row * 128 + seg * 32 + q4 * 8) * 2) = *(const LAS u32x4*)(gl + G_V + row * PQ + (seg * 32 + q4 * 8) * 2);
            *(u32x4*)(rec + GR_W + ((size_t)row * 128 + seg * 32 + q4 * 8) * 2) = *(const LAS u32x4*)(gl + G_K + row * PQ + (seg * 32 + q4 * 8) * 2); }
    }
    group_barrier(gbc, gbt);
}

constexpr int SP = 272, SPT = 144, SPU = 80;
constexpr int L_QD = 0, L_W = 17408, L_KT = 34816, L_IN = 53248, L_U = 62464, L_BUF = 67584;
constexpr int L_ST = 2 * L_BUF, L_VT = L_ST + 32 * SP, SCAN_LDS = L_VT + 32 * SPT;
static_assert(SCAN_LDS <= 155648, "gdn scan LDS");
__device__ __forceinline__ bf16x8 pack_cc(const f32x4& lo, const f32x4& hi) { const u32x4 w = {cvtpk(lo[0], lo[1]), cvtpk(lo[2], lo[3]), cvtpk(hi[0], hi[1]), cvtpk(hi[2], hi[3])}; return __builtin_bit_cast(bf16x8, w); }
__device__ __forceinline__ void scan_unit(LAS unsigned char* lds, int unit, const unsigned char* REC, const float* GL, bf16* O16  , const int w0) {
    const int tid = otid(w0), wid = __builtin_amdgcn_readfirstlane(tid >> 6), lane = tid & 63, fr = lane & 15, fq = lane >> 4;
    const int bhh = unit >> 2, q4 = unit & 3, b = bhh >> 5, h = bhh & 31, nt = wid & 1, mt = wid >> 1;
    f32x4 S[2];
    S[0] = (f32x4){0.f, 0.f, 0.f, 0.f}; S[1] = (f32x4){0.f, 0.f, 0.f, 0.f};
    u32x4 st[8];
    int srcoff[8], dstoff[8];
#pragma unroll
    for (int i = 0; i < 8; ++i) { const int p = tid + 512 * i; int so, d;
        if (p < 1024) { so = (int)GR_QD + p * 16; d = L_QD + (p >> 4) * SP + (p & 15) * 16; }
        else if (p < 2048) { const int q = p - 1024; so = (int)GR_W + q * 16; d = L_W + (q >> 4) * SP + (q & 15) * 16; }
        else if (p < 3072) { const int q = p - 2048; so = (int)GR_KT + q * 16; d = L_KT + (q >> 3) * SPT + (q & 7) * 16; }
        else if (p < 3584) { const int q = p - 3072; so = (int)GR_IN + q * 16; d = L_IN + (q >> 3) * SPT + (q & 7) * 16; }
        else { const int q = (p - 3584) & 255; so = (int)GR_U + (q >> 2) * 256 + q4 * 64 + (q & 3) * 16; d = L_U + (q >> 2) * SPU + (q & 3) * 16; }
        srcoff[i] = so; dstoff[i] = d; }
    const bool has8 = tid < 256;
#define GDN_ISSUE(c_) do { const unsigned char* rec_ = REC + ((size_t)bhh * 128 + (c_)) * GR_BYTES; \
        _Pragma("unroll") for (int i = 0; i < 7; ++i) st[i] = *(const u32x4*)(rec_ + srcoff[i]); if (has8) st[7] = *(const u32x4*)(rec_ + srcoff[7]); } while (0)
#define GDN_STASH(buf_) do { LAS unsigned char* bp_ = lds + (buf_) * L_BUF; \
        _Pragma("unroll") for (int i = 0; i < 7; ++i) *(LAS u32x4*)(bp_ + dstoff[i]) = st[i]; if (has8) *(LAS u32x4*)(bp_ + dstoff[7]) = st[7]; } while (0)
    { const u32x4 z4 = ozero4(); for (int i = tid; i < (32 * SP) / 16; i += 512) *(LAS u32x4*)(lds + L_ST + i * 16) = z4; }
    GDN_ISSUE(0); GDN_STASH(0); __syncthreads();
    float gl_n = GL[bhh * 128]; asm volatile("" ::: "memory");
    GDN_ISSUE(1);
    bf16* orow = O16 + ((size_t)b * SEQ + 16 * mt + 4 * fq) * 4096 + h * 128 + 32 * q4 + 16 * nt + fr;
    const LAS unsigned char* stp = lds + L_ST + (16 * nt + fr) * SP + 16 * fq;
    const LAS unsigned char* vtp = lds + L_VT + (16 * nt + fr) * SPT + 16 * fq;
#pragma unroll 1
    for (int c = 0; c < GDN_NCHUNK; ++c) {
        const LAS unsigned char* bp = lds + (c & 1) * L_BUF;
        const float glast = gl_n;
        bf16x8 Sb[4];
#pragma unroll
        for (int s = 0; s < 4; ++s) Sb[s] = *(const LAS bf16x8*)(stp + 64 * s);
        f32x4 aw = {0.f, 0.f, 0.f, 0.f}, ao = {0.f, 0.f, 0.f, 0.f};
#pragma unroll
        for (int s = 0; s < 4; ++s) { aw = __builtin_amdgcn_mfma_f32_16x16x32_bf16(*(const LAS bf16x8*)(bp + L_W + (16 * mt + fr) * SP + 64 * s + 16 * fq), Sb[s], aw, 0, 0, 0);
            ao = __builtin_amdgcn_mfma_f32_16x16x32_bf16(*(const LAS bf16x8*)(bp + L_QD + (16 * mt + fr) * SP + 64 * s + 16 * fq), Sb[s], ao, 0, 0, 0); }
        f32x4 vn;
#pragma unroll
        for (int e = 0; e < 4; ++e) vn[e] = bf2f(*(const LAS bf16*)(bp + L_U + (16 * mt + 4 * fq + e) * SPU + (16 * nt + fr) * 2)) - aw[e];
        *(LAS u32x2*)(lds + L_VT + (16 * nt + fr) * SPT + (16 * mt + 4 * fq) * 2) = (u32x2){cvtpk(vn[0], vn[1]), cvtpk(vn[2], vn[3])};
        __syncthreads();
        bf16x8 vb[2];
        vb[0] = *(const LAS bf16x8*)vtp; vb[1] = *(const LAS bf16x8*)(vtp + 64);
#pragma unroll
        for (int s2 = 0; s2 < 2; ++s2) ao = __builtin_amdgcn_mfma_f32_16x16x32_bf16(*(const LAS bf16x8*)(bp + L_IN + (16 * mt + fr) * SPT + 64 * s2 + 16 * fq), vb[s2], ao, 0, 0, 0);
#pragma unroll
        for (int kk = 0; kk < 2; ++kk) { f32x4 a = S[kk] * glast;
#pragma unroll
            for (int s2 = 0; s2 < 2; ++s2) a = __builtin_amdgcn_mfma_f32_16x16x32_bf16(*(const LAS bf16x8*)(bp + L_KT + (16 * (2 * mt + kk) + fr) * SPT + 64 * s2 + 16 * fq), vb[s2], a, 0, 0, 0);
            S[kk] = a;
            *(LAS u32x2*)(lds + L_ST + (16 * nt + fr) * SP + (16 * (2 * mt + kk) + 4 * fq) * 2) = (u32x2){cvtpk(a[0], a[1]), cvtpk(a[2], a[3])}; }
#pragma unroll
        for (int e = 0; e < 4; ++e) orow[(size_t)(c * 64 + e) * 4096] = (bf16)(cvtpk(ao[e], 0.f) & 0xffffu);
        if (c + 1 < GDN_NCHUNK) GDN_STASH((c + 1) & 1);
        __syncthreads();
        if (c + 1 < GDN_NCHUNK) { gl_n = GL[bhh * 128 + c + 1]; asm volatile("" ::: "memory"); }
        if (c + 2 < GDN_NCHUNK) GDN_ISSUE(c + 2);
    }
#undef GDN_ISSUE
#undef GDN_STASH
}
__device__ __forceinline__ void normgate(int gwv, int NGW, int lane, const bf16* O16, const bf16* PROJ, const float* normw, bf16* MIX) {
    const f32x4 n0 = *(const f32x4*)(normw + ((lane & 15) * 8)), n1 = *(const f32x4*)(normw + ((lane & 15) * 8) + 4);
#pragma unroll 2
    for (int it = gwv; it < M_TOK * 8; it += NGW) { const int row = it >> 3, c8 = (it & 7) * 512 + lane * 8;
        const u32x4 ow = *(const u32x4*)(O16 + (size_t)row * 4096 + c8); const f32x4 o0 = {bflo(ow.x), bfhi(ow.x), bflo(ow.y), bfhi(ow.y)}, o1 = {bflo(ow.z), bfhi(ow.z), bflo(ow.w), bfhi(ow.w)};
        const u32x4 zw = *(const u32x4*)(PROJ + (size_t)row * LDP + ZCOL + c8); float z[8]; unpack8(zw, z);
        float q = (o0[0] * o0[0] + o0[1] * o0[1]) + (o0[2] * o0[2] + o0[3] * o0[3]) + (o1[0] * o1[0] + o1[1] * o1[1]) + (o1[2] * o1[2] + o1[3] * o1[3]);
        q += __shfl_xor(q, 1); q += __shfl_xor(q, 2); q += __shfl_xor(q, 4); q += __shfl_xor(q, 8);
        const float rs = __builtin_amdgcn_rsqf(q * (1.0f / 128.0f) + NORM_EPS);
        f32x4 r0, r1;
#pragma unroll
        for (int e = 0; e < 4; ++e) { r0[e] = o0[e] * rs * n0[e] * siluf_(z[e]); r1[e] = o1[e] * rs * n1[e] * siluf_(z[4 + e]); }
        *(bf16x8*)(MIX + (size_t)row * 4096 + c8) = pack8(r0, r1); }
}
}
namespace s5 {
__device__ __forceinline__ void sincos_cw(float x, float& s, float& c) {
    const float kf = rintf(x * 0.6366197723675814f); const int k = (int)kf;
    float r = fmaf(kf, -1.5703125f, x); r = fmaf(kf, -4.837512969970703125e-4f, r); r = fmaf(kf, -7.54978995489188e-8f, r);
    const float r2 = r * r;
    float c1 = -1.9515295891e-4f, c2 = 8.3321608736e-3f, c3 = 2.443315711809948e-5f, c4 = -1.388731625493765e-3f; asm volatile("" : "+v"(c1), "+v"(c2), "+v"(c3), "+v"(c4));
    const float sp = fmaf(r * r2, fmaf(r2, fmaf(r2, c1, c2), -1.6666654611e-1f), r);
    const float cp = fmaf(r2 * r2, fmaf(r2, fmaf(r2, c3, c4), 4.166664568298827e-2f), fmaf(r2, -0.5f, 1.0f));
    const int q = k & 3;
    s = (q == 0) ? sp : (q == 1) ? cp : (q == 2) ? -sp : -cp;
    c = (q == 0) ? cp : (q == 1) ? -sp : (q == 2) ? -cp : sp;
}
__device__ __forceinline__ void zoh_of(int g, int p, const float* LRE, const float* LIM, const float* LSTEP, float& lr, float& li, float& zr, float& zi) {
    const float lam_re = LRE[g * 64 + p], lam_im = LIM[g * 64 + p], step = fexp(LSTEP[g]);
    const float mag = fexp(lam_re * step); float sn, cs; sincos_cw(lam_im * step, sn, cs);
    lr = mag * cs; li = mag * sn;
    const float den = lam_re * lam_re + lam_im * lam_im, num_re = lr - 1.0f;
    zr = (num_re * lam_re + li * lam_im) / den; zi = (li * lam_re - num_re * lam_im) / den;
}
struct Disc { float lr, li; bf16x8 bh[8]; };
__device__ __forceinline__ void discretise(Disc& d, int g, int lane, const float* LRE, const float* LIM, const float* BRE, const float* BIM, const float* LSTEP) {
    float zr, zi; zoh_of(g, lane, LRE, LIM, LSTEP, d.lr, d.li, zr, zi);
    const int fr = lane & 15, fq = lane >> 4, n0 = 8 * (fq & 1);
#pragma unroll
    for (int t = 0; t < 4; ++t) { const int p = 16 * t + fr; float lr, li; zoh_of(g, p, LRE, LIM, LSTEP, lr, li, zr, zi);
        const float* br = BRE + (size_t)(g * 64 + p) * 16 + n0; const float* bi = BIM + (size_t)(g * 64 + p) * 16 + n0;
        const f32x4 r0 = *(const f32x4*)br, r1 = *(const f32x4*)(br + 4), i0 = *(const f32x4*)bi, i1 = *(const f32x4*)(bi + 4);
        const f32x4 re0 = r0 * zr - i0 * zi, re1 = r1 * zr - i1 * zi, im0 = i0 * zr + r0 * zi, im1 = i1 * zr + r1 * zi;
        const u32x4 rh = __builtin_bit_cast(u32x4, pack8(re0, re1)), ih = __builtin_bit_cast(u32x4, pack8(im0, im1));
        float rhf[8], ihf[8]; unpack8(rh, rhf); unpack8(ih, ihf);
        const f32x4 rl0 = {re0[0] - rhf[0], re0[1] - rhf[1], re0[2] - rhf[2], re0[3] - rhf[3]}, rl1 = {re1[0] - rhf[4], re1[1] - rhf[5], re1[2] - rhf[6], re1[3] - rhf[7]};
        const f32x4 il0 = {im0[0] - ihf[0], im0[1] - ihf[1], im0[2] - ihf[2], im0[3] - ihf[3]}, il1 = {im1[0] - ihf[4], im1[1] - ihf[5], im1[2] - ihf[6], im1[3] - ihf[7]};
        d.bh[t] = fq < 2 ? __builtin_bit_cast(bf16x8, rh) : pack8(rl0, rl1); d.bh[4 + t] = fq < 2 ? __builtin_bit_cast(bf16x8, ih) : pack8(il0, il1); }
}
constexpr int BUP = 20;
__device__ __forceinline__ void bu_tile(const Disc& d, const LAS float* us, LAS float* but, int t0, int lane) {
    const int fr = lane & 15, fq = lane >> 4;
    const f32x4 u0 = *(const LAS f32x4*)(us + (t0 + fr) * 16 + 8 * (fq & 1)), u1 = *(const LAS f32x4*)(us + (t0 + fr) * 16 + 8 * (fq & 1) + 4);
    const bf16x8 af = pack8(u0, u1);
    f32x4 accs[8];
#pragma unroll
    for (int ct = 0; ct < 8; ++ct) { const f32x4 z4 = {0.f, 0.f, 0.f, 0.f}; accs[ct] = __builtin_amdgcn_mfma_f32_16x16x32_bf16(af, d.bh[ct], z4, 0, 0, 0); }
    asm volatile("s_nop 15\n\ts_nop 15" : "+v"(accs[0]), "+v"(accs[1]), "+v"(accs[2]), "+v"(accs[3]), "+v"(accs[4]), "+v"(accs[5]), "+v"(accs[6]), "+v"(accs[7]));
#pragma unroll
    for (int ct = 0; ct < 8; ++ct) *(LAS f32x4*)(but + (16 * ct + fr) * BUP + 4 * fq) = accs[ct];
}
struct Slab { u32x4 r[2]; };
__device__ __forceinline__ void slab_issue(Slab& s, const bf16* up  , int lane) {
#pragma unroll
    for (int i = 0; i < 2; ++i) { const int pc = 64 * i + lane; s.r[i] = *(const u32x4*)(up + (size_t)(pc >> 1) * LDP + (pc & 1) * 8); }
}
__device__ __forceinline__ void slab_store(const Slab& s, LAS float* us, int lane) {
#pragma unroll
    for (int i = 0; i < 2; ++i) { const int pc = 64 * i + lane; const u32x4 w = s.r[i];
        *(LAS f32x4*)(us + pc * 8) = (f32x4){bflo(w.x), bfhi(w.x), bflo(w.y), bfhi(w.y)}; *(LAS f32x4*)(us + pc * 8 + 4) = (f32x4){bflo(w.z), bfhi(w.z), bflo(w.w), bfhi(w.w)}; }
}
__device__ __forceinline__ void pass1(LAS float* us, LAS float* but, int gwv, int NGW, int lane, const bf16* U, const float* LRE, const float* LIM, const float* BRE, const float* BIM, const float* LSTEP, f32x2* ENDST) {
#pragma unroll 1
    for (int wu = gwv; wu < BATCH * SSM_G * SSM_NSEG; wu += NGW) {
        const int g = wu & 255, seg = (wu >> 8) & (SSM_NSEG - 1), b = wu >> 13, bg = b * 256 + g;
        Disc d; discretise(d, g, lane, LRE, LIM, BRE, BIM, LSTEP);
        const bf16* up = U + ((size_t)b * SEQ + (size_t)seg * SSM_SL) * LDP + 16 * g;
        float xr = 0.f, xi = 0.f;
        Slab sl; slab_issue(sl, up, lane);
#pragma unroll 1
        for (int tb = 0; tb < SSM_SL; tb += 64) {
            slab_store(sl, us, lane);
            if (tb + 64 < SSM_SL) slab_issue(sl, up + (size_t)(tb + 64) * LDP, lane);
#pragma unroll 1
            for (int t0 = 0; t0 < 64; t0 += 16) {
                bu_tile(d, us, but, t0, lane);
                f32x4 brv[4], biv[4];
#pragma unroll
                for (int q = 0; q < 4; ++q) { brv[q] = *(const LAS f32x4*)(but + lane * BUP + 4 * q); biv[q] = *(const LAS f32x4*)(but + (64 + lane) * BUP + 4 * q); }
#pragma unroll
                for (int t = 0; t < 16; ++t) { const float br = brv[t >> 2][t & 3], bi = biv[t >> 2][t & 3];
                    const float nr = fmaf(d.lr, xr, fmaf(-d.li, xi, br)), ni = fmaf(d.lr, xi, fmaf(d.li, xr, bi)); xr = nr; xi = ni; }
            }
        }
        ENDST[((size_t)bg * SSM_NSEG + seg) * 64 + lane] = (f32x2){xr, xi};
    }
}
__device__ __forceinline__ float gelu_tanh(float y) { const float a = 0.7978845608028654f * (y + 0.044715f * y * y * y); const float t = 1.0f - 2.0f * __builtin_amdgcn_rcpf(1.0f + fexp(2.0f * a)); return 0.5f * y * (1.0f + t); }
constexpr int XP = 272;
__device__ __forceinline__ void pass2(LAS unsigned char* xt  , int gwv, int NGW, int lane, const bf16* U, const float* LRE, const float* LIM, const float* BRE, const float* BIM,
                                      const float* CRE, const float* CIM, const float* LSTEP, const float* DSK, const f32x2* ENDST, bf16* Y1) {
    const int fr = lane & 15, fq = lane >> 4;
    LAS float* us = (LAS float*)(xt + 16 * XP); LAS float* but = (LAS float*)(xt + 16 * XP + 4096);
#pragma unroll 1
    for (int wu = gwv; wu < BATCH * SSM_G * SSM_NSEG; wu += NGW) {
        const int g = wu & 255, seg = (wu >> 8) & (SSM_NSEG - 1), b = wu >> 13, bg = b * 256 + g;
        Disc d; discretise(d, g, lane, LRE, LIM, BRE, BIM, LSTEP);
        const size_t row0 = (size_t)b * SEQ + (size_t)seg * SSM_SL;
        const bf16* up = U + row0 * LDP + 16 * g;
        Slab sl; slab_issue(sl, up, lane);
        float pr = d.lr, pi = d.li;
#pragma unroll
        for (int i = 0; i < 8; ++i) { const float a = pr * pr - pi * pi, c = 2.0f * pr * pi; pr = a; pi = c; }
        float xr = 0.f, xi = 0.f;
#pragma unroll 1
        for (int s = 0; s < seg; ++s) { const f32x2 e = ENDST[((size_t)bg * SSM_NSEG + s) * 64 + lane];
            const float nr = fmaf(pr, xr, fmaf(-pi, xi, e.x)), ni = fmaf(pr, xi, fmaf(pi, xr, e.y)); xr = nr; xi = ni; }
        bf16x8 cf[4];
#pragma unroll
        for (int s = 0; s < 4; ++s) { const float* cp = (s < 2 ? CRE : CIM) + (size_t)(g * 16 + fr) * 64 + 32 * (s & 1) + 8 * fq; const float sg = s < 2 ? 1.0f : -1.0f;
            const f32x4 a = *(const f32x4*)cp * sg, c = *(const f32x4*)(cp + 4) * sg; cf[s] = pack8(a, c); }
        const float dsk = DSK[16 * g + fr];
#pragma unroll 1
        for (int tb = 0; tb < SSM_SL; tb += 64) {
            slab_store(sl, us, lane);
            if (tb + 64 < SSM_SL) slab_issue(sl, up + (size_t)(tb + 64) * LDP, lane);
#pragma unroll 1
            for (int t0 = 0; t0 < 64; t0 += 16) {
                bu_tile(d, us, but, t0, lane);
                f32x4 brv[4], biv[4];
#pragma unroll
                for (int q = 0; q < 4; ++q) { brv[q] = *(const LAS f32x4*)(but + lane * BUP + 4 * q); biv[q] = *(const LAS f32x4*)(but + (64 + lane) * BUP + 4 * q); }
#pragma unroll
                for (int t = 0; t < 16; ++t) { const float br = brv[t >> 2][t & 3], bi = biv[t >> 2][t & 3];
                    const float nr = fmaf(d.lr, xr, fmaf(-d.li, xi, br)), ni = fmaf(d.lr, xi, fmaf(d.li, xr, bi)); xr = nr; xi = ni;
                    const unsigned w = cvtpk(xr, xi);
                    *(LAS bf16*)(xt + t * XP + lane * 2) = (bf16)(w & 0xffffu); *(LAS bf16*)(xt + t * XP + 128 + lane * 2) = (bf16)(w >> 16); }
                LDS_WAIT();
                f32x4 acc = {0.f, 0.f, 0.f, 0.f};
#pragma unroll
                for (int s = 0; s < 4; ++s) { const bf16x8 xa = *(const LAS bf16x8*)(xt + fr * XP + (32 * s + 8 * fq) * 2); acc = __builtin_amdgcn_mfma_f32_16x16x32_bf16(xa, cf[s], acc, 0, 0, 0); }
#pragma unroll
                for (int e = 0; e < 4; ++e) { const int tl = t0 + 4 * fq + e; const float u = us[tl * 16 + fr];
                    const float y = gelu_tanh(acc[e] + dsk * u);
                    Y1[(row0 + tb + tl) * 4096 + 16 * g + fr] = (bf16)(cvtpk(y, 0.f) & 0xffffu); }
                LDS_WAIT();
            }
        }
    }
}
}
constexpr int PH_PER_LAYER = 10, PH_FINAL = 40, PH_END = 41;
__host__ __device__ constexpr bool phase_exists(int ph) {
    if (ph == PH_FINAL) return true; if (ph < 0 || ph >= PH_FINAL) return false;
    const int L = ph / PH_PER_LAYER, k = ph % PH_PER_LAYER, kind = L % 3;
    if (k == 4) return kind != 0; return k <= 6;
}
typedef const __attribute__((address_space(4))) Args* kargs_t;
#define KARGS() ({ kargs_t p_ = (kargs_t)__builtin_amdgcn_kernarg_segment_ptr(); asm volatile("" : "+s"(p_)); p_; })
#define WSP(T, off) ((T*)(ws + (off)))
__global__ void __launch_bounds__(NTHR, 2) trunk_fwd(Args args_unused) {
    extern __shared__ __attribute__((aligned(16))) unsigned char lds_raw[];
    LAS unsigned char* lds = (LAS unsigned char*)lds_raw;
    const int w0 = __builtin_amdgcn_readfirstlane(threadIdx.x >> 6);
    const int G = gridDim.x, bx = blockIdx.x, vcu = (G % 8 == 0) ? (bx % 8) * (G / 8) + bx / 8 : bx, NGW = G * NWAVES;
#define TIDS() const int tid = otid(w0), lane = tid & 63, wid = __builtin_amdgcn_readfirstlane(tid >> 6), gwv = vcu * NWAVES + wid; (void)lane; (void)gwv
    { volatile LAS unsigned* MISC = (volatile LAS unsigned*)(lds + MISC_OFF); if (threadIdx.x < 32) MISC[threadIdx.x] = 0u; }
    __syncthreads();
    int lo, hi;
    { kargs_t ap = KARGS(); lo = ap->ph_lo; hi = ap->ph_hi;
      if (hi - lo > 1) (void)xcd_barrier_post((unsigned*)(ap->ws + WS_CTL) + CW_BAR + ap->li * XCD_BAR_WORDS, (volatile LAS unsigned*)(lds + MISC_OFF) + 8); }
#define IN(k) (lo <= (k) && (k) < hi)
#define SEAM(k) do { if ((k) + 1 < hi) { kargs_t ap_ = KARGS(); XcdBarrier b_; b_.bar = (unsigned*)(ap_->ws + WS_CTL) + CW_BAR + ap_->li * XCD_BAR_WORDS; b_.x = xb_xcc_id(); \
        b_.st = (volatile LAS unsigned*)(lds + MISC_OFF) + 8; b_.tid = (unsigned)otid(w0); xcd_barrier(b_); } } while (0)

#pragma unroll 1
    for (int L = 0; L < DEPTH; ++L) {
        const int base = L * PH_PER_LAYER, kind = L % 3, j = L / 3;

        if (IN(base + 0)) {
            kargs_t ap = KARGS(); unsigned char* ws = ap->ws; TIDS();
            LAS float* scr = (LAS float*)(lds + wid * 16384);
            const int n_in = kind == 0 ? 16416 : kind == 1 ? 16448 : 8192;
            const float* w_in = kind == 0 ? ap->in[I_FOX_WIN] + (size_t)j * 4096 * 16416 : kind == 1 ? ap->in[I_GDN_WIN] : ap->in[I_SSM_WIN];
            const float* w_out = kind == 0 ? ap->in[I_FOX_WOUT] + (size_t)j * 4096 * 4096 : kind == 1 ? ap->in[I_GDN_WOUT] : ap->in[I_SSM_WOUT];
            transpose_matrix(w_out, 4096, 4096, WSP(bf16, WS_WOUT), 4096, WSP(bf16, WS_WOUT), nullptr, scr, gwv, NGW, lane);
            transpose_matrix(ap->in[I_PLE_WGATE] + (size_t)L * 4096 * 4096, 4096, 4096, WSP(bf16, WS_WGATE), 4096, WSP(bf16, WS_WGATE), ap->in[I_NORM_PLE] + (size_t)L * D_MODEL, scr, gwv, NGW, lane);
            transpose_matrix(ap->in[I_PLE_WPROJ] + (size_t)L * 256 * 4096, 256, 4096, WSP(bf16, WS_WPP), 4096, WSP(bf16, WS_WPP), nullptr, scr, gwv, NGW, lane);
            if (kind == 2) transpose_matrix(ap->in[I_SSM_WGLU], 4096, 4096, WSP(bf16, WS_WGLU), 4096, WSP(bf16, WS_WGLU), nullptr, scr, gwv, NGW, lane);
            transpose_matrix(w_in, 4096, n_in, WSP(bf16, WS_WIN), 16384, WSP(bf16, WS_WSK), ap->in[I_NORM_MIX] + (size_t)L * D_MODEL, scr, gwv, NGW, lane);
            { const float* p = ap->in[I_P] + (size_t)L * M_TOK * PLE_DIM; bf16* P_BF = WSP(bf16, WS_PBF);
              for (size_t i = (size_t)bx * NTHR + tid; i < (size_t)M_TOK * PLE_DIM / 8; i += (size_t)G * NTHR) {
                  const f32x4 a = *(const f32x4*)(p + i * 8), b = *(const f32x4*)(p + i * 8 + 4); *(bf16x8*)(P_BF + i * 8) = pack8(a, b); } }
            if (L == 0) { const float* x = ap->in[I_X]; bf16* X0 = WSP(bf16, WS_X0); ssq_t* ssq_in = SSQ_PTR(0);
                for (int m = gwv; m < M_TOK; m += NGW) { const float s = row_to_bf16(x + (size_t)m * 4096, X0 + (size_t)m * 4096, lane); if (lane == 0) ssq_in[m] = ssq_fix(s); } }
            __syncthreads();
            SEAM(base + 0);
        }
        if (IN(base + 1)) {
            kargs_t ap = KARGS(); unsigned char* ws = ap->ws; TIDS();
            const bf16* A1 = WSP(bf16, WS_X0); const ssq_t* ssq_in = SSQ_PTR(2 * L);
            if (kind != 2) {
                LAS float* res = (LAS float*)lds; const bf16* W_SK = WSP(bf16, WS_WSK);
                for (int un = vcu; un < M_TOK / 64; un += G) {
                    const int r0 = un * 64;
                    if (kind == 0) {
                        float* CUML = WSP(float, WS_SMALL + SM_CUML); float* TTOT = WSP(float, WS_SMALL + SM_TTOT);
                        skinny_gemm<32>(A1, W_SK, ssq_in, r0, res, wid, lane);
                        __syncthreads();
                        if (tid < 32) { const int h = tid; const float bf = ap->in[I_FOX_BF][j * 32 + h]; float run = 0.f;
                            for (int r = 0; r < 64; ++r) { const float x = res[r * 32 + h] + bf; const float lf = fminf(x, 0.f) - flog(1.0f + fexp(-fabsf(x))); run += lf; CUML[(size_t)(r0 + r) * 32 + h] = run; }
                            TTOT[(size_t)un * 32 + h] = run; }
                    } else {
                        float* BETA = WSP(float, WS_SMALL + SM_BETA); float* GLOG = WSP(float, WS_SMALL + SM_GLOG);
                        const float* dtb = ap->in[I_GDN_DTB]; const float* alog = ap->in[I_GDN_ALOG];
                        skinny_gemm<64>(A1, W_SK, ssq_in, r0, res, wid, lane);
                        __syncthreads();
                        for (int e = tid; e < 64 * 32; e += NTHR) { const int r = e >> 5, h = e & 31;
                            BETA[(size_t)(r0 + r) * 32 + h] = sigmoidf_(res[r * 64 + h]);
                            const float x = res[r * 64 + 32 + h] + dtb[h]; const float sp = fmaxf(x, 0.f) + flog(1.0f + fexp(-fabsf(x)));
                            GLOG[(size_t)(r0 + r) * 32 + h] = -fexp(alog[h]) * sp; }
                    }
                    __syncthreads();
                }
            }
            const int n_main = kind == 2 ? 8192 : 16384;
            pg8::Gemm g{A1, WSP(bf16, WS_WIN), M_TOK, n_main, 4096}; pg8::StaticOrder S; S.init(M_TOK, n_main, G, bx);
            pg8::EpiProj E{kind == 2 ? WSP(bf16, WS_PROJ) + 8192 : WSP(bf16, WS_PROJ), LDP, ssq_in, nullptr, 0};
            pg8::gemm_phase<pg8::EpiProj, pg8::StaticOrder, true, true>(lds, g, S, E, w0);
            SEAM(base + 1);
        }
        if (IN(base + 2)) {
            kargs_t ap = KARGS(); unsigned char* ws = ap->ws; TIDS();
            if (kind == 0) {
                { const bf16* PROJ = WSP(bf16, WS_PROJ); float* QN2 = WSP(float, WS_SMALL + SM_QN2); float* KN2 = WSP(float, WS_SMALL + SM_KN2);
                  for (int it = gwv; it < BATCH * NHEAD * 128; it += NGW) fox::norm_item(PROJ, QN2, KN2, it, lane); }
                { const float* CUML = WSP(float, WS_SMALL + SM_CUML); const float* TTOT = WSP(float, WS_SMALL + SM_TTOT); float* CUM = WSP(float, WS_SMALL + SM_CUM);
                  LAS float* ps = (LAS float*)lds; LAS float* ct = ps + 512; LAS float* pr = ct + 64 * 33;
                  for (int un = vcu; un < BATCH * 128; un += G) { const int b = un >> 7, tile = un & 127, h = tid & 31, part = tid >> 5;
                      float sum = 0.f;
                      for (int tp = part; tp < tile; tp += 16) sum += TTOT[(size_t)(b * 128 + tp) * 32 + h];
                      ps[part * 32 + h] = sum;
                      { const f32x4 cv = *(const f32x4*)(CUML + ((size_t)b * SEQ + 64 * tile) * 32 + tid * 4); const int t = (tid * 4) >> 5, hh = (tid * 4) & 31;
#pragma unroll
                        for (int e = 0; e < 4; ++e) ct[t * 33 + hh + e] = cv[e]; }
                      __syncthreads();
                      if (tid < 32) { float p = 0.f;
#pragma unroll
                          for (int q = 0; q < 16; ++q) p += ps[q * 32 + tid];
                          pr[tid] = p; }
                      __syncthreads();
                      { const int t = tid & 63, hg = tid >> 6;
#pragma unroll
                        for (int k = 0; k < 4; ++k) { const int hh = hg * 4 + k; CUM[(size_t)(b * 32 + hh) * SEQ + 64 * tile + t] = pr[hh] + ct[t * 33 + hh]; } }
                      __syncthreads(); } }
            } else if (kind == 1) {
                const bf16* PROJ = WSP(bf16, WS_PROJ); const float* convw = ap->in[I_GDN_CONV]; const float* BETA = WSP(float, WS_SMALL + SM_BETA); const float* GLOG = WSP(float, WS_SMALL + SM_GLOG);
                float* GLT = WSP(float, WS_SMALL + SM_GL); unsigned char* REC = ws + WS_SCR;
                if (tid < 2) *(LAS unsigned*)(lds + tid * gdn::GRP_BYTES + gdn::G_S + 768) = 0u;
                __syncthreads();
                unsigned gbt = 0u;
                for (int pi = vcu; pi < BATCH * NHEAD * GDN_NCHUNK / 2; pi += G) gdn::prep_pair(lds, 2 * pi, PROJ, convw, BETA, GLOG, GLT, REC, gbt, w0);
                __syncthreads();
            } else if (kind == 2) {
                s5::pass1((LAS float*)(lds + wid * 16384), (LAS float*)(lds + wid * 16384 + 4096), gwv, NGW, lane, WSP(bf16, WS_PROJ) + 8192, ap->in[I_SSM_LRE], ap->in[I_SSM_LIM], ap->in[I_SSM_BRE], ap->in[I_SSM_BIM], ap->in[I_SSM_LSTEP], WSP(f32x2, WS_ENDST));
            }
            SEAM(base + 2);
        }
        if (IN(base + 3)) {
            kargs_t ap = KARGS(); unsigned char* ws = ap->ws; TIDS();
            if (kind == 0) fox::attn_phase((char*)lds_raw, WSP(bf16, WS_PROJ), WSP(bf16, WS_MIX), WSP(float, WS_SMALL + SM_CUM), WSP(float, WS_SMALL + SM_QN2), WSP(float, WS_SMALL + SM_KN2), vcu, G, w0);
            else if (kind == 1) { for (int un = vcu; un < BATCH * NHEAD * 4; un += G) gdn::scan_unit(lds, un, ws + WS_SCR, WSP(float, WS_SMALL + SM_GL), (bf16*)ap->out, w0); }
            else if (kind == 2) s5::pass2(lds + wid * 18944, gwv, NGW, lane, WSP(bf16, WS_PROJ) + 8192, ap->in[I_SSM_LRE], ap->in[I_SSM_LIM], ap->in[I_SSM_BRE], ap->in[I_SSM_BIM], ap->in[I_SSM_CRE], ap->in[I_SSM_CIM],
                           ap->in[I_SSM_LSTEP], ap->in[I_SSM_D], WSP(f32x2, WS_ENDST), WSP(bf16, WS_SCR + SS_Y1));
            SEAM(base + 3);
        }
        if (IN(base + 4) && kind == 1) {
            kargs_t ap = KARGS(); unsigned char* ws = ap->ws; TIDS();
            if (kind == 1) gdn::normgate(gwv, NGW, lane, (const bf16*)ap->out, WSP(bf16, WS_PROJ), ap->in[I_GDN_NORM], WSP(bf16, WS_MIX));
            SEAM(base + 4);
        }
        if (IN(base + 4) && kind == 2) {
            kargs_t ap = KARGS(); unsigned char* ws = ap->ws; TIDS();
            pg8::Gemm g{WSP(bf16, WS_SCR + SS_Y1), WSP(bf16, WS_WGLU), M_TOK, 4096, 4096}; pg8::StaticOrder S; S.init(M_TOK, 4096, G, bx);
            pg8::EpiGlu E{WSP(bf16, WS_MIX), WSP(bf16, WS_SCR + SS_Y1), WSP(bf16, WS_PROJ) + ZCOL, LDP, ap->in[I_SSM_BGLU]};
            if (kind == 2) pg8::gemm_phase<pg8::EpiGlu, pg8::StaticOrder, true, true>(lds, g, S, E, w0);
            SEAM(base + 4);
        }
        if (IN(base + 5)) {
            { kargs_t ap = KARGS(); unsigned char* ws = ap->ws;
                  pg8::Gemm g{WSP(bf16, WS_MIX), WSP(bf16, WS_WOUT), M_TOK, 4096, 4096}; pg8::StaticOrder S; S.init(M_TOK, 4096, G, bx);
                  pg8::EpiOut E{WSP(bf16, WS_X0), WSP(bf16, WS_X1), SSQ_PTR(2 * L + 1)};
                  pg8::gemm_phase<pg8::EpiOut, pg8::StaticOrder, true, true>(lds, g, S, E, w0); }
            { kargs_t ap = KARGS(); unsigned char* ws = ap->ws;
                  pg8::Gemm g{WSP(bf16, WS_PBF), WSP(bf16, WS_WPP), M_TOK, 4096, 256}; pg8::StaticOrder S; S.init(M_TOK, 4096, G, bx);
                  pg8::EpiProj E{WSP(bf16, WS_PP), 4096, nullptr, nullptr, 0};
                  pg8::gemm_phase<pg8::EpiProj, pg8::StaticOrder, true, true>(lds, g, S, E, w0); }
            SEAM(base + 5);
        }
        if (IN(base + 6)) {
            kargs_t ap = KARGS(); unsigned char* ws = ap->ws; TIDS();
            pg8::Gemm g{WSP(bf16, WS_X1), WSP(bf16, WS_WGATE), M_TOK, 4096, 4096}; pg8::StaticOrder S; S.init(M_TOK, 4096, G, bx);
            pg8::EpiGate E{WSP(bf16, WS_X1), WSP(bf16, WS_X0), WSP(bf16, WS_PP), SSQ_PTR(2 * L + 1), SSQ_PTR(2 * L + 2)};
            pg8::gemm_phase<pg8::EpiGate, pg8::StaticOrder, true, true>(lds, g, S, E, w0);
            SEAM(base + 6);
        }
    }
    if (IN(PH_FINAL)) {
        kargs_t ap = KARGS(); unsigned char* ws = ap->ws; float* H = ap->out; TIDS();
        const float* gf = ap->in[I_FINAL_NORM]; const ssq_t* ssq = SSQ_PTR(8); const bf16* X0 = WSP(bf16, WS_X0);
        const unsigned bad = __hip_atomic_load(WSP(unsigned, WS_CTL) + CW_BAR + XB_TMO, __ATOMIC_RELAXED, __HIP_MEMORY_SCOPE_AGENT);
        for (int m = gwv; m < M_TOK; m += NGW) { const float rs = bad ? __builtin_nanf("") : __builtin_amdgcn_rsqf(ssq_val(ssq[m]) * (1.0f / 4096.0f) + NORM_EPS); float* row = H + (size_t)m * 4096;
#pragma unroll
            for (int jj = 0; jj < 8; ++jj) { const int c = (jj * 64 + lane) * 8; const u32x4 w = *(const u32x4*)(X0 + (size_t)m * 4096 + c);
                const f32x4 g0 = *(const f32x4*)(gf + c), g1 = *(const f32x4*)(gf + c + 4);
                const f32x4 v0 = {bflo(w.x), bfhi(w.x), bflo(w.y), bfhi(w.y)}, v1 = {bflo(w.z), bfhi(w.z), bflo(w.w), bfhi(w.w)};
                *(f32x4*)(row + c) = v0 * rs * g0; *(f32x4*)(row + c + 4) = v1 * rs * g1; } }
    }
#undef IN
#undef SEAM
}

extern "C" void kernel_launch(void* const* d_in, const int* in_sizes, int n_in, void* d_out, int out_size, void* d_ws, size_t ws_size, hipStream_t stream) {
    static int grid = 0;
    if (grid == 0) {
        if (n_in != 28 || out_size != M_TOK * D_MODEL || ws_size < WS_END) { fprintf(stderr, "kernel_launch: unexpected shapes (n_in %d, out %d, ws %zu)\n", n_in, out_size, ws_size); grid = -1; return; }
        int dev = 0, cus = 0, per_cu = 0;
        if (hipGetDevice(&dev) != hipSuccess || hipDeviceGetAttribute(&cus, hipDeviceAttributeMultiprocessorCount, dev) != hipSuccess) { grid = -1; return; }
        if (hipFuncSetAttribute((const void*)trunk_fwd, hipFuncAttributeMaxDynamicSharedMemorySize, LDS_BYTES) != hipSuccess) { fprintf(stderr, "kernel_launch: hipFuncSetAttribute failed\n"); grid = -1; return; }
        if (hipOccupancyMaxActiveBlocksPerMultiprocessor(&per_cu, (const void*)trunk_fwd, NTHR, LDS_BYTES) != hipSuccess || per_cu < 1) { fprintf(stderr, "kernel_launch: occupancy query says %d\n", per_cu); per_cu = 1; }
        (void)hipGetLastError();
        grid = cus;
    }
    if (grid < 0) return;
    if (hipMemsetAsync((char*)d_ws + WS_CTL, 0, CTL_ZERO_BYTES, stream) != hipSuccess) return;
    Args a{};
    for (int i = 0; i < 28; ++i) a.in[i] = (const float*)d_in[i];
    a.out = (float*)d_out; a.ws = (unsigned char*)d_ws;
#if MK_PER_PHASE
    int li = 0;
    for (int ph = 0; ph < PH_END; ++ph) { if (!phase_exists(ph)) continue;
        a.ph_lo = ph; a.ph_hi = ph + 1; a.li = li++; a.pad = 0;
        hipLaunchKernelGGL(trunk_fwd, dim3(grid), dim3(NTHR), LDS_BYTES, stream, a); }
#elif defined(PROBE_PH)
    { int li = 0; const int cut = PROBE_PH + PROBE_LEN;
      a.ph_lo = 0; a.ph_hi = cut; a.li = li++; a.pad = 0; hipLaunchKernelGGL(trunk_fwd, dim3(grid), dim3(NTHR), LDS_BYTES, stream, a);
      a.pad = PROBE_MODE;
      for (int r = 0; r < PROBE_N; ++r) { a.ph_lo = PROBE_PH; a.ph_hi = cut; a.li = li++; hipLaunchKernelGGL(trunk_fwd, dim3(grid), dim3(NTHR), LDS_BYTES, stream, a); }
      a.pad = 0; a.ph_lo = cut; a.ph_hi = PH_END; a.li = li++; hipLaunchKernelGGL(trunk_fwd, dim3(grid), dim3(NTHR), LDS_BYTES, stream, a); }
#else
    a.ph_lo = 0; a.ph_hi = PH_END; a.li = 0; a.pad = 0;
    hipLaunchKernelGGL(trunk_fwd, dim3(grid), dim3(NTHR), LDS_BYTES, stream, a);
#endif
}
```
